# Optimizing an MI355X kernel written in HIP

```python
import jax, jax.numpy as jnp
from jax import lax
import numpy as np

D_MODEL = 2048
BATCH = 2
SEQ = 8192
DEPTH = 1

N_HEADS = 8
QK_HEAD_DIM = 128
V_HEAD_DIM = 128
KV_LORA_RANK = 256
IDX_HEADS = 16
IDX_HEAD_DIM = 64
TOPK_MAX = 256
Q_BLOCK = 128
ATTN_WIDTH = N_HEADS * V_HEAD_DIM
POOL_WINDOWS = (2, 4, 8, 16)
POOL_GROUP_DIM = 256
POOL_WIDTH = POOL_GROUP_DIM * len(POOL_WINDOWS)
N_BRANCHES = 2
Q_COLS = N_HEADS * QK_HEAD_DIM
CKV_COLS = KV_LORA_RANK
QI_COLS = IDX_HEADS * IDX_HEAD_DIM
KI_COLS = IDX_HEAD_DIM
WI_COLS = IDX_HEADS
POOL_COLS = POOL_WIDTH
GATE_COLS = N_BRANCHES * D_MODEL
IN_SPLITS = (Q_COLS, CKV_COLS, QI_COLS, KI_COLS, WI_COLS, POOL_COLS, GATE_COLS)
IN_COLS = sum(IN_SPLITS)
N_EXPERTS = 64
TOP_K = 8
N_GROUPS = 8
TOPK_GROUPS = 4
EXPERT_DIM = 512
SHARED_DIM = 512
ROUTED_SCALE = 2.5
EXPERT_CHUNK = 8
LN_EPS = 1e-5
RMS_EPS = 1e-6
DEEPNORM_ALPHA = (2.0 * DEPTH) ** 0.25
DEEPNORM_BETA = (8.0 * DEPTH) ** -0.25

kernel_name = "hybrid_dsa_pool_moe_deepnorm"


def layer_norm(x, g, b):
    xf = x.astype(jnp.float32)
    mu = jnp.mean(xf, axis=-1, keepdims=True)
    var = jnp.mean(jnp.square(xf - mu), axis=-1, keepdims=True)
    y = (xf - mu) * lax.rsqrt(var + LN_EPS) * g.astype(jnp.float32) + b.astype(jnp.float32)
    return y.astype(x.dtype)


def rms_norm(x, g):
    xf = x.astype(jnp.float32)
    y = xf * lax.rsqrt(jnp.mean(jnp.square(xf), axis=-1, keepdims=True) + RMS_EPS)
    return (y * g.astype(jnp.float32)).astype(x.dtype)


def dsa_attention(q, ckv, qi, ki, wi, w_uk, w_uv):
    B, S, _ = ckv.shape
    n_blk = S // Q_BLOCK
    k_sel = min(TOPK_MAX, S // 4)
    key_pos = jnp.arange(S)
    scale = QK_HEAD_DIM ** -0.5

    def one_block(blk):
        t0 = blk * Q_BLOCK
        qb = lax.dynamic_slice_in_dim(q, t0, Q_BLOCK, axis=1)
        qib = lax.dynamic_slice_in_dim(qi, t0, Q_BLOCK, axis=1)
        wib = lax.dynamic_slice_in_dim(wi, t0, Q_BLOCK, axis=1)
        qpos = t0 + jnp.arange(Q_BLOCK)
        rel = jax.nn.relu(jnp.einsum('bthd,bsd->bths', qib, ki))
        idx_score = jnp.einsum('bths,bth->bts', rel, wib).astype(jnp.float32)
        causal = key_pos[None, :] <= qpos[:, None]
        idx_score = jnp.where(causal[None], idx_score, -jnp.inf)
        _, sel = lax.top_k(idx_score, k_sel)
        valid = sel <= qpos[None, :, None]
        c_sel = jax.vmap(lambda c, i: c[i])(ckv, sel)
        q_lat = jnp.einsum('bthd,rhd->bthr', qb, w_uk)
        logits = jnp.einsum('bthr,btkr->bthk', q_lat, c_sel).astype(jnp.float32) * scale
        logits = jnp.where(valid[:, :, None, :], logits, -jnp.inf)
        p = jax.nn.softmax(logits, axis=-1).astype(ckv.dtype)
        o_lat = jnp.einsum('bthk,btkr->bthr', p, c_sel)
        o = jnp.einsum('bthr,rhd->bthd', o_lat, w_uv)
        return o.reshape(B, Q_BLOCK, N_HEADS * V_HEAD_DIM)

    out = lax.map(one_block, jnp.arange(n_blk))
    return out.transpose(1, 0, 2, 3).reshape(B, S, N_HEADS * V_HEAD_DIM)


def pool_mixer(xp, w_pool, pool_scale):
    B, S, _ = xp.shape
    xg = xp.reshape(B, S, len(POOL_WINDOWS), POOL_GROUP_DIM)
    pos = jnp.arange(S)
    outs = []
    for g, win in enumerate(POOL_WINDOWS):
        v = xg[:, :, g, :].astype(jnp.float32)
        cs = jnp.cumsum(v, axis=1)
        cs_shift = jnp.pad(cs, ((0, 0), (win, 0), (0, 0)))[:, :S]
        count = jnp.minimum(pos + 1, win).astype(jnp.float32)[None, :, None]
        diff = ((cs - cs_shift) / count - v).astype(xp.dtype)
        outs.append(jnp.einsum('bsc,cd->bsd', diff, w_pool[g]))
    return jnp.concatenate(outs, axis=-1) * pool_scale


def hybrid_mixer(x, w_in, ckv_norm_g, kidx_norm_g, kidx_norm_b, w_uk, w_uv, w_pool,
                 pool_scale, w_proj_attn, w_proj_pool, w_out):
    B, S, D = x.shape
    proj = jnp.einsum('bsd,dc->bsc', x, w_in)
    q, ckv, qi, ki, wi, xp, g = jnp.split(proj, list(np.cumsum(IN_SPLITS)[:-1]), axis=-1)
    q = q.reshape(B, S, N_HEADS, QK_HEAD_DIM)
    ckv = rms_norm(ckv, ckv_norm_g)
    qi = qi.reshape(B, S, IDX_HEADS, IDX_HEAD_DIM)
    ki = layer_norm(ki, kidx_norm_g, kidx_norm_b)
    wi = wi * (IDX_HEADS ** -0.5 * IDX_HEAD_DIM ** -0.5)
    attn = dsa_attention(q, ckv, qi, ki, wi, w_uk, w_uv)
    pool = pool_mixer(xp, w_pool, pool_scale)
    gates = jax.nn.sigmoid(g.astype(jnp.float32)).astype(x.dtype)
    g_attn, g_pool = jnp.split(gates, 2, axis=-1)
    merged = (g_attn * jnp.einsum('bsc,cd->bsd', attn, w_proj_attn)
              + g_pool * jnp.einsum('bsc,cd->bsd', pool, w_proj_pool))
    return jnp.einsum('bsd,de->bse', merged, w_out)


def moe_ffn(y, w_router, router_bias, w_gate_e, w_up_e, w_down_e, w_gate_s, w_up_s, w_down_s):
    B, S, D = y.shape
    yt = y.reshape(B * S, D)
    N = yt.shape[0]
    scores = jax.nn.sigmoid(yt.astype(jnp.float32) @ w_router.astype(jnp.float32))
    choice = scores + router_bias.astype(jnp.float32)
    per_grp = N_EXPERTS // N_GROUPS
    grp_score = lax.top_k(choice.reshape(N, N_GROUPS, per_grp), 2)[0].sum(-1)
    _, top_grp = lax.top_k(grp_score, TOPK_GROUPS)
    grp_mask = jax.nn.one_hot(top_grp, N_GROUPS, dtype=jnp.float32).sum(1)
    expert_mask = jnp.repeat(grp_mask, per_grp, axis=1)
    choice = jnp.where(expert_mask > 0, choice, -jnp.inf)
    _, top_e = lax.top_k(choice, TOP_K)
    w = jnp.take_along_axis(scores, top_e, axis=-1)
    w = w / jnp.sum(w, axis=-1, keepdims=True) * ROUTED_SCALE
    gates = jnp.sum(jax.nn.one_hot(top_e, N_EXPERTS, dtype=jnp.float32) * w[..., None], axis=1)
    routed = jnp.zeros((N, D), jnp.float32)
    for c0 in range(0, N_EXPERTS, EXPERT_CHUNK):
        sl = slice(c0, c0 + EXPERT_CHUNK)
        h = (jax.nn.silu(jnp.einsum('nd,edf->enf', yt, w_gate_e[sl]))
             * jnp.einsum('nd,edf->enf', yt, w_up_e[sl]))
        h = h * gates[:, sl].T[:, :, None].astype(h.dtype)
        routed = routed + jnp.einsum('enf,efd->nd', h, w_down_e[sl])
    shared = (jax.nn.silu(yt @ w_gate_s) * (yt @ w_up_s)) @ w_down_s
    return (routed + shared).astype(y.dtype).reshape(B, S, D)


def setup_inputs(seed: int = 0) -> dict:
    key = jax.random.key(seed)
    ks = jax.random.split(key, 26)
    L = DEPTH

    def nrm(k, shape, scale):
        return jax.random.normal(k, shape, jnp.float32) * scale

    def gain(k, shape):
        return 1.0 + 0.02 * jax.random.normal(k, shape, jnp.float32)

    beta = DEEPNORM_BETA
    return {
        "x": nrm(ks[0], (BATCH, SEQ, D_MODEL), 1.0),
        "w_in": nrm(ks[1], (L, D_MODEL, IN_COLS), D_MODEL ** -0.5),
        "ckv_norm_g": gain(ks[2], (L, KV_LORA_RANK)),
        "kidx_norm_g": gain(ks[3], (L, IDX_HEAD_DIM)),
        "kidx_norm_b": nrm(ks[4], (L, IDX_HEAD_DIM), 0.02),
        "w_uk": nrm(ks[5], (L, KV_LORA_RANK, N_HEADS, QK_HEAD_DIM), KV_LORA_RANK ** -0.5),
        "w_uv": nrm(ks[6], (L, KV_LORA_RANK, N_HEADS, V_HEAD_DIM), KV_LORA_RANK ** -0.5),
        "w_pool": nrm(ks[7], (L, len(POOL_WINDOWS), POOL_GROUP_DIM, POOL_GROUP_DIM), POOL_GROUP_DIM ** -0.5),
        "pool_scale": 1.0 + 0.1 * jax.random.normal(ks[8], (L, POOL_WIDTH), jnp.float32),
        "w_proj_attn": nrm(ks[9], (L, ATTN_WIDTH, D_MODEL), beta * ATTN_WIDTH ** -0.5),
        "w_proj_pool": nrm(ks[10], (L, POOL_WIDTH, D_MODEL), beta * POOL_WIDTH ** -0.5),
        "w_out": nrm(ks[11], (L, D_MODEL, D_MODEL), beta * D_MODEL ** -0.5),
        "ln1_g": gain(ks[12], (L, D_MODEL)),
        "ln1_b": nrm(ks[13], (L, D_MODEL), 0.02),
        "w_router": nrm(ks[14], (L, D_MODEL, N_EXPERTS), D_MODEL ** -0.5),
        "router_bias": nrm(ks[15], (L, N_EXPERTS), 0.01),
        "w_gate_e": nrm(ks[16], (L, N_EXPERTS, D_MODEL, EXPERT_DIM), D_MODEL ** -0.5),
        "w_up_e": nrm(ks[17], (L, N_EXPERTS, D_MODEL, EXPERT_DIM), D_MODEL ** -0.5),
        "w_down_e": nrm(ks[18], (L, N_EXPERTS, EXPERT_DIM, D_MODEL), beta * EXPERT_DIM ** -0.5),
        "w_gate_s": nrm(ks[19], (L, D_MODEL, SHARED_DIM), D_MODEL ** -0.5),
        "w_up_s": nrm(ks[20], (L, D_MODEL, SHARED_DIM), D_MODEL ** -0.5),
        "w_down_s": nrm(ks[21], (L, SHARED_DIM, D_MODEL), beta * SHARED_DIM ** -0.5),
        "ln2_g": gain(ks[22], (L, D_MODEL)),
        "ln2_b": nrm(ks[23], (L, D_MODEL), 0.02),
    }


def reference(x, w_in, ckv_norm_g, kidx_norm_g, kidx_norm_b, w_uk, w_uv, w_pool, pool_scale,
              w_proj_attn, w_proj_pool, w_out, ln1_g, ln1_b, w_router, router_bias,
              w_gate_e, w_up_e, w_down_e, w_gate_s, w_up_s, w_down_s, ln2_g, ln2_b):
    for l in range(DEPTH):
        mix = hybrid_mixer(x, w_in[l], ckv_norm_g[l], kidx_norm_g[l], kidx_norm_b[l], w_uk[l],
                           w_uv[l], w_pool[l], pool_scale[l], w_proj_attn[l], w_proj_pool[l], w_out[l])
        h = layer_norm(DEEPNORM_ALPHA * x + mix, ln1_g[l], ln1_b[l])
        ffn = moe_ffn(h, w_router[l], router_bias[l], w_gate_e[l], w_up_e[l], w_down_e[l],
                      w_gate_s[l], w_up_s[l], w_down_s[l])
        x = layer_norm(DEEPNORM_ALPHA * h + ffn, ln2_g[l], ln2_b[l])
    return x
```

```cpp
#include <hip/hip_runtime.h>
#include <cstdio>
#include <cstdint>

#define LAS __attribute__((address_space(3)))
#define GAS __attribute__((address_space(1)))
typedef unsigned short bf16;
typedef short bf16x8 __attribute__((ext_vector_type(8)));
typedef short s16x4 __attribute__((ext_vector_type(4)));
typedef float f32x4 __attribute__((ext_vector_type(4)));
typedef float f32x2 __attribute__((ext_vector_type(2)));
typedef unsigned u32x4 __attribute__((ext_vector_type(4)));
typedef unsigned u32x2 __attribute__((ext_vector_type(2)));

constexpr int NTOK = 16384, SEQ = 8192, DM = 2048;
constexpr int NH = 8, DQK = 128, DV = 128, RKV = 256, IH = 16, IDH = 64, TOPK = 256;
constexpr int NE = 64, EK = 8, EDIM = 512, NGRP = 65;
constexpr int WIN_ROWS = 7680;
constexpr float LN_EPS = 1e-5f, RMS_EPS = 1e-6f;
constexpr float DN_ALPHA = 1.189207115002721f;
constexpr int NSLOT = NTOK * 9;
constexpr size_t SC_TOT = (size_t)128 * 128 * (64 * 65 / 2);

constexpr size_t MiB = 1u << 20;
constexpr size_t WS_CTL = 0, CTL_BYTES = 1 * MiB;
constexpr size_t WS_WIN = 1 * MiB;
constexpr size_t WS_WUK = 31 * MiB;
constexpr size_t WS_WUV = 32 * MiB;
constexpr size_t WS_WPOOL = 33 * MiB;
constexpr size_t WS_WPA = 34 * MiB;
constexpr size_t WS_WPP = 38 * MiB;
constexpr size_t WS_WOUT = 42 * MiB;
constexpr size_t WS_CSCALE = 50 * MiB;
constexpr size_t WS_XB = 51 * MiB;
constexpr size_t WS_Q = 115 * MiB;
constexpr size_t WS_QI = 147 * MiB;
constexpr size_t WS_XP = 179 * MiB;
constexpr size_t WS_GATES = 211 * MiB;
constexpr size_t WS_CKVRAW = 339 * MiB;
constexpr size_t WS_KIWI = 355 * MiB;
constexpr size_t WS_CKVN = 371 * MiB;
constexpr size_t WS_KIN = 379 * MiB;
constexpr size_t WS_WI = 381 * MiB;
constexpr size_t WS_DIFF = 382 * MiB;
constexpr size_t WS_QLAT = 414 * MiB;
constexpr size_t WS_POOL = 478 * MiB;
constexpr size_t WS_SCORES = 510 * MiB;
constexpr size_t WS_SEL = 770 * MiB;
constexpr size_t WS_OLAT = 778 * MiB;
constexpr size_t WS_ATTN = 842 * MiB;
constexpr size_t WS_M1 = 874 * MiB;
constexpr size_t WS_MERGED = 938 * MiB;
constexpr size_t WS_H = 51 * MiB;
constexpr size_t WS_WD = 115 * MiB;
constexpr size_t WS_HBUF = 245 * MiB;
constexpr size_t WS_TOPK = 390 * MiB;
constexpr size_t WS_WGU = 394 * MiB;
constexpr size_t WS_Y = 394 * MiB;
constexpr size_t WS_END = 1024 * MiB;
static_assert(WS_SCORES + SC_TOT * 2 * 4 <= WS_SEL, "scores");
static_assert(WS_HBUF + (size_t)(NSLOT + 256) * EDIM * 2 <= WS_TOPK, "hbuf");
static_assert(WS_Y + (size_t)NSLOT * DM * 2 <= WS_END, "y");
constexpr size_t TK_E = 0;
constexpr size_t TK_W = 512 * 1024;
constexpr size_t TK_POS = 1024 * 1024;
constexpr size_t TK_ROWLIST = 1536 * 1024;
constexpr size_t TK_MTT = 2560 * 1024;
constexpr size_t TK_WRT = 3 * MiB;
constexpr int CW_BAR = 4096;
constexpr int CW_CNT = 16384;
constexpr int CW_FILL = 16384 + 64;
constexpr int CW_NMT = 16384 + 128;

constexpr int RING_BYTES = 131072;
constexpr int MISC_OFF = RING_BYTES;
constexpr int LDS_BYTES = 147456;
constexpr int NWAVES = 8, NTHR = 512;

#define RLX_AGENT __ATOMIC_RELAXED, __HIP_MEMORY_SCOPE_AGENT
#define LDS_WAIT() asm volatile("s_waitcnt lgkmcnt(0)" ::: "memory")
#define VM_WAIT() asm volatile("s_waitcnt vmcnt(0)" ::: "memory")

__device__ __forceinline__ int lane_id() { return (int)__builtin_amdgcn_mbcnt_hi(~0u, __builtin_amdgcn_mbcnt_lo(~0u, 0u)); }
__device__ __forceinline__ float bf2f(unsigned b) { return __uint_as_float(b << 16); }
__device__ __forceinline__ unsigned f2bf(float f) { unsigned u = __float_as_uint(f); return (u + 0x7fffu + ((u >> 16) & 1u)) >> 16; }
__device__ __forceinline__ unsigned pk2(float lo, float hi) { return f2bf(lo) | (f2bf(hi) << 16); }
__device__ __forceinline__ unsigned cvt_pk_bf16(float lo, float hi) { unsigned r; asm volatile("v_cvt_pk_bf16_f32 %0, %1, %2" : "=v"(r) : "v"(lo), "v"(hi)); return r; }
__device__ __forceinline__ float wave_sum(float v) {
#pragma unroll
    for (int o = 1; o < 64; o <<= 1) v += __shfl_xor(v, o);
    return v;
}
__device__ __forceinline__ int wave_sum_i(int v) {
#pragma unroll
    for (int o = 1; o < 64; o <<= 1) v += __shfl_xor(v, o);
    return v;
}

#define XB_TMO      128
#define XB_XCNT(j)  (256  + 64 * (j))
#define XB_XSUB(j)  (1280 + 64 * (j))
#define XB_XGEN(j)  (2304 + 64 * (j))
#define XB_TOP      3328
#define XB_TOPGEN   3392
#define XCD_BAR_WORDS 3456
#define XB_SPIN_CAP (1u << 24)

__device__ __forceinline__ unsigned xb_ld(unsigned* p)              { return __hip_atomic_load(p, __ATOMIC_RELAXED, __HIP_MEMORY_SCOPE_AGENT); }
__device__ __forceinline__ unsigned xb_add(unsigned* p, unsigned v) { return __hip_atomic_fetch_add(p, v, __ATOMIC_RELAXED, __HIP_MEMORY_SCOPE_AGENT); }
__device__ __forceinline__ unsigned xb_xcc_id() { return (unsigned)__builtin_amdgcn_s_getreg((3 << 11) | 20) & 0xFu; }
#define XB_SPIN(cond, bar) do { unsigned _sp = 0; while (cond) { __builtin_amdgcn_s_sleep(1); \
    if ((++_sp & 255u) == 0u) { if (xb_ld(&(bar)[XB_TMO])) break; if (_sp > XB_SPIN_CAP) { atomicAdd(&(bar)[XB_TMO], 1u); break; } } } } while (0)

struct XcdBarrier { unsigned* bar; unsigned x; volatile LAS unsigned* st; int wave; };

__device__ __forceinline__ XcdBarrier xcd_barrier_post(unsigned* bar, volatile LAS unsigned* st, int wave) {
    XcdBarrier b; b.bar = bar; b.x = xb_xcc_id(); b.st = st; b.wave = wave;
    if (wave == 0 && lane_id() == 0) (void)xb_add(&bar[XB_XCNT(b.x)], 1u);
    return b;
}
__device__ __forceinline__ void xcd_barrier_complete(unsigned* bar, unsigned x, unsigned& nloc, unsigned& nx) {
    const unsigned G = gridDim.x * gridDim.y * gridDim.z;
    unsigned sum, cnt, mine, sp = 0u;
    for (;;) {
        sum = 0u; cnt = 0u; mine = 0u;
#pragma unroll
        for (unsigned j = 0; j < 16; ++j) { const unsigned c = xb_ld(&bar[XB_XCNT(j)]); sum += c; cnt += (c > 0u) ? 1u : 0u; mine = (j == x) ? c : mine; }
        if (sum == G) break;
        __builtin_amdgcn_s_sleep(1);
        if ((++sp & 255u) == 0u) { if (xb_ld(&bar[XB_TMO])) break; if (sp > XB_SPIN_CAP) { atomicAdd(&bar[XB_TMO], 1u); break; } }
    }
    nloc = mine > 0u ? mine : 1u; nx = cnt > 0u ? cnt : 1u;
}
__device__ __forceinline__ void xcd_barrier(const XcdBarrier& b) {
    asm volatile("s_waitcnt vmcnt(0)" ::: "memory");
    __syncthreads();
    if (b.wave == 0 && lane_id() == 0) {
        unsigned* bar = b.bar;
        __builtin_amdgcn_s_waitcnt(0);
        unsigned nloc = b.st[0], nx = b.st[1];
        if (nloc == 0u) { xcd_barrier_complete(bar, b.x, nloc, nx); b.st[0] = nloc; b.st[1] = nx; }
        const unsigned old = xb_add(&bar[XB_XSUB(b.x)], 1u);
        const unsigned gen = old / nloc;
        if (old + 1u == (gen + 1u) * nloc) {
            __builtin_amdgcn_fence(__ATOMIC_RELEASE, "agent");
            asm volatile("s_waitcnt vmcnt(0)" ::: "memory");
            const unsigned og = xb_add(&bar[XB_TOP], 1u);
            const unsigned tg = og / nx;
            if (og + 1u == (tg + 1u) * nx) xb_add(&bar[XB_TOPGEN], 1u);
            else XB_SPIN(xb_ld(&bar[XB_TOPGEN]) == tg, bar);
            __builtin_amdgcn_fence(__ATOMIC_ACQUIRE, "agent");
            xb_add(&bar[XB_XGEN(b.x)], 1u);
            asm volatile("s_waitcnt vmcnt(0)" ::: "memory");
        } else {
            XB_SPIN(xb_ld(&bar[XB_XGEN(b.x)]) == gen, bar);
            __builtin_amdgcn_fence(__ATOMIC_ACQUIRE, "agent");
            asm volatile("s_waitcnt vmcnt(0)" ::: "memory");
        }
    }
    __syncthreads();
}

namespace pg8 {
constexpr int BM = 256, BK = 64, HALF = 128, HTB = HALF * BK * 2, STAGE_BYTES = 8 * HTB, NXCD = 8, WGM = 8;

__host__ __device__ __forceinline__ int lds_byte(int r, int c) { const int st = (r >> 4) * 2 + (c >> 5), rr = r & 15, cc = c & 31, ob = rr * 64 + cc * 2; return st * 1024 + (ob ^ (((ob >> 9) & 1) << 5)); }
__host__ __device__ __forceinline__ void stage_rc(int b, int& R, int& C) { const int st = b / 1024, sb = b % 1024, swz = sb ^ (((sb >> 9) & 1) << 5); R = (st >> 1) * 16 + swz / 64; C = (st & 1) * 32 + (swz % 64) / 2; }
__host__ __device__ __forceinline__ int perm32(int rho) { const int n = rho >> 4, i = rho & 15; return 8 * (i >> 2) + 4 * n + (i & 3); }

struct GUnit {
    const char* A;
    const char* B0;
    const char* B1;
    const int* rows;
    int nt;
    int pm, pn, aux0, aux1;
};

__device__ __forceinline__ void tile_order(int L, int nM, int nN, int& pm, int& pn) {
    const int nwg = nM * nN;
    int wgid = L; { const int q = nwg / NXCD, r = nwg % NXCD, xcd = wgid % NXCD, off = wgid / NXCD; wgid = (xcd < r ? xcd * (q + 1) : r * (q + 1) + (xcd - r) * q) + off; }
    const int nig = WGM * nN, gid = wgid / nig, fm = gid * WGM, gsz = (nM - fm) < WGM ? (nM - fm) : WGM;
    pm = fm + ((wgid % nig) % gsz); pn = (wgid % nig) / gsz;
}

template <class Epi, class Sched, bool GATHER, bool ALIGN_EPI, bool SP2>
__device__ __forceinline__ void gemm_phase(LAS unsigned char* lds, const int wave, const unsigned a_rs, const unsigned b_rs, const Sched& S, const Epi& E) {
    const int wid = wave, lane = lane_id(), tid = wid * 64 + lane, wr = wid >> 2, wc = wid & 3, fr = lane & 15, fq = lane >> 4;
    int R0, C0; stage_rc(tid * 16, R0, C0);
    unsigned voffA[2], voffB[2];
#pragma unroll
    for (int i = 0; i < 2; ++i) { const int R = R0 + 64 * i; const int Rb = (R & ~31) + perm32(R & 31);
        voffA[i] = (unsigned)R * a_rs + (unsigned)C0 * 2u; voffB[i] = (unsigned)Rb * b_rs + (unsigned)C0 * 2u; }
    unsigned vgc[2][2], vgn[2][2];
    const size_t kstep = (size_t)(BK * 2);
    const size_t hstepA = (size_t)HALF * a_rs;
    const unsigned ldsw = (unsigned)wid * 1024u;
    const int aoff = lds_byte(wr * 64 + fr, fq * 8), boff = lds_byte(wc * 32 + fr, fq * 8);
#define PG8_SA(b, h) (((b) * 2 + (h)) * HTB)
#define PG8_SB(b, h) ((4 + (b) * 2 + (h)) * HTB)
#define PG8_STAGE(bufoff, gbase, voff) do { _Pragma("unroll") for (int _i = 0; _i < 2; ++_i) \
        __builtin_amdgcn_global_load_lds((const unsigned*)((const char*)(gbase) + (voff)[_i]), (LAS unsigned*)(lds + (bufoff) + ldsw + _i * 8192), 16, 0, 0); } while (0)
#define PG8_STAGE_A(bufoff, gbase, h, vg) do { if constexpr (GATHER) { PG8_STAGE(bufoff, gbase, (vg)[h]); } else { PG8_STAGE(bufoff, (gbase) + (h) * hstepA, voffA); } } while (0)
#define PG8_LDA(dst, b, h) do { _Pragma("unroll") for (int m = 0; m < 4; ++m) _Pragma("unroll") for (int k = 0; k < 2; ++k) dst[m][k] = *(const LAS bf16x8*)(lds + PG8_SA(b, h) + aoff + m * 2048 + k * 1024); } while (0)
#define PG8_LDB(dst, b, h) do { _Pragma("unroll") for (int n = 0; n < 2; ++n) _Pragma("unroll") for (int k = 0; k < 2; ++k) dst[n][k] = *(const LAS bf16x8*)(lds + PG8_SB(b, h) + boff + n * 2048 + k * 1024); } while (0)
#define PG8_MMA(ai, bj, At, Bt) do { __builtin_amdgcn_s_setprio(1); _Pragma("unroll") for (int m = 0; m < 4; ++m) _Pragma("unroll") for (int n = 0; n < 2; ++n) _Pragma("unroll") for (int k = 0; k < 2; ++k) \
        acc[ai][bj][m][n] = __builtin_amdgcn_mfma_f32_16x16x32_bf16(Bt[n][k], At[m][k], acc[ai][bj][m][n], 0, 0, 0); __builtin_amdgcn_s_setprio(0); } while (0)
#define PG8_WAIT_V(n) asm volatile("s_waitcnt vmcnt(" #n ")" ::: "memory")
#define PG8_WAIT_L(n) asm volatile("s_waitcnt lgkmcnt(" #n ")" ::: "memory")
#define PG8_BAR __builtin_amdgcn_s_barrier()
#define PG8_SCHED __builtin_amdgcn_sched_barrier(0)
#define PG8_GOFF(dst, u) do { if constexpr (GATHER) { _Pragma("unroll") for (int _h = 0; _h < 2; ++_h) _Pragma("unroll") for (int _i = 0; _i < 2; ++_i) \
        dst[_h][_i] = (unsigned)(u).rows[_h * HALF + R0 + 64 * _i] * a_rs + (unsigned)C0 * 2u; } } while (0)
    GUnit cur, nxt; int ui = 0;
    if (!S.next(0, cur)) return;
    f32x4 acc[2][2][4][2];
#pragma unroll
    for (int a = 0; a < 2; ++a)
#pragma unroll
        for (int b = 0; b < 2; ++b)
#pragma unroll
            for (int m = 0; m < 4; ++m)
#pragma unroll
                for (int n = 0; n < 2; ++n) acc[a][b][m][n] = (f32x4){0.f, 0.f, 0.f, 0.f};
    bf16x8 At[4][2], B0[2][2], B1[2][2];
    const char* cA = cur.A; const char* cB0 = cur.B0; const char* cB1 = cur.B1; int cnt = cur.nt;
    PG8_GOFF(vgc, cur);
    if constexpr (SP2) {
        PG8_STAGE(PG8_SB(0, 0), cB0, voffB); PG8_STAGE(PG8_SB(0, 1), cB1, voffB); PG8_STAGE_A(PG8_SA(0, 0), cA, 0, vgc); PG8_STAGE_A(PG8_SA(0, 1), cA, 1, vgc);
        if (wr == 1) PG8_BAR;
        PG8_WAIT_V(2); PG8_BAR;
        PG8_STAGE(PG8_SB(1, 0), cB0 + kstep, voffB); PG8_STAGE_A(PG8_SA(1, 0), cA + kstep, 0, vgc); PG8_STAGE(PG8_SB(1, 1), cB1 + kstep, voffB);
        PG8_WAIT_V(6); PG8_BAR;
    } else {
        PG8_STAGE(PG8_SB(0, 0), cB0, voffB); PG8_STAGE_A(PG8_SA(0, 0), cA, 0, vgc); PG8_STAGE(PG8_SB(0, 1), cB1, voffB); PG8_STAGE_A(PG8_SA(0, 1), cA, 1, vgc);
        if (wr == 1) PG8_BAR;
        PG8_WAIT_V(4); PG8_BAR;
        PG8_STAGE(PG8_SB(1, 0), cB0 + kstep, voffB); PG8_STAGE_A(PG8_SA(1, 0), cA + kstep, 0, vgc); PG8_STAGE(PG8_SB(1, 1), cB1 + kstep, voffB);
        PG8_WAIT_V(6); PG8_BAR;
    }
    for (;;) {
        const bool has_next = S.next(ui + 1, nxt);
        const char* nA = has_next ? nxt.A : cA; const char* nB0 = has_next ? nxt.B0 : cB0; const char* nB1 = has_next ? nxt.B1 : cB1;
        if constexpr (GATHER) {
            if (has_next) { PG8_GOFF(vgn, nxt); }
            else {
#pragma unroll
                for (int _h = 0; _h < 2; ++_h)
#pragma unroll
                    for (int _i = 0; _i < 2; ++_i) vgn[_h][_i] = vgc[_h][_i];
            }
        }
        for (int t = 0; t < cnt; t += 2) {
            const bool last = (t == cnt - 2);
            const char* a1 = cA + (size_t)(t + 1) * kstep;
            const char* a2 = last ? nA : cA + (size_t)(t + 2) * kstep;
            const char* b2 = last ? nB0 : cB0 + (size_t)(t + 2) * kstep; const char* b2h = last ? nB1 : cB1 + (size_t)(t + 2) * kstep;
            const char* a3 = a2 + kstep; const char* b3 = b2 + kstep; const char* b3h = b2h + kstep;
            unsigned vg2[2][2];
            if constexpr (GATHER) {
#pragma unroll
                for (int _h = 0; _h < 2; ++_h)
#pragma unroll
                    for (int _i = 0; _i < 2; ++_i) vg2[_h][_i] = last ? vgn[_h][_i] : vgc[_h][_i];
            }
            if constexpr (SP2) {
            PG8_LDB(B0, 0, 0); PG8_LDB(B1, 0, 1); PG8_SCHED; PG8_LDA(At, 0, 0); PG8_STAGE_A(PG8_SA(1, 1), a1, 1, vgc);
            PG8_WAIT_V(8); PG8_WAIT_L(0); PG8_BAR; PG8_MMA(0, 0, At, B0); PG8_MMA(0, 1, At, B1); PG8_BAR; PG8_SCHED;
            PG8_LDA(At, 0, 1); PG8_STAGE(PG8_SB(0, 0), b2, voffB); PG8_STAGE(PG8_SB(0, 1), b2h, voffB); PG8_STAGE_A(PG8_SA(0, 0), a2, 0, vg2);
            PG8_WAIT_V(8); PG8_WAIT_L(0); PG8_BAR; PG8_MMA(1, 0, At, B0); PG8_MMA(1, 1, At, B1); PG8_BAR; PG8_SCHED;
            PG8_LDB(B0, 1, 0); PG8_LDB(B1, 1, 1); PG8_SCHED; PG8_LDA(At, 1, 0); PG8_STAGE_A(PG8_SA(0, 1), a2, 1, vg2);
            PG8_WAIT_V(8); PG8_WAIT_L(0); PG8_BAR; PG8_MMA(0, 0, At, B0); PG8_MMA(0, 1, At, B1); PG8_BAR; PG8_SCHED;
            PG8_LDA(At, 1, 1); PG8_STAGE(PG8_SB(1, 0), b3, voffB); PG8_STAGE(PG8_SB(1, 1), b3h, voffB); PG8_STAGE_A(PG8_SA(1, 0), a3, 0, vg2);
            PG8_WAIT_V(8); PG8_WAIT_L(0); PG8_BAR; PG8_MMA(1, 0, At, B0); PG8_MMA(1, 1, At, B1); PG8_BAR; PG8_SCHED;
            } else {
            PG8_LDB(B0, 0, 0); PG8_SCHED; PG8_LDA(At, 0, 0); PG8_STAGE_A(PG8_SA(1, 1), a1, 1, vgc);
            PG8_WAIT_L(8); PG8_BAR; PG8_WAIT_L(0); PG8_MMA(0, 0, At, B0); PG8_BAR; PG8_SCHED;
            PG8_LDB(B1, 0, 1); PG8_STAGE(PG8_SB(0, 0), b2, voffB);
            PG8_BAR; PG8_WAIT_L(0); PG8_MMA(0, 1, At, B1); PG8_BAR;
            PG8_LDA(At, 0, 1); PG8_STAGE_A(PG8_SA(0, 0), a2, 0, vg2);
            PG8_BAR; PG8_WAIT_L(0); PG8_MMA(1, 0, At, B0); PG8_BAR; PG8_SCHED;
            PG8_STAGE(PG8_SB(0, 1), b2h, voffB);
            PG8_WAIT_V(6); PG8_BAR; PG8_MMA(1, 1, At, B1); PG8_BAR;
            PG8_LDB(B0, 1, 0); PG8_SCHED; PG8_LDA(At, 1, 0); PG8_STAGE_A(PG8_SA(0, 1), a2, 1, vg2);
            PG8_WAIT_L(8); PG8_BAR; PG8_WAIT_L(0); PG8_MMA(0, 0, At, B0); PG8_BAR; PG8_SCHED;
            PG8_LDB(B1, 1, 1); PG8_STAGE(PG8_SB(1, 0), b3, voffB);
            PG8_BAR; PG8_WAIT_L(0); PG8_MMA(0, 1, At, B1); PG8_BAR;
            PG8_LDA(At, 1, 1); PG8_STAGE_A(PG8_SA(1, 0), a3, 0, vg2);
            PG8_BAR; PG8_WAIT_L(0); PG8_MMA(1, 0, At, B0); PG8_BAR; PG8_SCHED;
            PG8_STAGE(PG8_SB(1, 1), b3h, voffB);
            PG8_WAIT_V(6); PG8_BAR; PG8_MMA(1, 1, At, B1); PG8_BAR;
            }
        }
        if constexpr (ALIGN_EPI) { if (wr == 0) PG8_BAR; }
        { int fr2 = fr, fq2 = fq; asm volatile("" : "+v"(fr2), "+v"(fq2)); E(acc, cur, wr, wc, fr2, fq2); }
        if (!has_next) break;
#pragma unroll
        for (int a = 0; a < 2; ++a)
#pragma unroll
            for (int b = 0; b < 2; ++b)
#pragma unroll
                for (int m = 0; m < 4; ++m)
#pragma unroll
                    for (int n = 0; n < 2; ++n) acc[a][b][m][n] = (f32x4){0.f, 0.f, 0.f, 0.f};
        cur = nxt; cA = nA; cB0 = nB0; cB1 = nB1; cnt = cur.nt; ++ui;
        if constexpr (GATHER) {
#pragma unroll
            for (int _h = 0; _h < 2; ++_h)
#pragma unroll
                for (int _i = 0; _i < 2; ++_i) vgc[_h][_i] = vgn[_h][_i];
        }
        if constexpr (ALIGN_EPI) { if (wr == 1) PG8_BAR; }
    }
    PG8_WAIT_V(0);
    if constexpr (!ALIGN_EPI) { if (wr == 0) PG8_BAR; }
    PG8_BAR;
#undef PG8_SA
#undef PG8_SB
#undef PG8_STAGE
#undef PG8_STAGE_A
#undef PG8_LDA
#undef PG8_LDB
#undef PG8_MMA
#undef PG8_WAIT_V
#undef PG8_WAIT_L
#undef PG8_BAR
#undef PG8_SCHED
#undef PG8_GOFF
}
}

struct Frame {
    LAS unsigned char* lds;
    volatile LAS unsigned* MISC;
    unsigned* ctl;
    unsigned char* ws;
    float* out;
    int wave, G, bid;
};
using pg8::GUnit;

template <class Fill> struct DenseSched {
    int nM, nN, G, c; Fill f;
    __device__ __forceinline__ bool next(int i, GUnit& u) const {
        const long L = (long)i * G + c; if (L >= (long)nM * nN) return false;
        int pm, pn; pg8::tile_order((int)L, nM, nN, pm, pn); u.pm = pm; u.pn = pn; u.rows = nullptr; u.aux0 = 0; u.aux1 = 0; f(u); return true;
    }
};
struct FillPlain {
    const char* A; const char* B; unsigned a_rs, b_rs; int nt;
    __device__ __forceinline__ void operator()(GUnit& u) const { u.A = A + (size_t)u.pm * 256 * a_rs; u.B0 = B + (size_t)u.pn * 256 * b_rs; u.B1 = u.B0 + (size_t)128 * b_rs; u.nt = nt; }
};
struct FillQlatPool {
    const char* q; const char* diff; const char* wuk; const char* wpool;
    __device__ __forceinline__ void operator()(GUnit& u) const {
        if (u.pn < 8) { u.A = q + (size_t)u.pm * 256 * 2048 + (size_t)((u.pn & ~1) * 128) * 2; u.B0 = wuk + (size_t)u.pn * 256 * 512; }
        else { const int g = u.pn - 8; u.A = diff + (size_t)u.pm * 256 * 2048 + (size_t)(g * 256) * 2; u.B0 = wpool + (size_t)g * 256 * 512; }
        u.B1 = u.B0 + (size_t)128 * 512; u.nt = 4;
    }
};
struct FillO {
    const char* olat; const char* wuv;
    __device__ __forceinline__ void operator()(GUnit& u) const { u.A = olat + (size_t)u.pm * 256 * 4096 + (size_t)(u.pn * 512) * 2; u.B0 = wuv + (size_t)u.pn * 256 * 1024; u.B1 = u.B0 + (size_t)128 * 1024; u.nt = 8; }
};

#define EPI_LOOP_ROWS for (int ai = 0; ai < 2; ++ai) _Pragma("unroll") for (int m = 0; m < 4; ++m)
__device__ __forceinline__ u32x4 pack8(const f32x4 v0, const f32x4 v1) { u32x4 w; w.x = cvt_pk_bf16(v0[0], v0[1]); w.y = cvt_pk_bf16(v0[2], v0[3]); w.z = cvt_pk_bf16(v1[0], v1[1]); w.w = cvt_pk_bf16(v1[2], v1[3]); return w; }
__device__ __forceinline__ float sigmoidf_(float x) { return 1.0f / (1.0f + __expf(-x)); }

struct EpiP1 {
    bf16* q; bf16* qi; bf16* xp; bf16* gates; float* ckvraw; float* kiwi;
    __device__ __forceinline__ void operator()(const f32x4 (&acc)[2][2][4][2], const GUnit& u, int wr, int wc, int fr, int fq) const {
        const int row0 = u.pm * 256 + wr * 64 + fr, cl = wc * 32 + 8 * fq;
        if (u.pn < 28) {
            bf16* base; int ld, c0; bool sg = false;
            if (u.pn < 4) { base = q; ld = 1024; c0 = u.pn * 256; } else if (u.pn < 8) { base = qi; ld = 1024; c0 = (u.pn - 4) * 256; }
            else if (u.pn < 12) { base = xp; ld = 1024; c0 = (u.pn - 8) * 256; } else { base = gates; ld = 4096; c0 = (u.pn - 12) * 256; sg = true; }
#pragma unroll
            EPI_LOOP_ROWS { bf16* rowp = base + (size_t)(row0 + ai * 128 + m * 16) * ld + c0 + cl;
#pragma unroll
                for (int bj = 0; bj < 2; ++bj) { f32x4 v0 = acc[ai][bj][m][0], v1 = acc[ai][bj][m][1];
                    if (sg) {
#pragma unroll
                        for (int j = 0; j < 4; ++j) { v0[j] = sigmoidf_(v0[j]); v1[j] = sigmoidf_(v1[j]); } }
                    *(u32x4*)(rowp + bj * 128) = pack8(v0, v1); } }
        } else {
            float* base = (u.pn == 28) ? ckvraw : kiwi;
#pragma unroll
            EPI_LOOP_ROWS { float* rowp = base + (size_t)(row0 + ai * 128 + m * 16) * 256 + cl;
#pragma unroll
                for (int bj = 0; bj < 2; ++bj) { *(f32x4*)(rowp + bj * 128) = acc[ai][bj][m][0]; *(f32x4*)(rowp + bj * 128 + 4) = acc[ai][bj][m][1]; } }
        }
    }
};
struct EpiQlatPool {
    bf16* qlat; bf16* pool; const float* colscale;
    __device__ __forceinline__ void operator()(const f32x4 (&acc)[2][2][4][2], const GUnit& u, int wr, int wc, int fr, int fq) const {
        const int row0 = u.pm * 256 + wr * 64 + fr, cl = wc * 32 + 8 * fq;
        const bool ql = u.pn < 8;
        bf16* base = ql ? qlat + u.pn * 256 : pool + (u.pn - 8) * 256; const int ld = ql ? 2048 : 1024;
        const float* sp = colscale + u.pn * 256 + cl;
#pragma unroll
        EPI_LOOP_ROWS { bf16* rowp = base + (size_t)(row0 + ai * 128 + m * 16) * ld + cl;
#pragma unroll
            for (int bj = 0; bj < 2; ++bj) { const f32x4 s0 = *(const f32x4*)(sp + bj * 128), s1 = *(const f32x4*)(sp + bj * 128 + 4);
                *(u32x4*)(rowp + bj * 128) = pack8(acc[ai][bj][m][0] * s0, acc[ai][bj][m][1] * s1); } }
    }
};
struct EpiBf16 {
    bf16* O; int ld;
    __device__ __forceinline__ void operator()(const f32x4 (&acc)[2][2][4][2], const GUnit& u, int wr, int wc, int fr, int fq) const {
        const int row0 = u.pm * 256 + wr * 64 + fr, cl = u.pn * 256 + wc * 32 + 8 * fq;
#pragma unroll
        EPI_LOOP_ROWS { bf16* rowp = O + (size_t)(row0 + ai * 128 + m * 16) * ld + cl;
#pragma unroll
            for (int bj = 0; bj < 2; ++bj) *(u32x4*)(rowp + bj * 128) = pack8(acc[ai][bj][m][0], acc[ai][bj][m][1]); }
    }
};
__device__ __forceinline__ void unpack8(const u32x4 w, f32x4& a, f32x4& b) {
    a[0] = bf2f(w.x & 0xffffu); a[1] = bf2f(w.x >> 16); a[2] = bf2f(w.y & 0xffffu); a[3] = bf2f(w.y >> 16);
    b[0] = bf2f(w.z & 0xffffu); b[1] = bf2f(w.z >> 16); b[2] = bf2f(w.w & 0xffffu); b[3] = bf2f(w.w >> 16);
}
template <int MODE> struct EpiGate {
    const bf16* gates; bf16* M1; bf16* merged;
    __device__ __forceinline__ void operator()(const f32x4 (&acc)[2][2][4][2], const GUnit& u, int wr, int wc, int fr, int fq) const {
        const int row0 = u.pm * 256 + wr * 64 + fr, cl = u.pn * 256 + wc * 32 + 8 * fq;
#pragma unroll
        EPI_LOOP_ROWS { const size_t r = (size_t)(row0 + ai * 128 + m * 16);
#pragma unroll
            for (int bj = 0; bj < 2; ++bj) { const int c = cl + bj * 128;
                f32x4 g0, g1; unpack8(*(const u32x4*)(gates + r * 4096 + (MODE ? 2048 : 0) + c), g0, g1);
                f32x4 v0 = acc[ai][bj][m][0] * g0, v1 = acc[ai][bj][m][1] * g1;
                if (MODE) { f32x4 p0, p1; unpack8(*(const u32x4*)(M1 + r * 2048 + c), p0, p1); v0 += p0; v1 += p1; *(u32x4*)(merged + r * 2048 + c) = pack8(v0, v1); }
                else *(u32x4*)(M1 + r * 2048 + c) = pack8(v0, v1); } }
    }
};
struct EpiPre {
    const float* x; float* pre;
    __device__ __forceinline__ void operator()(const f32x4 (&acc)[2][2][4][2], const GUnit& u, int wr, int wc, int fr, int fq) const {
        const int row0 = u.pm * 256 + wr * 64 + fr, cl = u.pn * 256 + wc * 32 + 8 * fq;
#pragma unroll
        EPI_LOOP_ROWS { const size_t o = (size_t)(row0 + ai * 128 + m * 16) * 2048 + cl;
#pragma unroll
            for (int bj = 0; bj < 2; ++bj) { const f32x4 x0 = *(const f32x4*)(x + o + bj * 128), x1 = *(const f32x4*)(x + o + bj * 128 + 4);
                *(f32x4*)(pre + o + bj * 128) = x0 * DN_ALPHA + acc[ai][bj][m][0]; *(f32x4*)(pre + o + bj * 128 + 4) = x1 * DN_ALPHA + acc[ai][bj][m][1]; } }
    }
};
struct MoeSched {
    const int* mtt; int nmt; int NT; int G, c; bool gateup;
    const char* h; const char* hbuf; const char* wgu; const char* wd; const int* rowlist;
    __device__ __forceinline__ bool next(int i, GUnit& u) const {
        const int total = nmt * NT; int U;
        if ((G & 7) == 0) { const int x = c & 7, j = i * (G >> 3) + (c >> 3); const int lo = (int)(((long)total * x) >> 3), hi = (int)(((long)total * (x + 1)) >> 3); U = lo + j; if (U >= hi) return false; }
        else { const long L = (long)i * G + c; if (L >= total) return false; U = (int)L; }
        return fill(U, u);
    }
    __device__ __forceinline__ bool fill(int U, GUnit& u) const {
        const int MT = U / NT, nt_ = U - MT * NT;
        const int g = __builtin_amdgcn_readfirstlane(mtt[MT * 4 + 0]), p0 = __builtin_amdgcn_readfirstlane(mtt[MT * 4 + 1]), nv = __builtin_amdgcn_readfirstlane(mtt[MT * 4 + 2]);
        u.pm = p0; u.pn = nt_; u.aux0 = nv; u.aux1 = g;
        if (gateup) { u.A = h; u.rows = rowlist + p0; u.B0 = wgu + ((size_t)g * 1024 + (size_t)nt_ * 256) * 4096; u.B1 = u.B0 + (size_t)128 * 4096; u.nt = 32; }
        else { u.A = hbuf + (size_t)p0 * 1024; u.rows = nullptr; u.B0 = wd + ((size_t)g * 2048 + (size_t)nt_ * 256) * 1024; u.B1 = u.B0 + (size_t)128 * 1024; u.nt = 8; }
        return true;
    }
};
struct EpiSwiGLU {
    bf16* H;
    __device__ __forceinline__ void operator()(const f32x4 (&acc)[2][2][4][2], const GUnit& u, int wr, int wc, int fr, int fq) const {
        const int cl = u.pn * 128 + wc * 32 + 8 * fq;
#pragma unroll
        EPI_LOOP_ROWS { const int r = ai * 128 + wr * 64 + m * 16 + fr;
            if (r < u.aux0) { f32x4 v[2];
#pragma unroll
                for (int n = 0; n < 2; ++n)
#pragma unroll
                    for (int j = 0; j < 4; ++j) { const float g = acc[ai][0][m][n][j], up = acc[ai][1][m][n][j]; v[n][j] = g * sigmoidf_(g) * up; }
                *(u32x4*)(H + (size_t)(u.pm + r) * 512 + cl) = pack8(v[0], v[1]); } }
    }
};
struct EpiY {
    bf16* Y;
    __device__ __forceinline__ void operator()(const f32x4 (&acc)[2][2][4][2], const GUnit& u, int wr, int wc, int fr, int fq) const {
        const int cl = u.pn * 256 + wc * 32 + 8 * fq;
#pragma unroll
        EPI_LOOP_ROWS { const int r = ai * 128 + wr * 64 + m * 16 + fr;
            if (r < u.aux0) { bf16* rowp = Y + (size_t)(u.pm + r) * 2048 + cl;
#pragma unroll
                for (int bj = 0; bj < 2; ++bj) *(u32x4*)(rowp + bj * 128) = pack8(acc[ai][bj][m][0], acc[ai][bj][m][1]); } }
    }
};

template <class RowMap>
__device__ __forceinline__ void tr_item(const float* W, int ldw, int nvalid, bf16* WT, int ldT, LAS float* scr, int kb, int nb, int lane, const RowMap& rm) {
    const int k0 = 64 * kb, n0 = 32 * nb;
    const int ncol = n0 + (lane & 31);
#pragma unroll 8
    for (int i = 0; i < 32; ++i) { const int kk = 2 * i + (lane >> 5); scr[kk * 33 + (lane & 31)] = (ncol < nvalid) ? W[(size_t)(k0 + kk) * ldw + ncol] : 0.f; }
    LDS_WAIT(); asm volatile("" ::: "memory");
    const int c = lane & 7;
#pragma unroll
    for (int j = 0; j < 4; ++j) { const int nl = (lane >> 3) + 8 * j; const LAS float* s = scr + (8 * c) * 33 + nl;
        u32x4 o; o.x = pk2(s[0 * 33], s[1 * 33]); o.y = pk2(s[2 * 33], s[3 * 33]); o.z = pk2(s[4 * 33], s[5 * 33]); o.w = pk2(s[6 * 33], s[7 * 33]);
        if (n0 + nl < nvalid) *(u32x4*)(WT + (size_t)rm(n0 + nl) * ldT + k0 + 8 * c) = o; }
    LDS_WAIT(); asm volatile("" ::: "memory");
}
struct MapId { int off; __device__ __forceinline__ int operator()(int n) const { return off + n; } };
struct MapWin {
    __device__ __forceinline__ int operator()(int n) const {
        if (n < 1024) return n;
        if (n < 1280) return 7168 + (n - 1024);
        if (n < 2304) return 1024 + (n - 1280);
        if (n < 2368) return 7424 + (n - 2304);
        if (n < 2384) return 7488 + (n - 2368);
        if (n < 3408) return 2048 + (n - 2384);
        return 3072 + (n - 3408);
    }
};
struct MapGU { int up; __device__ __forceinline__ int operator()(int f) const { return (f >> 7) * 256 + up * 128 + (f & 127); } };

__device__ __forceinline__ void phase_convert_small(Frame& F, const float* x, const float* w_in, const float* w_uk, const float* w_uv, const float* w_pool, const float* w_pa, const float* w_pp, const float* w_out, const float* pscale) {
    const int lane_ = lane_id(), tid_ = F.wave * 64 + lane_;
    { float* cs = (float*)(F.ws + WS_CSCALE); for (size_t i = (size_t)F.bid * NTHR + tid_; i < 3072; i += (size_t)F.G * NTHR) cs[i] = (i < 2048) ? 1.0f : pscale[i - 2048]; }
    bf16* xb = (bf16*)(F.ws + WS_XB);
    const size_t gt = (size_t)F.bid * NTHR + tid_, nth = (size_t)F.G * NTHR;
    for (size_t i = gt; i < (size_t)NTOK * DM / 8; i += nth) { const f32x4 a = ((const f32x4*)x)[2 * i], b = ((const f32x4*)x)[2 * i + 1];
        u32x4 o; o.x = pk2(a[0], a[1]); o.y = pk2(a[2], a[3]); o.z = pk2(b[0], b[1]); o.w = pk2(b[2], b[3]); ((u32x4*)xb)[i] = o; }
    LAS float* scr = (LAS float*)(F.lds + F.wave * 8704);
    const int gw = F.bid * NWAVES + F.wave, NGW = F.G * NWAVES;
    constexpr int I_IN = 32 * 235, I_POOL = 4 * 4 * 8, I_PA = 16 * 64, I_PP = 16 * 64, I_OUT = 32 * 64;
    constexpr int NIT = I_IN + I_POOL + I_PA + I_PP + I_OUT;
    for (int it = gw; it < NIT; it += NGW) {
        int r = it;
        if (r < I_IN) { tr_item(w_in, 7504, 7504, (bf16*)(F.ws + WS_WIN), 2048, scr, r / 235, r % 235, lane_, MapWin{}); continue; } r -= I_IN;
        if (r < I_POOL) { const int g = r / 32, q = r % 32; tr_item(w_pool + (size_t)g * 65536, 256, 256, (bf16*)(F.ws + WS_WPOOL) + (size_t)g * 65536, 256, scr, q / 8, q % 8, lane_, MapId{0}); continue; } r -= I_POOL;
        if (r < I_PA) { tr_item(w_pa, 2048, 2048, (bf16*)(F.ws + WS_WPA), 1024, scr, r / 64, r % 64, lane_, MapId{0}); continue; } r -= I_PA;
        if (r < I_PP) { tr_item(w_pp, 2048, 2048, (bf16*)(F.ws + WS_WPP), 1024, scr, r / 64, r % 64, lane_, MapId{0}); continue; } r -= I_PP;
        tr_item(w_out, 2048, 2048, (bf16*)(F.ws + WS_WOUT), 2048, scr, r / 64, r % 64, lane_, MapId{0});
    }
    { bf16* wp = (bf16*)(F.ws + WS_WIN) + (size_t)7504 * 2048; for (size_t i = gt; i < (size_t)176 * 2048 / 8; i += nth) ((u32x4*)wp)[i] = (u32x4){0u, 0u, 0u, 0u}; }
    { const float* wuk = w_uk; bf16* o = (bf16*)(F.ws + WS_WUK);
      for (size_t i = gt; i < (size_t)2048 * 256; i += nth) { const int kp = (int)(i & 255), row = (int)(i >> 8), h = row >> 8, r = row & 255;
          o[i] = ((kp >> 7) == (h & 1)) ? (bf16)f2bf(wuk[(size_t)r * 1024 + h * 128 + (kp & 127)]) : (bf16)0; } }
    { const float* wuv = w_uv; bf16* o = (bf16*)(F.ws + WS_WUV);
      for (size_t i = gt; i < (size_t)1024 * 512; i += nth) { const int kp = (int)(i & 511), row = (int)(i >> 9), pn = row >> 8, hh = (row >> 7) & 1, d = row & 127, hh2 = kp >> 8, r = kp & 255;
          o[i] = (hh == hh2) ? (bf16)f2bf(wuv[(size_t)r * 1024 + (2 * pn + hh) * 128 + d]) : (bf16)0; } }
}

__device__ __forceinline__ void phase_convert_experts(Frame& F, const float* wge, const float* wue, const float* wde, const float* wgs, const float* wus, const float* wds) {
    const int lane_ = lane_id(), tid_ = F.wave * 64 + lane_;
    LAS float* scr = (LAS float*)(F.lds + F.wave * 8704);
    const int gw = F.bid * NWAVES + F.wave, NGW = F.G * NWAVES;
    constexpr int PER = 1536, NIT = NGRP * PER;
    for (int it = gw; it < NIT; it += NGW) {
        const int g = it / PER; int r = it - g * PER;
        const float* wg = (g < NE) ? wge + (size_t)g * 2048 * 512 : wgs;
        const float* wu = (g < NE) ? wue + (size_t)g * 2048 * 512 : wus;
        const float* wd = (g < NE) ? wde + (size_t)g * 512 * 2048 : wds;
        bf16* ogu = (bf16*)(F.ws + WS_WGU) + (size_t)g * 1024 * 2048; bf16* od = (bf16*)(F.ws + WS_WD) + (size_t)g * 2048 * 512;
        if (r < 512) { tr_item(wg, 512, 512, ogu, 2048, scr, r / 16, r % 16, lane_, MapGU{0}); continue; } r -= 512;
        if (r < 512) { tr_item(wu, 512, 512, ogu, 2048, scr, r / 16, r % 16, lane_, MapGU{1}); continue; } r -= 512;
        tr_item(wd, 2048, 2048, od, 512, scr, r / 64, r % 64, lane_, MapId{0});
    }
}

__device__ __forceinline__ void phase_postproc(Frame& F, const float* cg, const float* kg, const float* kb) {
    const int lane_ = lane_id(), tid_ = F.wave * 64 + lane_;
    const float* ckvraw = (const float*)(F.ws + WS_CKVRAW); const float* kiwi = (const float*)(F.ws + WS_KIWI);
    bf16* ckvn = (bf16*)(F.ws + WS_CKVN); bf16* kin = (bf16*)(F.ws + WS_KIN); float* wis = (float*)(F.ws + WS_WI);
    const int gw = F.bid * NWAVES + F.wave, NGW = F.G * NWAVES, lane = lane_;
    for (int t = gw; t < NTOK; t += NGW) {
        const f32x4 v = *(const f32x4*)(ckvraw + (size_t)t * 256 + lane * 4);
        const float ss = wave_sum(v[0] * v[0] + v[1] * v[1] + v[2] * v[2] + v[3] * v[3]);
        const float rs = 1.0f / sqrtf(ss * (1.0f / 256.0f) + RMS_EPS);
        const f32x4 g4 = *(const f32x4*)(cg + lane * 4);
        u32x2 o; o.x = pk2(v[0] * rs * g4[0], v[1] * rs * g4[1]); o.y = pk2(v[2] * rs * g4[2], v[3] * rs * g4[3]);
        *(u32x2*)(ckvn + (size_t)t * 256 + lane * 4) = o;
        const float kv = kiwi[(size_t)t * 256 + lane];
        const float mu = wave_sum(kv) * (1.0f / 64.0f); const float dlt = kv - mu;
        const float var = wave_sum(dlt * dlt) * (1.0f / 64.0f);
        const float y = dlt * (1.0f / sqrtf(var + LN_EPS)) * kg[lane] + kb[lane];
        kin[(size_t)t * 64 + lane] = (bf16)f2bf(y);
        if (lane < 16) wis[(size_t)t * 16 + lane] = kiwi[(size_t)t * 256 + 64 + lane] * 0.03125f;
    }
    const bf16* xp = (const bf16*)(F.ws + WS_XP); bf16* diff = (bf16*)(F.ws + WS_DIFF);
    const size_t gt = (size_t)F.bid * NTHR + tid_, nth = (size_t)F.G * NTHR;
    for (size_t i = gt; i < (size_t)NTOK * 128; i += nth) {
        const int t = (int)(i >> 7), cgp = (int)(i & 127), g = cgp >> 5, win = 2 << g, pos = t & (SEQ - 1);
        const int cntw = (pos + 1 < win) ? pos + 1 : win;
        f32x4 s0 = {0.f, 0.f, 0.f, 0.f}, s1 = {0.f, 0.f, 0.f, 0.f}, c0, c1;
        for (int j = 0; j < cntw; ++j) { f32x4 a, b; unpack8(*(const u32x4*)(xp + (size_t)(t - j) * 1024 + cgp * 8), a, b); if (j == 0) { c0 = a; c1 = b; } s0 += a; s1 += b; }
        const float inv = 1.0f / (float)cntw;
        *(u32x4*)(diff + (size_t)t * 1024 + cgp * 8) = pack8(s0 * inv - c0, s1 * inv - c1);
    }
}

__device__ __forceinline__ size_t score_rowbase(int b, int p) { const int jq = p >> 7; return (size_t)b * SC_TOT + (size_t)16384 * (size_t)(jq * (jq + 1) / 2) + (size_t)(p & 127) * (size_t)(128 * (jq + 1)); }

__device__ __forceinline__ void phase_index_scores(Frame& F) {
    const int lane_ = lane_id(), tid_ = F.wave * 64 + lane_;
    const bf16* qi = (const bf16*)(F.ws + WS_QI); const bf16* kin = (const bf16*)(F.ws + WS_KIN); const float* wis = (const float*)(F.ws + WS_WI);
    float* scores = (float*)(F.ws + WS_SCORES);
    const int lane = lane_, w = F.wave, fq = lane >> 4, j16 = lane & 15, tid = tid_;
    LAS unsigned char* kb = F.lds;
    const int sR = tid >> 3, sc = tid & 7, sP = (sR & 3) * 16 + (sR >> 2);
    const int st_off = sP * 128 + ((sc ^ ((sP >> 1) & 7)) * 16);
    for (int it = 0;; ++it) {
        const int jj = (it >> 1) * F.G + F.bid; if (jj >= 256) break;
        const int s = (it & 1) ? 511 - jj : jj;
        const int b = s & 1, qg = s >> 1, tq0 = qg * 32;
        const int nsteps = (tq0 + 32 + 63) / 64;
        bf16x8 Af[4][2];
        { const size_t tok = (size_t)b * SEQ + tq0 + 4 * w + (j16 >> 2);
#pragma unroll
          for (int g = 0; g < 4; ++g)
#pragma unroll
              for (int ks = 0; ks < 2; ++ks) Af[g][ks] = *(const bf16x8*)(qi + tok * 1024 + (4 * g + (j16 & 3)) * 64 + ks * 32 + 8 * fq); }
        f32x4 wv[4];
        { const size_t tok = (size_t)b * SEQ + tq0 + 4 * w + fq;
#pragma unroll
          for (int g = 0; g < 4; ++g) wv[g] = *(const f32x4*)(wis + tok * 16 + 4 * g); }
        float* orow = scores + score_rowbase(b, tq0 + 4 * w + fq);
        const bf16* kbase = kin + (size_t)b * SEQ * 64;
        u32x4 stg = *(const u32x4*)(kbase + (size_t)sR * 64 + sc * 8);
        __syncthreads();
        *(LAS u32x4*)(kb + st_off) = stg;
        __syncthreads();
        for (int step = 0; step < nsteps; ++step) {
            const int cur = step & 1;
            if (step + 1 < nsteps) stg = *(const u32x4*)(kbase + (size_t)((step + 1) * 64 + sR) * 64 + sc * 8);
            f32x4 res;
#pragma unroll
            for (int u = 0; u < 4; ++u) {
                const int P = u * 16 + j16;
                f32x4 a4[4];
#pragma unroll
                for (int g = 0; g < 4; ++g) a4[g] = (f32x4){0.f, 0.f, 0.f, 0.f};
#pragma unroll
                for (int ks = 0; ks < 2; ++ks) {
                    const bf16x8 bfr = *(const LAS bf16x8*)(kb + cur * 8192 + P * 128 + (((fq + 4 * ks) ^ ((P >> 1) & 7)) * 16));
#pragma unroll
                    for (int g = 0; g < 4; ++g) a4[g] = __builtin_amdgcn_mfma_f32_16x16x32_bf16(Af[g][ks], bfr, a4[g], 0, 0, 0);
                }
                float sres = 0.f;
#pragma unroll
                for (int g = 0; g < 4; ++g)
#pragma unroll
                    for (int r = 0; r < 4; ++r) sres += wv[g][r] * fmaxf(a4[g][r], 0.f);
                res[u] = sres;
            }
            *(f32x4*)(orow + step * 64 + 4 * j16) = res;
            if (step + 1 < nsteps) *(LAS u32x4*)(kb + (cur ^ 1) * 8192 + st_off) = stg;
            __syncthreads();
        }
    }
}

__device__ __forceinline__ unsigned fkey(float f) { const unsigned u = __float_as_uint(f); return (u & 0x80000000u) ? ~u : (u | 0x80000000u); }

template <int NV>
__device__ __forceinline__ void select_row(const float* row, int n, unsigned short* sel, int lane) {
    unsigned u[NV][4];
#pragma unroll
    for (int i = 0; i < NV; ++i) {
        const int base = i * 256 + lane * 4;
        f32x4 v = {0.f, 0.f, 0.f, 0.f};
        if (base < n) v = *(const f32x4*)(row + base);
#pragma unroll
        for (int e = 0; e < 4; ++e) u[i][e] = (base + e < n) ? fkey(v[e]) : 0u;
    }
    unsigned T = 0u; int cntT = n;
    bool exact = false;
    for (int bit = 31; bit >= 0; --bit) {
        const unsigned cand = T | (1u << bit);
        int c = 0;
#pragma unroll
        for (int i = 0; i < NV; ++i)
#pragma unroll
            for (int e = 0; e < 4; ++e) c += (u[i][e] >= cand) ? 1 : 0;
        c = wave_sum_i(c);
        if (c >= TOPK) { T = cand; cntT = c; if (c == TOPK) { exact = true; break; } }
    }
    int cgt = 0;
    if (!exact) {
#pragma unroll
        for (int i = 0; i < NV; ++i)
#pragma unroll
            for (int e = 0; e < 4; ++e) cgt += (u[i][e] > T) ? 1 : 0;
        cgt = wave_sum_i(cgt);
    }
    int pg = 0, pe = exact ? 0 : cgt;
    const unsigned long long lt = (1ull << lane) - 1ull;
#pragma unroll
    for (int i = 0; i < NV; ++i)
#pragma unroll
        for (int e = 0; e < 4; ++e) {
            const unsigned val = u[i][e]; const int idx = i * 256 + lane * 4 + e;
            const bool gsel = exact ? (val >= T) : (val > T);
            const unsigned long long mg = __ballot(gsel);
            if (gsel) sel[pg + __popcll(mg & lt)] = (unsigned short)idx;
            pg += __popcll(mg);
            if (!exact) {
                const bool esel = (val == T);
                const unsigned long long me = __ballot(esel);
                const int pos = pe + __popcll(me & lt);
                if (esel && pos < TOPK) sel[pos] = (unsigned short)idx;
                pe += __popcll(me);
            }
        }
}

__device__ __forceinline__ void phase_select(Frame& F) {
    const int lane_ = lane_id(), tid_ = F.wave * 64 + lane_;
    const float* scores = (const float*)(F.ws + WS_SCORES);
    unsigned short* selb = (unsigned short*)(F.ws + WS_SEL);
    const int gw = F.bid * NWAVES + F.wave, NGW = F.G * NWAVES, lane = lane_;
    for (int it = 0;; ++it) {
        const int jj = (it >> 1) * NGW + gw; if (jj >= NTOK / 2) break;
        const int s = (it & 1) ? NTOK - 1 - jj : jj;
        const int b = s & 1, p = s >> 1, n = p + 1;
        unsigned short* sel = selb + ((size_t)b * SEQ + p) * TOPK;
        if (n <= TOPK) {
#pragma unroll
            for (int q = 0; q < 4; ++q) { const int i = q * 64 + lane; sel[i] = (i < n) ? (unsigned short)i : (unsigned short)0xFFFFu; }
        } else {
            const float* row = scores + score_rowbase(b, p);
            if (n <= 2048) select_row<8>(row, n, sel, lane);
            else if (n <= 4096) select_row<16>(row, n, sel, lane);
            else if (n <= 6144) select_row<24>(row, n, sel, lane);
            else select_row<32>(row, n, sel, lane);
        }
    }
}

__device__ __forceinline__ int c_lds(int row, int chunk) { return row * 512 + ((chunk ^ ((row & 7) << 1)) * 16); }

__device__ __forceinline__ void phase_sparse_attn(Frame& F) {
    const int lane_ = lane_id(), tid_ = F.wave * 64 + lane_;
    const bf16* qlat = (const bf16*)(F.ws + WS_QLAT); const bf16* ckvn = (const bf16*)(F.ws + WS_CKVN);
    const unsigned short* selb = (const unsigned short*)(F.ws + WS_SEL); bf16* olat = (bf16*)(F.ws + WS_OLAT);
    const int lane = lane_, fq = lane >> 4, j16 = lane & 15;
    LAS unsigned char* cb = F.lds + F.wave * 16384;
    const float sl2 = 0.08838834764831845f * 1.4426950408889634f;
    const int xh = (F.G % 8 == 0) ? ((F.bid & 7) >> 2) : 0, nsplit = (F.G % 8 == 0) ? 2 : 1;
    const int wloc = (F.G % 8 == 0) ? (((F.bid >> 3) * 4 + (F.bid & 3)) * NWAVES + F.wave) : (F.bid * NWAVES + F.wave);
    const int nwl = (F.G % 8 == 0) ? (F.G / 2) * NWAVES : F.G * NWAVES;
    const int ntk = NTOK / nsplit;
    for (int tl = wloc; tl < ntk; tl += nwl) {
        const int t = xh * ntk + tl, b = t / SEQ, pos = t % SEQ;
        const int nvalid = (pos + 1 < TOPK) ? pos + 1 : TOPK;
        const unsigned short* sel = selb + (size_t)t * TOPK;
        bf16x8 Qb[8];
#pragma unroll
        for (int ks = 0; ks < 8; ++ks) { bf16x8 z = {0, 0, 0, 0, 0, 0, 0, 0}; if (j16 < 8) z = *(const bf16x8*)(qlat + ((size_t)t * 8 + j16) * 256 + ks * 32 + 8 * fq); Qb[ks] = z; }
        float mrun = -INFINITY, lrun = 0.f;
        f32x4 O[16];
#pragma unroll
        for (int rt = 0; rt < 16; ++rt) O[rt] = (f32x4){0.f, 0.f, 0.f, 0.f};
        const int nch = (nvalid + 31) >> 5;
        for (int c = 0; c < nch; ++c) {
            u32x4 gv[16];
#pragma unroll
            for (int it = 0; it < 16; ++it) { const int row = 2 * it + (lane >> 5); int key = sel[c * 32 + row]; key = (key >= SEQ) ? 0 : key;
                gv[it] = *(const u32x4*)(ckvn + ((size_t)b * SEQ + key) * 256 + (lane & 31) * 8); }
#pragma unroll
            for (int it = 0; it < 16; ++it) { const int row = 2 * it + (lane >> 5); *(LAS u32x4*)(cb + c_lds(row, lane & 31)) = gv[it]; }
            LDS_WAIT();
            f32x4 Sa = {0.f, 0.f, 0.f, 0.f}, Sb = {0.f, 0.f, 0.f, 0.f};
#pragma unroll
            for (int ks = 0; ks < 8; ++ks) {
                const bf16x8 a0 = *(const LAS bf16x8*)(cb + c_lds(j16, 4 * ks + fq));
                const bf16x8 a1 = *(const LAS bf16x8*)(cb + c_lds(16 + j16, 4 * ks + fq));
                Sa = __builtin_amdgcn_mfma_f32_16x16x32_bf16(a0, Qb[ks], Sa, 0, 0, 0);
                Sb = __builtin_amdgcn_mfma_f32_16x16x32_bf16(a1, Qb[ks], Sb, 0, 0, 0);
            }
            float xa[4], xb[4]; float cm = -INFINITY;
#pragma unroll
            for (int r = 0; r < 4; ++r) { const int ka = c * 32 + 4 * fq + r, kb2 = ka + 16;
                xa[r] = (ka < nvalid) ? Sa[r] * sl2 : -INFINITY; xb[r] = (kb2 < nvalid) ? Sb[r] * sl2 : -INFINITY; cm = fmaxf(cm, fmaxf(xa[r], xb[r])); }
            cm = fmaxf(cm, __shfl_xor(cm, 16)); cm = fmaxf(cm, __shfl_xor(cm, 32));
            const float mnew = fmaxf(mrun, cm);
            const float alpha = __builtin_amdgcn_exp2f(mrun - mnew);
            float ps = 0.f; f32x4 pa, pb;
#pragma unroll
            for (int r = 0; r < 4; ++r) { pa[r] = __builtin_amdgcn_exp2f(xa[r] - mnew); pb[r] = __builtin_amdgcn_exp2f(xb[r] - mnew); ps += pa[r] + pb[r]; }
            ps += __shfl_xor(ps, 16); ps += __shfl_xor(ps, 32);
            lrun = lrun * alpha + ps; mrun = mnew;
            const u32x4 pw = pack8(pa, pb); const bf16x8 Pb = __builtin_bit_cast(bf16x8, pw);
#pragma unroll
            for (int rt = 0; rt < 16; ++rt) O[rt] = O[rt] * alpha;
            const int q4 = j16 >> 2, p4 = j16 & 3;
#pragma unroll
            for (int rt = 0; rt < 16; ++rt) {
                const int ra = 4 * fq + q4, rb = 16 + 4 * fq + q4, ch = 2 * rt + (p4 >> 1);
                const s16x4 lo = __builtin_bit_cast(s16x4, __builtin_amdgcn_ds_read_tr16_b64_v4i16((LAS s16x4*)(cb + c_lds(ra, ch) + 8 * (p4 & 1))));
                const s16x4 hi = __builtin_bit_cast(s16x4, __builtin_amdgcn_ds_read_tr16_b64_v4i16((LAS s16x4*)(cb + c_lds(rb, ch) + 8 * (p4 & 1))));
                const bf16x8 af = {lo[0], lo[1], lo[2], lo[3], hi[0], hi[1], hi[2], hi[3]};
                O[rt] = __builtin_amdgcn_mfma_f32_16x16x32_bf16(af, Pb, O[rt], 0, 0, 0);
            }
            LDS_WAIT();
        }
        const float inv = 1.0f / lrun;
        if (j16 < 8) {
            bf16* orow = olat + ((size_t)t * 8 + j16) * 256 + 4 * fq;
#pragma unroll
            for (int rt = 0; rt < 16; ++rt) { u32x2 o; o.x = pk2(O[rt][0] * inv, O[rt][1] * inv); o.y = pk2(O[rt][2] * inv, O[rt][3] * inv); *(u32x2*)(orow + rt * 16) = o; }
        }
    }
}

__device__ __forceinline__ void phase_ln1_router(Frame& F, const float* g1, const float* b1, const float* wr_, const float* rbias) {
    const int lane_ = lane_id(), tid_ = F.wave * 64 + lane_;
    const float* pre = F.out;
    bf16* h = (bf16*)(F.ws + WS_H);
    int* tk_e = (int*)(F.ws + WS_TOPK + TK_E); float* tk_w = (float*)(F.ws + WS_TOPK + TK_W);
    const int lane = lane_, w = F.wave, tid = tid_;
    LAS float* Wt = (LAS float*)F.lds;
    LAS float* hrow = (LAS float*)(F.lds + 32768) + w * 2048;
    LAS unsigned* hist = (LAS unsigned*)(F.lds + 32768 + 65536);
    if (tid < 64) hist[tid] = 0u;
    __syncthreads();
    for (int chunk = F.bid; chunk < NTOK / 8; chunk += F.G) {
        const int t = chunk * 8 + w;
        f32x4 v[8]; float s = 0.f;
#pragma unroll
        for (int i = 0; i < 8; ++i) { v[i] = *(const f32x4*)(pre + (size_t)t * DM + (lane + 64 * i) * 4); s += (v[i][0] + v[i][1]) + (v[i][2] + v[i][3]); }
        const float mean = wave_sum(s) * (1.0f / DM); float s2 = 0.f;
#pragma unroll
        for (int i = 0; i < 8; ++i) { v[i] = v[i] - mean; s2 += (v[i][0] * v[i][0] + v[i][1] * v[i][1]) + (v[i][2] * v[i][2] + v[i][3] * v[i][3]); }
        const float rstd = 1.0f / sqrtf(wave_sum(s2) * (1.0f / DM) + LN_EPS);
#pragma unroll
        for (int i = 0; i < 8; ++i) { const int c = (lane + 64 * i) * 4; const f32x4 gg = *(const f32x4*)(g1 + c), bb = *(const f32x4*)(b1 + c);
            const f32x4 y = v[i] * rstd * gg + bb;
            u32x2 o; o.x = pk2(y[0], y[1]); o.y = pk2(y[2], y[3]); *(u32x2*)(h + (size_t)t * DM + c) = o;
            *(LAS f32x4*)(hrow + c) = y; }
        float acc = 0.f;
        for (int dt = 0; dt < 16; ++dt) {
            __syncthreads();
#pragma unroll
            for (int q = 0; q < 4; ++q) { const int idx = tid + 512 * q; *(LAS f32x4*)(Wt + idx * 4) = *(const f32x4*)(wr_ + (size_t)dt * 8192 + idx * 4); }
            __syncthreads();
#pragma unroll 8
            for (int dd = 0; dd < 128; dd += 4) { const f32x4 hv = *(const LAS f32x4*)(hrow + dt * 128 + dd);
                acc += hv[0] * Wt[(dd + 0) * 64 + lane]; acc += hv[1] * Wt[(dd + 1) * 64 + lane]; acc += hv[2] * Wt[(dd + 2) * 64 + lane]; acc += hv[3] * Wt[(dd + 3) * 64 + lane]; }
        }
        const float sc = 1.0f / (1.0f + expf(-acc));
        const float ch = sc + rbias[lane];
        int rk = 0;
#pragma unroll
        for (int k = 1; k < 8; ++k) { const int src = (lane & ~7) | ((lane + k) & 7); const float o = __shfl(ch, src); rk += (o > ch || (o == ch && src < lane)) ? 1 : 0; }
        float gs = (rk < 2) ? ch : 0.f; gs += __shfl_xor(gs, 1); gs += __shfl_xor(gs, 2); gs += __shfl_xor(gs, 4);
        int grk = 0; const int myg = lane >> 3;
#pragma unroll
        for (int g = 0; g < 8; ++g) { const float o = __shfl(gs, g * 8); grk += (o > gs || (o == gs && g < myg)) ? 1 : 0; }
        const float cm = (grk < 4) ? ch : -INFINITY;
        int erk = 0;
        for (int j = 0; j < 64; ++j) { const float o = __shfl(cm, j); erk += (o > cm || (o == cm && j < lane)) ? 1 : 0; }
        const bool selx = (erk < EK) && (grk < 4);
        const float ssum = wave_sum(selx ? sc : 0.f);
        if (selx) { tk_e[(size_t)t * 8 + erk] = lane; tk_w[(size_t)t * 8 + erk] = sc / ssum * 2.5f; __hip_atomic_fetch_add(&hist[lane], 1u, __ATOMIC_RELAXED, __HIP_MEMORY_SCOPE_WORKGROUP); }
    }
    __syncthreads();
    if (tid < 64 && hist[tid]) atomicAdd(F.ctl + CW_CNT + tid, hist[tid]);
}

__device__ __forceinline__ void phase_scatter(Frame& F) {
    const int lane_ = lane_id(), tid_ = F.wave * 64 + lane_;
    const int tid = tid_;
    LAS int* segs = (LAS int*)F.lds;
    LAS unsigned* lcnt = (LAS unsigned*)(F.lds + 1024);
    LAS unsigned* lbase = (LAS unsigned*)(F.lds + 2048);
    const int* tk_e = (const int*)(F.ws + WS_TOPK + TK_E); int* tk_pos = (int*)(F.ws + WS_TOPK + TK_POS);
    int* rowlist = (int*)(F.ws + WS_TOPK + TK_ROWLIST); int* mtt = (int*)(F.ws + WS_TOPK + TK_MTT);
    if (tid == 0) { int a = 0; for (int e = 0; e < NE; ++e) { segs[e] = a; a += (int)__hip_atomic_load(F.ctl + CW_CNT + e, RLX_AGENT); } segs[NE] = a; segs[NE + 1] = a + NTOK; }
    __syncthreads();
    if (F.bid == 0) {
        if (tid == 0) { int mt = 0;
            for (int g = 0; g < NGRP; ++g) { const int p0 = segs[g], n = segs[g + 1] - p0;
                for (int r = 0; r < n; r += 256) { mtt[mt * 4 + 0] = g; mtt[mt * 4 + 1] = p0 + r; mtt[mt * 4 + 2] = (n - r < 256) ? n - r : 256; mtt[mt * 4 + 3] = 0; ++mt; } }
            __hip_atomic_store(F.ctl + CW_NMT, (unsigned)mt, RLX_AGENT); }
        if (tid < 256) rowlist[NSLOT + tid] = 0;
    }
    const int sh0 = segs[NE];
    for (int chunk = F.bid; chunk < NTOK / 64; chunk += F.G) {
        if (tid < 64) lcnt[tid] = 0u;
        __syncthreads();
        const int t = chunk * 64 + (tid >> 3), k = tid & 7;
        const int e = tk_e[(size_t)t * 8 + k];
        const unsigned li = __hip_atomic_fetch_add(&lcnt[e], 1u, __ATOMIC_RELAXED, __HIP_MEMORY_SCOPE_WORKGROUP);
        __syncthreads();
        if (tid < 64) lbase[tid] = lcnt[tid] ? atomicAdd(F.ctl + CW_FILL + tid, lcnt[tid]) : 0u;
        __syncthreads();
        const int p = segs[e] + (int)lbase[e] + (int)li;
        rowlist[p] = t; tk_pos[(size_t)t * 8 + k] = p;
        if (tid < 64) rowlist[sh0 + chunk * 64 + tid] = chunk * 64 + tid;
        __syncthreads();
    }
}

__device__ __forceinline__ void phase_combine(Frame& F, const float* g2, const float* b2) {
    const int lane_ = lane_id(), tid_ = F.wave * 64 + lane_;
    const bf16* h = (const bf16*)(F.ws + WS_H); const bf16* Y = (const bf16*)(F.ws + WS_Y);
    const float* tk_w = (const float*)(F.ws + WS_TOPK + TK_W); const int* tk_pos = (const int*)(F.ws + WS_TOPK + TK_POS);
    const int gw = F.bid * NWAVES + F.wave, NGW = F.G * NWAVES, lane = lane_;
    for (int t = gw; t < NTOK; t += NGW) {
        f32x4 a[4][2];
#pragma unroll
        for (int i = 0; i < 4; ++i) { f32x4 x0, x1; unpack8(*(const u32x4*)(h + (size_t)t * DM + (lane + 64 * i) * 8), x0, x1); a[i][0] = x0 * DN_ALPHA; a[i][1] = x1 * DN_ALPHA; }
#pragma unroll
        for (int k = 0; k < 9; ++k) {
            const int p = (k < 8) ? tk_pos[(size_t)t * 8 + k] : NTOK * 8 + t; const float wk = (k < 8) ? tk_w[(size_t)t * 8 + k] : 1.0f;
#pragma unroll
            for (int i = 0; i < 4; ++i) { f32x4 y0, y1; unpack8(*(const u32x4*)(Y + (size_t)p * DM + (lane + 64 * i) * 8), y0, y1); a[i][0] += y0 * wk; a[i][1] += y1 * wk; }
        }
        float s = 0.f;
#pragma unroll
        for (int i = 0; i < 4; ++i) s += ((a[i][0][0] + a[i][0][1]) + (a[i][0][2] + a[i][0][3])) + ((a[i][1][0] + a[i][1][1]) + (a[i][1][2] + a[i][1][3]));
        const float mean = wave_sum(s) * (1.0f / DM); float s2 = 0.f;
#pragma unroll
        for (int i = 0; i < 4; ++i) { a[i][0] = a[i][0] - mean; a[i][1] = a[i][1] - mean;
            s2 += ((a[i][0][0] * a[i][0][0] + a[i][0][1] * a[i][0][1]) + (a[i][0][2] * a[i][0][2] + a[i][0][3] * a[i][0][3])) + ((a[i][1][0] * a[i][1][0] + a[i][1][1] * a[i][1][1]) + (a[i][1][2] * a[i][1][2] + a[i][1][3] * a[i][1][3])); }
        const float rstd = 1.0f / sqrtf(wave_sum(s2) * (1.0f / DM) + LN_EPS);
#pragma unroll
        for (int i = 0; i < 4; ++i) { const int c = (lane + 64 * i) * 8;
            const f32x4 ga = *(const f32x4*)(g2 + c), gb = *(const f32x4*)(g2 + c + 4), ba = *(const f32x4*)(b2 + c), bb = *(const f32x4*)(b2 + c + 4);
            *(f32x4*)(F.out + (size_t)t * DM + c) = a[i][0] * rstd * ga + ba; *(f32x4*)(F.out + (size_t)t * DM + c + 4) = a[i][1] * rstd * gb + bb; }
    }
}

constexpr int NPHASE = 16;
struct Args { const float* in[24]; float* out; unsigned char* ws; int ph_lo, ph_hi; };

__global__ void __launch_bounds__(NTHR, 2) mk_fwd(Args args) {
    extern __shared__ __attribute__((aligned(16))) unsigned char lds_raw[];
    Frame F;
    F.lds = (LAS unsigned char*)lds_raw;
    F.MISC = (volatile LAS unsigned*)(F.lds + MISC_OFF);
    F.wave = __builtin_amdgcn_readfirstlane(threadIdx.x >> 6);
    F.G = gridDim.x; F.bid = blockIdx.x;
    F.ws = args.ws; F.ctl = (unsigned*)(args.ws + WS_CTL); F.out = args.out;
    for (int u = threadIdx.x; u < (LDS_BYTES - MISC_OFF) / 4; u += NTHR) ((LAS unsigned*)(F.lds + MISC_OFF))[u] = 0u;
    __syncthreads();
    const int lo = args.ph_lo, hi = args.ph_hi;
    const bool multi = (hi - lo) > 1;
    XcdBarrier bar; bar.bar = F.ctl + CW_BAR; bar.x = 0; bar.st = nullptr; bar.wave = F.wave;
    if (multi) bar = xcd_barrier_post(F.ctl + CW_BAR, F.MISC + 8, F.wave);
#ifndef ONLY_PHASE
#define ONLY_PHASE -1
#endif
#define IN(k) ((ONLY_PHASE < 0 || ONLY_PHASE == (k)) && lo <= (k) && (k) < hi)
#define SEAM(k) do { if (IN(k) && IN((k) + 1)) xcd_barrier(bar); } while (0)
    unsigned char* ws = args.ws;

    if (IN(0)) { phase_convert_small(F, args.in[0], args.in[1], args.in[5], args.in[6], args.in[7], args.in[9], args.in[10], args.in[11], args.in[8]); } SEAM(0);

    if (IN(1)) {
        FillPlain f{(const char*)(ws + WS_XB), (const char*)(ws + WS_WIN), 4096u, 4096u, 32};
        DenseSched<FillPlain> S{64, 30, F.G, F.bid, f};
        EpiP1 E{(bf16*)(ws + WS_Q), (bf16*)(ws + WS_QI), (bf16*)(ws + WS_XP), (bf16*)(ws + WS_GATES), (float*)(ws + WS_CKVRAW), (float*)(ws + WS_KIWI)};
        pg8::gemm_phase<EpiP1, DenseSched<FillPlain>, false, true, true>(F.lds, F.wave, 4096u, 4096u, S, E);
    } SEAM(1);

    if (IN(2)) { phase_postproc(F, args.in[2], args.in[3], args.in[4]); } SEAM(2);

    if (IN(3)) {
        FillQlatPool f{(const char*)(ws + WS_Q), (const char*)(ws + WS_DIFF), (const char*)(ws + WS_WUK), (const char*)(ws + WS_WPOOL)};
        DenseSched<FillQlatPool> S{64, 12, F.G, F.bid, f};
        EpiQlatPool E{(bf16*)(ws + WS_QLAT), (bf16*)(ws + WS_POOL), (const float*)(ws + WS_CSCALE)};
        pg8::gemm_phase<EpiQlatPool, DenseSched<FillQlatPool>, false, true, true>(F.lds, F.wave, 2048u, 512u, S, E);
    } SEAM(3);

    if (IN(4)) { phase_index_scores(F); } SEAM(4);
    if (IN(5)) { phase_select(F); } SEAM(5);
    if (IN(6)) { phase_sparse_attn(F); } SEAM(6);

    if (IN(7)) {
        FillO f{(const char*)(ws + WS_OLAT), (const char*)(ws + WS_WUV)};
        DenseSched<FillO> S{64, 4, F.G, F.bid, f};
        EpiBf16 E{(bf16*)(ws + WS_ATTN), 1024};
        pg8::gemm_phase<EpiBf16, DenseSched<FillO>, false, true, true>(F.lds, F.wave, 4096u, 1024u, S, E);
    } SEAM(7);

    if (IN(8)) {
        FillPlain f{(const char*)(ws + WS_ATTN), (const char*)(ws + WS_WPA), 2048u, 2048u, 16};
        DenseSched<FillPlain> S{64, 8, F.G, F.bid, f};
        EpiGate<0> E{(const bf16*)(ws + WS_GATES), (bf16*)(ws + WS_M1), (bf16*)(ws + WS_MERGED)};
        pg8::gemm_phase<EpiGate<0>, DenseSched<FillPlain>, false, true, true>(F.lds, F.wave, 2048u, 2048u, S, E);
    } SEAM(8);

    if (IN(9)) {
        FillPlain f{(const char*)(ws + WS_POOL), (const char*)(ws + WS_WPP), 2048u, 2048u, 16};
        DenseSched<FillPlain> S{64, 8, F.G, F.bid, f};
        EpiGate<1> E{(const bf16*)(ws + WS_GATES), (bf16*)(ws + WS_M1), (bf16*)(ws + WS_MERGED)};
        pg8::gemm_phase<EpiGate<1>, DenseSched<FillPlain>, false, true, true>(F.lds, F.wave, 2048u, 2048u, S, E);
    } SEAM(9);

    if (IN(10)) {
        FillPlain f{(const char*)(ws + WS_MERGED), (const char*)(ws + WS_WOUT), 4096u, 4096u, 32};
        DenseSched<FillPlain> S{64, 8, F.G, F.bid, f};
        EpiPre E{args.in[0], F.out};
        pg8::gemm_phase<EpiPre, DenseSched<FillPlain>, false, true, true>(F.lds, F.wave, 4096u, 4096u, S, E);
    } SEAM(10);

    if (IN(11)) { phase_ln1_router(F, args.in[12], args.in[13], args.in[14], args.in[15]); __syncthreads(); phase_convert_experts(F, args.in[16], args.in[17], args.in[18], args.in[19], args.in[20], args.in[21]); } SEAM(11);
    if (IN(12)) { phase_scatter(F); } SEAM(12);

    if (IN(13)) {
        const int nmt = (int)__hip_atomic_load(F.ctl + CW_NMT, RLX_AGENT);
        MoeSched S{(const int*)(ws + WS_TOPK + TK_MTT), nmt, 4, F.G, F.bid, true, (const char*)(ws + WS_H), (const char*)(ws + WS_HBUF), (const char*)(ws + WS_WGU), (const char*)(ws + WS_WD), (const int*)(ws + WS_TOPK + TK_ROWLIST)};
        EpiSwiGLU E{(bf16*)(ws + WS_HBUF)};
        pg8::gemm_phase<EpiSwiGLU, MoeSched, true, true, true>(F.lds, F.wave, 4096u, 4096u, S, E);
    } SEAM(13);

    if (IN(14)) {
        const int nmt = (int)__hip_atomic_load(F.ctl + CW_NMT, RLX_AGENT);
        MoeSched S{(const int*)(ws + WS_TOPK + TK_MTT), nmt, 8, F.G, F.bid, false, (const char*)(ws + WS_H), (const char*)(ws + WS_HBUF), (const char*)(ws + WS_WGU), (const char*)(ws + WS_WD), (const int*)(ws + WS_TOPK + TK_ROWLIST)};
        EpiY E{(bf16*)(ws + WS_Y)};
        pg8::gemm_phase<EpiY, MoeSched, false, true, true>(F.lds, F.wave, 1024u, 1024u, S, E);
    } SEAM(14);

    if (IN(15)) { phase_combine(F, args.in[22], args.in[23]); }
#undef IN
#undef SEAM
}

#ifndef MK_ONE_LAUNCH
#define MK_ONE_LAUNCH 1
#endif
extern "C" void kernel_launch(void* const* d_in, const int* in_sizes, int n_in, void* d_out, int out_size, void* d_ws, size_t ws_size, hipStream_t stream) {
    static int grid = 0;
    if (grid == 0) {
        if (n_in != 24 || out_size != NTOK * DM || ws_size < WS_END) { fprintf(stderr, "kernel_launch: unexpected shapes (n_in %d out %d ws %zu)\n", n_in, out_size, ws_size); grid = -1; return; }
        int dev = 0, cus = 0;
        if (hipGetDevice(&dev) != hipSuccess || hipDeviceGetAttribute(&cus, hipDeviceAttributeMultiprocessorCount, dev) != hipSuccess) { grid = -1; return; }
        if (hipFuncSetAttribute((const void*)mk_fwd, hipFuncAttributeMaxDynamicSharedMemorySize, LDS_BYTES) != hipSuccess) { fprintf(stderr, "kernel_launch: hipFuncSetAttribute failed\n"); grid = -1; return; }
        int per_cu = 0;
        if (hipOccupancyMaxActiveBlocksPerMultiprocessor(&per_cu, (const void*)mk_fwd, NTHR, LDS_BYTES) != hipSuccess || per_cu < 1) fprintf(stderr, "kernel_launch: occupancy query says %d\n", per_cu);
        (void)hipGetLastError();
        grid = cus;
    }
    if (grid < 0) return;
    if (hipMemsetAsync((char*)d_ws + WS_CTL, 0, CTL_BYTES, stream) != hipSuccess) return;
    Args a{};
    for (int i = 0; i < 24; ++i) a.in[i] = (const float*)d_in[i];
    a.out = (float*)d_out; a.ws = (unsigned char*)d_ws;
#if MK_ONE_LAUNCH
    a.ph_lo = 0; a.ph_hi = NPHASE;
    hipLaunchKernelGGL(mk_fwd, dim3(grid), dim3(NTHR), LDS_BYTES, stream, a);
#else
    for (int p = 0; p < NPHASE; ++p) { a.ph_lo = p; a.ph_hi = p + 1; hipLaunchKernelGGL(mk_fwd, dim3(grid), dim3(NTHR), LDS_BYTES, stream, a); }
#endif
}
```

```cpp
#include <hip/hip_runtime.h>
#include <cstdio>
#include <cstdint>

#define LAS __attribute__((address_space(3)))
#define GAS __attribute__((address_space(1)))
typedef unsigned short bf16;
typedef short bf16x8 __attribute__((ext_vector_type(8)));
typedef short s16x4 __attribute__((ext_vector_type(4)));
typedef float f32x4 __attribute__((ext_vector_type(4)));
typedef float f32x2 __attribute__((ext_vector_type(2)));
typedef unsigned u32x4 __attribute__((ext_vector_type(4)));
typedef unsigned u32x2 __attribute__((ext_vector_type(2)));

constexpr int NTOK = 16384, SEQ = 8192, DM = 2048;
constexpr int NH = 8, DQK = 128, DV = 128, RKV = 256, IH = 16, IDH = 64, TOPK = 256;
constexpr int NE = 64, EK = 8, EDIM = 512, NGRP = 65;
constexpr int WIN_ROWS = 7680;
constexpr float LN_EPS = 1e-5f, RMS_EPS = 1e-6f;
constexpr float DN_ALPHA = 1.189207115002721f;
constexpr int NSLOT = NTOK * 9;
constexpr size_t SC_TOT = (size_t)128 * 128 * (64 * 65 / 2);

constexpr size_t MiB = 1u << 20;
constexpr size_t WS_CTL = 0, CTL_BYTES = 1 * MiB;
constexpr size_t WS_WIN = 1 * MiB;
constexpr size_t WS_WUK = 31 * MiB;
constexpr size_t WS_WUV = 32 * MiB;
constexpr size_t WS_WPOOL = 33 * MiB;
constexpr size_t WS_WPA = 34 * MiB;
constexpr size_t WS_WPP = 38 * MiB;
constexpr size_t WS_WOUT = 42 * MiB;
constexpr size_t WS_CSCALE = 50 * MiB;
constexpr size_t WS_WRT = 50 * MiB + 65536;
constexpr size_t WS_XB = 51 * MiB;
constexpr size_t WS_Q = 115 * MiB;
constexpr size_t WS_QI = 147 * MiB;
constexpr size_t WS_XP = 179 * MiB;
constexpr size_t WS_GATES = 211 * MiB;
constexpr size_t WS_CKVRAW = 339 * MiB;
constexpr size_t WS_KIWI = 355 * MiB;
constexpr size_t WS_CKVN = 371 * MiB;
constexpr size_t WS_KIN = 379 * MiB;
constexpr size_t WS_WI = 381 * MiB;
constexpr size_t WS_DIFF = 382 * MiB;
constexpr size_t WS_QLAT = 414 * MiB;
constexpr size_t WS_POOL = 478 * MiB;
constexpr size_t WS_SCORES = 510 * MiB;
constexpr size_t WS_SEL = 770 * MiB;
constexpr size_t WS_OLAT = 778 * MiB;
constexpr size_t WS_ATTN = 842 * MiB;
constexpr size_t WS_M1 = 874 * MiB;
constexpr size_t WS_MERGED = 938 * MiB;
constexpr size_t WS_H = 51 * MiB;
constexpr size_t WS_WD = 115 * MiB;
constexpr size_t WS_HBUF = 245 * MiB;
constexpr size_t WS_TOPK = 390 * MiB;
constexpr size_t WS_WGU = 394 * MiB;
constexpr size_t WS_Y = 394 * MiB;
constexpr size_t WS_END = 1024 * MiB;
static_assert(WS_SCORES + SC_TOT * 2 * 4 <= WS_SEL, "scores");
static_assert(WS_HBUF + (size_t)(NSLOT + 256) * EDIM * 2 <= WS_TOPK, "hbuf");
static_assert(WS_Y + (size_t)NSLOT * DM * 2 <= WS_END, "y");
constexpr size_t TK_E = 0;
constexpr size_t TK_W = 512 * 1024;
constexpr size_t TK_POS = 1024 * 1024;
constexpr size_t TK_ROWLIST = 1536 * 1024;
constexpr size_t TK_MTT = 2560 * 1024;
constexpr size_t TK_WRT = 3 * MiB;
constexpr int CW_BAR = 4096;
constexpr int CW_CNT = 16384;
constexpr int CW_FILL = 16384 + 64;
constexpr int CW_CVQ = 16384 + 192;
constexpr int CW_NMT = 16384 + 128;

constexpr int RING_BYTES = 131072;
constexpr int MISC_OFF = RING_BYTES;
constexpr int LDS_BYTES = 147456;
constexpr int NWAVES = 8, NTHR = 512;

#define RLX_AGENT __ATOMIC_RELAXED, __HIP_MEMORY_SCOPE_AGENT
#define LDS_WAIT() asm volatile("s_waitcnt lgkmcnt(0)" ::: "memory")
#define VM_WAIT() asm volatile("s_waitcnt vmcnt(0)" ::: "memory")

__device__ __forceinline__ int lane_id() { return (int)__builtin_amdgcn_mbcnt_hi(~0u, __builtin_amdgcn_mbcnt_lo(~0u, 0u)); }
__device__ __forceinline__ float bf2f(unsigned b) { return __uint_as_float(b << 16); }
__device__ __forceinline__ unsigned f2bf(float f) { unsigned u = __float_as_uint(f); return (u + 0x7fffu + ((u >> 16) & 1u)) >> 16; }
__device__ __forceinline__ unsigned pk2(float lo, float hi) { return f2bf(lo) | (f2bf(hi) << 16); }
__device__ __forceinline__ unsigned cvt_pk_bf16(float lo, float hi) { unsigned r; asm volatile("v_cvt_pk_bf16_f32 %0, %1, %2" : "=v"(r) : "v"(lo), "v"(hi)); return r; }
__device__ __forceinline__ float wave_sum(float v) {
#pragma unroll
    for (int o = 1; o < 64; o <<= 1) v += __shfl_xor(v, o);
    return v;
}
__device__ __forceinline__ int wave_sum_i(int v) {
#pragma unroll
    for (int o = 1; o < 64; o <<= 1) v += __shfl_xor(v, o);
    return v;
}

#define XB_TMO      128
#define XB_XCNT(j)  (256  + 64 * (j))
#define XB_XSUB(j)  (1280 + 64 * (j))
#define XB_XGEN(j)  (2304 + 64 * (j))
#define XB_TOP      3328
#define XB_TOPGEN   3392
#define XCD_BAR_WORDS 3456
#define XB_SPIN_CAP (1u << 24)

__device__ __forceinline__ unsigned xb_ld(unsigned* p)              { return __hip_atomic_load(p, __ATOMIC_RELAXED, __HIP_MEMORY_SCOPE_AGENT); }
__device__ __forceinline__ unsigned xb_add(unsigned* p, unsigned v) { return __hip_atomic_fetch_add(p, v, __ATOMIC_RELAXED, __HIP_MEMORY_SCOPE_AGENT); }
__device__ __forceinline__ unsigned xb_xcc_id() { return (unsigned)__builtin_amdgcn_s_getreg((3 << 11) | 20) & 0xFu; }
#define XB_SPIN(cond, bar) do { unsigned _sp = 0; while (cond) { __builtin_amdgcn_s_sleep(1); \
    if ((++_sp & 255u) == 0u) { if (xb_ld(&(bar)[XB_TMO])) break; if (_sp > XB_SPIN_CAP) { atomicAdd(&(bar)[XB_TMO], 1u); break; } } } } while (0)

struct XcdBarrier { unsigned* bar; unsigned x; volatile LAS unsigned* st; int wave; };

__device__ __forceinline__ XcdBarrier xcd_barrier_post(unsigned* bar, volatile LAS unsigned* st, int wave) {
    XcdBarrier b; b.bar = bar; b.x = xb_xcc_id(); b.st = st; b.wave = wave;
    if (wave == 0 && lane_id() == 0) (void)xb_add(&bar[XB_XCNT(b.x)], 1u);
    return b;
}
__device__ __forceinline__ void xcd_barrier_complete(unsigned* bar, unsigned x, unsigned& nloc, unsigned& nx) {
    const unsigned G = gridDim.x * gridDim.y * gridDim.z;
    unsigned sum, cnt, mine, sp = 0u;
    for (;;) {
        sum = 0u; cnt = 0u; mine = 0u;
#pragma unroll
        for (unsigned j = 0; j < 16; ++j) { const unsigned c = xb_ld(&bar[XB_XCNT(j)]); sum += c; cnt += (c > 0u) ? 1u : 0u; mine = (j == x) ? c : mine; }
        if (sum == G) break;
        __builtin_amdgcn_s_sleep(1);
        if ((++sp & 255u) == 0u) { if (xb_ld(&bar[XB_TMO])) break; if (sp > XB_SPIN_CAP) { atomicAdd(&bar[XB_TMO], 1u); break; } }
    }
    nloc = mine > 0u ? mine : 1u; nx = cnt > 0u ? cnt : 1u;
}
__device__ __forceinline__ void xcd_barrier(const XcdBarrier& b) {
    asm volatile("s_waitcnt vmcnt(0)" ::: "memory");
    __syncthreads();
    if (b.wave == 0 && lane_id() == 0) {
        unsigned* bar = b.bar;
        __builtin_amdgcn_s_waitcnt(0);
        unsigned nloc = b.st[0], nx = b.st[1];
        if (nloc == 0u) { xcd_barrier_complete(bar, b.x, nloc, nx); b.st[0] = nloc; b.st[1] = nx; }
        const unsigned old = xb_add(&bar[XB_XSUB(b.x)], 1u);
        const unsigned gen = old / nloc;
        if (old + 1u == (gen + 1u) * nloc) {
            __builtin_amdgcn_fence(__ATOMIC_RELEASE, "agent");
            asm volatile("s_waitcnt vmcnt(0)" ::: "memory");
            const unsigned og = xb_add(&bar[XB_TOP], 1u);
            const unsigned tg = og / nx;
            if (og + 1u == (tg + 1u) * nx) xb_add(&bar[XB_TOPGEN], 1u);
            else XB_SPIN(xb_ld(&bar[XB_TOPGEN]) == tg, bar);
            __builtin_amdgcn_fence(__ATOMIC_ACQUIRE, "agent");
            xb_add(&bar[XB_XGEN(b.x)], 1u);
            asm volatile("s_waitcnt vmcnt(0)" ::: "memory");
        } else {
            XB_SPIN(xb_ld(&bar[XB_XGEN(b.x)]) == gen, bar);
            __builtin_amdgcn_fence(__ATOMIC_ACQUIRE, "agent");
            asm volatile("s_waitcnt vmcnt(0)" ::: "memory");
        }
    }
    __syncthreads();
}

namespace pg8 {
constexpr int BM = 256, BK = 64, HALF = 128, HTB = HALF * BK * 2, STAGE_BYTES = 8 * HTB, NXCD = 8, WGM = 8;

__host__ __device__ __forceinline__ int lds_byte(int r, int c) { const int st = (r >> 4) * 2 + (c >> 5), rr = r & 15, cc = c & 31, ob = rr * 64 + cc * 2; return st * 1024 + (ob ^ (((ob >> 9) & 1) << 5)); }
__host__ __device__ __forceinline__ void stage_rc(int b, int& R, int& C) { const int st = b / 1024, sb = b % 1024, swz = sb ^ (((sb >> 9) & 1) << 5); R = (st >> 1) * 16 + swz / 64; C = (st & 1) * 32 + (swz % 64) / 2; }
__host__ __device__ __forceinline__ int perm32(int rho) { const int n = rho >> 4, i = rho & 15; return 8 * (i >> 2) + 4 * n + (i & 3); }

struct GUnit {
    const char* A;
    const char* B0;
    const char* B1;
    const int* rows;
    int nt;
    int pm, pn, aux0, aux1;
};

__device__ __forceinline__ void tile_order(int L, int nM, int nN, int& pm, int& pn) {
    const int nwg = nM * nN;
    int wgid = L; { const int q = nwg / NXCD, r = nwg % NXCD, xcd = wgid % NXCD, off = wgid / NXCD; wgid = (xcd < r ? xcd * (q + 1) : r * (q + 1) + (xcd - r) * q) + off; }
    const int nig = WGM * nN, gid = wgid / nig, fm = gid * WGM, gsz = (nM - fm) < WGM ? (nM - fm) : WGM;
    pm = fm + ((wgid % nig) % gsz); pn = (wgid % nig) / gsz;
}

template <class Epi, class Sched, bool GATHER, bool ALIGN_EPI, bool SP2>
__device__ __forceinline__ void gemm_phase(LAS unsigned char* lds, const int wave, const unsigned a_rs, const unsigned b_rs, const Sched& S, const Epi& E) {
    const int wid = wave, lane = lane_id(), tid = wid * 64 + lane, wr = wid >> 2, wc = wid & 3, fr = lane & 15, fq = lane >> 4;
    int R0, C0; stage_rc(tid * 16, R0, C0);
    unsigned voffA[2], voffB[2];
#pragma unroll
    for (int i = 0; i < 2; ++i) { const int R = R0 + 64 * i; const int Rb = (R & ~31) + perm32(R & 31);
        voffA[i] = (unsigned)R * a_rs + (unsigned)C0 * 2u; voffB[i] = (unsigned)Rb * b_rs + (unsigned)C0 * 2u; }
    unsigned vgc[2][2], vgn[2][2];
    const size_t kstep = (size_t)(BK * 2);
    const size_t hstepA = (size_t)HALF * a_rs;
    const unsigned ldsw = (unsigned)wid * 1024u;
    const int aoff = lds_byte(wr * 64 + fr, fq * 8), boff = lds_byte(wc * 32 + fr, fq * 8);
#define PG8_SA(b, h) (((b) * 2 + (h)) * HTB)
#define PG8_SB(b, h) ((4 + (b) * 2 + (h)) * HTB)
#define PG8_STAGE(bufoff, gbase, voff) do { _Pragma("unroll") for (int _i = 0; _i < 2; ++_i) \
        __builtin_amdgcn_global_load_lds((const unsigned*)((const char*)(gbase) + (voff)[_i]), (LAS unsigned*)(lds + (bufoff) + ldsw + _i * 8192), 16, 0, 0); } while (0)
#define PG8_STAGE_A(bufoff, gbase, h, vg) do { if constexpr (GATHER) { PG8_STAGE(bufoff, gbase, (vg)[h]); } else { PG8_STAGE(bufoff, (gbase) + (h) * hstepA, voffA); } } while (0)
#define PG8_LDA(dst, b, h) do { _Pragma("unroll") for (int m = 0; m < 4; ++m) _Pragma("unroll") for (int k = 0; k < 2; ++k) dst[m][k] = *(const LAS bf16x8*)(lds + PG8_SA(b, h) + aoff + m * 2048 + k * 1024); } while (0)
#define PG8_LDB(dst, b, h) do { _Pragma("unroll") for (int n = 0; n < 2; ++n) _Pragma("unroll") for (int k = 0; k < 2; ++k) dst[n][k] = *(const LAS bf16x8*)(lds + PG8_SB(b, h) + boff + n * 2048 + k * 1024); } while (0)
#define PG8_MMA(ai, bj, At, Bt) do { __builtin_amdgcn_s_setprio(1); _Pragma("unroll") for (int m = 0; m < 4; ++m) _Pragma("unroll") for (int n = 0; n < 2; ++n) _Pragma("unroll") for (int k = 0; k < 2; ++k) \
        acc[ai][bj][m][n] = __builtin_amdgcn_mfma_f32_16x16x32_bf16(Bt[n][k], At[m][k], acc[ai][bj][m][n], 0, 0, 0); __builtin_amdgcn_s_setprio(0); } while (0)
#define PG8_WAIT_V(n) asm volatile("s_waitcnt vmcnt(" #n ")" ::: "memory")
#define PG8_WAIT_L(n) asm volatile("s_waitcnt lgkmcnt(" #n ")" ::: "memory")
#define PG8_BAR __builtin_amdgcn_s_barrier()
#define PG8_SCHED __builtin_amdgcn_sched_barrier(0)
#define PG8_GOFF(dst, u) do { if constexpr (GATHER) { _Pragma("unroll") for (int _h = 0; _h < 2; ++_h) _Pragma("unroll") for (int _i = 0; _i < 2; ++_i) \
        dst[_h][_i] = (unsigned)(u).rows[_h * HALF + R0 + 64 * _i] * a_rs + (unsigned)C0 * 2u; } } while (0)
    GUnit cur, nxt; int ui = 0;
    if (!S.next(0, cur)) return;
    f32x4 acc[2][2][4][2];
#pragma unroll
    for (int a = 0; a < 2; ++a)
#pragma unroll
        for (int b = 0; b < 2; ++b)
#pragma unroll
            for (int m = 0; m < 4; ++m)
#pragma unroll
                for (int n = 0; n < 2; ++n) acc[a][b][m][n] = (f32x4){0.f, 0.f, 0.f, 0.f};
    bf16x8 At[4][2], B0[2][2], B1[2][2];
    const char* cA = cur.A; const char* cB0 = cur.B0; const char* cB1 = cur.B1; int cnt = cur.nt;
    PG8_GOFF(vgc, cur);
    if constexpr (SP2) {
        PG8_STAGE(PG8_SB(0, 0), cB0, voffB); PG8_STAGE(PG8_SB(0, 1), cB1, voffB); PG8_STAGE_A(PG8_SA(0, 0), cA, 0, vgc); PG8_STAGE_A(PG8_SA(0, 1), cA, 1, vgc);
        if (wr == 1) PG8_BAR;
        PG8_WAIT_V(2); PG8_BAR;
        PG8_STAGE(PG8_SB(1, 0), cB0 + kstep, voffB); PG8_STAGE_A(PG8_SA(1, 0), cA + kstep, 0, vgc); PG8_STAGE(PG8_SB(1, 1), cB1 + kstep, voffB);
        PG8_WAIT_V(6); PG8_BAR;
    } else {
        PG8_STAGE(PG8_SB(0, 0), cB0, voffB); PG8_STAGE_A(PG8_SA(0, 0), cA, 0, vgc); PG8_STAGE(PG8_SB(0, 1), cB1, voffB); PG8_STAGE_A(PG8_SA(0, 1), cA, 1, vgc);
        if (wr == 1) PG8_BAR;
        PG8_WAIT_V(4); PG8_BAR;
        PG8_STAGE(PG8_SB(1, 0), cB0 + kstep, voffB); PG8_STAGE_A(PG8_SA(1, 0), cA + kstep, 0, vgc); PG8_STAGE(PG8_SB(1, 1), cB1 + kstep, voffB);
        PG8_WAIT_V(6); PG8_BAR;
    }
    for (;;) {
        const bool has_next = S.next(ui + 1, nxt);
        const char* nA = has_next ? nxt.A : cA; const char* nB0 = has_next ? nxt.B0 : cB0; const char* nB1 = has_next ? nxt.B1 : cB1;
        if constexpr (GATHER) {
            if (has_next) { PG8_GOFF(vgn, nxt); }
            else {
#pragma unroll
                for (int _h = 0; _h < 2; ++_h)
#pragma unroll
                    for (int _i = 0; _i < 2; ++_i) vgn[_h][_i] = vgc[_h][_i];
            }
        }
        for (int t = 0; t < cnt; t += 2) {
            const bool last = (t == cnt - 2);
            const char* a1 = cA + (size_t)(t + 1) * kstep;
            const char* a2 = last ? nA : cA + (size_t)(t + 2) * kstep;
            const char* b2 = last ? nB0 : cB0 + (size_t)(t + 2) * kstep; const char* b2h = last ? nB1 : cB1 + (size_t)(t + 2) * kstep;
            const char* a3 = a2 + kstep; const char* b3 = b2 + kstep; const char* b3h = b2h + kstep;
            unsigned vg2[2][2];
            if constexpr (GATHER) {
#pragma unroll
                for (int _h = 0; _h < 2; ++_h)
#pragma unroll
                    for (int _i = 0; _i < 2; ++_i) vg2[_h][_i] = last ? vgn[_h][_i] : vgc[_h][_i];
            }
            if constexpr (SP2) {
            PG8_LDB(B0, 0, 0); PG8_LDB(B1, 0, 1); PG8_SCHED; PG8_LDA(At, 0, 0); PG8_STAGE_A(PG8_SA(1, 1), a1, 1, vgc);
            PG8_WAIT_V(8); PG8_WAIT_L(0); PG8_BAR; PG8_MMA(0, 0, At, B0); PG8_MMA(0, 1, At, B1); PG8_BAR; PG8_SCHED;
            PG8_LDA(At, 0, 1); PG8_STAGE(PG8_SB(0, 0), b2, voffB); PG8_STAGE(PG8_SB(0, 1), b2h, voffB); PG8_STAGE_A(PG8_SA(0, 0), a2, 0, vg2);
            PG8_WAIT_V(8); PG8_WAIT_L(0); PG8_BAR; PG8_MMA(1, 0, At, B0); PG8_MMA(1, 1, At, B1); PG8_BAR; PG8_SCHED;
            PG8_LDB(B0, 1, 0); PG8_LDB(B1, 1, 1); PG8_SCHED; PG8_LDA(At, 1, 0); PG8_STAGE_A(PG8_SA(0, 1), a2, 1, vg2);
            PG8_WAIT_V(8); PG8_WAIT_L(0); PG8_BAR; PG8_MMA(0, 0, At, B0); PG8_MMA(0, 1, At, B1); PG8_BAR; PG8_SCHED;
            PG8_LDA(At, 1, 1); PG8_STAGE(PG8_SB(1, 0), b3, voffB); PG8_STAGE(PG8_SB(1, 1), b3h, voffB); PG8_STAGE_A(PG8_SA(1, 0), a3, 0, vg2);
            PG8_WAIT_V(8); PG8_WAIT_L(0); PG8_BAR; PG8_MMA(1, 0, At, B0); PG8_MMA(1, 1, At, B1); PG8_BAR; PG8_SCHED;
            } else {
            PG8_LDB(B0, 0, 0); PG8_SCHED; PG8_LDA(At, 0, 0); PG8_STAGE_A(PG8_SA(1, 1), a1, 1, vgc);
            PG8_WAIT_L(8); PG8_BAR; PG8_WAIT_L(0); PG8_MMA(0, 0, At, B0); PG8_BAR; PG8_SCHED;
            PG8_LDB(B1, 0, 1); PG8_STAGE(PG8_SB(0, 0), b2, voffB);
            PG8_BAR; PG8_WAIT_L(0); PG8_MMA(0, 1, At, B1); PG8_BAR;
            PG8_LDA(At, 0, 1); PG8_STAGE_A(PG8_SA(0, 0), a2, 0, vg2);
            PG8_BAR; PG8_WAIT_L(0); PG8_MMA(1, 0, At, B0); PG8_BAR; PG8_SCHED;
            PG8_STAGE(PG8_SB(0, 1), b2h, voffB);
            PG8_WAIT_V(6); PG8_BAR; PG8_MMA(1, 1, At, B1); PG8_BAR;
            PG8_LDB(B0, 1, 0); PG8_SCHED; PG8_LDA(At, 1, 0); PG8_STAGE_A(PG8_SA(0, 1), a2, 1, vg2);
            PG8_WAIT_L(8); PG8_BAR; PG8_WAIT_L(0); PG8_MMA(0, 0, At, B0); PG8_BAR; PG8_SCHED;
            PG8_LDB(B1, 1, 1); PG8_STAGE(PG8_SB(1, 0), b3, voffB);
            PG8_BAR; PG8_WAIT_L(0); PG8_MMA(0, 1, At, B1); PG8_BAR;
            PG8_LDA(At, 1, 1); PG8_STAGE_A(PG8_SA(1, 0), a3, 0, vg2);
            PG8_BAR; PG8_WAIT_L(0); PG8_MMA(1, 0, At, B0); PG8_BAR; PG8_SCHED;
            PG8_STAGE(PG8_SB(1, 1), b3h, voffB);
            PG8_WAIT_V(6); PG8_BAR; PG8_MMA(1, 1, At, B1); PG8_BAR;
            }
        }
        if constexpr (ALIGN_EPI) { if (wr == 0) PG8_BAR; }
        { int fr2 = fr, fq2 = fq; asm volatile("" : "+v"(fr2), "+v"(fq2)); E(acc, cur, wr, wc, fr2, fq2); }
        if (!has_next) break;
#pragma unroll
        for (int a = 0; a < 2; ++a)
#pragma unroll
            for (int b = 0; b < 2; ++b)
#pragma unroll
                for (int m = 0; m < 4; ++m)
#pragma unroll
                    for (int n = 0; n < 2; ++n) acc[a][b][m][n] = (f32x4){0.f, 0.f, 0.f, 0.f};
        cur = nxt; cA = nA; cB0 = nB0; cB1 = nB1; cnt = cur.nt; ++ui;
        if constexpr (GATHER) {
#pragma unroll
            for (int _h = 0; _h < 2; ++_h)
#pragma unroll
                for (int _i = 0; _i < 2; ++_i) vgc[_h][_i] = vgn[_h][_i];
        }
        if constexpr (ALIGN_EPI) { if (wr == 1) PG8_BAR; }
    }
    PG8_WAIT_V(0);
    if constexpr (!ALIGN_EPI) { if (wr == 0) PG8_BAR; }
    PG8_BAR;
#undef PG8_SA
#undef PG8_SB
#undef PG8_STAGE
#undef PG8_STAGE_A
#undef PG8_LDA
#undef PG8_LDB
#undef PG8_MMA
#undef PG8_WAIT_V
#undef PG8_WAIT_L
#undef PG8_BAR
#undef PG8_SCHED
#undef PG8_GOFF
}
}

struct Frame {
    LAS unsigned char* lds;
    volatile LAS unsigned* MISC;
    unsigned* ctl;
    unsigned char* ws;
    float* out;
    int wave, G, bid;
};
using pg8::GUnit;

template <class Fill> struct DenseSched {
    int nM, nN, G, c; Fill f;
    __device__ __forceinline__ bool next(int i, GUnit& u) const {
        const long L = (long)i * G + c; if (L >= (long)nM * nN) return false;
        int pm, pn; pg8::tile_order((int)L, nM, nN, pm, pn); u.pm = pm; u.pn = pn; u.rows = nullptr; u.aux0 = 0; u.aux1 = 0; f(u); return true;
    }
};
struct FillPlain {
    const char* A; const char* B; unsigned a_rs, b_rs; int nt;
    __device__ __forceinline__ void operator()(GUnit& u) const { u.A = A + (size_t)u.pm * 256 * a_rs; u.B0 = B + (size_t)u.pn * 256 * b_rs; u.B1 = u.B0 + (size_t)128 * b_rs; u.nt = nt; }
};
struct FillQlatPool {
    const char* q; const char* diff; const char* wuk; const char* wpool;
    __device__ __forceinline__ void operator()(GUnit& u) const {
        if (u.pn < 8) { u.A = q + (size_t)u.pm * 256 * 2048 + (size_t)((u.pn & ~1) * 128) * 2; u.B0 = wuk + (size_t)u.pn * 256 * 512; }
        else { const int g = u.pn - 8; u.A = diff + (size_t)u.pm * 256 * 2048 + (size_t)(g * 256) * 2; u.B0 = wpool + (size_t)g * 256 * 512; }
        u.B1 = u.B0 + (size_t)128 * 512; u.nt = 4;
    }
};
struct FillO {
    const char* olat; const char* wuv;
    __device__ __forceinline__ void operator()(GUnit& u) const { u.A = olat + (size_t)u.pm * 256 * 4096 + (size_t)(u.pn * 512) * 2; u.B0 = wuv + (size_t)u.pn * 256 * 1024; u.B1 = u.B0 + (size_t)128 * 1024; u.nt = 8; }
};

#define EPI_LOOP_ROWS for (int ai = 0; ai < 2; ++ai) _Pragma("unroll") for (int m = 0; m < 4; ++m)
__device__ __forceinline__ u32x4 pack8(const f32x4 v0, const f32x4 v1) { u32x4 w; w.x = cvt_pk_bf16(v0[0], v0[1]); w.y = cvt_pk_bf16(v0[2], v0[3]); w.z = cvt_pk_bf16(v1[0], v1[1]); w.w = cvt_pk_bf16(v1[2], v1[3]); return w; }
__device__ __forceinline__ float sigmoidf_(float x) { return 1.0f / (1.0f + __expf(-x)); }

struct EpiP1 {
    bf16* q; bf16* qi; bf16* xp; bf16* gates; float* ckvraw; float* kiwi;
    __device__ __forceinline__ void operator()(const f32x4 (&acc)[2][2][4][2], const GUnit& u, int wr, int wc, int fr, int fq) const {
        const int row0 = u.pm * 256 + wr * 64 + fr, cl = wc * 32 + 8 * fq;
        if (u.pn < 28) {
            bf16* base; int ld, c0; bool sg = false;
            if (u.pn < 4) { base = q; ld = 1024; c0 = u.pn * 256; } else if (u.pn < 8) { base = qi; ld = 1024; c0 = (u.pn - 4) * 256; }
            else if (u.pn < 12) { base = xp; ld = 1024; c0 = (u.pn - 8) * 256; } else { base = gates; ld = 4096; c0 = (u.pn - 12) * 256; sg = true; }
#pragma unroll
            EPI_LOOP_ROWS { bf16* rowp = base + (size_t)(row0 + ai * 128 + m * 16) * ld + c0 + cl;
#pragma unroll
                for (int bj = 0; bj < 2; ++bj) { f32x4 v0 = acc[ai][bj][m][0], v1 = acc[ai][bj][m][1];
                    if (sg) {
#pragma unroll
                        for (int j = 0; j < 4; ++j) { v0[j] = sigmoidf_(v0[j]); v1[j] = sigmoidf_(v1[j]); } }
                    *(u32x4*)(rowp + bj * 128) = pack8(v0, v1); } }
        } else {
            float* base = (u.pn == 28) ? ckvraw : kiwi;
#pragma unroll
            EPI_LOOP_ROWS { float* rowp = base + (size_t)(row0 + ai * 128 + m * 16) * 256 + cl;
#pragma unroll
                for (int bj = 0; bj < 2; ++bj) { *(f32x4*)(rowp + bj * 128) = acc[ai][bj][m][0]; *(f32x4*)(rowp + bj * 128 + 4) = acc[ai][bj][m][1]; } }
        }
    }
};
struct EpiQlatPool {
    bf16* qlat; bf16* pool; const float* colscale;
    __device__ __forceinline__ void operator()(const f32x4 (&acc)[2][2][4][2], const GUnit& u, int wr, int wc, int fr, int fq) const {
        const int row0 = u.pm * 256 + wr * 64 + fr, cl = wc * 32 + 8 * fq;
        const bool ql = u.pn < 8;
        bf16* base = ql ? qlat + u.pn * 256 : pool + (u.pn - 8) * 256; const int ld = ql ? 2048 : 1024;
        const float* sp = colscale + u.pn * 256 + cl;
#pragma unroll
        EPI_LOOP_ROWS { bf16* rowp = base + (size_t)(row0 + ai * 128 + m * 16) * ld + cl;
#pragma unroll
            for (int bj = 0; bj < 2; ++bj) { const f32x4 s0 = *(const f32x4*)(sp + bj * 128), s1 = *(const f32x4*)(sp + bj * 128 + 4);
                *(u32x4*)(rowp + bj * 128) = pack8(acc[ai][bj][m][0] * s0, acc[ai][bj][m][1] * s1); } }
    }
};
struct EpiBf16 {
    bf16* O; int ld;
    __device__ __forceinline__ void operator()(const f32x4 (&acc)[2][2][4][2], const GUnit& u, int wr, int wc, int fr, int fq) const {
        const int row0 = u.pm * 256 + wr * 64 + fr, cl = u.pn * 256 + wc * 32 + 8 * fq;
#pragma unroll
        EPI_LOOP_ROWS { bf16* rowp = O + (size_t)(row0 + ai * 128 + m * 16) * ld + cl;
#pragma unroll
            for (int bj = 0; bj < 2; ++bj) *(u32x4*)(rowp + bj * 128) = pack8(acc[ai][bj][m][0], acc[ai][bj][m][1]); }
    }
};
__device__ __forceinline__ void unpack8(const u32x4 w, f32x4& a, f32x4& b) {
    a[0] = bf2f(w.x & 0xffffu); a[1] = bf2f(w.x >> 16); a[2] = bf2f(w.y & 0xffffu); a[3] = bf2f(w.y >> 16);
    b[0] = bf2f(w.z & 0xffffu); b[1] = bf2f(w.z >> 16); b[2] = bf2f(w.w & 0xffffu); b[3] = bf2f(w.w >> 16);
}
template <int MODE> struct EpiGate {
    const bf16* gates; bf16* M1; bf16* merged;
    __device__ __forceinline__ void operator()(const f32x4 (&acc)[2][2][4][2], const GUnit& u, int wr, int wc, int fr, int fq) const {
        const int row0 = u.pm * 256 + wr * 64 + fr, cl = u.pn * 256 + wc * 32 + 8 * fq;
#pragma unroll
        EPI_LOOP_ROWS { const size_t r = (size_t)(row0 + ai * 128 + m * 16);
#pragma unroll
            for (int bj = 0; bj < 2; ++bj) { const int c = cl + bj * 128;
                f32x4 g0, g1; unpack8(*(const u32x4*)(gates + r * 4096 + (MODE ? 2048 : 0) + c), g0, g1);
                f32x4 v0 = acc[ai][bj][m][0] * g0, v1 = acc[ai][bj][m][1] * g1;
                if (MODE) { f32x4 p0, p1; unpack8(*(const u32x4*)(M1 + r * 2048 + c), p0, p1); v0 += p0; v1 += p1; *(u32x4*)(merged + r * 2048 + c) = pack8(v0, v1); }
                else *(u32x4*)(M1 + r * 2048 + c) = pack8(v0, v1); } }
    }
};
struct EpiPre {
    const float* x; float* pre;
    __device__ __forceinline__ void operator()(const f32x4 (&acc)[2][2][4][2], const GUnit& u, int wr, int wc, int fr, int fq) const {
        const int row0 = u.pm * 256 + wr * 64 + fr, cl = u.pn * 256 + wc * 32 + 8 * fq;
#pragma unroll
        EPI_LOOP_ROWS { const size_t o = (size_t)(row0 + ai * 128 + m * 16) * 2048 + cl;
#pragma unroll
            for (int bj = 0; bj < 2; ++bj) { const f32x4 x0 = *(const f32x4*)(x + o + bj * 128), x1 = *(const f32x4*)(x + o + bj * 128 + 4);
                *(f32x4*)(pre + o + bj * 128) = x0 * DN_ALPHA + acc[ai][bj][m][0]; *(f32x4*)(pre + o + bj * 128 + 4) = x1 * DN_ALPHA + acc[ai][bj][m][1]; } }
    }
};
struct MoeSched {
    const int* mtt; int nmt; int NT; int G, c; bool gateup;
    const char* h; const char* hbuf; const char* wgu; const char* wd; const int* rowlist;
    __device__ __forceinline__ bool next(int i, GUnit& u) const {
        const int total = nmt * NT; int U;
        if ((G & 7) == 0) { const int x = c & 7, j = i * (G >> 3) + (c >> 3); const int lo = (int)(((long)total * x) >> 3), hi = (int)(((long)total * (x + 1)) >> 3); U = lo + j; if (U >= hi) return false; }
        else { const long L = (long)i * G + c; if (L >= total) return false; U = (int)L; }
        return fill(U, u);
    }
    __device__ __forceinline__ bool fill(int U, GUnit& u) const {
        const int MT = U / NT, nt_ = U - MT * NT;
        const int g = __builtin_amdgcn_readfirstlane(mtt[MT * 4 + 0]), p0 = __builtin_amdgcn_readfirstlane(mtt[MT * 4 + 1]), nv = __builtin_amdgcn_readfirstlane(mtt[MT * 4 + 2]);
        u.pm = p0; u.pn = nt_; u.aux0 = nv; u.aux1 = g;
        if (gateup) { u.A = h; u.rows = rowlist + p0; u.B0 = wgu + ((size_t)g * 1024 + (size_t)nt_ * 256) * 4096; u.B1 = u.B0 + (size_t)128 * 4096; u.nt = 32; }
        else { u.A = hbuf + (size_t)p0 * 1024; u.rows = nullptr; u.B0 = wd + ((size_t)g * 2048 + (size_t)nt_ * 256) * 1024; u.B1 = u.B0 + (size_t)128 * 1024; u.nt = 8; }
        return true;
    }
};
struct EpiSwiGLU {
    bf16* H;
    __device__ __forceinline__ void operator()(const f32x4 (&acc)[2][2][4][2], const GUnit& u, int wr, int wc, int fr, int fq) const {
        const int cl = u.pn * 128 + wc * 32 + 8 * fq;
#pragma unroll
        EPI_LOOP_ROWS { const int r = ai * 128 + wr * 64 + m * 16 + fr;
            if (r < u.aux0) { f32x4 v[2];
#pragma unroll
                for (int n = 0; n < 2; ++n)
#pragma unroll
                    for (int j = 0; j < 4; ++j) { const float g = acc[ai][0][m][n][j], up = acc[ai][1][m][n][j]; v[n][j] = g * sigmoidf_(g) * up; }
                *(u32x4*)(H + (size_t)(u.pm + r) * 512 + cl) = pack8(v[0], v[1]); } }
    }
};
struct EpiY {
    bf16* Y;
    __device__ __forceinline__ void operator()(const f32x4 (&acc)[2][2][4][2], const GUnit& u, int wr, int wc, int fr, int fq) const {
        const int cl = u.pn * 256 + wc * 32 + 8 * fq;
#pragma unroll
        EPI_LOOP_ROWS { const int r = ai * 128 + wr * 64 + m * 16 + fr;
            if (r < u.aux0) { bf16* rowp = Y + (size_t)(u.pm + r) * 2048 + cl;
#pragma unroll
                for (int bj = 0; bj < 2; ++bj) *(u32x4*)(rowp + bj * 128) = pack8(acc[ai][bj][m][0], acc[ai][bj][m][1]); } }
    }
};

template <class RowMap>
__device__ __forceinline__ void tr_item(const float* W, int ldw, int nvalid, bf16* WT, int ldT, LAS float* scr, int kb, int nb, int lane, const RowMap& rm) {
    const int k0 = 64 * kb, n0 = 32 * nb;
    const int ncol = n0 + (lane & 31);
#pragma unroll 8
    for (int i = 0; i < 32; ++i) { const int kk = 2 * i + (lane >> 5); scr[kk * 33 + (lane & 31)] = (ncol < nvalid) ? W[(size_t)(k0 + kk) * ldw + ncol] : 0.f; }
    LDS_WAIT(); asm volatile("" ::: "memory");
    const int c = lane & 7;
#pragma unroll
    for (int j = 0; j < 4; ++j) { const int nl = (lane >> 3) + 8 * j; const LAS float* s = scr + (8 * c) * 33 + nl;
        u32x4 o; o.x = pk2(s[0 * 33], s[1 * 33]); o.y = pk2(s[2 * 33], s[3 * 33]); o.z = pk2(s[4 * 33], s[5 * 33]); o.w = pk2(s[6 * 33], s[7 * 33]);
        if (n0 + nl < nvalid) *(u32x4*)(WT + (size_t)rm(n0 + nl) * ldT + k0 + 8 * c) = o; }
    LDS_WAIT(); asm volatile("" ::: "memory");
}
struct MapId { int off; __device__ __forceinline__ int operator()(int n) const { return off + n; } };
struct MapWin {
    __device__ __forceinline__ int operator()(int n) const {
        if (n < 1024) return n;
        if (n < 1280) return 7168 + (n - 1024);
        if (n < 2304) return 1024 + (n - 1280);
        if (n < 2368) return 7424 + (n - 2304);
        if (n < 2384) return 7488 + (n - 2368);
        if (n < 3408) return 2048 + (n - 2384);
        return 3072 + (n - 3408);
    }
};
struct MapGU { int up; __device__ __forceinline__ int operator()(int f) const { return (f >> 7) * 256 + up * 128 + (f & 127); } };

__device__ __forceinline__ void phase_convert_small(Frame& F, const float* x, const float* w_in, const float* w_uk, const float* w_uv, const float* w_pool, const float* w_pa, const float* w_pp, const float* w_out, const float* pscale, const float* w_router) {
    const int lane_ = lane_id(), tid_ = F.wave * 64 + lane_;
    { float* wt = (float*)(F.ws + WS_WRT); for (size_t i = (size_t)F.bid * NTHR + tid_; i < (size_t)64 * 2048; i += (size_t)F.G * NTHR) { const int e = (int)(i >> 11), d = (int)(i & 2047); wt[i] = w_router[(size_t)d * 64 + e]; } }
    { float* cs = (float*)(F.ws + WS_CSCALE); for (size_t i = (size_t)F.bid * NTHR + tid_; i < 3072; i += (size_t)F.G * NTHR) cs[i] = (i < 2048) ? 1.0f : pscale[i - 2048]; }
    bf16* xb = (bf16*)(F.ws + WS_XB);
    const size_t gt = (size_t)F.bid * NTHR + tid_, nth = (size_t)F.G * NTHR;
    for (size_t i = gt; i < (size_t)NTOK * DM / 8; i += nth) { const f32x4 a = ((const f32x4*)x)[2 * i], b = ((const f32x4*)x)[2 * i + 1];
        u32x4 o; o.x = pk2(a[0], a[1]); o.y = pk2(a[2], a[3]); o.z = pk2(b[0], b[1]); o.w = pk2(b[2], b[3]); ((u32x4*)xb)[i] = o; }
    LAS float* scr = (LAS float*)(F.lds + F.wave * 8704);
    const int gw = F.bid * NWAVES + F.wave, NGW = F.G * NWAVES;
    constexpr int I_IN = 32 * 235, I_POOL = 4 * 4 * 8, I_PA = 16 * 64, I_PP = 16 * 64, I_OUT = 32 * 64;
    constexpr int NIT = I_IN + I_POOL + I_PA + I_PP + I_OUT;
    for (int it = gw; it < NIT; it += NGW) {
        int r = it;
        if (r < I_IN) { tr_item(w_in, 7504, 7504, (bf16*)(F.ws + WS_WIN), 2048, scr, r / 235, r % 235, lane_, MapWin{}); continue; } r -= I_IN;
        if (r < I_POOL) { const int g = r / 32, q = r % 32; tr_item(w_pool + (size_t)g * 65536, 256, 256, (bf16*)(F.ws + WS_WPOOL) + (size_t)g * 65536, 256, scr, q / 8, q % 8, lane_, MapId{0}); continue; } r -= I_POOL;
        if (r < I_PA) { tr_item(w_pa, 2048, 2048, (bf16*)(F.ws + WS_WPA), 1024, scr, r / 64, r % 64, lane_, MapId{0}); continue; } r -= I_PA;
        if (r < I_PP) { tr_item(w_pp, 2048, 2048, (bf16*)(F.ws + WS_WPP), 1024, scr, r / 64, r % 64, lane_, MapId{0}); continue; } r -= I_PP;
        tr_item(w_out, 2048, 2048, (bf16*)(F.ws + WS_WOUT), 2048, scr, r / 64, r % 64, lane_, MapId{0});
    }
    { bf16* wp = (bf16*)(F.ws + WS_WIN) + (size_t)7504 * 2048; for (size_t i = gt; i < (size_t)176 * 2048 / 8; i += nth) ((u32x4*)wp)[i] = (u32x4){0u, 0u, 0u, 0u}; }
    { const float* wuk = w_uk; bf16* o = (bf16*)(F.ws + WS_WUK);
      for (size_t i = gt; i < (size_t)2048 * 256; i += nth) { const int kp = (int)(i & 255), row = (int)(i >> 8), h = row >> 8, r = row & 255;
          o[i] = ((kp >> 7) == (h & 1)) ? (bf16)f2bf(wuk[(size_t)r * 1024 + h * 128 + (kp & 127)]) : (bf16)0; } }
    { const float* wuv = w_uv; bf16* o = (bf16*)(F.ws + WS_WUV);
      for (size_t i = gt; i < (size_t)1024 * 512; i += nth) { const int kp = (int)(i & 511), row = (int)(i >> 9), pn = row >> 8, hh = (row >> 7) & 1, d = row & 127, hh2 = kp >> 8, r = kp & 255;
          o[i] = (hh == hh2) ? (bf16)f2bf(wuv[(size_t)r * 1024 + (2 * pn + hh) * 128 + d]) : (bf16)0; } }
}

__device__ __forceinline__ void phase_convert_experts(Frame& F, const float* wge, const float* wue, const float* wde, const float* wgs, const float* wus, const float* wds) {
    const int lane_ = lane_id();
    LAS float* scr = (LAS float*)(F.lds + 32768 + F.wave * 8704);
    constexpr int PER = 1536, NIT = NGRP * PER, BATCH = 8;
    for (;;) {
        int base = 0;
        if (lane_ == 0) base = (int)__hip_atomic_fetch_add(F.ctl + CW_CVQ, (unsigned)BATCH, RLX_AGENT);
        base = __builtin_amdgcn_readfirstlane(base);
        if (base >= NIT) break;
        for (int it = base; it < base + BATCH && it < NIT; ++it) {
            const int g = it / PER; int r = it - g * PER;
            const float* wg = (g < NE) ? wge + (size_t)g * 2048 * 512 : wgs;
            const float* wu = (g < NE) ? wue + (size_t)g * 2048 * 512 : wus;
            const float* wd = (g < NE) ? wde + (size_t)g * 512 * 2048 : wds;
            bf16* ogu = (bf16*)(F.ws + WS_WGU) + (size_t)g * 1024 * 2048; bf16* od = (bf16*)(F.ws + WS_WD) + (size_t)g * 2048 * 512;
            if (r < 512) { tr_item(wg, 512, 512, ogu, 2048, scr, r / 16, r % 16, lane_, MapGU{0}); continue; } r -= 512;
            if (r < 512) { tr_item(wu, 512, 512, ogu, 2048, scr, r / 16, r % 16, lane_, MapGU{1}); continue; } r -= 512;
            tr_item(wd, 2048, 2048, od, 512, scr, r / 64, r % 64, lane_, MapId{0});
        }
    }
}

__device__ __forceinline__ void phase_postproc(Frame& F, const float* cg, const float* kg, const float* kb) {
    const int lane_ = lane_id(), tid_ = F.wave * 64 + lane_;
    const float* ckvraw = (const float*)(F.ws + WS_CKVRAW); const float* kiwi = (const float*)(F.ws + WS_KIWI);
    bf16* ckvn = (bf16*)(F.ws + WS_CKVN); bf16* kin = (bf16*)(F.ws + WS_KIN); float* wis = (float*)(F.ws + WS_WI);
    const int gw = F.bid * NWAVES + F.wave, NGW = F.G * NWAVES, lane = lane_;
    for (int t = gw; t < NTOK; t += NGW) {
        const f32x4 v = *(const f32x4*)(ckvraw + (size_t)t * 256 + lane * 4);
        const float ss = wave_sum(v[0] * v[0] + v[1] * v[1] + v[2] * v[2] + v[3] * v[3]);
        const float rs = 1.0f / sqrtf(ss * (1.0f / 256.0f) + RMS_EPS);
        const f32x4 g4 = *(const f32x4*)(cg + lane * 4);
        u32x2 o; o.x = pk2(v[0] * rs * g4[0], v[1] * rs * g4[1]); o.y = pk2(v[2] * rs * g4[2], v[3] * rs * g4[3]);
        *(u32x2*)(ckvn + (size_t)t * 256 + lane * 4) = o;
        const float kv = kiwi[(size_t)t * 256 + lane];
        const float mu = wave_sum(kv) * (1.0f / 64.0f); const float dlt = kv - mu;
        const float var = wave_sum(dlt * dlt) * (1.0f / 64.0f);
        const float y = dlt * (1.0f / sqrtf(var + LN_EPS)) * kg[lane] + kb[lane];
        kin[(size_t)t * 64 + lane] = (bf16)f2bf(y);
        if (lane < 16) wis[(size_t)t * 16 + lane] = kiwi[(size_t)t * 256 + 64 + lane] * 0.03125f;
    }
    const bf16* xp = (const bf16*)(F.ws + WS_XP); bf16* diff = (bf16*)(F.ws + WS_DIFF);
    const size_t gt = (size_t)F.bid * NTHR + tid_, nth = (size_t)F.G * NTHR;
    for (size_t i = gt; i < (size_t)NTOK * 128; i += nth) {
        const int t = (int)(i >> 7), cgp = (int)(i & 127), g = cgp >> 5, win = 2 << g, pos = t & (SEQ - 1);
        const int cntw = (pos + 1 < win) ? pos + 1 : win;
        f32x4 s0 = {0.f, 0.f, 0.f, 0.f}, s1 = {0.f, 0.f, 0.f, 0.f}, c0, c1;
        for (int j = 0; j < cntw; ++j) { f32x4 a, b; unpack8(*(const u32x4*)(xp + (size_t)(t - j) * 1024 + cgp * 8), a, b); if (j == 0) { c0 = a; c1 = b; } s0 += a; s1 += b; }
        const float inv = 1.0f / (float)cntw;
        *(u32x4*)(diff + (size_t)t * 1024 + cgp * 8) = pack8(s0 * inv - c0, s1 * inv - c1);
    }
}

__device__ __forceinline__ size_t score_rowbase(int b, int p) { const int jq = p >> 7; return (size_t)b * SC_TOT + (size_t)16384 * (size_t)(jq * (jq + 1) / 2) + (size_t)(p & 127) * (size_t)(128 * (jq + 1)); }

__device__ __forceinline__ void phase_index_scores(Frame& F) {
    const int lane_ = lane_id(), tid_ = F.wave * 64 + lane_;
    const bf16* qi = (const bf16*)(F.ws + WS_QI); const bf16* kin = (const bf16*)(F.ws + WS_KIN); const float* wis = (const float*)(F.ws + WS_WI);
    float* scores = (float*)(F.ws + WS_SCORES);
    const int lane = lane_, w = F.wave, fq = lane >> 4, j16 = lane & 15, tid = tid_;
    LAS unsigned char* kb = F.lds;
    const int sR = tid >> 3, sc = tid & 7, sP = (sR & 3) * 16 + (sR >> 2);
    const int st_off = sP * 128 + ((sc ^ ((sP >> 1) & 7)) * 16);
    for (int it = 0;; ++it) {
        const int jj = (it >> 1) * F.G + F.bid; if (jj >= 256) break;
        const int s = (it & 1) ? 511 - jj : jj;
        const int b = s & 1, qg = s >> 1, tq0 = qg * 32;
        const int nsteps = (tq0 + 32 + 63) / 64;
        bf16x8 Af[4][2];
        { const size_t tok = (size_t)b * SEQ + tq0 + 4 * w + (j16 >> 2);
#pragma unroll
          for (int g = 0; g < 4; ++g)
#pragma unroll
              for (int ks = 0; ks < 2; ++ks) Af[g][ks] = *(const bf16x8*)(qi + tok * 1024 + (4 * g + (j16 & 3)) * 64 + ks * 32 + 8 * fq); }
        f32x4 wv[4];
        { const size_t tok = (size_t)b * SEQ + tq0 + 4 * w + fq;
#pragma unroll
          for (int g = 0; g < 4; ++g) wv[g] = *(const f32x4*)(wis + tok * 16 + 4 * g); }
        float* orow = scores + score_rowbase(b, tq0 + 4 * w + fq);
        const bf16* kbase = kin + (size_t)b * SEQ * 64;
        u32x4 stg = *(const u32x4*)(kbase + (size_t)sR * 64 + sc * 8);
        __syncthreads();
        *(LAS u32x4*)(kb + st_off) = stg;
        __syncthreads();
        for (int step = 0; step < nsteps; ++step) {
            const int cur = step & 1;
            if (step + 1 < nsteps) stg = *(const u32x4*)(kbase + (size_t)((step + 1) * 64 + sR) * 64 + sc * 8);
            f32x4 res;
#pragma unroll
            for (int u = 0; u < 4; ++u) {
                const int P = u * 16 + j16;
                f32x4 a4[4];
#pragma unroll
                for (int g = 0; g < 4; ++g) a4[g] = (f32x4){0.f, 0.f, 0.f, 0.f};
#pragma unroll
                for (int ks = 0; ks < 2; ++ks) {
                    const bf16x8 bfr = *(const LAS bf16x8*)(kb + cur * 8192 + P * 128 + (((fq + 4 * ks) ^ ((P >> 1) & 7)) * 16));
#pragma unroll
                    for (int g = 0; g < 4; ++g) a4[g] = __builtin_amdgcn_mfma_f32_16x16x32_bf16(Af[g][ks], bfr, a4[g], 0, 0, 0);
                }
                float sres = 0.f;
#pragma unroll
                for (int g = 0; g < 4; ++g)
#pragma unroll
                    for (int r = 0; r < 4; ++r) sres += wv[g][r] * fmaxf(a4[g][r], 0.f);
                res[u] = sres;
            }
            *(f32x4*)(orow + step * 64 + 4 * j16) = res;
            if (step + 1 < nsteps) *(LAS u32x4*)(kb + (cur ^ 1) * 8192 + st_off) = stg;
            __syncthreads();
        }
    }
}

__device__ __forceinline__ unsigned fkey(float f) { const unsigned u = __float_as_uint(f); return (u & 0x80000000u) ? ~u : (u | 0x80000000u); }

template <int NV>
__device__ __forceinline__ void select_row(const float* row, int n, unsigned short* sel, int lane) {
    unsigned u[NV][4];
#pragma unroll
    for (int i = 0; i < NV; ++i) {
        const int base = i * 256 + lane * 4;
        f32x4 v = {0.f, 0.f, 0.f, 0.f};
        if (base < n) v = *(const f32x4*)(row + base);
#pragma unroll
        for (int e = 0; e < 4; ++e) u[i][e] = (base + e < n) ? fkey(v[e]) : 0u;
    }
    unsigned T = 0u; int cntT = n;
    bool exact = false;
    for (int bit = 31; bit >= 0; --bit) {
        const unsigned cand = T | (1u << bit);
        int c = 0;
#pragma unroll
        for (int i = 0; i < NV; ++i)
#pragma unroll
            for (int e = 0; e < 4; ++e) c += (u[i][e] >= cand) ? 1 : 0;
        c = wave_sum_i(c);
        if (c >= TOPK) { T = cand; cntT = c; if (c == TOPK) { exact = true; break; } }
    }
    int cgt = 0;
    if (!exact) {
#pragma unroll
        for (int i = 0; i < NV; ++i)
#pragma unroll
            for (int e = 0; e < 4; ++e) cgt += (u[i][e] > T) ? 1 : 0;
        cgt = wave_sum_i(cgt);
    }
    int pg = 0, pe = exact ? 0 : cgt;
    const unsigned long long lt = (1ull << lane) - 1ull;
#pragma unroll
    for (int i = 0; i < NV; ++i)
#pragma unroll
        for (int e = 0; e < 4; ++e) {
            const unsigned val = u[i][e]; const int idx = i * 256 + lane * 4 + e;
            const bool gsel = exact ? (val >= T) : (val > T);
            const unsigned long long mg = __ballot(gsel);
            if (gsel) sel[pg + __popcll(mg & lt)] = (unsigned short)idx;
            pg += __popcll(mg);
            if (!exact) {
                const bool esel = (val == T);
                const unsigned long long me = __ballot(esel);
                const int pos = pe + __popcll(me & lt);
                if (esel && pos < TOPK) sel[pos] = (unsigned short)idx;
                pe += __popcll(me);
            }
        }
}

__device__ __forceinline__ void phase_select(Frame& F) {
    const int lane_ = lane_id(), tid_ = F.wave * 64 + lane_;
    const float* scores = (const float*)(F.ws + WS_SCORES);
    unsigned short* selb = (unsigned short*)(F.ws + WS_SEL);
    const int gw = F.bid * NWAVES + F.wave, NGW = F.G * NWAVES, lane = lane_;
    for (int it = 0;; ++it) {
        const int jj = (it >> 1) * NGW + gw; if (jj >= NTOK / 2) break;
        const int s = (it & 1) ? NTOK - 1 - jj : jj;
        const int b = s & 1, p = s >> 1, n = p + 1;
        unsigned short* sel = selb + ((size_t)b * SEQ + p) * TOPK;
        if (n <= TOPK) {
#pragma unroll
            for (int q = 0; q < 4; ++q) { const int i = q * 64 + lane; sel[i] = (i < n) ? (unsigned short)i : (unsigned short)0xFFFFu; }
        } else {
            const float* row = scores + score_rowbase(b, p);
            if (n <= 2048) select_row<8>(row, n, sel, lane);
            else if (n <= 4096) select_row<16>(row, n, sel, lane);
            else if (n <= 6144) select_row<24>(row, n, sel, lane);
            else select_row<32>(row, n, sel, lane);
        }
    }
}

__device__ __forceinline__ int c_lds(int row, int chunk) { return row * 512 + ((chunk ^ ((row & 7) << 1)) * 16); }

__device__ __forceinline__ void phase_sparse_attn(Frame& F) {
    const int lane_ = lane_id(), tid_ = F.wave * 64 + lane_;
    const bf16* qlat = (const bf16*)(F.ws + WS_QLAT); const bf16* ckvn = (const bf16*)(F.ws + WS_CKVN);
    const unsigned short* selb = (const unsigned short*)(F.ws + WS_SEL); bf16* olat = (bf16*)(F.ws + WS_OLAT);
    const int lane = lane_, fq = lane >> 4, j16 = lane & 15;
    LAS unsigned char* cb = F.lds + F.wave * 16384;
    const float sl2 = 0.08838834764831845f * 1.4426950408889634f;
    const int xh = (F.G % 8 == 0) ? ((F.bid & 7) >> 2) : 0, nsplit = (F.G % 8 == 0) ? 2 : 1;
    const int wloc = (F.G % 8 == 0) ? (((F.bid >> 3) * 4 + (F.bid & 3)) * NWAVES + F.wave) : (F.bid * NWAVES + F.wave);
    const int nwl = (F.G % 8 == 0) ? (F.G / 2) * NWAVES : F.G * NWAVES;
    const int ntk = NTOK / nsplit;
    for (int tl = wloc; tl < ntk; tl += nwl) {
        const int t = xh * ntk + tl, b = t / SEQ, pos = t % SEQ;
        const int nvalid = (pos + 1 < TOPK) ? pos + 1 : TOPK;
        const unsigned short* sel = selb + (size_t)t * TOPK;
        bf16x8 Qb[8];
#pragma unroll
        for (int ks = 0; ks < 8; ++ks) { bf16x8 z = {0, 0, 0, 0, 0, 0, 0, 0}; if (j16 < 8) z = *(const bf16x8*)(qlat + ((size_t)t * 8 + j16) * 256 + ks * 32 + 8 * fq); Qb[ks] = z; }
        float mrun = -INFINITY, lrun = 0.f;
        f32x4 O[16];
#pragma unroll
        for (int rt = 0; rt < 16; ++rt) O[rt] = (f32x4){0.f, 0.f, 0.f, 0.f};
        const int nch = (nvalid + 31) >> 5;
        for (int c = 0; c < nch; ++c) {
            u32x4 gv[16];
#pragma unroll
            for (int it = 0; it < 16; ++it) { const int row = 2 * it + (lane >> 5); int key = sel[c * 32 + row]; key = (key >= SEQ) ? 0 : key;
                gv[it] = *(const u32x4*)(ckvn + ((size_t)b * SEQ + key) * 256 + (lane & 31) * 8); }
#pragma unroll
            for (int it = 0; it < 16; ++it) { const int row = 2 * it + (lane >> 5); *(LAS u32x4*)(cb + c_lds(row, lane & 31)) = gv[it]; }
            LDS_WAIT();
            f32x4 Sa = {0.f, 0.f, 0.f, 0.f}, Sb = {0.f, 0.f, 0.f, 0.f};
#pragma unroll
            for (int ks = 0; ks < 8; ++ks) {
                const bf16x8 a0 = *(const LAS bf16x8*)(cb + c_lds(j16, 4 * ks + fq));
                const bf16x8 a1 = *(const LAS bf16x8*)(cb + c_lds(16 + j16, 4 * ks + fq));
                Sa = __builtin_amdgcn_mfma_f32_16x16x32_bf16(a0, Qb[ks], Sa, 0, 0, 0);
                Sb = __builtin_amdgcn_mfma_f32_16x16x32_bf16(a1, Qb[ks], Sb, 0, 0, 0);
            }
            float xa[4], xb[4]; float cm = -INFINITY;
#pragma unroll
            for (int r = 0; r < 4; ++r) { const int ka = c * 32 + 4 * fq + r, kb2 = ka + 16;
                xa[r] = (ka < nvalid) ? Sa[r] * sl2 : -INFINITY; xb[r] = (kb2 < nvalid) ? Sb[r] * sl2 : -INFINITY; cm = fmaxf(cm, fmaxf(xa[r], xb[r])); }
            cm = fmaxf(cm, __shfl_xor(cm, 16)); cm = fmaxf(cm, __shfl_xor(cm, 32));
            const float mnew = fmaxf(mrun, cm);
            const float alpha = __builtin_amdgcn_exp2f(mrun - mnew);
            float ps = 0.f; f32x4 pa, pb;
#pragma unroll
            for (int r = 0; r < 4; ++r) { pa[r] = __builtin_amdgcn_exp2f(xa[r] - mnew); pb[r] = __builtin_amdgcn_exp2f(xb[r] - mnew); ps += pa[r] + pb[r]; }
            ps += __shfl_xor(ps, 16); ps += __shfl_xor(ps, 32);
            lrun = lrun * alpha + ps; mrun = mnew;
            const u32x4 pw = pack8(pa, pb); const bf16x8 Pb = __builtin_bit_cast(bf16x8, pw);
#pragma unroll
            for (int rt = 0; rt < 16; ++rt) O[rt] = O[rt] * alpha;
            const int q4 = j16 >> 2, p4 = j16 & 3;
#pragma unroll
            for (int rt = 0; rt < 16; ++rt) {
                const int ra = 4 * fq + q4, rb = 16 + 4 * fq + q4, ch = 2 * rt + (p4 >> 1);
                const s16x4 lo = __builtin_bit_cast(s16x4, __builtin_amdgcn_ds_read_tr16_b64_v4i16((LAS s16x4*)(cb + c_lds(ra, ch) + 8 * (p4 & 1))));
                const s16x4 hi = __builtin_bit_cast(s16x4, __builtin_amdgcn_ds_read_tr16_b64_v4i16((LAS s16x4*)(cb + c_lds(rb, ch) + 8 * (p4 & 1))));
                const bf16x8 af = {lo[0], lo[1], lo[2], lo[3], hi[0], hi[1], hi[2], hi[3]};
                O[rt] = __builtin_amdgcn_mfma_f32_16x16x32_bf16(af, Pb, O[rt], 0, 0, 0);
            }
            LDS_WAIT();
        }
        const float inv = 1.0f / lrun;
        if (j16 < 8) {
            bf16* orow = olat + ((size_t)t * 8 + j16) * 256 + 4 * fq;
#pragma unroll
            for (int rt = 0; rt < 16; ++rt) { u32x2 o; o.x = pk2(O[rt][0] * inv, O[rt][1] * inv); o.y = pk2(O[rt][2] * inv, O[rt][3] * inv); *(u32x2*)(orow + rt * 16) = o; }
        }
    }
}

__device__ __forceinline__ void routing_token(const float acc, const int lane, const float* rbias, int* tk_e, float* tk_w, LAS unsigned* hist, const size_t t, const bool do_count) {
    const float sc = 1.0f / (1.0f + expf(-acc));
    const float ch = sc + rbias[lane];
    int rk = 0;
#pragma unroll
    for (int k = 1; k < 8; ++k) { const int src = (lane & ~7) | ((lane + k) & 7); const float o = __shfl(ch, src); rk += (o > ch || (o == ch && src < lane)) ? 1 : 0; }
    float gs = (rk < 2) ? ch : 0.f; gs += __shfl_xor(gs, 1); gs += __shfl_xor(gs, 2); gs += __shfl_xor(gs, 4);
    int grk = 0; const int myg = lane >> 3;
#pragma unroll
    for (int g = 0; g < 8; ++g) { const float o = __shfl(gs, g * 8); grk += (o > gs || (o == gs && g < myg)) ? 1 : 0; }
    const float cm = (grk < 4) ? ch : -INFINITY;
    int erk = 0;
    for (int j = 0; j < 64; ++j) { const float o = __shfl(cm, j); erk += (o > cm || (o == cm && j < lane)) ? 1 : 0; }
    const bool selx = (erk < EK) && (grk < 4);
    const float ssum = wave_sum(selx ? sc : 0.f);
    if (selx) { tk_e[t * 8 + erk] = lane; tk_w[t * 8 + erk] = sc / ssum * 2.5f; if (do_count) __hip_atomic_fetch_add(&hist[lane], 1u, __ATOMIC_RELAXED, __HIP_MEMORY_SCOPE_WORKGROUP); }
}
__device__ __forceinline__ void phase_ln1_router(Frame& F, const float* g1, const float* b1, const float* rbias, const bool do_count) {
    const int lane_ = lane_id(), tid_ = F.wave * 64 + lane_;
    const float* pre = F.out;
    const float* wrT = (const float*)(F.ws + WS_WRT);
    bf16* h = (bf16*)(F.ws + WS_H);
    int* tk_e = (int*)(F.ws + WS_TOPK + TK_E); float* tk_w = (float*)(F.ws + WS_TOPK + TK_W);
    const int lane = lane_, w = F.wave, tid = tid_;
    LAS float* stats = (LAS float*)F.lds;
    LAS float* lg = (LAS float*)(F.lds + 1024) + (w & 3) * 1024;
    LAS unsigned* hist = (LAS unsigned*)(F.lds + 1024 + 16384);
    if (do_count && tid < 64) hist[tid] = 0u;
    for (int chunk = F.bid; chunk < NTOK / 64; chunk += F.G) {
        __syncthreads();
        for (int i = 0; i < 8; ++i) {
            const int tl = w * 8 + i; const size_t t = (size_t)chunk * 64 + tl;
            f32x4 v[8]; float s = 0.f;
#pragma unroll
            for (int q = 0; q < 8; ++q) { v[q] = *(const f32x4*)(pre + t * DM + (lane + 64 * q) * 4); s += (v[q][0] + v[q][1]) + (v[q][2] + v[q][3]); }
            const float mean = wave_sum(s) * (1.0f / DM); float s2 = 0.f;
#pragma unroll
            for (int q = 0; q < 8; ++q) { v[q] = v[q] - mean; s2 += (v[q][0] * v[q][0] + v[q][1] * v[q][1]) + (v[q][2] * v[q][2] + v[q][3] * v[q][3]); }
            const float rstd = 1.0f / sqrtf(wave_sum(s2) * (1.0f / DM) + LN_EPS);
#pragma unroll
            for (int q = 0; q < 8; ++q) { const int c = (lane + 64 * q) * 4; const f32x4 gg = *(const f32x4*)(g1 + c), bb = *(const f32x4*)(b1 + c);
                const f32x4 y = v[q] * rstd * gg + bb;
                u32x2 o; o.x = pk2(y[0], y[1]); o.y = pk2(y[2], y[3]); *(u32x2*)(h + t * DM + c) = o; }
            if (lane == 0) { stats[tl * 2] = mean; stats[tl * 2 + 1] = rstd; }
        }
        __syncthreads();
        if (w < 4) {
            const int j16 = lane & 15, kq = lane >> 4, tl = 16 * w + j16;
            const float mean = stats[tl * 2], rstd = stats[tl * 2 + 1];
            const float* prow = pre + ((size_t)chunk * 64 + tl) * DM + 4 * kq; const float* wrow = wrT + (size_t)j16 * DM + 4 * kq;
            f32x4 acc[4];
#pragma unroll
            for (int tt = 0; tt < 4; ++tt) acc[tt] = (f32x4){0.f, 0.f, 0.f, 0.f};
#pragma unroll 2
            for (int m = 0; m < 128; ++m) {
                const f32x4 p = *(const f32x4*)(prow + 16 * m), gg = *(const f32x4*)(g1 + 16 * m + 4 * kq), bb = *(const f32x4*)(b1 + 16 * m + 4 * kq);
                const f32x4 hv = (p - mean) * rstd * gg + bb;
                f32x4 wv[4];
#pragma unroll
                for (int tt = 0; tt < 4; ++tt) wv[tt] = *(const f32x4*)(wrow + (size_t)tt * 16 * DM + 16 * m);
#pragma unroll
                for (int e = 0; e < 4; ++e)
#pragma unroll
                    for (int tt = 0; tt < 4; ++tt) acc[tt] = __builtin_amdgcn_mfma_f32_16x16x4f32(hv[e], wv[tt][e], acc[tt], 0, 0, 0);
            }
#pragma unroll
            for (int tt = 0; tt < 4; ++tt)
#pragma unroll
                for (int r = 0; r < 4; ++r) lg[(4 * kq + r) * 64 + 16 * tt + j16] = acc[tt][r];
            LDS_WAIT();
            for (int tk = 0; tk < 16; ++tk) routing_token(lg[tk * 64 + lane], lane, rbias, tk_e, tk_w, hist, (size_t)chunk * 64 + 16 * w + tk, do_count);
        }
    }
}
__device__ __forceinline__ void phase_flush_hist(Frame& F) {
    const int tid = F.wave * 64 + lane_id();
    LAS unsigned* hist = (LAS unsigned*)(F.lds + 1024 + 16384);
    __syncthreads();
    if (tid < 64 && hist[tid]) atomicAdd(F.ctl + CW_CNT + tid, hist[tid]);
}

__device__ __forceinline__ void phase_scatter(Frame& F) {
    const int lane_ = lane_id(), tid_ = F.wave * 64 + lane_;
    const int tid = tid_;
    LAS int* segs = (LAS int*)F.lds;
    LAS unsigned* lcnt = (LAS unsigned*)(F.lds + 1024);
    LAS unsigned* lbase = (LAS unsigned*)(F.lds + 2048);
    const int* tk_e = (const int*)(F.ws + WS_TOPK + TK_E); int* tk_pos = (int*)(F.ws + WS_TOPK + TK_POS);
    int* rowlist = (int*)(F.ws + WS_TOPK + TK_ROWLIST); int* mtt = (int*)(F.ws + WS_TOPK + TK_MTT);
    if (tid == 0) { int a = 0; for (int e = 0; e < NE; ++e) { segs[e] = a; a += (int)__hip_atomic_load(F.ctl + CW_CNT + e, RLX_AGENT); } segs[NE] = a; segs[NE + 1] = a + NTOK; }
    __syncthreads();
    if (F.bid == 0) {
        if (tid == 0) { int mt = 0;
            for (int g = 0; g < NGRP; ++g) { const int p0 = segs[g], n = segs[g + 1] - p0;
                for (int r = 0; r < n; r += 256) { mtt[mt * 4 + 0] = g; mtt[mt * 4 + 1] = p0 + r; mtt[mt * 4 + 2] = (n - r < 256) ? n - r : 256; mtt[mt * 4 + 3] = 0; ++mt; } }
            __hip_atomic_store(F.ctl + CW_NMT, (unsigned)mt, RLX_AGENT); }
        if (tid < 256) rowlist[NSLOT + tid] = 0;
    }
    const int sh0 = segs[NE];
    for (int chunk = F.bid; chunk < NTOK / 64; chunk += F.G) {
        if (tid < 64) lcnt[tid] = 0u;
        __syncthreads();
        const int t = chunk * 64 + (tid >> 3), k = tid & 7;
        const int e = tk_e[(size_t)t * 8 + k];
        const unsigned li = __hip_atomic_fetch_add(&lcnt[e], 1u, __ATOMIC_RELAXED, __HIP_MEMORY_SCOPE_WORKGROUP);
        __syncthreads();
        if (tid < 64) lbase[tid] = lcnt[tid] ? atomicAdd(F.ctl + CW_FILL + tid, lcnt[tid]) : 0u;
        __syncthreads();
        const int p = segs[e] + (int)lbase[e] + (int)li;
        rowlist[p] = t; tk_pos[(size_t)t * 8 + k] = p;
        if (tid < 64) rowlist[sh0 + chunk * 64 + tid] = chunk * 64 + tid;
        __syncthreads();
    }
}

__device__ __forceinline__ void phase_combine(Frame& F, const float* g2, const float* b2) {
    const int lane_ = lane_id(), tid_ = F.wave * 64 + lane_;
    const bf16* h = (const bf16*)(F.ws + WS_H); const bf16* Y = (const bf16*)(F.ws + WS_Y);
    const float* tk_w = (const float*)(F.ws + WS_TOPK + TK_W); const int* tk_pos = (const int*)(F.ws + WS_TOPK + TK_POS);
    const int gw = F.bid * NWAVES + F.wave, NGW = F.G * NWAVES, lane = lane_;
    for (int t = gw; t < NTOK; t += NGW) {
        f32x4 a[4][2];
#pragma unroll
        for (int i = 0; i < 4; ++i) { f32x4 x0, x1; unpack8(*(const u32x4*)(h + (size_t)t * DM + (lane + 64 * i) * 8), x0, x1); a[i][0] = x0 * DN_ALPHA; a[i][1] = x1 * DN_ALPHA; }
#pragma unroll
        for (int k = 0; k < 9; ++k) {
            const int p = (k < 8) ? tk_pos[(size_t)t * 8 + k] : NTOK * 8 + t; const float wk = (k < 8) ? tk_w[(size_t)t * 8 + k] : 1.0f;
#pragma unroll
            for (int i = 0; i < 4; ++i) { f32x4 y0, y1; unpack8(*(const u32x4*)(Y + (size_t)p * DM + (lane + 64 * i) * 8), y0, y1); a[i][0] += y0 * wk; a[i][1] += y1 * wk; }
        }
        float s = 0.f;
#pragma unroll
        for (int i = 0; i < 4; ++i) s += ((a[i][0][0] + a[i][0][1]) + (a[i][0][2] + a[i][0][3])) + ((a[i][1][0] + a[i][1][1]) + (a[i][1][2] + a[i][1][3]));
        const float mean = wave_sum(s) * (1.0f / DM); float s2 = 0.f;
#pragma unroll
        for (int i = 0; i < 4; ++i) { a[i][0] = a[i][0] - mean; a[i][1] = a[i][1] - mean;
            s2 += ((a[i][0][0] * a[i][0][0] + a[i][0][1] * a[i][0][1]) + (a[i][0][2] * a[i][0][2] + a[i][0][3] * a[i][0][3])) + ((a[i][1][0] * a[i][1][0] + a[i][1][1] * a[i][1][1]) + (a[i][1][2] * a[i][1][2] + a[i][1][3] * a[i][1][3])); }
        const float rstd = 1.0f / sqrtf(wave_sum(s2) * (1.0f / DM) + LN_EPS);
#pragma unroll
        for (int i = 0; i < 4; ++i) { const int c = (lane + 64 * i) * 8;
            const f32x4 ga = *(const f32x4*)(g2 + c), gb = *(const f32x4*)(g2 + c + 4), ba = *(const f32x4*)(b2 + c), bb = *(const f32x4*)(b2 + c + 4);
            *(f32x4*)(F.out + (size_t)t * DM + c) = a[i][0] * rstd * ga + ba; *(f32x4*)(F.out + (size_t)t * DM + c + 4) = a[i][1] * rstd * gb + bb; }
    }
}

constexpr int NPHASE = 16;
constexpr unsigned REPEAT_MASK = 0x0u;
struct Args { const float* in[24]; float* out; unsigned char* ws; int ph_lo, ph_hi; };

__global__ void __launch_bounds__(NTHR, 2) mk_fwd(Args args) {
    extern __shared__ __attribute__((aligned(16))) unsigned char lds_raw[];
    Frame F;
    F.lds = (LAS unsigned char*)lds_raw;
    F.MISC = (volatile LAS unsigned*)(F.lds + MISC_OFF);
    F.wave = __builtin_amdgcn_readfirstlane(threadIdx.x >> 6);
    F.G = gridDim.x; F.bid = blockIdx.x;
    F.ws = args.ws; F.ctl = (unsigned*)(args.ws + WS_CTL); F.out = args.out;
    for (int u = threadIdx.x; u < (LDS_BYTES - MISC_OFF) / 4; u += NTHR) ((LAS unsigned*)(F.lds + MISC_OFF))[u] = 0u;
    __syncthreads();
    const int lo = args.ph_lo, hi = args.ph_hi;
    const bool multi = (hi - lo) > 1;
    XcdBarrier bar; bar.bar = F.ctl + CW_BAR; bar.x = 0; bar.st = nullptr; bar.wave = F.wave;
    if (multi) bar = xcd_barrier_post(F.ctl + CW_BAR, F.MISC + 8, F.wave);
#ifndef ONLY_PHASE
#define ONLY_PHASE -1
#endif
#define IN(k) ((ONLY_PHASE < 0 || ONLY_PHASE == (k)) && lo <= (k) && (k) < hi)
#define SEAM(k) do { if (IN(k) && IN((k) + 1)) xcd_barrier(bar); } while (0)
    unsigned char* ws = args.ws;

    if (IN(0)) for (int rep_ = 0; rep_ < 1 + (int)((REPEAT_MASK >> 0) & 1u); ++rep_) { phase_convert_small(F, args.in[0], args.in[1], args.in[5], args.in[6], args.in[7], args.in[9], args.in[10], args.in[11], args.in[8], args.in[14]); } SEAM(0);

    if (IN(1)) for (int rep_ = 0; rep_ < 1 + (int)((REPEAT_MASK >> 1) & 1u); ++rep_) {
        FillPlain f{(const char*)(ws + WS_XB), (const char*)(ws + WS_WIN), 4096u, 4096u, 32};
        DenseSched<FillPlain> S{64, 30, F.G, F.bid, f};
        EpiP1 E{(bf16*)(ws + WS_Q), (bf16*)(ws + WS_QI), (bf16*)(ws + WS_XP), (bf16*)(ws + WS_GATES), (float*)(ws + WS_CKVRAW), (float*)(ws + WS_KIWI)};
        pg8::gemm_phase<EpiP1, DenseSched<FillPlain>, false, true, true>(F.lds, F.wave, 4096u, 4096u, S, E);
    } SEAM(1);

    if (IN(2)) for (int rep_ = 0; rep_ < 1 + (int)((REPEAT_MASK >> 2) & 1u); ++rep_) { phase_postproc(F, args.in[2], args.in[3], args.in[4]); } SEAM(2);

    if (IN(3)) for (int rep_ = 0; rep_ < 1 + (int)((REPEAT_MASK >> 3) & 1u); ++rep_) {
        FillQlatPool f{(const char*)(ws + WS_Q), (const char*)(ws + WS_DIFF), (const char*)(ws + WS_WUK), (const char*)(ws + WS_WPOOL)};
        DenseSched<FillQlatPool> S{64, 12, F.G, F.bid, f};
        EpiQlatPool E{(bf16*)(ws + WS_QLAT), (bf16*)(ws + WS_POOL), (const float*)(ws + WS_CSCALE)};
        pg8::gemm_phase<EpiQlatPool, DenseSched<FillQlatPool>, false, true, true>(F.lds, F.wave, 2048u, 512u, S, E);
    } SEAM(3);

    if (IN(4)) for (int rep_ = 0; rep_ < 1 + (int)((REPEAT_MASK >> 4) & 1u); ++rep_) { phase_index_scores(F); } SEAM(4);
    if (IN(5)) for (int rep_ = 0; rep_ < 1 + (int)((REPEAT_MASK >> 5) & 1u); ++rep_) { phase_select(F); } SEAM(5);
    if (IN(6)) for (int rep_ = 0; rep_ < 1 + (int)((REPEAT_MASK >> 6) & 1u); ++rep_) { phase_sparse_attn(F); } SEAM(6);

    if (IN(7)) for (int rep_ = 0; rep_ < 1 + (int)((REPEAT_MASK >> 7) & 1u); ++rep_) {
        FillO f{(const char*)(ws + WS_OLAT), (const char*)(ws + WS_WUV)};
        DenseSched<FillO> S{64, 4, F.G, F.bid, f};
        EpiBf16 E{(bf16*)(ws + WS_ATTN), 1024};
        pg8::gemm_phase<EpiBf16, DenseSched<FillO>, false, true, true>(F.lds, F.wave, 4096u, 1024u, S, E);
    } SEAM(7);

    if (IN(8)) for (int rep_ = 0; rep_ < 1 + (int)((REPEAT_MASK >> 8) & 1u); ++rep_) {
        FillPlain f{(const char*)(ws + WS_ATTN), (const char*)(ws + WS_WPA), 2048u, 2048u, 16};
        DenseSched<FillPlain> S{64, 8, F.G, F.bid, f};
        EpiGate<0> E{(const bf16*)(ws + WS_GATES), (bf16*)(ws + WS_M1), (bf16*)(ws + WS_MERGED)};
        pg8::gemm_phase<EpiGate<0>, DenseSched<FillPlain>, false, true, true>(F.lds, F.wave, 2048u, 2048u, S, E);
    } SEAM(8);

    if (IN(9)) for (int rep_ = 0; rep_ < 1 + (int)((REPEAT_MASK >> 9) & 1u); ++rep_) {
        FillPlain f{(const char*)(ws + WS_POOL), (const char*)(ws + WS_WPP), 2048u, 2048u, 16};
        DenseSched<FillPlain> S{64, 8, F.G, F.bid, f};
        EpiGate<1> E{(const bf16*)(ws + WS_GATES), (bf16*)(ws + WS_M1), (bf16*)(ws + WS_MERGED)};
        pg8::gemm_phase<EpiGate<1>, DenseSched<FillPlain>, false, true, true>(F.lds, F.wave, 2048u, 2048u, S, E);
    } SEAM(9);

    if (IN(10)) for (int rep_ = 0; rep_ < 1 + (int)((REPEAT_MASK >> 10) & 1u); ++rep_) {
        FillPlain f{(const char*)(ws + WS_MERGED), (const char*)(ws + WS_WOUT), 4096u, 4096u, 32};
        DenseSched<FillPlain> S{64, 8, F.G, F.bid, f};
        EpiPre E{args.in[0], F.out};
        pg8::gemm_phase<EpiPre, DenseSched<FillPlain>, false, true, true>(F.lds, F.wave, 4096u, 4096u, S, E);
    } SEAM(10);

    if (IN(11)) for (int rep_ = 0; rep_ < 1 + (int)((REPEAT_MASK >> 11) & 1u); ++rep_) {
        for (int rl_ = 0; rl_ < 1 + (int)((REPEAT_MASK >> 17) & 1u); ++rl_) phase_ln1_router(F, args.in[12], args.in[13], args.in[15], rl_ == 0);
        phase_convert_experts(F, args.in[16], args.in[17], args.in[18], args.in[19], args.in[20], args.in[21]);
        phase_flush_hist(F);
    } SEAM(11);
    if (IN(12)) for (int rep_ = 0; rep_ < 1 + (int)((REPEAT_MASK >> 12) & 1u); ++rep_) { phase_scatter(F); } SEAM(12);

    if (IN(13)) for (int rep_ = 0; rep_ < 1 + (int)((REPEAT_MASK >> 13) & 1u); ++rep_) {
        const int nmt = (int)__hip_atomic_load(F.ctl + CW_NMT, RLX_AGENT);
        MoeSched S{(const int*)(ws + WS_TOPK + TK_MTT), nmt, 4, F.G, F.bid, true, (const char*)(ws + WS_H), (const char*)(ws + WS_HBUF), (const char*)(ws + WS_WGU), (const char*)(ws + WS_WD), (const int*)(ws + WS_TOPK + TK_ROWLIST)};
        EpiSwiGLU E{(bf16*)(ws + WS_HBUF)};
        pg8::gemm_phase<EpiSwiGLU, MoeSched, true, true, true>(F.lds, F.wave, 4096u, 4096u, S, E);
    } SEAM(13);

    if (IN(14)) for (int rep_ = 0; rep_ < 1 + (int)((REPEAT_MASK >> 14) & 1u); ++rep_) {
        const int nmt = (int)__hip_atomic_load(F.ctl + CW_NMT, RLX_AGENT);
        MoeSched S{(const int*)(ws + WS_TOPK + TK_MTT), nmt, 8, F.G, F.bid, false, (const char*)(ws + WS_H), (const char*)(ws + WS_HBUF), (const char*)(ws + WS_WGU), (const char*)(ws + WS_WD), (const int*)(ws + WS_TOPK + TK_ROWLIST)};
        EpiY E{(bf16*)(ws + WS_Y)};
        pg8::gemm_phase<EpiY, MoeSched, false, true, true>(F.lds, F.wave, 1024u, 1024u, S, E);
    } SEAM(14);

    if (IN(15)) for (int rep_ = 0; rep_ < 1 + (int)((REPEAT_MASK >> 15) & 1u); ++rep_) { phase_combine(F, args.in[22], args.in[23]); }
#undef IN
#undef SEAM
}

#ifndef MK_ONE_LAUNCH
#define MK_ONE_LAUNCH 1
#endif
extern "C" void kernel_launch(void* const* d_in, const int* in_sizes, int n_in, void* d_out, int out_size, void* d_ws, size_t ws_size, hipStream_t stream) {
    static int grid = 0;
    if (grid == 0) {
        if (n_in != 24 || out_size != NTOK * DM || ws_size < WS_END) { fprintf(stderr, "kernel_launch: unexpected shapes (n_in %d out %d ws %zu)\n", n_in, out_size, ws_size); grid = -1; return; }
        int dev = 0, cus = 0;
        if (hipGetDevice(&dev) != hipSuccess || hipDeviceGetAttribute(&cus, hipDeviceAttributeMultiprocessorCount, dev) != hipSuccess) { grid = -1; return; }
        if (hipFuncSetAttribute((const void*)mk_fwd, hipFuncAttributeMaxDynamicSharedMemorySize, LDS_BYTES) != hipSuccess) { fprintf(stderr, "kernel_launch: hipFuncSetAttribute failed\n"); grid = -1; return; }
        int per_cu = 0;
        if (hipOccupancyMaxActiveBlocksPerMultiprocessor(&per_cu, (const void*)mk_fwd, NTHR, LDS_BYTES) != hipSuccess || per_cu < 1) fprintf(stderr, "kernel_launch: occupancy query says %d\n", per_cu);
        (void)hipGetLastError();
        grid = cus;
    }
    if (grid < 0) return;
    if (hipMemsetAsync((char*)d_ws + WS_CTL, 0, CTL_BYTES, stream) != hipSuccess) return;
    Args a{};
    for (int i = 0; i < 24; ++i) a.in[i] = (const float*)d_in[i];
    a.out = (float*)d_out; a.ws = (unsigned char*)d_ws;
#if MK_ONE_LAUNCH
    a.ph_lo = 0; a.ph_hi = NPHASE;
    hipLaunchKernelGGL(mk_fwd, dim3(grid), dim3(NTHR), LDS_BYTES, stream, a);
#else
    for (int p = 0; p < NPHASE; ++p) { a.ph_lo = p; a.ph_hi = p + 1; hipLaunchKernelGGL(mk_fwd, dim3(grid), dim3(NTHR), LDS_BYTES, stream, a); }
#endif
}
```

```cpp
#include <hip/hip_runtime.h>
#include <cstdio>
#include <cstdint>

#define LAS __attribute__((address_space(3)))
#define GAS __attribute__((address_space(1)))
typedef unsigned short bf16;
typedef short bf16x8 __attribute__((ext_vector_type(8)));
typedef short s16x4 __attribute__((ext_vector_type(4)));
typedef float f32x4 __attribute__((ext_vector_type(4)));
typedef float f32x2 __attribute__((ext_vector_type(2)));
typedef unsigned u32x4 __attribute__((ext_vector_type(4)));
typedef unsigned u32x2 __attribute__((ext_vector_type(2)));

constexpr int NTOK = 16384, SEQ = 8192, DM = 2048;
constexpr int NH = 8, DQK = 128, DV = 128, RKV = 256, IH = 16, IDH = 64, TOPK = 256;
constexpr int NE = 64, EK = 8, EDIM = 512, NGRP = 65;
constexpr int WIN_ROWS = 7680;
constexpr float LN_EPS = 1e-5f, RMS_EPS = 1e-6f;
constexpr float DN_ALPHA = 1.189207115002721f;
constexpr int NSLOT = NTOK * 9;
constexpr size_t SC_TOT = (size_t)128 * 128 * (64 * 65 / 2);

constexpr size_t MiB = 1u << 20;
constexpr size_t WS_CTL = 0, CTL_BYTES = 1 * MiB;
constexpr size_t WS_WIN = 1 * MiB;
constexpr size_t WS_WUK = 31 * MiB;
constexpr size_t WS_WUV = 32 * MiB;
constexpr size_t WS_WPOOL = 33 * MiB;
constexpr size_t WS_WPA = 34 * MiB;
constexpr size_t WS_WPP = 38 * MiB;
constexpr size_t WS_WOUT = 42 * MiB;
constexpr size_t WS_CSCALE = 50 * MiB;
constexpr size_t WS_WRT = 50 * MiB + 65536;
constexpr size_t WS_XB = 51 * MiB;
constexpr size_t WS_Q = 115 * MiB;
constexpr size_t WS_QI = 147 * MiB;
constexpr size_t WS_XP = 179 * MiB;
constexpr size_t WS_GATES = 211 * MiB;
constexpr size_t WS_CKVRAW = 339 * MiB;
constexpr size_t WS_KIWI = 355 * MiB;
constexpr size_t WS_CKVN = 371 * MiB;
constexpr size_t WS_KIN = 379 * MiB;
constexpr size_t WS_WI = 381 * MiB;
constexpr size_t WS_DIFF = 382 * MiB;
constexpr size_t WS_QLAT = 414 * MiB;
constexpr size_t WS_POOL = 478 * MiB;
constexpr size_t WS_SCORES = 510 * MiB;
constexpr size_t WS_SEL = 770 * MiB;
constexpr size_t WS_OLAT = 778 * MiB;
constexpr size_t WS_ATTN = 842 * MiB;
constexpr size_t WS_M1 = 874 * MiB;
constexpr size_t WS_MERGED = 938 * MiB;
constexpr size_t WS_H = 51 * MiB;
constexpr size_t WS_WD = 115 * MiB;
constexpr size_t WS_HBUF = 245 * MiB;
constexpr size_t WS_TOPK = 390 * MiB;
constexpr size_t WS_WGU = 394 * MiB;
constexpr size_t WS_Y = 394 * MiB;
constexpr size_t WS_END = 1024 * MiB;
static_assert(WS_SCORES + SC_TOT * 2 * 4 <= WS_SEL, "scores");
static_assert(WS_HBUF + (size_t)(NSLOT + 256) * EDIM * 2 <= WS_TOPK, "hbuf");
static_assert(WS_Y + (size_t)NSLOT * DM * 2 <= WS_END, "y");
constexpr size_t TK_E = 0;
constexpr size_t TK_W = 512 * 1024;
constexpr size_t TK_POS = 1024 * 1024;
constexpr size_t TK_ROWLIST = 1536 * 1024;
constexpr size_t TK_MTT = 2560 * 1024;
constexpr size_t TK_WRT = 3 * MiB;
constexpr int CW_BAR = 4096;
constexpr int CW_CNT = 16384;
constexpr int CW_FILL = 16384 + 64;
constexpr int CW_CVQ = 16384 + 192;
constexpr int CW_NMT = 16384 + 128;

constexpr int RING_BYTES = 131072;
constexpr int MISC_OFF = 143360;
constexpr int LDS_BYTES = 147456;
constexpr int NWAVES = 8, NTHR = 512;

#define RLX_AGENT __ATOMIC_RELAXED, __HIP_MEMORY_SCOPE_AGENT
#define LDS_WAIT() asm volatile("s_waitcnt lgkmcnt(0)" ::: "memory")
#define VM_WAIT() asm volatile("s_waitcnt vmcnt(0)" ::: "memory")

__device__ __forceinline__ int lane_id() { return (int)__builtin_amdgcn_mbcnt_hi(~0u, __builtin_amdgcn_mbcnt_lo(~0u, 0u)); }
__device__ __forceinline__ float bf2f(unsigned b) { return __uint_as_float(b << 16); }
__device__ __forceinline__ unsigned f2bf(float f) { unsigned u = __float_as_uint(f); return (u + 0x7fffu + ((u >> 16) & 1u)) >> 16; }
__device__ __forceinline__ unsigned pk2(float lo, float hi) { return f2bf(lo) | (f2bf(hi) << 16); }
__device__ __forceinline__ unsigned cvt_pk_bf16(float lo, float hi) { unsigned r; asm volatile("v_cvt_pk_bf16_f32 %0, %1, %2" : "=v"(r) : "v"(lo), "v"(hi)); return r; }
__device__ __forceinline__ float wave_sum(float v) {
#pragma unroll
    for (int o = 1; o < 64; o <<= 1) v += __shfl_xor(v, o);
    return v;
}
__device__ __forceinline__ int wave_sum_i(int v) {
#pragma unroll
    for (int o = 1; o < 64; o <<= 1) v += __shfl_xor(v, o);
    return v;
}

#define XB_TMO      128
#define XB_XCNT(j)  (256  + 64 * (j))
#define XB_XSUB(j)  (1280 + 64 * (j))
#define XB_XGEN(j)  (2304 + 64 * (j))
#define XB_TOP      3328
#define XB_TOPGEN   3392
#define XCD_BAR_WORDS 3456
#define XB_SPIN_CAP (1u << 24)

__device__ __forceinline__ unsigned xb_ld(unsigned* p)              { return __hip_atomic_load(p, __ATOMIC_RELAXED, __HIP_MEMORY_SCOPE_AGENT); }
__device__ __forceinline__ unsigned xb_add(unsigned* p, unsigned v) { return __hip_atomic_fetch_add(p, v, __ATOMIC_RELAXED, __HIP_MEMORY_SCOPE_AGENT); }
__device__ __forceinline__ unsigned xb_xcc_id() { return (unsigned)__builtin_amdgcn_s_getreg((3 << 11) | 20) & 0xFu; }
#define XB_SPIN(cond, bar) do { unsigned _sp = 0; while (cond) { __builtin_amdgcn_s_sleep(1); \
    if ((++_sp & 255u) == 0u) { if (xb_ld(&(bar)[XB_TMO])) break; if (_sp > XB_SPIN_CAP) { atomicAdd(&(bar)[XB_TMO], 1u); break; } } } } while (0)

struct XcdBarrier { unsigned* bar; unsigned x; volatile LAS unsigned* st; int wave; };

__device__ __forceinline__ XcdBarrier xcd_barrier_post(unsigned* bar, volatile LAS unsigned* st, int wave) {
    XcdBarrier b; b.bar = bar; b.x = xb_xcc_id(); b.st = st; b.wave = wave;
    if (wave == 0 && lane_id() == 0) (void)xb_add(&bar[XB_XCNT(b.x)], 1u);
    return b;
}
__device__ __forceinline__ void xcd_barrier_complete(unsigned* bar, unsigned x, unsigned& nloc, unsigned& nx) {
    const unsigned G = gridDim.x * gridDim.y * gridDim.z;
    unsigned sum, cnt, mine, sp = 0u;
    for (;;) {
        sum = 0u; cnt = 0u; mine = 0u;
#pragma unroll
        for (unsigned j = 0; j < 16; ++j) { const unsigned c = xb_ld(&bar[XB_XCNT(j)]); sum += c; cnt += (c > 0u) ? 1u : 0u; mine = (j == x) ? c : mine; }
        if (sum == G) break;
        __builtin_amdgcn_s_sleep(1);
        if ((++sp & 255u) == 0u) { if (xb_ld(&bar[XB_TMO])) break; if (sp > XB_SPIN_CAP) { atomicAdd(&bar[XB_TMO], 1u); break; } }
    }
    nloc = mine > 0u ? mine : 1u; nx = cnt > 0u ? cnt : 1u;
}
__device__ __forceinline__ void xcd_barrier(const XcdBarrier& b) {
    asm volatile("s_waitcnt vmcnt(0)" ::: "memory");
    __syncthreads();
    if (b.wave == 0 && lane_id() == 0) {
        unsigned* bar = b.bar;
        __builtin_amdgcn_s_waitcnt(0);
        unsigned nloc = b.st[0], nx = b.st[1];
        if (nloc == 0u) { xcd_barrier_complete(bar, b.x, nloc, nx); b.st[0] = nloc; b.st[1] = nx; }
        const unsigned old = xb_add(&bar[XB_XSUB(b.x)], 1u);
        const unsigned gen = old / nloc;
        if (old + 1u == (gen + 1u) * nloc) {
            __builtin_amdgcn_fence(__ATOMIC_RELEASE, "agent");
            asm volatile("s_waitcnt vmcnt(0)" ::: "memory");
            const unsigned og = xb_add(&bar[XB_TOP], 1u);
            const unsigned tg = og / nx;
            if (og + 1u == (tg + 1u) * nx) xb_add(&bar[XB_TOPGEN], 1u);
            else XB_SPIN(xb_ld(&bar[XB_TOPGEN]) == tg, bar);
            __builtin_amdgcn_fence(__ATOMIC_ACQUIRE, "agent");
            xb_add(&bar[XB_XGEN(b.x)], 1u);
            asm volatile("s_waitcnt vmcnt(0)" ::: "memory");
        } else {
            XB_SPIN(xb_ld(&bar[XB_XGEN(b.x)]) == gen, bar);
            __builtin_amdgcn_fence(__ATOMIC_ACQUIRE, "agent");
            asm volatile("s_waitcnt vmcnt(0)" ::: "memory");
        }
    }
    __syncthreads();
}

namespace pg8 {
constexpr int BM = 256, BK = 64, HALF = 128, HTB = HALF * BK * 2, STAGE_BYTES = 8 * HTB, NXCD = 8, WGM = 8;

__host__ __device__ __forceinline__ int lds_byte(int r, int c) { const int st = (r >> 4) * 2 + (c >> 5), rr = r & 15, cc = c & 31, ob = rr * 64 + cc * 2; return st * 1024 + (ob ^ (((ob >> 9) & 1) << 5)); }
__host__ __device__ __forceinline__ void stage_rc(int b, int& R, int& C) { const int st = b / 1024, sb = b % 1024, swz = sb ^ (((sb >> 9) & 1) << 5); R = (st >> 1) * 16 + swz / 64; C = (st & 1) * 32 + (swz % 64) / 2; }
__host__ __device__ __forceinline__ int perm32(int rho) { const int n = rho >> 4, i = rho & 15; return 8 * (i >> 2) + 4 * n + (i & 3); }

struct GUnit {
    const char* A;
    const char* B0;
    const char* B1;
    const int* rows;
    int nt;
    int pm, pn, aux0, aux1;
};

__device__ __forceinline__ void tile_order(int L, int nM, int nN, int& pm, int& pn) {
    const int nwg = nM * nN;
    int wgid = L; { const int q = nwg / NXCD, r = nwg % NXCD, xcd = wgid % NXCD, off = wgid / NXCD; wgid = (xcd < r ? xcd * (q + 1) : r * (q + 1) + (xcd - r) * q) + off; }
    const int nig = WGM * nN, gid = wgid / nig, fm = gid * WGM, gsz = (nM - fm) < WGM ? (nM - fm) : WGM;
    pm = fm + ((wgid % nig) % gsz); pn = (wgid % nig) / gsz;
}

template <class Epi, class Sched, bool GATHER, bool ALIGN_EPI, bool SP2>
__device__ __forceinline__ void gemm_phase(LAS unsigned char* lds, const int wave, const unsigned a_rs, const unsigned b_rs, const Sched& S, const Epi& E) {
    const int wid = wave, lane = lane_id(), tid = wid * 64 + lane, wr = wid >> 2, wc = wid & 3, fr = lane & 15, fq = lane >> 4;
    int R0, C0; stage_rc(tid * 16, R0, C0);
    unsigned voffA[2], voffB[2];
#pragma unroll
    for (int i = 0; i < 2; ++i) { const int R = R0 + 64 * i; const int Rb = (R & ~31) + perm32(R & 31);
        voffA[i] = (unsigned)R * a_rs + (unsigned)C0 * 2u; voffB[i] = (unsigned)Rb * b_rs + (unsigned)C0 * 2u; }
    unsigned vgc[2][2], vgn[2][2];
    const size_t kstep = (size_t)(BK * 2);
    const size_t hstepA = (size_t)HALF * a_rs;
    const unsigned ldsw = (unsigned)wid * 1024u;
    const int aoff = lds_byte(wr * 64 + fr, fq * 8), boff = lds_byte(wc * 32 + fr, fq * 8);
#define PG8_SA(b, h) (((b) * 2 + (h)) * HTB)
#define PG8_SB(b, h) ((4 + (b) * 2 + (h)) * HTB)
#define PG8_STAGE(bufoff, gbase, voff) do { _Pragma("unroll") for (int _i = 0; _i < 2; ++_i) \
        __builtin_amdgcn_global_load_lds((const unsigned*)((const char*)(gbase) + (voff)[_i]), (LAS unsigned*)(lds + (bufoff) + ldsw + _i * 8192), 16, 0, 0); } while (0)
#define PG8_STAGE_A(bufoff, gbase, h, vg) do { if constexpr (GATHER) { PG8_STAGE(bufoff, gbase, (vg)[h]); } else { PG8_STAGE(bufoff, (gbase) + (h) * hstepA, voffA); } } while (0)
#define PG8_LDA(dst, b, h) do { _Pragma("unroll") for (int m = 0; m < 4; ++m) _Pragma("unroll") for (int k = 0; k < 2; ++k) dst[m][k] = *(const LAS bf16x8*)(lds + PG8_SA(b, h) + aoff + m * 2048 + k * 1024); } while (0)
#define PG8_LDB(dst, b, h) do { _Pragma("unroll") for (int n = 0; n < 2; ++n) _Pragma("unroll") for (int k = 0; k < 2; ++k) dst[n][k] = *(const LAS bf16x8*)(lds + PG8_SB(b, h) + boff + n * 2048 + k * 1024); } while (0)
#define PG8_MMA(ai, bj, At, Bt) do { __builtin_amdgcn_s_setprio(1); _Pragma("unroll") for (int m = 0; m < 4; ++m) _Pragma("unroll") for (int n = 0; n < 2; ++n) _Pragma("unroll") for (int k = 0; k < 2; ++k) \
        acc[ai][bj][m][n] = __builtin_amdgcn_mfma_f32_16x16x32_bf16(Bt[n][k], At[m][k], acc[ai][bj][m][n], 0, 0, 0); __builtin_amdgcn_s_setprio(0); } while (0)
#define PG8_WAIT_V(n) asm volatile("s_waitcnt vmcnt(" #n ")" ::: "memory")
#define PG8_WAIT_L(n) asm volatile("s_waitcnt lgkmcnt(" #n ")" ::: "memory")
#define PG8_BAR __builtin_amdgcn_s_barrier()
#define PG8_SCHED __builtin_amdgcn_sched_barrier(0)
#define PG8_GOFF(dst, u) do { if constexpr (GATHER) { _Pragma("unroll") for (int _h = 0; _h < 2; ++_h) _Pragma("unroll") for (int _i = 0; _i < 2; ++_i) \
        dst[_h][_i] = (unsigned)(u).rows[_h * HALF + R0 + 64 * _i] * a_rs + (unsigned)C0 * 2u; } } while (0)
    GUnit cur, nxt; int ui = 0;
    if (!S.next(0, cur)) return;
    f32x4 acc[2][2][4][2];
#pragma unroll
    for (int a = 0; a < 2; ++a)
#pragma unroll
        for (int b = 0; b < 2; ++b)
#pragma unroll
            for (int m = 0; m < 4; ++m)
#pragma unroll
                for (int n = 0; n < 2; ++n) acc[a][b][m][n] = (f32x4){0.f, 0.f, 0.f, 0.f};
    bf16x8 At[4][2], B0[2][2], B1[2][2];
    const char* cA = cur.A; const char* cB0 = cur.B0; const char* cB1 = cur.B1; int cnt = cur.nt;
    PG8_GOFF(vgc, cur);
    if constexpr (SP2) {
        PG8_STAGE(PG8_SB(0, 0), cB0, voffB); PG8_STAGE(PG8_SB(0, 1), cB1, voffB); PG8_STAGE_A(PG8_SA(0, 0), cA, 0, vgc); PG8_STAGE_A(PG8_SA(0, 1), cA, 1, vgc);
        if (wr == 1) PG8_BAR;
        PG8_WAIT_V(2); PG8_BAR;
        PG8_STAGE(PG8_SB(1, 0), cB0 + kstep, voffB); PG8_STAGE_A(PG8_SA(1, 0), cA + kstep, 0, vgc); PG8_STAGE(PG8_SB(1, 1), cB1 + kstep, voffB);
        PG8_WAIT_V(6); PG8_BAR;
    } else {
        PG8_STAGE(PG8_SB(0, 0), cB0, voffB); PG8_STAGE_A(PG8_SA(0, 0), cA, 0, vgc); PG8_STAGE(PG8_SB(0, 1), cB1, voffB); PG8_STAGE_A(PG8_SA(0, 1), cA, 1, vgc);
        if (wr == 1) PG8_BAR;
        PG8_WAIT_V(4); PG8_BAR;
        PG8_STAGE(PG8_SB(1, 0), cB0 + kstep, voffB); PG8_STAGE_A(PG8_SA(1, 0), cA + kstep, 0, vgc); PG8_STAGE(PG8_SB(1, 1), cB1 + kstep, voffB);
        PG8_WAIT_V(6); PG8_BAR;
    }
    for (;;) {
        const bool has_next = S.next(ui + 1, nxt);
        const char* nA = has_next ? nxt.A : cA; const char* nB0 = has_next ? nxt.B0 : cB0; const char* nB1 = has_next ? nxt.B1 : cB1;
        if constexpr (GATHER) {
            if (has_next) { PG8_GOFF(vgn, nxt); }
            else {
#pragma unroll
                for (int _h = 0; _h < 2; ++_h)
#pragma unroll
                    for (int _i = 0; _i < 2; ++_i) vgn[_h][_i] = vgc[_h][_i];
            }
        }
        for (int t = 0; t < cnt; t += 2) {
            const bool last = (t == cnt - 2);
            const char* a1 = cA + (size_t)(t + 1) * kstep;
            const char* a2 = last ? nA : cA + (size_t)(t + 2) * kstep;
            const char* b2 = last ? nB0 : cB0 + (size_t)(t + 2) * kstep; const char* b2h = last ? nB1 : cB1 + (size_t)(t + 2) * kstep;
            const char* a3 = a2 + kstep; const char* b3 = b2 + kstep; const char* b3h = b2h + kstep;
            unsigned vg2[2][2];
            if constexpr (GATHER) {
#pragma unroll
                for (int _h = 0; _h < 2; ++_h)
#pragma unroll
                    for (int _i = 0; _i < 2; ++_i) vg2[_h][_i] = last ? vgn[_h][_i] : vgc[_h][_i];
            }
            if constexpr (SP2) {
            PG8_LDB(B0, 0, 0); PG8_LDB(B1, 0, 1); PG8_SCHED; PG8_LDA(At, 0, 0); PG8_STAGE_A(PG8_SA(1, 1), a1, 1, vgc);
            PG8_WAIT_V(8); PG8_WAIT_L(0); PG8_BAR; PG8_MMA(0, 0, At, B0); PG8_MMA(0, 1, At, B1); PG8_BAR; PG8_SCHED;
            PG8_LDA(At, 0, 1); PG8_STAGE(PG8_SB(0, 0), b2, voffB); PG8_STAGE(PG8_SB(0, 1), b2h, voffB); PG8_STAGE_A(PG8_SA(0, 0), a2, 0, vg2);
            PG8_WAIT_V(8); PG8_WAIT_L(0); PG8_BAR; PG8_MMA(1, 0, At, B0); PG8_MMA(1, 1, At, B1); PG8_BAR; PG8_SCHED;
            PG8_LDB(B0, 1, 0); PG8_LDB(B1, 1, 1); PG8_SCHED; PG8_LDA(At, 1, 0); PG8_STAGE_A(PG8_SA(0, 1), a2, 1, vg2);
            PG8_WAIT_V(8); PG8_WAIT_L(0); PG8_BAR; PG8_MMA(0, 0, At, B0); PG8_MMA(0, 1, At, B1); PG8_BAR; PG8_SCHED;
            PG8_LDA(At, 1, 1); PG8_STAGE(PG8_SB(1, 0), b3, voffB); PG8_STAGE(PG8_SB(1, 1), b3h, voffB); PG8_STAGE_A(PG8_SA(1, 0), a3, 0, vg2);
            PG8_WAIT_V(8); PG8_WAIT_L(0); PG8_BAR; PG8_MMA(1, 0, At, B0); PG8_MMA(1, 1, At, B1); PG8_BAR; PG8_SCHED;
            } else {
            PG8_LDB(B0, 0, 0); PG8_SCHED; PG8_LDA(At, 0, 0); PG8_STAGE_A(PG8_SA(1, 1), a1, 1, vgc);
            PG8_WAIT_L(8); PG8_BAR; PG8_WAIT_L(0); PG8_MMA(0, 0, At, B0); PG8_BAR; PG8_SCHED;
            PG8_LDB(B1, 0, 1); PG8_STAGE(PG8_SB(0, 0), b2, voffB);
            PG8_BAR; PG8_WAIT_L(0); PG8_MMA(0, 1, At, B1); PG8_BAR;
            PG8_LDA(At, 0, 1); PG8_STAGE_A(PG8_SA(0, 0), a2, 0, vg2);
            PG8_BAR; PG8_WAIT_L(0); PG8_MMA(1, 0, At, B0); PG8_BAR; PG8_SCHED;
            PG8_STAGE(PG8_SB(0, 1), b2h, voffB);
            PG8_WAIT_V(6); PG8_BAR; PG8_MMA(1, 1, At, B1); PG8_BAR;
            PG8_LDB(B0, 1, 0); PG8_SCHED; PG8_LDA(At, 1, 0); PG8_STAGE_A(PG8_SA(0, 1), a2, 1, vg2);
            PG8_WAIT_L(8); PG8_BAR; PG8_WAIT_L(0); PG8_MMA(0, 0, At, B0); PG8_BAR; PG8_SCHED;
            PG8_LDB(B1, 1, 1); PG8_STAGE(PG8_SB(1, 0), b3, voffB);
            PG8_BAR; PG8_WAIT_L(0); PG8_MMA(0, 1, At, B1); PG8_BAR;
            PG8_LDA(At, 1, 1); PG8_STAGE_A(PG8_SA(1, 0), a3, 0, vg2);
            PG8_BAR; PG8_WAIT_L(0); PG8_MMA(1, 0, At, B0); PG8_BAR; PG8_SCHED;
            PG8_STAGE(PG8_SB(1, 1), b3h, voffB);
            PG8_WAIT_V(6); PG8_BAR; PG8_MMA(1, 1, At, B1); PG8_BAR;
            }
        }
        if constexpr (ALIGN_EPI) { if (wr == 0) PG8_BAR; }
        { int fr2 = fr, fq2 = fq; asm volatile("" : "+v"(fr2), "+v"(fq2)); E(acc, cur, wr, wc, fr2, fq2); }
        if (!has_next) break;
#pragma unroll
        for (int a = 0; a < 2; ++a)
#pragma unroll
            for (int b = 0; b < 2; ++b)
#pragma unroll
                for (int m = 0; m < 4; ++m)
#pragma unroll
                    for (int n = 0; n < 2; ++n) acc[a][b][m][n] = (f32x4){0.f, 0.f, 0.f, 0.f};
        cur = nxt; cA = nA; cB0 = nB0; cB1 = nB1; cnt = cur.nt; ++ui;
        if constexpr (GATHER) {
#pragma unroll
            for (int _h = 0; _h < 2; ++_h)
#pragma unroll
                for (int _i = 0; _i < 2; ++_i) vgc[_h][_i] = vgn[_h][_i];
        }
        if constexpr (ALIGN_EPI) { if (wr == 1) PG8_BAR; }
    }
    PG8_WAIT_V(0);
    if constexpr (!ALIGN_EPI) { if (wr == 0) PG8_BAR; }
    PG8_BAR;
#undef PG8_SA
#undef PG8_SB
#undef PG8_STAGE
#undef PG8_STAGE_A
#undef PG8_LDA
#undef PG8_LDB
#undef PG8_MMA
#undef PG8_WAIT_V
#undef PG8_WAIT_L
#undef PG8_BAR
#undef PG8_SCHED
#undef PG8_GOFF
}
}

struct Frame {
    LAS unsigned char* lds;
    volatile LAS unsigned* MISC;
    unsigned* ctl;
    unsigned char* ws;
    float* out;
    int wave, G, bid;
};
using pg8::GUnit;

template <class Fill> struct DenseSched {
    int nM, nN, G, c; Fill f;
    __device__ __forceinline__ bool next(int i, GUnit& u) const {
        const long L = (long)i * G + c; if (L >= (long)nM * nN) return false;
        int pm, pn; pg8::tile_order((int)L, nM, nN, pm, pn); u.pm = pm; u.pn = pn; u.rows = nullptr; u.aux0 = 0; u.aux1 = 0; f(u); return true;
    }
};
struct FillPlain {
    const char* A; const char* B; unsigned a_rs, b_rs; int nt;
    __device__ __forceinline__ void operator()(GUnit& u) const { u.A = A + (size_t)u.pm * 256 * a_rs; u.B0 = B + (size_t)u.pn * 256 * b_rs; u.B1 = u.B0 + (size_t)128 * b_rs; u.nt = nt; }
};
struct FillQlatPool {
    const char* q; const char* diff; const char* wuk; const char* wpool;
    __device__ __forceinline__ void operator()(GUnit& u) const {
        if (u.pn < 8) { u.A = q + (size_t)u.pm * 256 * 2048 + (size_t)((u.pn & ~1) * 128) * 2; u.B0 = wuk + (size_t)u.pn * 256 * 512; }
        else { const int g = u.pn - 8; u.A = diff + (size_t)u.pm * 256 * 2048 + (size_t)(g * 256) * 2; u.B0 = wpool + (size_t)g * 256 * 512; }
        u.B1 = u.B0 + (size_t)128 * 512; u.nt = 4;
    }
};
struct FillO {
    const char* olat; const char* wuv;
    __device__ __forceinline__ void operator()(GUnit& u) const { u.A = olat + (size_t)u.pm * 256 * 4096 + (size_t)(u.pn * 512) * 2; u.B0 = wuv + (size_t)u.pn * 256 * 1024; u.B1 = u.B0 + (size_t)128 * 1024; u.nt = 8; }
};

#define EPI_LOOP_ROWS for (int ai = 0; ai < 2; ++ai) _Pragma("unroll") for (int m = 0; m < 4; ++m)
__device__ __forceinline__ u32x4 pack8(const f32x4 v0, const f32x4 v1) { u32x4 w; w.x = cvt_pk_bf16(v0[0], v0[1]); w.y = cvt_pk_bf16(v0[2], v0[3]); w.z = cvt_pk_bf16(v1[0], v1[1]); w.w = cvt_pk_bf16(v1[2], v1[3]); return w; }
__device__ __forceinline__ float sigmoidf_(float x) { return 1.0f / (1.0f + __expf(-x)); }

struct EpiP1 {
    bf16* q; bf16* qi; bf16* xp; bf16* gates; float* ckvraw; float* kiwi;
    __device__ __forceinline__ void operator()(const f32x4 (&acc)[2][2][4][2], const GUnit& u, int wr, int wc, int fr, int fq) const {
        const int row0 = u.pm * 256 + wr * 64 + fr, cl = wc * 32 + 8 * fq;
        if (u.pn < 28) {
            bf16* base; int ld, c0; bool sg = false;
            if (u.pn < 4) { base = q; ld = 1024; c0 = u.pn * 256; } else if (u.pn < 8) { base = qi; ld = 1024; c0 = (u.pn - 4) * 256; }
            else if (u.pn < 12) { base = xp; ld = 1024; c0 = (u.pn - 8) * 256; } else { base = gates; ld = 4096; c0 = (u.pn - 12) * 256; sg = true; }
#pragma unroll
            EPI_LOOP_ROWS { bf16* rowp = base + (size_t)(row0 + ai * 128 + m * 16) * ld + c0 + cl;
#pragma unroll
                for (int bj = 0; bj < 2; ++bj) { f32x4 v0 = acc[ai][bj][m][0], v1 = acc[ai][bj][m][1];
                    if (sg) {
#pragma unroll
                        for (int j = 0; j < 4; ++j) { v0[j] = sigmoidf_(v0[j]); v1[j] = sigmoidf_(v1[j]); } }
                    *(u32x4*)(rowp + bj * 128) = pack8(v0, v1); } }
        } else {
            float* base = (u.pn == 28) ? ckvraw : kiwi;
#pragma unroll
            EPI_LOOP_ROWS { float* rowp = base + (size_t)(row0 + ai * 128 + m * 16) * 256 + cl;
#pragma unroll
                for (int bj = 0; bj < 2; ++bj) { *(f32x4*)(rowp + bj * 128) = acc[ai][bj][m][0]; *(f32x4*)(rowp + bj * 128 + 4) = acc[ai][bj][m][1]; } }
        }
    }
};
struct EpiQlatPool {
    bf16* qlat; bf16* pool; const float* colscale;
    __device__ __forceinline__ void operator()(const f32x4 (&acc)[2][2][4][2], const GUnit& u, int wr, int wc, int fr, int fq) const {
        const int row0 = u.pm * 256 + wr * 64 + fr, cl = wc * 32 + 8 * fq;
        const bool ql = u.pn < 8;
        bf16* base = ql ? qlat + u.pn * 256 : pool + (u.pn - 8) * 256; const int ld = ql ? 2048 : 1024;
        const float* sp = colscale + u.pn * 256 + cl;
#pragma unroll
        EPI_LOOP_ROWS { bf16* rowp = base + (size_t)(row0 + ai * 128 + m * 16) * ld + cl;
#pragma unroll
            for (int bj = 0; bj < 2; ++bj) { const f32x4 s0 = *(const f32x4*)(sp + bj * 128), s1 = *(const f32x4*)(sp + bj * 128 + 4);
                *(u32x4*)(rowp + bj * 128) = pack8(acc[ai][bj][m][0] * s0, acc[ai][bj][m][1] * s1); } }
    }
};
struct EpiBf16 {
    bf16* O; int ld;
    __device__ __forceinline__ void operator()(const f32x4 (&acc)[2][2][4][2], const GUnit& u, int wr, int wc, int fr, int fq) const {
        const int row0 = u.pm * 256 + wr * 64 + fr, cl = u.pn * 256 + wc * 32 + 8 * fq;
#pragma unroll
        EPI_LOOP_ROWS { bf16* rowp = O + (size_t)(row0 + ai * 128 + m * 16) * ld + cl;
#pragma unroll
            for (int bj = 0; bj < 2; ++bj) *(u32x4*)(rowp + bj * 128) = pack8(acc[ai][bj][m][0], acc[ai][bj][m][1]); }
    }
};
__device__ __forceinline__ void unpack8(const u32x4 w, f32x4& a, f32x4& b) {
    a[0] = bf2f(w.x & 0xffffu); a[1] = bf2f(w.x >> 16); a[2] = bf2f(w.y & 0xffffu); a[3] = bf2f(w.y >> 16);
    b[0] = bf2f(w.z & 0xffffu); b[1] = bf2f(w.z >> 16); b[2] = bf2f(w.w & 0xffffu); b[3] = bf2f(w.w >> 16);
}
template <int MODE> struct EpiGate {
    const bf16* gates; bf16* M1; bf16* merged;
    __device__ __forceinline__ void operator()(const f32x4 (&acc)[2][2][4][2], const GUnit& u, int wr, int wc, int fr, int fq) const {
        const int row0 = u.pm * 256 + wr * 64 + fr, cl = u.pn * 256 + wc * 32 + 8 * fq;
#pragma unroll
        EPI_LOOP_ROWS { const size_t r = (size_t)(row0 + ai * 128 + m * 16);
#pragma unroll
            for (int bj = 0; bj < 2; ++bj) { const int c = cl + bj * 128;
                f32x4 g0, g1; unpack8(*(const u32x4*)(gates + r * 4096 + (MODE ? 2048 : 0) + c), g0, g1);
                f32x4 v0 = acc[ai][bj][m][0] * g0, v1 = acc[ai][bj][m][1] * g1;
                if (MODE) { f32x4 p0, p1; unpack8(*(const u32x4*)(M1 + r * 2048 + c), p0, p1); v0 += p0; v1 += p1; *(u32x4*)(merged + r * 2048 + c) = pack8(v0, v1); }
                else *(u32x4*)(M1 + r * 2048 + c) = pack8(v0, v1); } }
    }
};
struct EpiPre {
    const float* x; float* pre;
    __device__ __forceinline__ void operator()(const f32x4 (&acc)[2][2][4][2], const GUnit& u, int wr, int wc, int fr, int fq) const {
        const int row0 = u.pm * 256 + wr * 64 + fr, cl = u.pn * 256 + wc * 32 + 8 * fq;
#pragma unroll
        EPI_LOOP_ROWS { const size_t o = (size_t)(row0 + ai * 128 + m * 16) * 2048 + cl;
#pragma unroll
            for (int bj = 0; bj < 2; ++bj) { const f32x4 x0 = *(const f32x4*)(x + o + bj * 128), x1 = *(const f32x4*)(x + o + bj * 128 + 4);
                *(f32x4*)(pre + o + bj * 128) = x0 * DN_ALPHA + acc[ai][bj][m][0]; *(f32x4*)(pre + o + bj * 128 + 4) = x1 * DN_ALPHA + acc[ai][bj][m][1]; } }
    }
};
struct MoeSched {
    const int* mtt; int nmt; int NT; int G, c; bool gateup;
    const char* h; const char* hbuf; const char* wgu; const char* wd; const int* rowlist;
    __device__ __forceinline__ bool next(int i, GUnit& u) const {
        const int total = nmt * NT; int U;
        if ((G & 7) == 0) { const int x = c & 7, j = i * (G >> 3) + (c >> 3); const int lo = (int)(((long)total * x) >> 3), hi = (int)(((long)total * (x + 1)) >> 3); U = lo + j; if (U >= hi) return false; }
        else { const long L = (long)i * G + c; if (L >= total) return false; U = (int)L; }
        return fill(U, u);
    }
    __device__ __forceinline__ bool fill(int U, GUnit& u) const {
        const int MT = U / NT, nt_ = U - MT * NT;
        const int g = __builtin_amdgcn_readfirstlane(mtt[MT * 4 + 0]), p0 = __builtin_amdgcn_readfirstlane(mtt[MT * 4 + 1]), nv = __builtin_amdgcn_readfirstlane(mtt[MT * 4 + 2]);
        u.pm = p0; u.pn = nt_; u.aux0 = nv; u.aux1 = g;
        if (gateup) { u.A = h; u.rows = rowlist + p0; u.B0 = wgu + ((size_t)g * 1024 + (size_t)nt_ * 256) * 4096; u.B1 = u.B0 + (size_t)128 * 4096; u.nt = 32; }
        else { u.A = hbuf + (size_t)p0 * 1024; u.rows = nullptr; u.B0 = wd + ((size_t)g * 2048 + (size_t)nt_ * 256) * 1024; u.B1 = u.B0 + (size_t)128 * 1024; u.nt = 8; }
        return true;
    }
};
struct EpiSwiGLU {
    bf16* H;
    __device__ __forceinline__ void operator()(const f32x4 (&acc)[2][2][4][2], const GUnit& u, int wr, int wc, int fr, int fq) const {
        const int cl = u.pn * 128 + wc * 32 + 8 * fq;
#pragma unroll
        EPI_LOOP_ROWS { const int r = ai * 128 + wr * 64 + m * 16 + fr;
            if (r < u.aux0) { f32x4 v[2];
#pragma unroll
                for (int n = 0; n < 2; ++n)
#pragma unroll
                    for (int j = 0; j < 4; ++j) { const float g = acc[ai][0][m][n][j], up = acc[ai][1][m][n][j]; v[n][j] = g * sigmoidf_(g) * up; }
                *(u32x4*)(H + (size_t)(u.pm + r) * 512 + cl) = pack8(v[0], v[1]); } }
    }
};
struct EpiY {
    bf16* Y;
    __device__ __forceinline__ void operator()(const f32x4 (&acc)[2][2][4][2], const GUnit& u, int wr, int wc, int fr, int fq) const {
        const int cl = u.pn * 256 + wc * 32 + 8 * fq;
#pragma unroll
        EPI_LOOP_ROWS { const int r = ai * 128 + wr * 64 + m * 16 + fr;
            if (r < u.aux0) { bf16* rowp = Y + (size_t)(u.pm + r) * 2048 + cl;
#pragma unroll
                for (int bj = 0; bj < 2; ++bj) *(u32x4*)(rowp + bj * 128) = pack8(acc[ai][bj][m][0], acc[ai][bj][m][1]); } }
    }
};

template <class RowMap>
__device__ __forceinline__ void tr_item(const float* W, int ldw, int nvalid, bf16* WT, int ldT, LAS float* scr, int kb, int nb, int lane, const RowMap& rm) {
    const int k0 = 64 * kb, n0 = 32 * nb;
    const int c4 = 4 * (lane & 7), kr = lane >> 3;
    f32x4 v[8];
#pragma unroll
    for (int i = 0; i < 8; ++i) { v[i] = (f32x4){0.f, 0.f, 0.f, 0.f}; if (n0 + c4 < nvalid) v[i] = *(const f32x4*)(W + (size_t)(k0 + 8 * i + kr) * ldw + n0 + c4); }
#pragma unroll
    for (int i = 0; i < 8; ++i) { LAS float* d = scr + (8 * i + kr) * 33 + c4; d[0] = v[i][0]; d[1] = v[i][1]; d[2] = v[i][2]; d[3] = v[i][3]; }
    LDS_WAIT(); asm volatile("" ::: "memory");
    const int c = lane & 7;
#pragma unroll
    for (int j = 0; j < 4; ++j) { const int nl = (lane >> 3) + 8 * j; const LAS float* s = scr + (8 * c) * 33 + nl;
        u32x4 o; o.x = pk2(s[0 * 33], s[1 * 33]); o.y = pk2(s[2 * 33], s[3 * 33]); o.z = pk2(s[4 * 33], s[5 * 33]); o.w = pk2(s[6 * 33], s[7 * 33]);
        if (n0 + nl < nvalid) *(u32x4*)(WT + (size_t)rm(n0 + nl) * ldT + k0 + 8 * c) = o; }
    LDS_WAIT(); asm volatile("" ::: "memory");
}
struct MapId { int off; __device__ __forceinline__ int operator()(int n) const { return off + n; } };
struct MapWin {
    __device__ __forceinline__ int operator()(int n) const {
        if (n < 1024) return n;
        if (n < 1280) return 7168 + (n - 1024);
        if (n < 2304) return 1024 + (n - 1280);
        if (n < 2368) return 7424 + (n - 2304);
        if (n < 2384) return 7488 + (n - 2368);
        if (n < 3408) return 2048 + (n - 2384);
        return 3072 + (n - 3408);
    }
};
struct MapGU { int up; __device__ __forceinline__ int operator()(int f) const { return (f >> 7) * 256 + up * 128 + (f & 127); } };

__device__ __forceinline__ void phase_convert_small(Frame& F, const float* x, const float* w_in, const float* w_uk, const float* w_uv, const float* w_pool, const float* w_pa, const float* w_pp, const float* w_out, const float* pscale, const float* w_router) {
    const int lane_ = lane_id(), tid_ = F.wave * 64 + lane_;
    { float* wt = (float*)(F.ws + WS_WRT); for (size_t i = (size_t)F.bid * NTHR + tid_; i < (size_t)64 * 2048; i += (size_t)F.G * NTHR) { const int e = (int)(i >> 11), d = (int)(i & 2047); wt[i] = w_router[(size_t)d * 64 + e]; } }
    { float* cs = (float*)(F.ws + WS_CSCALE); for (size_t i = (size_t)F.bid * NTHR + tid_; i < 3072; i += (size_t)F.G * NTHR) cs[i] = (i < 2048) ? 1.0f : pscale[i - 2048]; }
    bf16* xb = (bf16*)(F.ws + WS_XB);
    const size_t gt = (size_t)F.bid * NTHR + tid_, nth = (size_t)F.G * NTHR;
#pragma unroll 4
    for (size_t i = gt; i < (size_t)NTOK * DM / 8; i += nth) { const f32x4 a = ((const f32x4*)x)[2 * i], b = ((const f32x4*)x)[2 * i + 1];
        u32x4 o; o.x = pk2(a[0], a[1]); o.y = pk2(a[2], a[3]); o.z = pk2(b[0], b[1]); o.w = pk2(b[2], b[3]); ((u32x4*)xb)[i] = o; }
    LAS float* scr = (LAS float*)(F.lds + F.wave * 8704);
    const int gw = F.bid * NWAVES + F.wave, NGW = F.G * NWAVES;
    constexpr int I_IN = 32 * 235, I_POOL = 4 * 4 * 8, I_PA = 16 * 64, I_PP = 16 * 64, I_OUT = 32 * 64;
    constexpr int NIT = I_IN + I_POOL + I_PA + I_PP + I_OUT;
    for (int it = gw; it < NIT; it += NGW) {
        int r = it;
        if (r < I_IN) { tr_item(w_in, 7504, 7504, (bf16*)(F.ws + WS_WIN), 2048, scr, r / 235, r % 235, lane_, MapWin{}); continue; } r -= I_IN;
        if (r < I_POOL) { const int g = r / 32, q = r % 32; tr_item(w_pool + (size_t)g * 65536, 256, 256, (bf16*)(F.ws + WS_WPOOL) + (size_t)g * 65536, 256, scr, q / 8, q % 8, lane_, MapId{0}); continue; } r -= I_POOL;
        if (r < I_PA) { tr_item(w_pa, 2048, 2048, (bf16*)(F.ws + WS_WPA), 1024, scr, r / 64, r % 64, lane_, MapId{0}); continue; } r -= I_PA;
        if (r < I_PP) { tr_item(w_pp, 2048, 2048, (bf16*)(F.ws + WS_WPP), 1024, scr, r / 64, r % 64, lane_, MapId{0}); continue; } r -= I_PP;
        tr_item(w_out, 2048, 2048, (bf16*)(F.ws + WS_WOUT), 2048, scr, r / 64, r % 64, lane_, MapId{0});
    }
    { bf16* wp = (bf16*)(F.ws + WS_WIN) + (size_t)7504 * 2048; for (size_t i = gt; i < (size_t)176 * 2048 / 8; i += nth) ((u32x4*)wp)[i] = (u32x4){0u, 0u, 0u, 0u}; }
    { const float* wuk = w_uk; bf16* o = (bf16*)(F.ws + WS_WUK);
      for (size_t i = gt; i < (size_t)2048 * 256; i += nth) { const int kp = (int)(i & 255), row = (int)(i >> 8), h = row >> 8, r = row & 255;
          o[i] = ((kp >> 7) == (h & 1)) ? (bf16)f2bf(wuk[(size_t)r * 1024 + h * 128 + (kp & 127)]) : (bf16)0; } }
    { const float* wuv = w_uv; bf16* o = (bf16*)(F.ws + WS_WUV);
      for (size_t i = gt; i < (size_t)1024 * 512; i += nth) { const int kp = (int)(i & 511), row = (int)(i >> 9), pn = row >> 8, hh = (row >> 7) & 1, d = row & 127, hh2 = kp >> 8, r = kp & 255;
          o[i] = (hh == hh2) ? (bf16)f2bf(wuv[(size_t)r * 1024 + (2 * pn + hh) * 128 + d]) : (bf16)0; } }
}

__device__ __forceinline__ void phase_convert_experts(Frame& F, const float* wge, const float* wue, const float* wde, const float* wgs, const float* wus, const float* wds) {
    const int lane_ = lane_id();
    LAS float* scr = (LAS float*)(F.lds + 32768 + F.wave * 8704);
    constexpr int PER = 1536, NIT = NGRP * PER, BATCH = 8;
    for (;;) {
        int base = 0;
        if (lane_ == 0) base = (int)__hip_atomic_fetch_add(F.ctl + CW_CVQ, (unsigned)BATCH, RLX_AGENT);
        base = __builtin_amdgcn_readfirstlane(base);
        if (base >= NIT) break;
        for (int it = base; it < base + BATCH && it < NIT; ++it) {
            const int g = it / PER; int r = it - g * PER;
            const float* wg = (g < NE) ? wge + (size_t)g * 2048 * 512 : wgs;
            const float* wu = (g < NE) ? wue + (size_t)g * 2048 * 512 : wus;
            const float* wd = (g < NE) ? wde + (size_t)g * 512 * 2048 : wds;
            bf16* ogu = (bf16*)(F.ws + WS_WGU) + (size_t)g * 1024 * 2048; bf16* od = (bf16*)(F.ws + WS_WD) + (size_t)g * 2048 * 512;
            if (r < 512) { tr_item(wg, 512, 512, ogu, 2048, scr, r / 16, r % 16, lane_, MapGU{0}); continue; } r -= 512;
            if (r < 512) { tr_item(wu, 512, 512, ogu, 2048, scr, r / 16, r % 16, lane_, MapGU{1}); continue; } r -= 512;
            tr_item(wd, 2048, 2048, od, 512, scr, r / 64, r % 64, lane_, MapId{0});
        }
    }
}

__device__ __forceinline__ void phase_postproc(Frame& F, const float* cg, const float* kg, const float* kb) {
    const int lane_ = lane_id(), tid_ = F.wave * 64 + lane_;
    const float* ckvraw = (const float*)(F.ws + WS_CKVRAW); const float* kiwi = (const float*)(F.ws + WS_KIWI);
    unsigned* ckvn = (unsigned*)(F.ws + WS_CKVN); bf16* kin = (bf16*)(F.ws + WS_KIN); float* wis = (float*)(F.ws + WS_WI);
    const int gw = F.bid * NWAVES + F.wave, NGW = F.G * NWAVES, lane = lane_;
    const f32x4 g4 = *(const f32x4*)(cg + lane * 4); const float kgl = kg[lane], kbl = kb[lane];
    for (int t0 = gw; t0 < NTOK; t0 += 4 * NGW) {
        f32x4 v[4]; float kv[4], wv[4];
#pragma unroll
        for (int q = 0; q < 4; ++q) { const int t = t0 + q * NGW; v[q] = (f32x4){0.f, 0.f, 0.f, 0.f}; kv[q] = 0.f; wv[q] = 0.f;
            if (t < NTOK) { v[q] = *(const f32x4*)(ckvraw + (size_t)t * 256 + lane * 4); kv[q] = kiwi[(size_t)t * 256 + lane]; wv[q] = kiwi[(size_t)t * 256 + 64 + (lane & 15)]; } }
#pragma unroll
        for (int q = 0; q < 4; ++q) { const int t = t0 + q * NGW;
            const float ss = wave_sum(v[q][0] * v[q][0] + v[q][1] * v[q][1] + v[q][2] * v[q][2] + v[q][3] * v[q][3]);
            const float rs = 1.0f / sqrtf(ss * (1.0f / 256.0f) + RMS_EPS);
            int o8 = __builtin_amdgcn_cvt_pk_fp8_f32(v[q][0] * rs * g4[0], v[q][1] * rs * g4[1], 0, false);
            o8 = __builtin_amdgcn_cvt_pk_fp8_f32(v[q][2] * rs * g4[2], v[q][3] * rs * g4[3], o8, true);
            const float mu = wave_sum(kv[q]) * (1.0f / 64.0f); const float dlt = kv[q] - mu;
            const float var = wave_sum(dlt * dlt) * (1.0f / 64.0f);
            const float y = dlt * (1.0f / sqrtf(var + LN_EPS)) * kgl + kbl;
            if (t < NTOK) { ckvn[(size_t)t * 64 + lane] = (unsigned)o8; kin[(size_t)t * 64 + lane] = (bf16)f2bf(y); if (lane < 16) wis[(size_t)t * 16 + lane] = wv[q] * 0.03125f; } }
    }
    const bf16* xp = (const bf16*)(F.ws + WS_XP); bf16* diff = (bf16*)(F.ws + WS_DIFF);
    const size_t gt = (size_t)F.bid * NTHR + tid_, nth = (size_t)F.G * NTHR;
    for (size_t i = gt; i < (size_t)(NTOK / 16) * 128; i += nth) {
        const int run = (int)(i >> 7), cgp = (int)(i & 127), g = cgp >> 5, win = 2 << g, tb = run * 16, posb = tb & (SEQ - 1);
        const bf16* col = xp + cgp * 8;
        f32x4 s0 = {0.f, 0.f, 0.f, 0.f}, s1 = {0.f, 0.f, 0.f, 0.f};
#pragma unroll
        for (int j = 1; j < 16; ++j) if (j < win && posb - j >= 0) { f32x4 a, b; unpack8(*(const u32x4*)(col + (size_t)(tb - j) * 1024), a, b); s0 += a; s1 += b; }
#pragma unroll
        for (int q = 0; q < 16; ++q) { const int t = tb + q, pos = posb + q;
            f32x4 a, b; unpack8(*(const u32x4*)(col + (size_t)t * 1024), a, b); s0 += a; s1 += b;
            const int cntw = (pos + 1 < win) ? pos + 1 : win; const float inv = 1.0f / (float)cntw;
            *(u32x4*)(diff + (size_t)t * 1024 + cgp * 8) = pack8(s0 * inv - a, s1 * inv - b);
            if (pos - win + 1 >= 0) { f32x4 c, d; unpack8(*(const u32x4*)(col + (size_t)(t - win + 1) * 1024), c, d); s0 -= c; s1 -= d; } }
    }
}

__device__ __forceinline__ size_t score_rowbase(int b, int p) { const int jq = p >> 7; return (size_t)b * SC_TOT + (size_t)16384 * (size_t)(jq * (jq + 1) / 2) + (size_t)(p & 127) * (size_t)(128 * (jq + 1)); }

__device__ __forceinline__ void phase_index_scores(Frame& F) {
    const int lane_ = lane_id(), tid_ = F.wave * 64 + lane_;
    const bf16* qi = (const bf16*)(F.ws + WS_QI); const bf16* kin = (const bf16*)(F.ws + WS_KIN); const float* wis = (const float*)(F.ws + WS_WI);
    float* scores = (float*)(F.ws + WS_SCORES);
    const int lane = lane_, w = F.wave, fq = lane >> 4, j16 = lane & 15, tid = tid_;
    LAS unsigned char* kb = F.lds;
    const int sR = tid >> 3, sc = tid & 7, sP = (sR & 3) * 16 + (sR >> 2);
    const int st_off = sP * 128 + ((sc ^ ((sP >> 1) & 7)) * 16);
    for (int it = 0;; ++it) {
        const int jj = (it >> 1) * F.G + F.bid; if (jj >= 256) break;
        const int s = (it & 1) ? 511 - jj : jj;
        const int b = s & 1, qg = s >> 1, tq0 = qg * 32;
        const int nsteps = (tq0 + 32 + 63) / 64;
        bf16x8 Af[4][2];
        { const size_t tok = (size_t)b * SEQ + tq0 + 4 * w + (j16 >> 2);
#pragma unroll
          for (int g = 0; g < 4; ++g)
#pragma unroll
              for (int ks = 0; ks < 2; ++ks) Af[g][ks] = *(const bf16x8*)(qi + tok * 1024 + (4 * g + (j16 & 3)) * 64 + ks * 32 + 8 * fq); }
        f32x4 wv[4];
        { const size_t tok = (size_t)b * SEQ + tq0 + 4 * w + fq;
#pragma unroll
          for (int g = 0; g < 4; ++g) wv[g] = *(const f32x4*)(wis + tok * 16 + 4 * g); }
        float* orow = scores + score_rowbase(b, tq0 + 4 * w + fq);
        const bf16* kbase = kin + (size_t)b * SEQ * 64;
        u32x4 stg = *(const u32x4*)(kbase + (size_t)sR * 64 + sc * 8);
        __syncthreads();
        *(LAS u32x4*)(kb + st_off) = stg;
        __syncthreads();
        for (int step = 0; step < nsteps; ++step) {
            const int cur = step & 1;
            if (step + 1 < nsteps) stg = *(const u32x4*)(kbase + (size_t)((step + 1) * 64 + sR) * 64 + sc * 8);
            f32x4 res;
#pragma unroll
            for (int u = 0; u < 4; ++u) {
                const int P = u * 16 + j16;
                f32x4 a4[4];
#pragma unroll
                for (int g = 0; g < 4; ++g) a4[g] = (f32x4){0.f, 0.f, 0.f, 0.f};
#pragma unroll
                for (int ks = 0; ks < 2; ++ks) {
                    const bf16x8 bfr = *(const LAS bf16x8*)(kb + cur * 8192 + P * 128 + (((fq + 4 * ks) ^ ((P >> 1) & 7)) * 16));
#pragma unroll
                    for (int g = 0; g < 4; ++g) a4[g] = __builtin_amdgcn_mfma_f32_16x16x32_bf16(Af[g][ks], bfr, a4[g], 0, 0, 0);
                }
                float sres = 0.f;
#pragma unroll
                for (int g = 0; g < 4; ++g)
#pragma unroll
                    for (int r = 0; r < 4; ++r) sres += wv[g][r] * fmaxf(a4[g][r], 0.f);
                res[u] = sres;
            }
            *(f32x4*)(orow + step * 64 + 4 * j16) = res;
            if (step + 1 < nsteps) *(LAS u32x4*)(kb + (cur ^ 1) * 8192 + st_off) = stg;
            __syncthreads();
        }
    }
}

__device__ __forceinline__ unsigned fkey(float f) { const unsigned u = __float_as_uint(f); return (u & 0x80000000u) ? ~u : (u | 0x80000000u); }

template <int NV>
__device__ __forceinline__ void select_row(const float* row, int n, unsigned short* sel, int lane) {
    unsigned u[NV][4];
#pragma unroll
    for (int i = 0; i < NV; ++i) {
        const int base = i * 256 + lane * 4;
        f32x4 v = {0.f, 0.f, 0.f, 0.f};
        if (base < n) v = *(const f32x4*)(row + base);
#pragma unroll
        for (int e = 0; e < 4; ++e) u[i][e] = (base + e < n) ? fkey(v[e]) : 0u;
    }
    unsigned T = 0u; int cntT = n;
    bool exact = false;
    for (int bit = 31; bit >= 0; --bit) {
        const unsigned cand = T | (1u << bit);
        int c = 0;
#pragma unroll
        for (int i = 0; i < NV; ++i)
#pragma unroll
            for (int e = 0; e < 4; ++e) c += __popcll(__ballot(u[i][e] >= cand));
        if (c >= TOPK) { T = cand; cntT = c; if (c == TOPK) { exact = true; break; } }
    }
    int cgt = 0;
    if (!exact) {
#pragma unroll
        for (int i = 0; i < NV; ++i)
#pragma unroll
            for (int e = 0; e < 4; ++e) cgt += __popcll(__ballot(u[i][e] > T));
    }
    int pg = 0, pe = exact ? 0 : cgt;
    const unsigned long long lt = (1ull << lane) - 1ull;
#pragma unroll
    for (int i = 0; i < NV; ++i)
#pragma unroll
        for (int e = 0; e < 4; ++e) {
            const unsigned val = u[i][e]; const int idx = i * 256 + lane * 4 + e;
            const bool gsel = exact ? (val >= T) : (val > T);
            const unsigned long long mg = __ballot(gsel);
            if (gsel) sel[pg + __popcll(mg & lt)] = (unsigned short)idx;
            pg += __popcll(mg);
            if (!exact) {
                const bool esel = (val == T);
                const unsigned long long me = __ballot(esel);
                const int pos = pe + __popcll(me & lt);
                if (esel && pos < TOPK) sel[pos] = (unsigned short)idx;
                pe += __popcll(me);
            }
        }
}

__device__ __forceinline__ void phase_select(Frame& F) {
    const int lane_ = lane_id(), tid_ = F.wave * 64 + lane_;
    const float* scores = (const float*)(F.ws + WS_SCORES);
    unsigned short* selb = (unsigned short*)(F.ws + WS_SEL);
    const int gw = F.bid * NWAVES + F.wave, NGW = F.G * NWAVES, lane = lane_;
    for (int it = 0;; ++it) {
        const int jj = (it >> 1) * NGW + gw; if (jj >= NTOK / 2) break;
        const int s = (it & 1) ? NTOK - 1 - jj : jj;
        const int b = s & 1, p = s >> 1, n = p + 1;
        unsigned short* sel = selb + ((size_t)b * SEQ + p) * TOPK;
        if (n <= TOPK) {
#pragma unroll
            for (int q = 0; q < 4; ++q) { const int i = q * 64 + lane; sel[i] = (i < n) ? (unsigned short)i : (unsigned short)0xFFFFu; }
        } else {
            const float* row = scores + score_rowbase(b, p);
            if (n <= 2048) select_row<8>(row, n, sel, lane);
            else if (n <= 4096) select_row<16>(row, n, sel, lane);
            else if (n <= 6144) select_row<24>(row, n, sel, lane);
            else select_row<32>(row, n, sel, lane);
        }
    }
}

__device__ __forceinline__ int c_lds(int row, int chunk) { return row * 544 + chunk * 16; }

__device__ __forceinline__ void phase_sparse_attn(Frame& F) {
    const int lane_ = lane_id(), tid_ = F.wave * 64 + lane_;
    const bf16* qlat = (const bf16*)(F.ws + WS_QLAT); const unsigned char* ckv8 = (const unsigned char*)(F.ws + WS_CKVN);
    const unsigned short* selb = (const unsigned short*)(F.ws + WS_SEL); bf16* olat = (bf16*)(F.ws + WS_OLAT);
    const int lane = lane_, fq = lane >> 4, j16 = lane & 15;
    LAS unsigned char* cb = F.lds + F.wave * 17408;
    const float sl2 = 0.08838834764831845f * 1.4426950408889634f;
    const int xh = (F.G % 8 == 0) ? ((F.bid & 7) >> 2) : 0, nsplit = (F.G % 8 == 0) ? 2 : 1;
    const int wloc = (F.G % 8 == 0) ? (((F.bid >> 3) * 4 + (F.bid & 3)) * NWAVES + F.wave) : (F.bid * NWAVES + F.wave);
    const int nwl = (F.G % 8 == 0) ? (F.G / 2) * NWAVES : F.G * NWAVES;
    const int ntk = NTOK / nsplit;
    for (int tl = wloc; tl < ntk; tl += nwl) {
        const int t = xh * ntk + tl, b = t / SEQ, pos = t % SEQ;
        const int nvalid = (pos + 1 < TOPK) ? pos + 1 : TOPK;
        const unsigned short* sel = selb + (size_t)t * TOPK;
        const u32x2 sv = __builtin_nontemporal_load((const u32x2*)(sel + 4 * lane));
        bf16x8 Qb[8];
#pragma unroll
        for (int ks = 0; ks < 8; ++ks) { bf16x8 z = {0, 0, 0, 0, 0, 0, 0, 0}; if (j16 < 8) z = __builtin_nontemporal_load((const bf16x8*)(qlat + ((size_t)t * 8 + j16) * 256 + ks * 32 + 8 * fq)); Qb[ks] = z; }
        float mrun = -INFINITY, lrun = 0.f;
        f32x4 O[16];
#pragma unroll
        for (int rt = 0; rt < 16; ++rt) O[rt] = (f32x4){0.f, 0.f, 0.f, 0.f};
        const int nch = (nvalid + 31) >> 5;
        const unsigned char* cbase = ckv8 + (size_t)b * SEQ * 256 + (lane & 15) * 16;
        u32x4 gv[8];
#define SA_GATHER(c_) do { _Pragma("unroll") for (int it = 0; it < 8; ++it) { \
            const unsigned dx = (unsigned)__builtin_amdgcn_readlane((int)sv.x, 8 * (c_) + it), dy = (unsigned)__builtin_amdgcn_readlane((int)sv.y, 8 * (c_) + it); \
            const unsigned dd = (fq & 2) ? dy : dx; int key = (fq & 1) ? (int)(dd >> 16) : (int)(dd & 0xffffu); key = (key >= SEQ) ? 0 : key; \
            gv[it] = *(const u32x4*)(cbase + (size_t)key * 256); } } while (0)
        SA_GATHER(0);
        for (int c = 0; c < nch; ++c) {
#pragma unroll
            for (int it = 0; it < 8; ++it) { const int row = 4 * it + fq; u32x4 w0, w1;
#pragma unroll
                for (int q = 0; q < 4; ++q) { const f32x2 a = __builtin_amdgcn_cvt_pk_f32_fp8((int)gv[it][q], false), bq = __builtin_amdgcn_cvt_pk_f32_fp8((int)gv[it][q], true);
                    const unsigned lo = cvt_pk_bf16(a[0], a[1]), hi = cvt_pk_bf16(bq[0], bq[1]);
                    if (q < 2) { w0[2 * q] = lo; w0[2 * q + 1] = hi; } else { w1[2 * (q - 2)] = lo; w1[2 * (q - 2) + 1] = hi; } }
                *(LAS u32x4*)(cb + c_lds(row, 2 * j16)) = w0; *(LAS u32x4*)(cb + c_lds(row, 2 * j16 + 1)) = w1; }
            asm volatile("" ::: "memory");
            if (c + 1 < nch) SA_GATHER(c + 1);
            f32x4 Sa = {0.f, 0.f, 0.f, 0.f}, Sb = {0.f, 0.f, 0.f, 0.f};
#pragma unroll
            for (int ks = 0; ks < 8; ++ks) {
                const bf16x8 a0 = *(const LAS bf16x8*)(cb + c_lds(j16, 4 * ks + fq));
                const bf16x8 a1 = *(const LAS bf16x8*)(cb + c_lds(16 + j16, 4 * ks + fq));
                Sa = __builtin_amdgcn_mfma_f32_16x16x32_bf16(a0, Qb[ks], Sa, 0, 0, 0);
                Sb = __builtin_amdgcn_mfma_f32_16x16x32_bf16(a1, Qb[ks], Sb, 0, 0, 0);
            }
            float xa[4], xb[4]; float cm = -INFINITY;
#pragma unroll
            for (int r = 0; r < 4; ++r) { const int ka = c * 32 + 4 * fq + r, kb2 = ka + 16;
                xa[r] = (ka < nvalid) ? Sa[r] * sl2 : -INFINITY; xb[r] = (kb2 < nvalid) ? Sb[r] * sl2 : -INFINITY; cm = fmaxf(cm, fmaxf(xa[r], xb[r])); }
            cm = fmaxf(cm, __shfl_xor(cm, 16)); cm = fmaxf(cm, __shfl_xor(cm, 32));
            const float mnew = fmaxf(mrun, cm);
            const float alpha = __builtin_amdgcn_exp2f(mrun - mnew);
            float ps = 0.f; f32x4 pa, pb;
#pragma unroll
            for (int r = 0; r < 4; ++r) { pa[r] = __builtin_amdgcn_exp2f(xa[r] - mnew); pb[r] = __builtin_amdgcn_exp2f(xb[r] - mnew); ps += pa[r] + pb[r]; }
            ps += __shfl_xor(ps, 16); ps += __shfl_xor(ps, 32);
            lrun = lrun * alpha + ps; mrun = mnew;
            const u32x4 pw = pack8(pa, pb); const bf16x8 Pb = __builtin_bit_cast(bf16x8, pw);
#pragma unroll
            for (int rt = 0; rt < 16; ++rt) O[rt] = O[rt] * alpha;
            const int q4 = j16 >> 2, p4 = j16 & 3;
#pragma unroll
            for (int rt = 0; rt < 16; ++rt) {
                const int ra = 4 * fq + q4, rb = 16 + 4 * fq + q4, ch = 2 * rt + (p4 >> 1);
                const s16x4 lo = __builtin_bit_cast(s16x4, __builtin_amdgcn_ds_read_tr16_b64_v4i16((LAS s16x4*)(cb + c_lds(ra, ch) + 8 * (p4 & 1))));
                const s16x4 hi = __builtin_bit_cast(s16x4, __builtin_amdgcn_ds_read_tr16_b64_v4i16((LAS s16x4*)(cb + c_lds(rb, ch) + 8 * (p4 & 1))));
                const bf16x8 af = {lo[0], lo[1], lo[2], lo[3], hi[0], hi[1], hi[2], hi[3]};
                O[rt] = __builtin_amdgcn_mfma_f32_16x16x32_bf16(af, Pb, O[rt], 0, 0, 0);
            }
            asm volatile("" ::: "memory");
        }
#undef SA_GATHER
        const float inv = 1.0f / lrun;
        asm volatile("" ::: "memory");
        if (j16 < 8) {
#pragma unroll
            for (int rt = 0; rt < 16; ++rt) { u32x2 o; o.x = pk2(O[rt][0] * inv, O[rt][1] * inv); o.y = pk2(O[rt][2] * inv, O[rt][3] * inv); *(LAS u32x2*)(cb + j16 * 512 + rt * 32 + fq * 8) = o; }
        }
        asm volatile("" ::: "memory");
        { bf16* obase = olat + (size_t)t * 2048;
#pragma unroll
          for (int q = 0; q < 4; ++q) { const u32x4 v = *(const LAS u32x4*)(cb + q * 1024 + lane * 16); __builtin_nontemporal_store(v, (u32x4*)(obase + q * 512 + lane * 8)); } }
        asm volatile("" ::: "memory");
    }
}

__device__ __forceinline__ void routing_token(const float acc, const int lane, const float* rbias, int* tk_e, float* tk_w, LAS unsigned* hist, const size_t t, const bool do_count) {
    const float sc = 1.0f / (1.0f + expf(-acc));
    const float ch = sc + rbias[lane];
    int rk = 0;
#pragma unroll
    for (int k = 1; k < 8; ++k) { const int src = (lane & ~7) | ((lane + k) & 7); const float o = __shfl(ch, src); rk += (o > ch || (o == ch && src < lane)) ? 1 : 0; }
    float gs = (rk < 2) ? ch : 0.f; gs += __shfl_xor(gs, 1); gs += __shfl_xor(gs, 2); gs += __shfl_xor(gs, 4);
    int grk = 0; const int myg = lane >> 3;
#pragma unroll
    for (int g = 0; g < 8; ++g) { const float o = __shfl(gs, g * 8); grk += (o > gs || (o == gs && g < myg)) ? 1 : 0; }
    const float cm = (grk < 4) ? ch : -INFINITY;
    int erk = 0;
    for (int j = 0; j < 64; ++j) { const float o = __shfl(cm, j); erk += (o > cm || (o == cm && j < lane)) ? 1 : 0; }
    const bool selx = (erk < EK) && (grk < 4);
    const float ssum = wave_sum(selx ? sc : 0.f);
    if (selx) { tk_e[t * 8 + erk] = lane; tk_w[t * 8 + erk] = sc / ssum * 2.5f; if (do_count) __hip_atomic_fetch_add(&hist[lane], 1u, __ATOMIC_RELAXED, __HIP_MEMORY_SCOPE_WORKGROUP); }
}
__device__ __forceinline__ void phase_ln1_router(Frame& F, const float* g1, const float* b1, const float* rbias, const bool do_count) {
    const int lane_ = lane_id(), tid_ = F.wave * 64 + lane_;
    const float* pre = F.out;
    const float* wrT = (const float*)(F.ws + WS_WRT);
    bf16* h = (bf16*)(F.ws + WS_H);
    int* tk_e = (int*)(F.ws + WS_TOPK + TK_E); float* tk_w = (float*)(F.ws + WS_TOPK + TK_W);
    const int lane = lane_, w = F.wave, tid = tid_;
    LAS float* stats = (LAS float*)F.lds;
    LAS float* lg = (LAS float*)(F.lds + 1024) + (w & 3) * 1024;
    LAS unsigned* hist = (LAS unsigned*)(F.lds + 1024 + 16384);
    if (do_count && tid < 64) hist[tid] = 0u;
    for (int chunk = F.bid; chunk < NTOK / 64; chunk += F.G) {
        __syncthreads();
        for (int i = 0; i < 8; ++i) {
            const int tl = w * 8 + i; const size_t t = (size_t)chunk * 64 + tl;
            f32x4 v[8]; float s = 0.f;
#pragma unroll
            for (int q = 0; q < 8; ++q) { v[q] = *(const f32x4*)(pre + t * DM + (lane + 64 * q) * 4); s += (v[q][0] + v[q][1]) + (v[q][2] + v[q][3]); }
            const float mean = wave_sum(s) * (1.0f / DM); float s2 = 0.f;
#pragma unroll
            for (int q = 0; q < 8; ++q) { v[q] = v[q] - mean; s2 += (v[q][0] * v[q][0] + v[q][1] * v[q][1]) + (v[q][2] * v[q][2] + v[q][3] * v[q][3]); }
            const float rstd = 1.0f / sqrtf(wave_sum(s2) * (1.0f / DM) + LN_EPS);
#pragma unroll
            for (int q = 0; q < 8; ++q) { const int c = (lane + 64 * q) * 4; const f32x4 gg = *(const f32x4*)(g1 + c), bb = *(const f32x4*)(b1 + c);
                const f32x4 y = v[q] * rstd * gg + bb;
                u32x2 o; o.x = pk2(y[0], y[1]); o.y = pk2(y[2], y[3]); *(u32x2*)(h + t * DM + c) = o; }
            if (lane == 0) { stats[tl * 2] = mean; stats[tl * 2 + 1] = rstd; }
        }
        __syncthreads();
        if (w < 4) {
            const int j16 = lane & 15, kq = lane >> 4, tl = 16 * w + j16;
            const float mean = stats[tl * 2], rstd = stats[tl * 2 + 1];
            const float* prow = pre + ((size_t)chunk * 64 + tl) * DM + 4 * kq; const float* wrow = wrT + (size_t)j16 * DM + 4 * kq;
            f32x4 acc[4];
#pragma unroll
            for (int tt = 0; tt < 4; ++tt) acc[tt] = (f32x4){0.f, 0.f, 0.f, 0.f};
#pragma unroll 2
            for (int m = 0; m < 128; ++m) {
                const f32x4 p = *(const f32x4*)(prow + 16 * m), gg = *(const f32x4*)(g1 + 16 * m + 4 * kq), bb = *(const f32x4*)(b1 + 16 * m + 4 * kq);
                const f32x4 hv = (p - mean) * rstd * gg + bb;
                f32x4 wv[4];
#pragma unroll
                for (int tt = 0; tt < 4; ++tt) wv[tt] = *(const f32x4*)(wrow + (size_t)tt * 16 * DM + 16 * m);
#pragma unroll
                for (int e = 0; e < 4; ++e)
#pragma unroll
                    for (int tt = 0; tt < 4; ++tt) acc[tt] = __builtin_amdgcn_mfma_f32_16x16x4f32(hv[e], wv[tt][e], acc[tt], 0, 0, 0);
            }
#pragma unroll
            for (int tt = 0; tt < 4; ++tt)
#pragma unroll
                for (int r = 0; r < 4; ++r) lg[(4 * kq + r) * 64 + 16 * tt + j16] = acc[tt][r];
            LDS_WAIT();
            for (int tk = 0; tk < 16; ++tk) routing_token(lg[tk * 64 + lane], lane, rbias, tk_e, tk_w, hist, (size_t)chunk * 64 + 16 * w + tk, do_count);
        }
    }
}
__device__ __forceinline__ void phase_flush_hist(Frame& F) {
    const int tid = F.wave * 64 + lane_id();
    LAS unsigned* hist = (LAS unsigned*)(F.lds + 1024 + 16384);
    __syncthreads();
    if (tid < 64 && hist[tid]) atomicAdd(F.ctl + CW_CNT + tid, hist[tid]);
}

__device__ __forceinline__ void phase_scatter(Frame& F) {
    const int lane_ = lane_id(), tid_ = F.wave * 64 + lane_;
    const int tid = tid_;
    LAS int* segs = (LAS int*)F.lds;
    LAS unsigned* lcnt = (LAS unsigned*)(F.lds + 1024);
    LAS unsigned* lbase = (LAS unsigned*)(F.lds + 2048);
    const int* tk_e = (const int*)(F.ws + WS_TOPK + TK_E); int* tk_pos = (int*)(F.ws + WS_TOPK + TK_POS);
    int* rowlist = (int*)(F.ws + WS_TOPK + TK_ROWLIST); int* mtt = (int*)(F.ws + WS_TOPK + TK_MTT);
    if (tid == 0) { int a = 0; for (int e = 0; e < NE; ++e) { segs[e] = a; a += (int)__hip_atomic_load(F.ctl + CW_CNT + e, RLX_AGENT); } segs[NE] = a; segs[NE + 1] = a + NTOK; }
    __syncthreads();
    if (F.bid == 0) {
        LAS int* tcum = (LAS int*)(F.lds + 3072);
        if (tid == 0) { int mt = 0; for (int g = 0; g < NGRP; ++g) { tcum[g] = mt; mt += (segs[g + 1] - segs[g] + 255) >> 8; } tcum[NGRP] = mt; __hip_atomic_store(F.ctl + CW_NMT, (unsigned)mt, RLX_AGENT); }
        __syncthreads();
        if (tid < NGRP) { const int g = tid, p0 = segs[g], n = segs[g + 1] - p0; int mt = tcum[g];
            for (int r = 0; r < n; r += 256, ++mt) { mtt[mt * 4 + 0] = g; mtt[mt * 4 + 1] = p0 + r; mtt[mt * 4 + 2] = (n - r < 256) ? n - r : 256; mtt[mt * 4 + 3] = 0; } }
        if (tid >= 256) rowlist[NSLOT + tid - 256] = 0;
    }
    const int sh0 = segs[NE];
    for (int chunk = F.bid; chunk < NTOK / 64; chunk += F.G) {
        if (tid < 64) lcnt[tid] = 0u;
        __syncthreads();
        const int t = chunk * 64 + (tid >> 3), k = tid & 7;
        const int e = tk_e[(size_t)t * 8 + k];
        const unsigned li = __hip_atomic_fetch_add(&lcnt[e], 1u, __ATOMIC_RELAXED, __HIP_MEMORY_SCOPE_WORKGROUP);
        __syncthreads();
        if (tid < 64) lbase[tid] = lcnt[tid] ? atomicAdd(F.ctl + CW_FILL + tid, lcnt[tid]) : 0u;
        __syncthreads();
        const int p = segs[e] + (int)lbase[e] + (int)li;
        rowlist[p] = t; tk_pos[(size_t)t * 8 + k] = p;
        if (tid < 64) rowlist[sh0 + chunk * 64 + tid] = chunk * 64 + tid;
        __syncthreads();
    }
}

__device__ __forceinline__ void phase_combine(Frame& F, const float* g2, const float* b2) {
    const int lane_ = lane_id(), tid_ = F.wave * 64 + lane_;
    const bf16* h = (const bf16*)(F.ws + WS_H); const bf16* Y = (const bf16*)(F.ws + WS_Y);
    const float* tk_w = (const float*)(F.ws + WS_TOPK + TK_W); const int* tk_pos = (const int*)(F.ws + WS_TOPK + TK_POS);
    const int gw = F.bid * NWAVES + F.wave, NGW = F.G * NWAVES, lane = lane_;
    for (int t = gw; t < NTOK; t += NGW) {
        f32x4 a[4][2];
#pragma unroll
        for (int i = 0; i < 4; ++i) { f32x4 x0, x1; unpack8(*(const u32x4*)(h + (size_t)t * DM + (lane + 64 * i) * 8), x0, x1); a[i][0] = x0 * DN_ALPHA; a[i][1] = x1 * DN_ALPHA; }
#pragma unroll
        for (int k = 0; k < 9; ++k) {
            const int p = (k < 8) ? tk_pos[(size_t)t * 8 + k] : NTOK * 8 + t; const float wk = (k < 8) ? tk_w[(size_t)t * 8 + k] : 1.0f;
#pragma unroll
            for (int i = 0; i < 4; ++i) { f32x4 y0, y1; unpack8(*(const u32x4*)(Y + (size_t)p * DM + (lane + 64 * i) * 8), y0, y1); a[i][0] += y0 * wk; a[i][1] += y1 * wk; }
        }
        float s = 0.f;
#pragma unroll
        for (int i = 0; i < 4; ++i) s += ((a[i][0][0] + a[i][0][1]) + (a[i][0][2] + a[i][0][3])) + ((a[i][1][0] + a[i][1][1]) + (a[i][1][2] + a[i][1][3]));
        const float mean = wave_sum(s) * (1.0f / DM); float s2 = 0.f;
#pragma unroll
        for (int i = 0; i < 4; ++i) { a[i][0] = a[i][0] - mean; a[i][1] = a[i][1] - mean;
            s2 += ((a[i][0][0] * a[i][0][0] + a[i][0][1] * a[i][0][1]) + (a[i][0][2] * a[i][0][2] + a[i][0][3] * a[i][0][3])) + ((a[i][1][0] * a[i][1][0] + a[i][1][1] * a[i][1][1]) + (a[i][1][2] * a[i][1][2] + a[i][1][3] * a[i][1][3])); }
        const float rstd = 1.0f / sqrtf(wave_sum(s2) * (1.0f / DM) + LN_EPS);
#pragma unroll
        for (int i = 0; i < 4; ++i) { const int c = (lane + 64 * i) * 8;
            const f32x4 ga = *(const f32x4*)(g2 + c), gb = *(const f32x4*)(g2 + c + 4), ba = *(const f32x4*)(b2 + c), bb = *(const f32x4*)(b2 + c + 4);
            *(f32x4*)(F.out + (size_t)t * DM + c) = a[i][0] * rstd * ga + ba; *(f32x4*)(F.out + (size_t)t * DM + c + 4) = a[i][1] * rstd * gb + bb; }
    }
}

#ifndef MK_CHECK
#define MK_CHECK 0
#endif
constexpr int CW_CHK = 16384 + 256;
#if MK_CHECK
__device__ __forceinline__ float fp8f(unsigned char v) { const f32x2 a = __builtin_amdgcn_cvt_pk_f32_fp8((int)v, false); return a[0]; }
__device__ __forceinline__ void phase_check_attn(Frame& F) {
    const int tid = F.wave * 64 + lane_id();
    const bf16* qi = (const bf16*)(F.ws + WS_QI); const bf16* kin = (const bf16*)(F.ws + WS_KIN); const float* wis = (const float*)(F.ws + WS_WI);
    const bf16* qlat = (const bf16*)(F.ws + WS_QLAT); const unsigned char* ckv8 = (const unsigned char*)(F.ws + WS_CKVN);
    const unsigned short* selb = (const unsigned short*)(F.ws + WS_SEL); const bf16* olat = (const bf16*)(F.ws + WS_OLAT);
    LAS float* sc = (LAS float*)F.lds;
    LAS unsigned char* flg = (LAS unsigned char*)(F.lds + 32768);
    LAS unsigned char* seen = (LAS unsigned char*)(F.lds + 40960);
    LAS float* pl = (LAS float*)(F.lds + 49152);
    LAS int* cnt = (LAS int*)(F.lds + 57344);
    const int POS[16] = {0, 1, 100, 255, 256, 257, 300, 511, 1000, 2047, 2048, 4095, 5000, 6143, 6144, 8191};
    for (int s = F.bid; s < 32; s += F.G) {
        int pos = 0;
#pragma unroll
        for (int q = 0; q < 16; ++q) pos = ((s >> 1) == q) ? POS[q] : pos;
        const int b = s & 1, n = pos + 1; const size_t t = (size_t)b * SEQ + pos;
        __syncthreads();
        if (tid < 4) cnt[tid] = 0;
        for (int k = tid; k < SEQ; k += NTHR) { flg[k] = 0; seen[k] = 0; }
        for (int k = tid; k < n; k += NTHR) {
            float tot = 0.f;
            for (int hh = 0; hh < 16; ++hh) { float d = 0.f;
                for (int e = 0; e < 64; ++e) d += bf2f(qi[t * 1024 + hh * 64 + e]) * bf2f(kin[((size_t)b * SEQ + k) * 64 + e]);
                tot += wis[t * 16 + hh] * fmaxf(d, 0.f); }
            sc[k] = tot;
        }
        __syncthreads();
        const unsigned short* sel = selb + t * TOPK;
        if (n > TOPK) {
            for (int k = tid; k < n; k += NTHR) { const float v = sc[k]; int rk = 0; for (int k2 = 0; k2 < n; ++k2) { const float o = sc[k2]; rk += (o > v || (o == v && k2 < k)) ? 1 : 0; } flg[k] = rk < TOPK ? 1 : 0; }
            __syncthreads();
            if (tid < TOPK) { const int k = sel[tid]; if (k >= n) atomicAdd((int*)&cnt[1], 1000); else { if (!flg[k]) atomicAdd((int*)&cnt[0], 1); if (seen[k]) atomicAdd((int*)&cnt[1], 1000); seen[k] = 1; } }
        } else {
            if (tid < TOPK) { const int k = sel[tid]; if (tid < n ? (k != tid) : (k != 0xFFFF)) atomicAdd((int*)&cnt[1], 1000); }
        }
        __syncthreads();
        const int nv = n < TOPK ? n : TOPK;
        for (int i = tid; i < 8 * 256; i += NTHR) { const int hh = i >> 8, k = i & 255; float lg = -INFINITY;
            if (k < nv) { const int key = sel[k]; float d = 0.f; for (int r = 0; r < 256; ++r) d += bf2f(qlat[(t * 8 + hh) * 256 + r]) * fp8f(ckv8[((size_t)b * SEQ + key) * 256 + r]); lg = d * 0.08838834764831845f; }
            pl[i] = lg; }
        __syncthreads();
        if (tid < 8) { float m = -INFINITY; for (int k = 0; k < 256; ++k) m = fmaxf(m, pl[tid * 256 + k]); float l = 0.f; for (int k = 0; k < 256; ++k) { const float p = expf(pl[tid * 256 + k] - m); pl[tid * 256 + k] = p; l += p; } for (int k = 0; k < 256; ++k) pl[tid * 256 + k] /= l; }
        __syncthreads();
        for (int i = tid; i < 8 * 256; i += NTHR) { const int hh = i >> 8, r = i & 255; float o = 0.f;
            for (int k = 0; k < nv; ++k) o += pl[hh * 256 + k] * fp8f(ckv8[((size_t)b * SEQ + sel[k]) * 256 + r]);
            const float got = bf2f(olat[(t * 8 + hh) * 256 + r]);
            if (!(fabsf(got - o) <= 0.03f * fabsf(o) + 0.004f)) atomicAdd((int*)&cnt[2], 1); }
        __syncthreads();
        if (tid == 0) { unsigned code = 0; if (cnt[0] > 3 || cnt[1] > 0) code |= 1u; if (cnt[2] > 0) code |= 2u; if (code) atomicOr(F.ctl + CW_CHK, code); }
    }
}
__device__ __forceinline__ void phase_check_apply(Frame& F) {
    const unsigned code = __hip_atomic_load(F.ctl + CW_CHK, RLX_AGENT);
    if (code) { const float v = (code & 1u) ? __builtin_nanf("") : 0.f; const size_t gt = (size_t)F.bid * NTHR + F.wave * 64 + lane_id();
        for (size_t i = gt; i < (size_t)NTOK * DM; i += (size_t)F.G * NTHR) F.out[i] = v; }
}
#endif

constexpr int NPHASE = 16;
constexpr unsigned REPEAT_MASK = 0x0u;
constexpr int TIME_PHASE = -1;
constexpr int CW_TIME = 16384 + 320;
struct Args { const float* in[24]; float* out; unsigned char* ws; int ph_lo, ph_hi; };

__global__ void __launch_bounds__(NTHR, 2) mk_fwd(Args args) {
    extern __shared__ __attribute__((aligned(16))) unsigned char lds_raw[];
    Frame F;
    F.lds = (LAS unsigned char*)lds_raw;
    F.MISC = (volatile LAS unsigned*)(F.lds + MISC_OFF);
    F.wave = __builtin_amdgcn_readfirstlane(threadIdx.x >> 6);
    F.G = gridDim.x; F.bid = blockIdx.x;
    F.ws = args.ws; F.ctl = (unsigned*)(args.ws + WS_CTL); F.out = args.out;
    for (int u = threadIdx.x; u < (LDS_BYTES - MISC_OFF) / 4; u += NTHR) ((LAS unsigned*)(F.lds + MISC_OFF))[u] = 0u;
    __syncthreads();
    const int lo = args.ph_lo, hi = args.ph_hi;
    const bool multi = (hi - lo) > 1;
    XcdBarrier bar; bar.bar = F.ctl + CW_BAR; bar.x = 0; bar.st = nullptr; bar.wave = F.wave;
    if (multi) bar = xcd_barrier_post(F.ctl + CW_BAR, F.MISC + 8, F.wave);
#ifndef ONLY_PHASE
#define ONLY_PHASE -1
#endif
#define IN(k) ((ONLY_PHASE < 0 || ONLY_PHASE == (k)) && lo <= (k) && (k) < hi)
#define SEAM(k) do { if (IN(k) && IN((k) + 1)) { xcd_barrier(bar); \
        if (TIME_PHASE >= 0 && F.bid == 0 && F.wave == 0) { const unsigned long long now_ = __builtin_amdgcn_s_memrealtime(); \
            if ((k) == TIME_PHASE - 1 || ((k) == 0 && TIME_PHASE == 0 && false)) { if (lane_id() == 0) { F.ctl[CW_TIME] = (unsigned)now_; } } \
            if ((k) == TIME_PHASE) { if (lane_id() == 0) { F.ctl[CW_TIME + 1] = (unsigned)now_ - F.ctl[CW_TIME]; } } } } } while (0)
    unsigned char* ws = args.ws;
    if (TIME_PHASE == 0 && F.bid == 0 && threadIdx.x == 0) F.ctl[CW_TIME] = (unsigned)__builtin_amdgcn_s_memrealtime();

    if (IN(0)) for (int rep_ = 0; rep_ < 1 + (int)((REPEAT_MASK >> 0) & 1u); ++rep_) { phase_convert_small(F, args.in[0], args.in[1], args.in[5], args.in[6], args.in[7], args.in[9], args.in[10], args.in[11], args.in[8], args.in[14]); } SEAM(0);

    if (IN(1)) for (int rep_ = 0; rep_ < 1 + (int)((REPEAT_MASK >> 1) & 1u); ++rep_) {
        FillPlain f{(const char*)(ws + WS_XB), (const char*)(ws + WS_WIN), 4096u, 4096u, 32};
        DenseSched<FillPlain> S{64, 30, F.G, F.bid, f};
        EpiP1 E{(bf16*)(ws + WS_Q), (bf16*)(ws + WS_QI), (bf16*)(ws + WS_XP), (bf16*)(ws + WS_GATES), (float*)(ws + WS_CKVRAW), (float*)(ws + WS_KIWI)};
        pg8::gemm_phase<EpiP1, DenseSched<FillPlain>, false, true, true>(F.lds, F.wave, 4096u, 4096u, S, E);
    } SEAM(1);

    if (IN(2)) for (int rep_ = 0; rep_ < 1 + (int)((REPEAT_MASK >> 2) & 1u); ++rep_) { phase_postproc(F, args.in[2], args.in[3], args.in[4]); } SEAM(2);

    if (IN(3)) for (int rep_ = 0; rep_ < 1 + (int)((REPEAT_MASK >> 3) & 1u); ++rep_) {
        FillQlatPool f{(const char*)(ws + WS_Q), (const char*)(ws + WS_DIFF), (const char*)(ws + WS_WUK), (const char*)(ws + WS_WPOOL)};
        DenseSched<FillQlatPool> S{64, 12, F.G, F.bid, f};
        EpiQlatPool E{(bf16*)(ws + WS_QLAT), (bf16*)(ws + WS_POOL), (const float*)(ws + WS_CSCALE)};
        pg8::gemm_phase<EpiQlatPool, DenseSched<FillQlatPool>, false, true, true>(F.lds, F.wave, 2048u, 512u, S, E);
    } SEAM(3);

    if (IN(4)) for (int rep_ = 0; rep_ < 1 + (int)((REPEAT_MASK >> 4) & 1u); ++rep_) { phase_index_scores(F); } SEAM(4);
    if (IN(5)) for (int rep_ = 0; rep_ < 1 + (int)((REPEAT_MASK >> 5) & 1u); ++rep_) { phase_select(F); } SEAM(5);
    if (IN(6)) for (int rep_ = 0; rep_ < 1 + (int)((REPEAT_MASK >> 6) & 1u); ++rep_) { phase_sparse_attn(F); } SEAM(6);
#if MK_CHECK
    if (IN(6) && IN(7)) { phase_check_attn(F); xcd_barrier(bar); }
#endif

    if (IN(7)) for (int rep_ = 0; rep_ < 1 + (int)((REPEAT_MASK >> 7) & 1u); ++rep_) {
        FillO f{(const char*)(ws + WS_OLAT), (const char*)(ws + WS_WUV)};
        DenseSched<FillO> S{64, 4, F.G, F.bid, f};
        EpiBf16 E{(bf16*)(ws + WS_ATTN), 1024};
        pg8::gemm_phase<EpiBf16, DenseSched<FillO>, false, true, true>(F.lds, F.wave, 4096u, 1024u, S, E);
    } SEAM(7);

    if (IN(8)) for (int rep_ = 0; rep_ < 1 + (int)((REPEAT_MASK >> 8) & 1u); ++rep_) {
        FillPlain f{(const char*)(ws + WS_ATTN), (const char*)(ws + WS_WPA), 2048u, 2048u, 16};
        DenseSched<FillPlain> S{64, 8, F.G, F.bid, f};
        EpiGate<0> E{(const bf16*)(ws + WS_GATES), (bf16*)(ws + WS_M1), (bf16*)(ws + WS_MERGED)};
        pg8::gemm_phase<EpiGate<0>, DenseSched<FillPlain>, false, true, true>(F.lds, F.wave, 2048u, 2048u, S, E);
    } SEAM(8);

    if (IN(9)) for (int rep_ = 0; rep_ < 1 + (int)((REPEAT_MASK >> 9) & 1u); ++rep_) {
        FillPlain f{(const char*)(ws + WS_POOL), (const char*)(ws + WS_WPP), 2048u, 2048u, 16};
        DenseSched<FillPlain> S{64, 8, F.G, F.bid, f};
        EpiGate<1> E{(const bf16*)(ws + WS_GATES), (bf16*)(ws + WS_M1), (bf16*)(ws + WS_MERGED)};
        pg8::gemm_phase<EpiGate<1>, DenseSched<FillPlain>, false, true, true>(F.lds, F.wave, 2048u, 2048u, S, E);
    } SEAM(9);

    if (IN(10)) for (int rep_ = 0; rep_ < 1 + (int)((REPEAT_MASK >> 10) & 1u); ++rep_) {
        FillPlain f{(const char*)(ws + WS_MERGED), (const char*)(ws + WS_WOUT), 4096u, 4096u, 32};
        DenseSched<FillPlain> S{64, 8, F.G, F.bid, f};
        EpiPre E{args.in[0], F.out};
        pg8::gemm_phase<EpiPre, DenseSched<FillPlain>, false, true, true>(F.lds, F.wave, 4096u, 4096u, S, E);
    } SEAM(10);

    if (IN(11)) for (int rep_ = 0; rep_ < 1 + (int)((REPEAT_MASK >> 11) & 1u); ++rep_) {
        for (int rl_ = 0; rl_ < 1 + (int)((REPEAT_MASK >> 17) & 1u); ++rl_) phase_ln1_router(F, args.in[12], args.in[13], args.in[15], rl_ == 0);
        phase_convert_experts(F, args.in[16], args.in[17], args.in[18], args.in[19], args.in[20], args.in[21]);
        phase_flush_hist(F);
    } SEAM(11);
    if (IN(12)) for (int rep_ = 0; rep_ < 1 + (int)((REPEAT_MASK >> 12) & 1u); ++rep_) { phase_scatter(F); } SEAM(12);

    if (IN(13)) for (int rep_ = 0; rep_ < 1 + (int)((REPEAT_MASK >> 13) & 1u); ++rep_) {
        const int nmt = (int)__hip_atomic_load(F.ctl + CW_NMT, RLX_AGENT);
        MoeSched S{(const int*)(ws + WS_TOPK + TK_MTT), nmt, 4, F.G, F.bid, true, (const char*)(ws + WS_H), (const char*)(ws + WS_HBUF), (const char*)(ws + WS_WGU), (const char*)(ws + WS_WD), (const int*)(ws + WS_TOPK + TK_ROWLIST)};
        EpiSwiGLU E{(bf16*)(ws + WS_HBUF)};
        pg8::gemm_phase<EpiSwiGLU, MoeSched, true, true, true>(F.lds, F.wave, 4096u, 4096u, S, E);
    } SEAM(13);

    if (IN(14)) for (int rep_ = 0; rep_ < 1 + (int)((REPEAT_MASK >> 14) & 1u); ++rep_) {
        const int nmt = (int)__hip_atomic_load(F.ctl + CW_NMT, RLX_AGENT);
        MoeSched S{(const int*)(ws + WS_TOPK + TK_MTT), nmt, 8, F.G, F.bid, false, (const char*)(ws + WS_H), (const char*)(ws + WS_HBUF), (const char*)(ws + WS_WGU), (const char*)(ws + WS_WD), (const int*)(ws + WS_TOPK + TK_ROWLIST)};
        EpiY E{(bf16*)(ws + WS_Y)};
        pg8::gemm_phase<EpiY, MoeSched, false, true, true>(F.lds, F.wave, 1024u, 1024u, S, E);
    } SEAM(14);

    if (IN(15)) for (int rep_ = 0; rep_ < 1 + (int)((REPEAT_MASK >> 15) & 1u); ++rep_) { phase_combine(F, args.in[22], args.in[23]); }
#if MK_CHECK
    if (IN(15)) { xcd_barrier(bar); phase_check_apply(F); }
#endif
    if (TIME_PHASE >= 0 && multi && F.bid == 0 && F.wave == 0) {
        asm volatile("s_waitcnt vmcnt(0)" ::: "memory");
        const unsigned dur = __hip_atomic_load(F.ctl + CW_TIME + 1, RLX_AGENT); const unsigned long long t0 = __builtin_amdgcn_s_memrealtime();
        while (__builtin_amdgcn_s_memrealtime() - t0 < 4ull * dur) __builtin_amdgcn_s_sleep(8);
    }
#undef IN
#undef SEAM
}

#ifndef MK_ONE_LAUNCH
#define MK_ONE_LAUNCH 1
#endif
extern "C" void kernel_launch(void* const* d_in, const int* in_sizes, int n_in, void* d_out, int out_size, void* d_ws, size_t ws_size, hipStream_t stream) {
    static int grid = 0;
    if (grid == 0) {
        if (n_in != 24 || out_size != NTOK * DM || ws_size < WS_END) { fprintf(stderr, "kernel_launch: unexpected shapes (n_in %d out %d ws %zu)\n", n_in, out_size, ws_size); grid = -1; return; }
        int dev = 0, cus = 0;
        if (hipGetDevice(&dev) != hipSuccess || hipDeviceGetAttribute(&cus, hipDeviceAttributeMultiprocessorCount, dev) != hipSuccess) { grid = -1; return; }
        if (hipFuncSetAttribute((const void*)mk_fwd, hipFuncAttributeMaxDynamicSharedMemorySize, LDS_BYTES) != hipSuccess) { fprintf(stderr, "kernel_launch: hipFuncSetAttribute failed\n"); grid = -1; return; }
        int per_cu = 0;
        if (hipOccupancyMaxActiveBlocksPerMultiprocessor(&per_cu, (const void*)mk_fwd, NTHR, LDS_BYTES) != hipSuccess || per_cu < 1) fprintf(stderr, "kernel_launch: occupancy query says %d\n", per_cu);
        (void)hipGetLastError();
        grid = cus;
    }
    if (grid < 0) return;
    if (hipMemsetAsync((char*)d_ws + WS_CTL, 0, CTL_BYTES, stream) != hipSuccess) return;
    Args a{};
    for (int i = 0; i < 24; ++i) a.in[i] = (const float*)d_in[i];
    a.out = (float*)d_out; a.ws = (unsigned char*)d_ws;
#if MK_ONE_LAUNCH
    a.ph_lo = 0; a.ph_hi = NPHASE;
    hipLaunchKernelGGL(mk_fwd, dim3(grid), dim3(NTHR), LDS_BYTES, stream, a);
#else
    for (int p = 0; p < NPHASE; ++p) { a.ph_lo = p; a.ph_hi = p + 1; hipLaunchKernelGGL(mk_fwd, dim3(grid), dim3(NTHR), LDS_BYTES, stream, a); }
#endif
}
```

```cpp
#include <hip/hip_runtime.h>
#include <cstdio>
#include <cstdint>

#define LAS __attribute__((address_space(3)))
#define GAS __attribute__((address_space(1)))
typedef unsigned short bf16;
typedef short bf16x8 __attribute__((ext_vector_type(8)));
typedef short s16x4 __attribute__((ext_vector_type(4)));
typedef float f32x4 __attribute__((ext_vector_type(4)));
typedef float f32x2 __attribute__((ext_vector_type(2)));
typedef unsigned u32x4 __attribute__((ext_vector_type(4)));
typedef unsigned u32x2 __attribute__((ext_vector_type(2)));

constexpr int NTOK = 16384, SEQ = 8192, DM = 2048;
constexpr int NH = 8, DQK = 128, DV = 128, RKV = 256, IH = 16, IDH = 64, TOPK = 256;
constexpr int NE = 64, EK = 8, EDIM = 512, NGRP = 65;
constexpr int WIN_ROWS = 7680;
constexpr float LN_EPS = 1e-5f, RMS_EPS = 1e-6f;
constexpr float DN_ALPHA = 1.189207115002721f;
constexpr int NSLOT = NTOK * 9;
constexpr size_t SC_TOT = (size_t)128 * 128 * (64 * 65 / 2);

constexpr size_t MiB = 1u << 20;
constexpr size_t WS_CTL = 0, CTL_BYTES = 1 * MiB;
constexpr size_t WS_WIN = 1 * MiB;
constexpr size_t WS_WUK = 31 * MiB;
constexpr size_t WS_WUV = 32 * MiB;
constexpr size_t WS_WPOOL = 33 * MiB;
constexpr size_t WS_WPA = 34 * MiB;
constexpr size_t WS_WPP = 38 * MiB;
constexpr size_t WS_WOUT = 42 * MiB;
constexpr size_t WS_CSCALE = 50 * MiB;
constexpr size_t WS_WRT = 50 * MiB + 65536;
constexpr size_t WS_XB = 51 * MiB;
constexpr size_t WS_Q = 115 * MiB;
constexpr size_t WS_QI = 147 * MiB;
constexpr size_t WS_XP = 179 * MiB;
constexpr size_t WS_GATES = 211 * MiB;
constexpr size_t WS_CKVRAW = 339 * MiB;
constexpr size_t WS_KIWI = 355 * MiB;
constexpr size_t WS_CKVN = 371 * MiB;
constexpr size_t WS_KIN = 379 * MiB;
constexpr size_t WS_WI = 381 * MiB;
constexpr size_t WS_DIFF = 382 * MiB;
constexpr size_t WS_QLAT = 414 * MiB;
constexpr size_t WS_POOL = 478 * MiB;
constexpr size_t WS_SCORES = 510 * MiB;
constexpr size_t WS_SEL = 770 * MiB;
constexpr size_t WS_OLAT = 778 * MiB;
constexpr size_t WS_ATTN = 842 * MiB;
constexpr size_t WS_M1 = 874 * MiB;
constexpr size_t WS_MERGED = 938 * MiB;
constexpr size_t WS_H = 51 * MiB;
constexpr size_t WS_WD = 115 * MiB;
constexpr size_t WS_HBUF = 245 * MiB;
constexpr size_t WS_TOPK = 390 * MiB;
constexpr size_t WS_WGU = 394 * MiB;
constexpr size_t WS_Y = 394 * MiB;
constexpr size_t WS_END = 1024 * MiB;
static_assert(WS_SCORES + SC_TOT * 2 * 4 <= WS_SEL, "scores");
static_assert(WS_HBUF + (size_t)(NSLOT + 256) * EDIM * 2 <= WS_TOPK, "hbuf");
static_assert(WS_Y + (size_t)NSLOT * DM * 2 <= WS_END, "y");
constexpr size_t TK_E = 0;
constexpr size_t TK_W = 512 * 1024;
constexpr size_t TK_POS = 1024 * 1024;
constexpr size_t TK_ROWLIST = 1536 * 1024;
constexpr size_t TK_MTT = 2560 * 1024;
constexpr size_t TK_WRT = 3 * MiB;
constexpr int CW_BAR = 4096;
constexpr int CW_CNT = 16384;
constexpr int CW_FILL = 16384 + 64;
constexpr int CW_CVQ = 16384 + 192;
constexpr int CW_NMT = 16384 + 128;

constexpr int RING_BYTES = 131072;
constexpr int MISC_OFF = 143360;
constexpr int LDS_BYTES = 147456;
constexpr int NWAVES = 8, NTHR = 512;

#define RLX_AGENT __ATOMIC_RELAXED, __HIP_MEMORY_SCOPE_AGENT
#define LDS_WAIT() asm volatile("s_waitcnt lgkmcnt(0)" ::: "memory")
#define VM_WAIT() asm volatile("s_waitcnt vmcnt(0)" ::: "memory")

__device__ __forceinline__ int lane_id() { return (int)__builtin_amdgcn_mbcnt_hi(~0u, __builtin_amdgcn_mbcnt_lo(~0u, 0u)); }
__device__ __forceinline__ float bf2f(unsigned b) { return __uint_as_float(b << 16); }
__device__ __forceinline__ unsigned f2bf(float f) { unsigned u = __float_as_uint(f); return (u + 0x7fffu + ((u >> 16) & 1u)) >> 16; }
__device__ __forceinline__ unsigned pk2(float lo, float hi) { return f2bf(lo) | (f2bf(hi) << 16); }
__device__ __forceinline__ unsigned cvt_pk_bf16(float lo, float hi) { unsigned r; asm volatile("v_cvt_pk_bf16_f32 %0, %1, %2" : "=v"(r) : "v"(lo), "v"(hi)); return r; }
__device__ __forceinline__ float wave_sum(float v) {
#pragma unroll
    for (int o = 1; o < 64; o <<= 1) v += __shfl_xor(v, o);
    return v;
}
__device__ __forceinline__ int wave_sum_i(int v) {
#pragma unroll
    for (int o = 1; o < 64; o <<= 1) v += __shfl_xor(v, o);
    return v;
}

#define XB_TMO      128
#define XB_XCNT(j)  (256  + 64 * (j))
#define XB_XSUB(j)  (1280 + 64 * (j))
#define XB_XGEN(j)  (2304 + 64 * (j))
#define XB_TOP      3328
#define XB_TOPGEN   3392
#define XCD_BAR_WORDS 3456
#define XB_SPIN_CAP (1u << 24)

__device__ __forceinline__ unsigned xb_ld(unsigned* p)              { return __hip_atomic_load(p, __ATOMIC_RELAXED, __HIP_MEMORY_SCOPE_AGENT); }
__device__ __forceinline__ unsigned xb_add(unsigned* p, unsigned v) { return __hip_atomic_fetch_add(p, v, __ATOMIC_RELAXED, __HIP_MEMORY_SCOPE_AGENT); }
__device__ __forceinline__ unsigned xb_xcc_id() { return (unsigned)__builtin_amdgcn_s_getreg((3 << 11) | 20) & 0xFu; }
#define XB_SPIN(cond, bar) do { unsigned _sp = 0; while (cond) { __builtin_amdgcn_s_sleep(1); \
    if ((++_sp & 255u) == 0u) { if (xb_ld(&(bar)[XB_TMO])) break; if (_sp > XB_SPIN_CAP) { atomicAdd(&(bar)[XB_TMO], 1u); break; } } } } while (0)

struct XcdBarrier { unsigned* bar; unsigned x; volatile LAS unsigned* st; int wave; };

__device__ __forceinline__ XcdBarrier xcd_barrier_post(unsigned* bar, volatile LAS unsigned* st, int wave) {
    XcdBarrier b; b.bar = bar; b.x = xb_xcc_id(); b.st = st; b.wave = wave;
    if (wave == 0 && lane_id() == 0) (void)xb_add(&bar[XB_XCNT(b.x)], 1u);
    return b;
}
__device__ __forceinline__ void xcd_barrier_complete(unsigned* bar, unsigned x, unsigned& nloc, unsigned& nx) {
    const unsigned G = gridDim.x * gridDim.y * gridDim.z;
    unsigned sum, cnt, mine, sp = 0u;
    for (;;) {
        sum = 0u; cnt = 0u; mine = 0u;
#pragma unroll
        for (unsigned j = 0; j < 16; ++j) { const unsigned c = xb_ld(&bar[XB_XCNT(j)]); sum += c; cnt += (c > 0u) ? 1u : 0u; mine = (j == x) ? c : mine; }
        if (sum == G) break;
        __builtin_amdgcn_s_sleep(1);
        if ((++sp & 255u) == 0u) { if (xb_ld(&bar[XB_TMO])) break; if (sp > XB_SPIN_CAP) { atomicAdd(&bar[XB_TMO], 1u); break; } }
    }
    nloc = mine > 0u ? mine : 1u; nx = cnt > 0u ? cnt : 1u;
}
__device__ __forceinline__ void xcd_barrier(const XcdBarrier& b) {
    asm volatile("s_waitcnt vmcnt(0)" ::: "memory");
    __syncthreads();
    if (b.wave == 0 && lane_id() == 0) {
        unsigned* bar = b.bar;
        __builtin_amdgcn_s_waitcnt(0);
        unsigned nloc = b.st[0], nx = b.st[1];
        if (nloc == 0u) { xcd_barrier_complete(bar, b.x, nloc, nx); b.st[0] = nloc; b.st[1] = nx; }
        const unsigned old = xb_add(&bar[XB_XSUB(b.x)], 1u);
        const unsigned gen = old / nloc;
        if (old + 1u == (gen + 1u) * nloc) {
            __builtin_amdgcn_fence(__ATOMIC_RELEASE, "agent");
            asm volatile("s_waitcnt vmcnt(0)" ::: "memory");
            const unsigned og = xb_add(&bar[XB_TOP], 1u);
            const unsigned tg = og / nx;
            if (og + 1u == (tg + 1u) * nx) xb_add(&bar[XB_TOPGEN], 1u);
            else XB_SPIN(xb_ld(&bar[XB_TOPGEN]) == tg, bar);
            __builtin_amdgcn_fence(__ATOMIC_ACQUIRE, "agent");
            xb_add(&bar[XB_XGEN(b.x)], 1u);
            asm volatile("s_waitcnt vmcnt(0)" ::: "memory");
        } else {
            XB_SPIN(xb_ld(&bar[XB_XGEN(b.x)]) == gen, bar);
            __builtin_amdgcn_fence(__ATOMIC_ACQUIRE, "agent");
            asm volatile("s_waitcnt vmcnt(0)" ::: "memory");
        }
    }
    __syncthreads();
}

namespace pg8 {
constexpr int BM = 256, BK = 64, HALF = 128, HTB = HALF * BK * 2, STAGE_BYTES = 8 * HTB, NXCD = 8, WGM = 8;

__host__ __device__ __forceinline__ int lds_byte(int r, int c) { const int st = (r >> 4) * 2 + (c >> 5), rr = r & 15, cc = c & 31, ob = rr * 64 + cc * 2; return st * 1024 + (ob ^ (((ob >> 9) & 1) << 5)); }
__host__ __device__ __forceinline__ void stage_rc(int b, int& R, int& C) { const int st = b / 1024, sb = b % 1024, swz = sb ^ (((sb >> 9) & 1) << 5); R = (st >> 1) * 16 + swz / 64; C = (st & 1) * 32 + (swz % 64) / 2; }
__host__ __device__ __forceinline__ int perm32(int rho) { const int n = rho >> 4, i = rho & 15; return 8 * (i >> 2) + 4 * n + (i & 3); }

__device__ __forceinline__ const char* uptr(const char* p) { const unsigned long long v = (unsigned long long)p; const unsigned lo = __builtin_amdgcn_readfirstlane((unsigned)v), hi = __builtin_amdgcn_readfirstlane((unsigned)(v >> 32)); return (const char*)(((unsigned long long)hi << 32) | lo); }
struct GUnit {
    const char* A;
    const char* B0;
    const char* B1;
    const int* rows;
    int nt;
    int pm, pn, aux0, aux1;
};

__device__ __forceinline__ void tile_order(int L, int nM, int nN, int& pm, int& pn) {
    const int nwg = nM * nN;
    int wgid = L; { const int q = nwg / NXCD, r = nwg % NXCD, xcd = wgid % NXCD, off = wgid / NXCD; wgid = (xcd < r ? xcd * (q + 1) : r * (q + 1) + (xcd - r) * q) + off; }
    const int nig = WGM * nN, gid = wgid / nig, fm = gid * WGM, gsz = (nM - fm) < WGM ? (nM - fm) : WGM;
    pm = fm + ((wgid % nig) % gsz); pn = (wgid % nig) / gsz;
}

template <class Epi, class Sched, bool GATHER, bool ALIGN_EPI, bool SP2>
__device__ __forceinline__ void gemm_phase(LAS unsigned char* lds, const int wave, const unsigned a_rs, const unsigned b_rs, const Sched& S, const Epi& E) {
    const int wid = wave, lane = lane_id(), tid = wid * 64 + lane, wr = wid >> 2, wc = wid & 3, fr = lane & 15, fq = lane >> 4;
    int R0, C0; stage_rc(tid * 16, R0, C0);
    unsigned voffA[2], voffB[2];
#pragma unroll
    for (int i = 0; i < 2; ++i) { const int R = R0 + 64 * i; const int Rb = (R & ~31) + perm32(R & 31);
        voffA[i] = (unsigned)R * a_rs + (unsigned)C0 * 2u; voffB[i] = (unsigned)Rb * b_rs + (unsigned)C0 * 2u; }
    unsigned vgc[2][2], vgn[2][2];
    const size_t kstep = (size_t)(BK * 2);
    const size_t hstepA = (size_t)HALF * a_rs;
    const unsigned ldsw = (unsigned)wid * 1024u;
    const int aoff = lds_byte(wr * 64 + fr, fq * 8), boff = lds_byte(wc * 32 + fr, fq * 8);
#define PG8_SA(b, h) (((b) * 2 + (h)) * HTB)
#define PG8_SB(b, h) ((4 + (b) * 2 + (h)) * HTB)
#define PG8_STAGE(bufoff, gbase, voff) do { const char* _gb = (const char*)(gbase); asm volatile("" : "+s"(_gb)); _Pragma("unroll") for (int _i = 0; _i < 2; ++_i) \
        __builtin_amdgcn_global_load_lds((const unsigned*)(_gb + (voff)[_i]), (LAS unsigned*)(lds + (bufoff) + ldsw + _i * 8192), 16, 0, 0); } while (0)
#define PG8_STAGE_A(bufoff, gbase, h, vg) do { if constexpr (GATHER) { PG8_STAGE(bufoff, gbase, (vg)[h]); } else { PG8_STAGE(bufoff, (gbase) + (h) * hstepA, voffA); } } while (0)
#define PG8_LDA(dst, b, h) do { _Pragma("unroll") for (int m = 0; m < 4; ++m) _Pragma("unroll") for (int k = 0; k < 2; ++k) dst[m][k] = *(const LAS bf16x8*)(lds + PG8_SA(b, h) + aoff + m * 2048 + k * 1024); } while (0)
#define PG8_LDB(dst, b, h) do { _Pragma("unroll") for (int n = 0; n < 2; ++n) _Pragma("unroll") for (int k = 0; k < 2; ++k) dst[n][k] = *(const LAS bf16x8*)(lds + PG8_SB(b, h) + boff + n * 2048 + k * 1024); } while (0)
#define PG8_MMA(ai, bj, At, Bt) do { __builtin_amdgcn_s_setprio(1); _Pragma("unroll") for (int m = 0; m < 4; ++m) _Pragma("unroll") for (int n = 0; n < 2; ++n) _Pragma("unroll") for (int k = 0; k < 2; ++k) \
        acc[ai][bj][m][n] = __builtin_amdgcn_mfma_f32_16x16x32_bf16(Bt[n][k], At[m][k], acc[ai][bj][m][n], 0, 0, 0); __builtin_amdgcn_s_setprio(0); } while (0)
#define PG8_WAIT_V(n) asm volatile("s_waitcnt vmcnt(" #n ")" ::: "memory")
#define PG8_WAIT_L(n) asm volatile("s_waitcnt lgkmcnt(" #n ")" ::: "memory")
#define PG8_BAR __builtin_amdgcn_s_barrier()
#define PG8_SCHED __builtin_amdgcn_sched_barrier(0)
#define PG8_GOFF(dst, u) do { if constexpr (GATHER) { _Pragma("unroll") for (int _h = 0; _h < 2; ++_h) _Pragma("unroll") for (int _i = 0; _i < 2; ++_i) \
        dst[_h][_i] = (unsigned)(u).rows[_h * HALF + R0 + 64 * _i] * a_rs + (unsigned)C0 * 2u; } } while (0)
    GUnit cur, nxt; int ui = 0;
    if (!S.next(0, cur)) return;
    f32x4 acc[2][2][4][2];
#pragma unroll
    for (int a = 0; a < 2; ++a)
#pragma unroll
        for (int b = 0; b < 2; ++b)
#pragma unroll
            for (int m = 0; m < 4; ++m)
#pragma unroll
                for (int n = 0; n < 2; ++n) acc[a][b][m][n] = (f32x4){0.f, 0.f, 0.f, 0.f};
    bf16x8 At[4][2], B0[2][2], B1[2][2];
    const char* cA = uptr(cur.A); const char* cB0 = uptr(cur.B0); const char* cB1 = uptr(cur.B1); int cnt = __builtin_amdgcn_readfirstlane(cur.nt);
    PG8_GOFF(vgc, cur);
    if constexpr (SP2) {
        PG8_STAGE(PG8_SB(0, 0), cB0, voffB); PG8_STAGE(PG8_SB(0, 1), cB1, voffB); PG8_STAGE_A(PG8_SA(0, 0), cA, 0, vgc); PG8_STAGE_A(PG8_SA(0, 1), cA, 1, vgc);
        if (wr == 1) PG8_BAR;
        PG8_WAIT_V(2); PG8_BAR;
        PG8_STAGE(PG8_SB(1, 0), cB0 + kstep, voffB); PG8_STAGE_A(PG8_SA(1, 0), cA + kstep, 0, vgc); PG8_STAGE(PG8_SB(1, 1), cB1 + kstep, voffB);
        PG8_WAIT_V(6); PG8_BAR;
    } else {
        PG8_STAGE(PG8_SB(0, 0), cB0, voffB); PG8_STAGE_A(PG8_SA(0, 0), cA, 0, vgc); PG8_STAGE(PG8_SB(0, 1), cB1, voffB); PG8_STAGE_A(PG8_SA(0, 1), cA, 1, vgc);
        if (wr == 1) PG8_BAR;
        PG8_WAIT_V(4); PG8_BAR;
        PG8_STAGE(PG8_SB(1, 0), cB0 + kstep, voffB); PG8_STAGE_A(PG8_SA(1, 0), cA + kstep, 0, vgc); PG8_STAGE(PG8_SB(1, 1), cB1 + kstep, voffB);
        PG8_WAIT_V(6); PG8_BAR;
    }
    for (;;) {
        const bool has_next = S.next(ui + 1, nxt);
        const char* nA = uptr(has_next ? nxt.A : cA); const char* nB0 = uptr(has_next ? nxt.B0 : cB0); const char* nB1 = uptr(has_next ? nxt.B1 : cB1);
        if constexpr (GATHER) {
            if (has_next) { PG8_GOFF(vgn, nxt); }
            else {
#pragma unroll
                for (int _h = 0; _h < 2; ++_h)
#pragma unroll
                    for (int _i = 0; _i < 2; ++_i) vgn[_h][_i] = vgc[_h][_i];
            }
        }
        for (int t = 0; t < cnt; t += 2) {
            const bool last = (t == cnt - 2);
            const char* a1 = cA + (size_t)(t + 1) * kstep;
            const char* a2 = last ? nA : cA + (size_t)(t + 2) * kstep;
            const char* b2 = last ? nB0 : cB0 + (size_t)(t + 2) * kstep; const char* b2h = last ? nB1 : cB1 + (size_t)(t + 2) * kstep;
            const char* a3 = a2 + kstep; const char* b3 = b2 + kstep; const char* b3h = b2h + kstep;
            unsigned vg2[2][2];
            if constexpr (GATHER) {
#pragma unroll
                for (int _h = 0; _h < 2; ++_h)
#pragma unroll
                    for (int _i = 0; _i < 2; ++_i) vg2[_h][_i] = last ? vgn[_h][_i] : vgc[_h][_i];
            }
            if constexpr (SP2) {
            PG8_LDB(B0, 0, 0); PG8_LDB(B1, 0, 1); PG8_SCHED; PG8_LDA(At, 0, 0); PG8_STAGE_A(PG8_SA(1, 1), a1, 1, vgc);
            PG8_WAIT_V(8); PG8_WAIT_L(0); PG8_BAR; PG8_MMA(0, 0, At, B0); PG8_MMA(0, 1, At, B1); PG8_BAR; PG8_SCHED;
            PG8_LDA(At, 0, 1); PG8_STAGE(PG8_SB(0, 0), b2, voffB); PG8_STAGE(PG8_SB(0, 1), b2h, voffB); PG8_STAGE_A(PG8_SA(0, 0), a2, 0, vg2);
            PG8_WAIT_V(8); PG8_WAIT_L(0); PG8_BAR; PG8_MMA(1, 0, At, B0); PG8_MMA(1, 1, At, B1); PG8_BAR; PG8_SCHED;
            PG8_LDB(B0, 1, 0); PG8_LDB(B1, 1, 1); PG8_SCHED; PG8_LDA(At, 1, 0); PG8_STAGE_A(PG8_SA(0, 1), a2, 1, vg2);
            PG8_WAIT_V(8); PG8_WAIT_L(0); PG8_BAR; PG8_MMA(0, 0, At, B0); PG8_MMA(0, 1, At, B1); PG8_BAR; PG8_SCHED;
            PG8_LDA(At, 1, 1); PG8_STAGE(PG8_SB(1, 0), b3, voffB); PG8_STAGE(PG8_SB(1, 1), b3h, voffB); PG8_STAGE_A(PG8_SA(1, 0), a3, 0, vg2);
            PG8_WAIT_V(8); PG8_WAIT_L(0); PG8_BAR; PG8_MMA(1, 0, At, B0); PG8_MMA(1, 1, At, B1); PG8_BAR; PG8_SCHED;
            } else {
            PG8_LDB(B0, 0, 0); PG8_SCHED; PG8_LDA(At, 0, 0); PG8_STAGE_A(PG8_SA(1, 1), a1, 1, vgc);
            PG8_WAIT_L(8); PG8_BAR; PG8_WAIT_L(0); PG8_MMA(0, 0, At, B0); PG8_BAR; PG8_SCHED;
            PG8_LDB(B1, 0, 1); PG8_STAGE(PG8_SB(0, 0), b2, voffB);
            PG8_BAR; PG8_WAIT_L(0); PG8_MMA(0, 1, At, B1); PG8_BAR;
            PG8_LDA(At, 0, 1); PG8_STAGE_A(PG8_SA(0, 0), a2, 0, vg2);
            PG8_BAR; PG8_WAIT_L(0); PG8_MMA(1, 0, At, B0); PG8_BAR; PG8_SCHED;
            PG8_STAGE(PG8_SB(0, 1), b2h, voffB);
            PG8_WAIT_V(6); PG8_BAR; PG8_MMA(1, 1, At, B1); PG8_BAR;
            PG8_LDB(B0, 1, 0); PG8_SCHED; PG8_LDA(At, 1, 0); PG8_STAGE_A(PG8_SA(0, 1), a2, 1, vg2);
            PG8_WAIT_L(8); PG8_BAR; PG8_WAIT_L(0); PG8_MMA(0, 0, At, B0); PG8_BAR; PG8_SCHED;
            PG8_LDB(B1, 1, 1); PG8_STAGE(PG8_SB(1, 0), b3, voffB);
            PG8_BAR; PG8_WAIT_L(0); PG8_MMA(0, 1, At, B1); PG8_BAR;
            PG8_LDA(At, 1, 1); PG8_STAGE_A(PG8_SA(1, 0), a3, 0, vg2);
            PG8_BAR; PG8_WAIT_L(0); PG8_MMA(1, 0, At, B0); PG8_BAR; PG8_SCHED;
            PG8_STAGE(PG8_SB(1, 1), b3h, voffB);
            PG8_WAIT_V(6); PG8_BAR; PG8_MMA(1, 1, At, B1); PG8_BAR;
            }
        }
        if constexpr (ALIGN_EPI) { if (wr == 0) PG8_BAR; }
        { int l2 = lane_id(); asm volatile("" : "+v"(l2)); const int fr2 = l2 & 15, fq2 = l2 >> 4; E(acc, cur, wr, wc, fr2, fq2); }
        if (!has_next) break;
#pragma unroll
        for (int a = 0; a < 2; ++a)
#pragma unroll
            for (int b = 0; b < 2; ++b)
#pragma unroll
                for (int m = 0; m < 4; ++m)
#pragma unroll
                    for (int n = 0; n < 2; ++n) acc[a][b][m][n] = (f32x4){0.f, 0.f, 0.f, 0.f};
        cur = nxt; cA = nA; cB0 = nB0; cB1 = nB1; cnt = __builtin_amdgcn_readfirstlane(cur.nt); ++ui;
        if constexpr (GATHER) {
#pragma unroll
            for (int _h = 0; _h < 2; ++_h)
#pragma unroll
                for (int _i = 0; _i < 2; ++_i) vgc[_h][_i] = vgn[_h][_i];
        }
        if constexpr (ALIGN_EPI) { if (wr == 1) PG8_BAR; }
    }
    PG8_WAIT_V(0);
    if constexpr (!ALIGN_EPI) { if (wr == 0) PG8_BAR; }
    PG8_BAR;
#undef PG8_SA
#undef PG8_SB
#undef PG8_STAGE
#undef PG8_STAGE_A
#undef PG8_LDA
#undef PG8_LDB
#undef PG8_MMA
#undef PG8_WAIT_V
#undef PG8_WAIT_L
#undef PG8_BAR
#undef PG8_SCHED
#undef PG8_GOFF
}
}

struct Frame {
    LAS unsigned char* lds;
    volatile LAS unsigned* MISC;
    unsigned* ctl;
    unsigned char* ws;
    float* out;
    int wave, G, bid;
};
using pg8::GUnit;

template <class Fill> struct DenseSched {
    int nM, nN, G, c; Fill f;
    __device__ __forceinline__ bool next(int i, GUnit& u) const {
        const long L = (long)i * G + c; if (L >= (long)nM * nN) return false;
        int pm, pn; pg8::tile_order((int)L, nM, nN, pm, pn); u.pm = pm; u.pn = pn; u.rows = nullptr; u.aux0 = 0; u.aux1 = 0; f(u); return true;
    }
};
struct FillPlain {
    const char* A; const char* B; unsigned a_rs, b_rs; int nt;
    __device__ __forceinline__ void operator()(GUnit& u) const { u.A = A + (size_t)u.pm * 256 * a_rs; u.B0 = B + (size_t)u.pn * 256 * b_rs; u.B1 = u.B0 + (size_t)128 * b_rs; u.nt = nt; }
};
struct FillQlatPool {
    const char* q; const char* diff; const char* wuk; const char* wpool;
    __device__ __forceinline__ void operator()(GUnit& u) const {
        if (u.pn < 8) { u.A = q + (size_t)u.pm * 256 * 2048 + (size_t)((u.pn & ~1) * 128) * 2; u.B0 = wuk + (size_t)u.pn * 256 * 512; }
        else { const int g = u.pn - 8; u.A = diff + (size_t)u.pm * 256 * 2048 + (size_t)(g * 256) * 2; u.B0 = wpool + (size_t)g * 256 * 512; }
        u.B1 = u.B0 + (size_t)128 * 512; u.nt = 4;
    }
};
struct FillO {
    const char* olat; const char* wuv;
    __device__ __forceinline__ void operator()(GUnit& u) const { u.A = olat + (size_t)u.pm * 256 * 4096 + (size_t)(u.pn * 512) * 2; u.B0 = wuv + (size_t)u.pn * 256 * 1024; u.B1 = u.B0 + (size_t)128 * 1024; u.nt = 8; }
};

#define EPI_LOOP_ROWS for (int ai = 0; ai < 2; ++ai) _Pragma("unroll") for (int m = 0; m < 4; ++m)
__device__ __forceinline__ u32x4 pack8(const f32x4 v0, const f32x4 v1) { u32x4 w; w.x = cvt_pk_bf16(v0[0], v0[1]); w.y = cvt_pk_bf16(v0[2], v0[3]); w.z = cvt_pk_bf16(v1[0], v1[1]); w.w = cvt_pk_bf16(v1[2], v1[3]); return w; }
__device__ __forceinline__ float sigmoidf_(float x) { return 1.0f / (1.0f + __expf(-x)); }

struct EpiP1 {
    bf16* q; bf16* qi; bf16* xp; bf16* gates; float* ckvraw; float* kiwi;
    __device__ __forceinline__ void operator()(const f32x4 (&acc)[2][2][4][2], const GUnit& u, int wr, int wc, int fr, int fq) const {
        const int row0 = u.pm * 256 + wr * 64 + fr, cl = wc * 32 + 8 * fq;
        if (u.pn < 28) {
            bf16* base; int ld, c0; bool sg = false;
            if (u.pn < 4) { base = q; ld = 1024; c0 = u.pn * 256; } else if (u.pn < 8) { base = qi; ld = 1024; c0 = (u.pn - 4) * 256; }
            else if (u.pn < 12) { base = xp; ld = 1024; c0 = (u.pn - 8) * 256; } else { base = gates; ld = 4096; c0 = (u.pn - 12) * 256; sg = true; }
#pragma unroll
            EPI_LOOP_ROWS { bf16* rowp = base + (size_t)(row0 + ai * 128 + m * 16) * ld + c0 + cl;
#pragma unroll
                for (int bj = 0; bj < 2; ++bj) { f32x4 v0 = acc[ai][bj][m][0], v1 = acc[ai][bj][m][1];
                    if (sg) {
#pragma unroll
                        for (int j = 0; j < 4; ++j) { v0[j] = sigmoidf_(v0[j]); v1[j] = sigmoidf_(v1[j]); } }
                    *(u32x4*)(rowp + bj * 128) = pack8(v0, v1); } }
        } else {
            float* base = (u.pn == 28) ? ckvraw : kiwi;
#pragma unroll
            EPI_LOOP_ROWS { float* rowp = base + (size_t)(row0 + ai * 128 + m * 16) * 256 + cl;
#pragma unroll
                for (int bj = 0; bj < 2; ++bj) { *(f32x4*)(rowp + bj * 128) = acc[ai][bj][m][0]; *(f32x4*)(rowp + bj * 128 + 4) = acc[ai][bj][m][1]; } }
        }
    }
};
struct EpiQlatPool {
    bf16* qlat; bf16* pool; const float* colscale;
    __device__ __forceinline__ void operator()(const f32x4 (&acc)[2][2][4][2], const GUnit& u, int wr, int wc, int fr, int fq) const {
        const int row0 = u.pm * 256 + wr * 64 + fr, cl = wc * 32 + 8 * fq;
        const bool ql = u.pn < 8;
        bf16* base = ql ? qlat + u.pn * 256 : pool + (u.pn - 8) * 256; const int ld = ql ? 2048 : 1024;
        const float* sp = colscale + u.pn * 256 + cl;
        __builtin_amdgcn_sched_barrier(0);
        const f32x4 s00 = *(const f32x4*)(sp), s01 = *(const f32x4*)(sp + 4), s10 = *(const f32x4*)(sp + 128), s11 = *(const f32x4*)(sp + 132);
#pragma unroll
        EPI_LOOP_ROWS { bf16* rowp = base + (size_t)(row0 + ai * 128 + m * 16) * ld + cl;
            *(u32x4*)(rowp) = pack8(acc[ai][0][m][0] * s00, acc[ai][0][m][1] * s01);
            *(u32x4*)(rowp + 128) = pack8(acc[ai][1][m][0] * s10, acc[ai][1][m][1] * s11); }
    }
};
struct EpiBf16 {
    bf16* O; int ld;
    __device__ __forceinline__ void operator()(const f32x4 (&acc)[2][2][4][2], const GUnit& u, int wr, int wc, int fr, int fq) const {
        const int row0 = u.pm * 256 + wr * 64 + fr, cl = u.pn * 256 + wc * 32 + 8 * fq;
#pragma unroll
        EPI_LOOP_ROWS { bf16* rowp = O + (size_t)(row0 + ai * 128 + m * 16) * ld + cl;
#pragma unroll
            for (int bj = 0; bj < 2; ++bj) *(u32x4*)(rowp + bj * 128) = pack8(acc[ai][bj][m][0], acc[ai][bj][m][1]); }
    }
};
__device__ __forceinline__ void unpack8(const u32x4 w, f32x4& a, f32x4& b) {
    a[0] = bf2f(w.x & 0xffffu); a[1] = bf2f(w.x >> 16); a[2] = bf2f(w.y & 0xffffu); a[3] = bf2f(w.y >> 16);
    b[0] = bf2f(w.z & 0xffffu); b[1] = bf2f(w.z >> 16); b[2] = bf2f(w.w & 0xffffu); b[3] = bf2f(w.w >> 16);
}
template <int MODE> struct EpiGate {
    const bf16* gates; bf16* M1; bf16* merged;
    __device__ __forceinline__ void operator()(const f32x4 (&acc)[2][2][4][2], const GUnit& u, int wr, int wc, int fr, int fq) const {
        const int row0 = u.pm * 256 + wr * 64 + fr, cl = u.pn * 256 + wc * 32 + 8 * fq;
#pragma unroll
        for (int ai = 0; ai < 2; ++ai) {
            u32x4 gq[4][2], mq[4][2];
#pragma unroll
            for (int m = 0; m < 4; ++m)
#pragma unroll
                for (int bj = 0; bj < 2; ++bj) { const size_t r = (size_t)(row0 + ai * 128 + m * 16); const int c = cl + bj * 128;
                    gq[m][bj] = *(const u32x4*)(gates + r * 4096 + (MODE ? 2048 : 0) + c); if (MODE) mq[m][bj] = *(const u32x4*)(M1 + r * 2048 + c); }
            __builtin_amdgcn_sched_barrier(0);
#pragma unroll
            for (int m = 0; m < 4; ++m)
#pragma unroll
                for (int bj = 0; bj < 2; ++bj) { const size_t r = (size_t)(row0 + ai * 128 + m * 16); const int c = cl + bj * 128;
                    f32x4 g0, g1; unpack8(gq[m][bj], g0, g1);
                    f32x4 v0 = acc[ai][bj][m][0] * g0, v1 = acc[ai][bj][m][1] * g1;
                    if (MODE) { f32x4 p0, p1; unpack8(mq[m][bj], p0, p1); v0 += p0; v1 += p1; *(u32x4*)(merged + r * 2048 + c) = pack8(v0, v1); }
                    else *(u32x4*)(M1 + r * 2048 + c) = pack8(v0, v1); }
            __builtin_amdgcn_sched_barrier(0);
        }
    }
};
struct EpiPre {
    const float* x; float* pre;
    __device__ __forceinline__ void operator()(const f32x4 (&acc)[2][2][4][2], const GUnit& u, int wr, int wc, int fr, int fq) const {
        const int row0 = u.pm * 256 + wr * 64 + fr, cl = u.pn * 256 + wc * 32 + 8 * fq;
#pragma unroll
        for (int ai = 0; ai < 2; ++ai) {
            f32x4 xq[4][2][2];
#pragma unroll
            for (int m = 0; m < 4; ++m)
#pragma unroll
                for (int bj = 0; bj < 2; ++bj) { const size_t o = (size_t)(row0 + ai * 128 + m * 16) * 2048 + cl + bj * 128; xq[m][bj][0] = __builtin_nontemporal_load((const f32x4*)(x + o)); xq[m][bj][1] = __builtin_nontemporal_load((const f32x4*)(x + o + 4)); }
            __builtin_amdgcn_sched_barrier(0);
#pragma unroll
            for (int m = 0; m < 4; ++m)
#pragma unroll
                for (int bj = 0; bj < 2; ++bj) { const size_t o = (size_t)(row0 + ai * 128 + m * 16) * 2048 + cl + bj * 128;
                    *(f32x4*)(pre + o) = xq[m][bj][0] * DN_ALPHA + acc[ai][bj][m][0]; *(f32x4*)(pre + o + 4) = xq[m][bj][1] * DN_ALPHA + acc[ai][bj][m][1]; }
            __builtin_amdgcn_sched_barrier(0);
        }
    }
};
struct MoeSched {
    const int* mtt; int nmt; int NT; int G, c; bool gateup;
    const char* h; const char* hbuf; const char* wgu; const char* wd; const int* rowlist;
    __device__ __forceinline__ bool next(int i, GUnit& u) const {
        const int total = nmt * NT; int U;
        if ((G & 7) == 0) { const int x = c & 7, j = i * (G >> 3) + (c >> 3); const int lo = (int)(((long)total * x) >> 3), hi = (int)(((long)total * (x + 1)) >> 3); U = lo + j; if (U >= hi) return false; }
        else { const long L = (long)i * G + c; if (L >= total) return false; U = (int)L; }
        return fill(U, u);
    }
    __device__ __forceinline__ bool fill(int U, GUnit& u) const {
        const int MT = U / NT, nt_ = U - MT * NT;
        const int g = __builtin_amdgcn_readfirstlane(mtt[MT * 4 + 0]), p0 = __builtin_amdgcn_readfirstlane(mtt[MT * 4 + 1]), nv = __builtin_amdgcn_readfirstlane(mtt[MT * 4 + 2]);
        u.pm = p0; u.pn = nt_; u.aux0 = nv; u.aux1 = g;
        if (gateup) { u.A = h; u.rows = rowlist + p0; u.B0 = wgu + ((size_t)g * 1024 + (size_t)nt_ * 256) * 4096; u.B1 = u.B0 + (size_t)128 * 4096; u.nt = 32; }
        else { u.A = hbuf + (size_t)p0 * 1024; u.rows = nullptr; u.B0 = wd + ((size_t)g * 2048 + (size_t)nt_ * 256) * 1024; u.B1 = u.B0 + (size_t)128 * 1024; u.nt = 8; }
        return true;
    }
};
struct EpiSwiGLU {
    bf16* H;
    __device__ __forceinline__ void operator()(const f32x4 (&acc)[2][2][4][2], const GUnit& u, int wr, int wc, int fr, int fq) const {
        const int cl = u.pn * 128 + wc * 32 + 8 * fq;
#pragma unroll
        EPI_LOOP_ROWS { const int r = ai * 128 + wr * 64 + m * 16 + fr;
            if (r < u.aux0) { f32x4 v[2];
#pragma unroll
                for (int n = 0; n < 2; ++n)
#pragma unroll
                    for (int j = 0; j < 4; ++j) { const float g = acc[ai][0][m][n][j], up = acc[ai][1][m][n][j]; v[n][j] = g * sigmoidf_(g) * up; }
                *(u32x4*)(H + (size_t)(u.pm + r) * 512 + cl) = pack8(v[0], v[1]); } }
    }
};
struct EpiY {
    bf16* Y;
    __device__ __forceinline__ void operator()(const f32x4 (&acc)[2][2][4][2], const GUnit& u, int wr, int wc, int fr, int fq) const {
        const int cl = u.pn * 256 + wc * 32 + 8 * fq;
#pragma unroll
        EPI_LOOP_ROWS { const int r = ai * 128 + wr * 64 + m * 16 + fr;
            if (r < u.aux0) { bf16* rowp = Y + (size_t)(u.pm + r) * 2048 + cl;
#pragma unroll
                for (int bj = 0; bj < 2; ++bj) *(u32x4*)(rowp + bj * 128) = pack8(acc[ai][bj][m][0], acc[ai][bj][m][1]); } }
    }
};

template <class RowMap>
__device__ __forceinline__ void tr_item(const float* W, int ldw, int nvalid, bf16* WT, int ldT, LAS float* scr, int kb, int nb, int lane, const RowMap& rm) {
    const int k0 = 64 * kb, n0 = 32 * nb;
    const int c4 = 4 * (lane & 7), kr = lane >> 3;
    f32x4 v[8];
#pragma unroll
    for (int i = 0; i < 8; ++i) { v[i] = (f32x4){0.f, 0.f, 0.f, 0.f}; if (n0 + c4 < nvalid) v[i] = *(const f32x4*)(W + (size_t)(k0 + 8 * i + kr) * ldw + n0 + c4); }
#pragma unroll
    for (int i = 0; i < 8; ++i) { LAS float* d = scr + (8 * i + kr) * 33 + c4; d[0] = v[i][0]; d[1] = v[i][1]; d[2] = v[i][2]; d[3] = v[i][3]; }
    LDS_WAIT(); asm volatile("" ::: "memory");
    const int c = lane & 7;
#pragma unroll
    for (int j = 0; j < 4; ++j) { const int nl = (lane >> 3) + 8 * j; const LAS float* s = scr + (8 * c) * 33 + nl;
        u32x4 o; o.x = pk2(s[0 * 33], s[1 * 33]); o.y = pk2(s[2 * 33], s[3 * 33]); o.z = pk2(s[4 * 33], s[5 * 33]); o.w = pk2(s[6 * 33], s[7 * 33]);
        if (n0 + nl < nvalid) *(u32x4*)(WT + (size_t)rm(n0 + nl) * ldT + k0 + 8 * c) = o; }
    LDS_WAIT(); asm volatile("" ::: "memory");
}
struct MapId { int off; __device__ __forceinline__ int operator()(int n) const { return off + n; } };
struct MapWin {
    __device__ __forceinline__ int operator()(int n) const {
        if (n < 1024) return n;
        if (n < 1280) return 7168 + (n - 1024);
        if (n < 2304) return 1024 + (n - 1280);
        if (n < 2368) return 7424 + (n - 2304);
        if (n < 2384) return 7488 + (n - 2368);
        if (n < 3408) return 2048 + (n - 2384);
        return 3072 + (n - 3408);
    }
};
struct MapGU { int up; __device__ __forceinline__ int operator()(int f) const { return (f >> 7) * 256 + up * 128 + (f & 127); } };

__device__ __forceinline__ void phase_convert_small(Frame& F, const float* x, const float* w_in, const float* w_uk, const float* w_uv, const float* w_pool, const float* w_pa, const float* w_pp, const float* w_out, const float* pscale, const float* w_router) {
    const int lane_ = lane_id(), tid_ = F.wave * 64 + lane_;
    { float* wt = (float*)(F.ws + WS_WRT); for (size_t i = (size_t)F.bid * NTHR + tid_; i < (size_t)64 * 2048; i += (size_t)F.G * NTHR) { const int e = (int)(i >> 11), d = (int)(i & 2047); wt[i] = w_router[(size_t)d * 64 + e]; } }
    { float* cs = (float*)(F.ws + WS_CSCALE); for (size_t i = (size_t)F.bid * NTHR + tid_; i < 3072; i += (size_t)F.G * NTHR) cs[i] = (i < 2048) ? 1.0f : pscale[i - 2048]; }
    bf16* xb = (bf16*)(F.ws + WS_XB);
    const size_t gt = (size_t)F.bid * NTHR + tid_, nth = (size_t)F.G * NTHR;
    for (size_t i0 = gt; i0 < (size_t)NTOK * DM / 8; i0 += 4 * nth) {
        f32x4 a[4], b[4];
#pragma unroll
        for (int q = 0; q < 4; ++q) { const size_t i = i0 + q * nth; a[q] = __builtin_nontemporal_load((const f32x4*)x + 2 * i); b[q] = __builtin_nontemporal_load((const f32x4*)x + 2 * i + 1); }
        __builtin_amdgcn_sched_barrier(0);
#pragma unroll
        for (int q = 0; q < 4; ++q) { const size_t i = i0 + q * nth; u32x4 o; o.x = pk2(a[q][0], a[q][1]); o.y = pk2(a[q][2], a[q][3]); o.z = pk2(b[q][0], b[q][1]); o.w = pk2(b[q][2], b[q][3]); ((u32x4*)xb)[i] = o; }
    }
    LAS float* scr = (LAS float*)(F.lds + F.wave * 8704);
    const int gw = F.bid * NWAVES + F.wave, NGW = F.G * NWAVES;
    constexpr int I_IN = 32 * 235, I_POOL = 4 * 4 * 8, I_PA = 16 * 64, I_PP = 16 * 64, I_OUT = 32 * 64;
    constexpr int NIT = I_IN + I_POOL + I_PA + I_PP + I_OUT;
    for (int it = gw; it < NIT; it += NGW) {
        int r = it;
        if (r < I_IN) { tr_item(w_in, 7504, 7504, (bf16*)(F.ws + WS_WIN), 2048, scr, r / 235, r % 235, lane_, MapWin{}); continue; } r -= I_IN;
        if (r < I_POOL) { const int g = r / 32, q = r % 32; tr_item(w_pool + (size_t)g * 65536, 256, 256, (bf16*)(F.ws + WS_WPOOL) + (size_t)g * 65536, 256, scr, q / 8, q % 8, lane_, MapId{0}); continue; } r -= I_POOL;
        if (r < I_PA) { tr_item(w_pa, 2048, 2048, (bf16*)(F.ws + WS_WPA), 1024, scr, r / 64, r % 64, lane_, MapId{0}); continue; } r -= I_PA;
        if (r < I_PP) { tr_item(w_pp, 2048, 2048, (bf16*)(F.ws + WS_WPP), 1024, scr, r / 64, r % 64, lane_, MapId{0}); continue; } r -= I_PP;
        tr_item(w_out, 2048, 2048, (bf16*)(F.ws + WS_WOUT), 2048, scr, r / 64, r % 64, lane_, MapId{0});
    }
    { bf16* wp = (bf16*)(F.ws + WS_WIN) + (size_t)7504 * 2048; for (size_t i = gt; i < (size_t)176 * 2048 / 8; i += nth) ((u32x4*)wp)[i] = (u32x4){0u, 0u, 0u, 0u}; }
    { const float* wuk = w_uk; bf16* o = (bf16*)(F.ws + WS_WUK);
      for (size_t i = gt; i < (size_t)2048 * 256; i += nth) { const int kp = (int)(i & 255), row = (int)(i >> 8), h = row >> 8, r = row & 255;
          o[i] = ((kp >> 7) == (h & 1)) ? (bf16)f2bf(wuk[(size_t)r * 1024 + h * 128 + (kp & 127)]) : (bf16)0; } }
    { const float* wuv = w_uv; bf16* o = (bf16*)(F.ws + WS_WUV);
      for (size_t i = gt; i < (size_t)1024 * 512; i += nth) { const int kp = (int)(i & 511), row = (int)(i >> 9), pn = row >> 8, hh = (row >> 7) & 1, d = row & 127, hh2 = kp >> 8, r = kp & 255;
          o[i] = (hh == hh2) ? (bf16)f2bf(wuv[(size_t)r * 1024 + (2 * pn + hh) * 128 + d]) : (bf16)0; } }
}

__device__ __forceinline__ void phase_convert_experts(Frame& F, const float* wge, const float* wue, const float* wde, const float* wgs, const float* wus, const float* wds) {
    const int lane_ = lane_id();
    LAS float* scr = (LAS float*)(F.lds + 32768 + F.wave * 8704);
    constexpr int PER = 1536, NIT = NGRP * PER, BATCH = 8;
    for (;;) {
        int base = 0;
        if (lane_ == 0) base = (int)__hip_atomic_fetch_add(F.ctl + CW_CVQ, (unsigned)BATCH, RLX_AGENT);
        base = __builtin_amdgcn_readfirstlane(base);
        if (base >= NIT) break;
        for (int it = base; it < base + BATCH && it < NIT; ++it) {
            const int g = it / PER; int r = it - g * PER;
            const float* wg = (g < NE) ? wge + (size_t)g * 2048 * 512 : wgs;
            const float* wu = (g < NE) ? wue + (size_t)g * 2048 * 512 : wus;
            const float* wd = (g < NE) ? wde + (size_t)g * 512 * 2048 : wds;
            bf16* ogu = (bf16*)(F.ws + WS_WGU) + (size_t)g * 1024 * 2048; bf16* od = (bf16*)(F.ws + WS_WD) + (size_t)g * 2048 * 512;
            if (r < 512) { tr_item(wg, 512, 512, ogu, 2048, scr, r / 16, r % 16, lane_, MapGU{0}); continue; } r -= 512;
            if (r < 512) { tr_item(wu, 512, 512, ogu, 2048, scr, r / 16, r % 16, lane_, MapGU{1}); continue; } r -= 512;
            tr_item(wd, 2048, 2048, od, 512, scr, r / 64, r % 64, lane_, MapId{0});
        }
    }
}

__device__ __forceinline__ void phase_postproc(Frame& F, const float* cg, const float* kg, const float* kb) {
    const int lane_ = lane_id(), tid_ = F.wave * 64 + lane_;
    const float* ckvraw = (const float*)(F.ws + WS_CKVRAW); const float* kiwi = (const float*)(F.ws + WS_KIWI);
    unsigned* ckvn = (unsigned*)(F.ws + WS_CKVN); bf16* kin = (bf16*)(F.ws + WS_KIN); float* wis = (float*)(F.ws + WS_WI);
    const int gw = F.bid * NWAVES + F.wave, NGW = F.G * NWAVES, lane = lane_;
    const f32x4 g4 = *(const f32x4*)(cg + lane * 4); const float kgl = kg[lane], kbl = kb[lane];
    for (int t0 = gw; t0 < NTOK; t0 += 4 * NGW) {
        f32x4 v[4]; float kv[4], wv[4];
#pragma unroll
        for (int q = 0; q < 4; ++q) { const int t = t0 + q * NGW; v[q] = (f32x4){0.f, 0.f, 0.f, 0.f}; kv[q] = 0.f; wv[q] = 0.f;
            if (t < NTOK) { v[q] = *(const f32x4*)(ckvraw + (size_t)t * 256 + lane * 4); kv[q] = kiwi[(size_t)t * 256 + lane]; wv[q] = kiwi[(size_t)t * 256 + 64 + (lane & 15)]; } }
#pragma unroll
        for (int q = 0; q < 4; ++q) { const int t = t0 + q * NGW;
            const float ss = wave_sum(v[q][0] * v[q][0] + v[q][1] * v[q][1] + v[q][2] * v[q][2] + v[q][3] * v[q][3]);
            const float rs = 1.0f / sqrtf(ss * (1.0f / 256.0f) + RMS_EPS);
            int o8 = __builtin_amdgcn_cvt_pk_fp8_f32(v[q][0] * rs * g4[0], v[q][1] * rs * g4[1], 0, false);
            o8 = __builtin_amdgcn_cvt_pk_fp8_f32(v[q][2] * rs * g4[2], v[q][3] * rs * g4[3], o8, true);
            const float mu = wave_sum(kv[q]) * (1.0f / 64.0f); const float dlt = kv[q] - mu;
            const float var = wave_sum(dlt * dlt) * (1.0f / 64.0f);
            const float y = dlt * (1.0f / sqrtf(var + LN_EPS)) * kgl + kbl;
            if (t < NTOK) { ckvn[(size_t)t * 64 + lane] = (unsigned)o8; kin[(size_t)t * 64 + lane] = (bf16)f2bf(y); if (lane < 16) wis[(size_t)t * 16 + lane] = wv[q] * 0.03125f; } }
    }
    const bf16* xp = (const bf16*)(F.ws + WS_XP); bf16* diff = (bf16*)(F.ws + WS_DIFF);
    const size_t gt = (size_t)F.bid * NTHR + tid_, nth = (size_t)F.G * NTHR;
    for (size_t i = gt; i < (size_t)(NTOK / 16) * 128; i += nth) {
        const int run = (int)(i >> 7), cgp = (int)(i & 127), g = cgp >> 5, win = 2 << g, tb = run * 16, posb = tb & (SEQ - 1);
        const bf16* col = xp + cgp * 8;
        u32x4 rw[31];
#pragma unroll
        for (int j = 0; j < 31; ++j) { const int dr = j - 15; rw[j] = (u32x4){0u, 0u, 0u, 0u}; if (dr >= 1 - win && posb + dr >= 0) rw[j] = *(const u32x4*)(col + (size_t)(tb + dr) * 1024); }
        __builtin_amdgcn_sched_barrier(0);
        f32x4 s0 = {0.f, 0.f, 0.f, 0.f}, s1 = {0.f, 0.f, 0.f, 0.f};
#pragma unroll
        for (int j = 1; j < 16; ++j) { if (j < win) { f32x4 a, b; unpack8(rw[15 - j], a, b); s0 += a; s1 += b; } }
#pragma unroll
        for (int q = 0; q < 16; ++q) { const int t = tb + q, pos = posb + q;
            f32x4 a, b; unpack8(rw[15 + q], a, b); s0 += a; s1 += b;
            const int cntw = (pos + 1 < win) ? pos + 1 : win; const float inv = 1.0f / (float)cntw;
            *(u32x4*)(diff + (size_t)t * 1024 + cgp * 8) = pack8(s0 * inv - a, s1 * inv - b);
            f32x4 c, d; const u32x4 r2 = rw[15 + q - 1], r4 = rw[15 + q - 3], r8 = rw[15 + q - 7], r16 = rw[15 + q - 15];
            const u32x4 rr = (win == 2) ? r2 : (win == 4) ? r4 : (win == 8) ? r8 : r16;
            unpack8(rr, c, d); s0 -= c; s1 -= d; }
    }
}

__device__ __forceinline__ size_t score_rowbase(int b, int p) { const int jq = p >> 7; return (size_t)b * SC_TOT + (size_t)16384 * (size_t)(jq * (jq + 1) / 2) + (size_t)(p & 127) * (size_t)(128 * (jq + 1)); }

__device__ __forceinline__ void phase_index_scores(Frame& F) {
    const int lane_ = lane_id(), tid_ = F.wave * 64 + lane_;
    const bf16* qi = (const bf16*)(F.ws + WS_QI); const bf16* kin = (const bf16*)(F.ws + WS_KIN); const float* wis = (const float*)(F.ws + WS_WI);
    float* scores = (float*)(F.ws + WS_SCORES);
    const int lane = lane_, w = F.wave, fq = lane >> 4, j16 = lane & 15, tid = tid_;
    LAS unsigned char* kb = F.lds;
    const int sR = tid >> 3, sc = tid & 7, sP = (sR & 3) * 16 + (sR >> 2);
    const int st_off = sP * 128 + ((sc ^ ((sP >> 1) & 7)) * 16);
    for (int it = 0;; ++it) {
        const int jj = (it >> 1) * F.G + F.bid; if (jj >= 256) break;
        const int s = (it & 1) ? 511 - jj : jj;
        const int b = s & 1, qg = s >> 1, tq0 = qg * 32;
        const int nsteps = (tq0 + 32 + 63) / 64;
        bf16x8 Af[4][2];
        { const size_t tok = (size_t)b * SEQ + tq0 + 4 * w + (j16 >> 2);
#pragma unroll
          for (int g = 0; g < 4; ++g)
#pragma unroll
              for (int ks = 0; ks < 2; ++ks) Af[g][ks] = *(const bf16x8*)(qi + tok * 1024 + (4 * g + (j16 & 3)) * 64 + ks * 32 + 8 * fq); }
        f32x4 wv[4];
        { const size_t tok = (size_t)b * SEQ + tq0 + 4 * w + fq;
#pragma unroll
          for (int g = 0; g < 4; ++g) wv[g] = *(const f32x4*)(wis + tok * 16 + 4 * g); }
        float* orow = scores + score_rowbase(b, tq0 + 4 * w + fq);
        const bf16* kbase = kin + (size_t)b * SEQ * 64;
        u32x4 stg = *(const u32x4*)(kbase + (size_t)sR * 64 + sc * 8);
        __syncthreads();
        *(LAS u32x4*)(kb + st_off) = stg;
        __syncthreads();
        for (int step = 0; step < nsteps; ++step) {
            const int cur = step & 1;
            if (step + 1 < nsteps) stg = *(const u32x4*)(kbase + (size_t)((step + 1) * 64 + sR) * 64 + sc * 8);
            f32x4 res;
#pragma unroll
            for (int u = 0; u < 4; ++u) {
                const int P = u * 16 + j16;
                f32x4 a4[4];
#pragma unroll
                for (int g = 0; g < 4; ++g) a4[g] = (f32x4){0.f, 0.f, 0.f, 0.f};
#pragma unroll
                for (int ks = 0; ks < 2; ++ks) {
                    const bf16x8 bfr = *(const LAS bf16x8*)(kb + cur * 8192 + P * 128 + (((fq + 4 * ks) ^ ((P >> 1) & 7)) * 16));
#pragma unroll
                    for (int g = 0; g < 4; ++g) a4[g] = __builtin_amdgcn_mfma_f32_16x16x32_bf16(Af[g][ks], bfr, a4[g], 0, 0, 0);
                }
                float sres = 0.f;
#pragma unroll
                for (int g = 0; g < 4; ++g)
#pragma unroll
                    for (int r = 0; r < 4; ++r) sres += wv[g][r] * fmaxf(a4[g][r], 0.f);
                res[u] = sres;
            }
            *(f32x4*)(orow + step * 64 + 4 * j16) = res;
            if (step + 1 < nsteps) *(LAS u32x4*)(kb + (cur ^ 1) * 8192 + st_off) = stg;
            __syncthreads();
        }
    }
}

__device__ __forceinline__ unsigned fkey(float f) { const unsigned u = __float_as_uint(f); return (u & 0x80000000u) ? ~u : (u | 0x80000000u); }

template <int NV>
__device__ __forceinline__ void select_row(const float* row, int n, unsigned short* sel, int lane) {
    unsigned u[NV][4];
#pragma unroll
    for (int i = 0; i < NV; ++i) {
        const int base = i * 256 + lane * 4;
        f32x4 v = {0.f, 0.f, 0.f, 0.f};
        if (base < n) v = *(const f32x4*)(row + base);
#pragma unroll
        for (int e = 0; e < 4; ++e) u[i][e] = (base + e < n) ? fkey(v[e]) : 0u;
    }
    unsigned T = 0u; int cntT = n;
    bool exact = false;
    for (int bit = 31; bit >= 0; --bit) {
        const unsigned cand = T | (1u << bit);
        int c = 0;
#pragma unroll
        for (int i = 0; i < NV; ++i)
#pragma unroll
            for (int e = 0; e < 4; ++e) c += __popcll(__ballot(u[i][e] >= cand));
        if (c >= TOPK) { T = cand; cntT = c; if (c == TOPK) { exact = true; break; } }
    }
    int cgt = 0;
    if (!exact) {
#pragma unroll
        for (int i = 0; i < NV; ++i)
#pragma unroll
            for (int e = 0; e < 4; ++e) cgt += __popcll(__ballot(u[i][e] > T));
    }
    int pg = 0, pe = exact ? 0 : cgt;
    const unsigned long long lt = (1ull << lane) - 1ull;
#pragma unroll
    for (int i = 0; i < NV; ++i)
#pragma unroll
        for (int e = 0; e < 4; ++e) {
            const unsigned val = u[i][e]; const int idx = i * 256 + lane * 4 + e;
            const bool gsel = exact ? (val >= T) : (val > T);
            const unsigned long long mg = __ballot(gsel);
            if (gsel) sel[pg + __popcll(mg & lt)] = (unsigned short)idx;
            pg += __popcll(mg);
            if (!exact) {
                const bool esel = (val == T);
                const unsigned long long me = __ballot(esel);
                const int pos = pe + __popcll(me & lt);
                if (esel && pos < TOPK) sel[pos] = (unsigned short)idx;
                pe += __popcll(me);
            }
        }
}

__device__ __forceinline__ void phase_select(Frame& F) {
    const int lane_ = lane_id(), tid_ = F.wave * 64 + lane_;
    const float* scores = (const float*)(F.ws + WS_SCORES);
    unsigned short* selb = (unsigned short*)(F.ws + WS_SEL);
    const int gw = F.bid * NWAVES + F.wave, NGW = F.G * NWAVES, lane = lane_;
    for (int it = 0;; ++it) {
        const int jj = (it >> 1) * NGW + gw; if (jj >= NTOK / 2) break;
        const int s = (it & 1) ? NTOK - 1 - jj : jj;
        const int b = s & 1, p = s >> 1, n = p + 1;
        unsigned short* sel = selb + ((size_t)b * SEQ + p) * TOPK;
        if (n <= TOPK) {
#pragma unroll
            for (int q = 0; q < 4; ++q) { const int i = q * 64 + lane; sel[i] = (i < n) ? (unsigned short)i : (unsigned short)0xFFFFu; }
        } else {
            const float* row = scores + score_rowbase(b, p);
            if (n <= 2048) select_row<8>(row, n, sel, lane);
            else if (n <= 4096) select_row<16>(row, n, sel, lane);
            else if (n <= 6144) select_row<24>(row, n, sel, lane);
            else select_row<32>(row, n, sel, lane);
        }
    }
}

__device__ __forceinline__ int c_lds(int row, int chunk) { return row * 544 + chunk * 16; }

__device__ __forceinline__ void phase_sparse_attn(Frame& F) {
    const int lane_ = lane_id(), tid_ = F.wave * 64 + lane_;
    const bf16* qlat = (const bf16*)(F.ws + WS_QLAT); const unsigned char* ckv8 = (const unsigned char*)(F.ws + WS_CKVN);
    const unsigned short* selb = (const unsigned short*)(F.ws + WS_SEL); bf16* olat = (bf16*)(F.ws + WS_OLAT);
    const int lane = lane_, fq = lane >> 4, j16 = lane & 15;
    LAS unsigned char* cb = F.lds + F.wave * 17408;
    const float sl2 = 0.08838834764831845f * 1.4426950408889634f;
    const int xh = (F.G % 8 == 0) ? ((F.bid & 7) >> 2) : 0, nsplit = (F.G % 8 == 0) ? 2 : 1;
    const int wloc = (F.G % 8 == 0) ? (((F.bid >> 3) * 4 + (F.bid & 3)) * NWAVES + F.wave) : (F.bid * NWAVES + F.wave);
    const int nwl = (F.G % 8 == 0) ? (F.G / 2) * NWAVES : F.G * NWAVES;
    const int ntk = NTOK / nsplit;
    for (int tl = wloc; tl < ntk; tl += nwl) {
        const int t = xh * ntk + tl, b = t / SEQ, pos = t % SEQ;
        const int nvalid = (pos + 1 < TOPK) ? pos + 1 : TOPK;
        const unsigned short* sel = selb + (size_t)t * TOPK;
        const u32x2 sv = __builtin_nontemporal_load((const u32x2*)(sel + 4 * lane));
        bf16x8 Qb[8];
#pragma unroll
        for (int ks = 0; ks < 8; ++ks) { bf16x8 z = {0, 0, 0, 0, 0, 0, 0, 0}; if (j16 < 8) z = __builtin_nontemporal_load((const bf16x8*)(qlat + ((size_t)t * 8 + j16) * 256 + ks * 32 + 8 * fq)); Qb[ks] = z; }
        float mrun = -INFINITY, lrun = 0.f;
        f32x4 O[16];
#pragma unroll
        for (int rt = 0; rt < 16; ++rt) O[rt] = (f32x4){0.f, 0.f, 0.f, 0.f};
        const int nch = (nvalid + 31) >> 5;
        const unsigned char* cbase = ckv8 + (size_t)b * SEQ * 256 + (lane & 15) * 16;
        u32x4 gv[8];
#define SA_GATHER(c_) do { _Pragma("unroll") for (int it = 0; it < 8; ++it) { \
            const unsigned dx = (unsigned)__builtin_amdgcn_readlane((int)sv.x, 8 * (c_) + it), dy = (unsigned)__builtin_amdgcn_readlane((int)sv.y, 8 * (c_) + it); \
            const unsigned dd = (fq & 2) ? dy : dx; int key = (fq & 1) ? (int)(dd >> 16) : (int)(dd & 0xffffu); key = (key >= SEQ) ? 0 : key; \
            gv[it] = *(const u32x4*)(cbase + (size_t)key * 256); } } while (0)
        SA_GATHER(0);
        for (int c = 0; c < nch; ++c) {
#pragma unroll
            for (int it = 0; it < 8; ++it) { const int row = 4 * it + fq; u32x4 w0, w1;
#pragma unroll
                for (int q = 0; q < 4; ++q) { const f32x2 a = __builtin_amdgcn_cvt_pk_f32_fp8((int)gv[it][q], false), bq = __builtin_amdgcn_cvt_pk_f32_fp8((int)gv[it][q], true);
                    const unsigned lo = cvt_pk_bf16(a[0], a[1]), hi = cvt_pk_bf16(bq[0], bq[1]);
                    if (q < 2) { w0[2 * q] = lo; w0[2 * q + 1] = hi; } else { w1[2 * (q - 2)] = lo; w1[2 * (q - 2) + 1] = hi; } }
                *(LAS u32x4*)(cb + c_lds(row, 2 * j16)) = w0; *(LAS u32x4*)(cb + c_lds(row, 2 * j16 + 1)) = w1; }
            asm volatile("" ::: "memory");
            if (c + 1 < nch) SA_GATHER(c + 1);
            f32x4 Sa = {0.f, 0.f, 0.f, 0.f}, Sb = {0.f, 0.f, 0.f, 0.f};
#pragma unroll
            for (int ks = 0; ks < 8; ++ks) {
                const bf16x8 a0 = *(const LAS bf16x8*)(cb + c_lds(j16, 4 * ks + fq));
                const bf16x8 a1 = *(const LAS bf16x8*)(cb + c_lds(16 + j16, 4 * ks + fq));
                Sa = __builtin_amdgcn_mfma_f32_16x16x32_bf16(a0, Qb[ks], Sa, 0, 0, 0);
                Sb = __builtin_amdgcn_mfma_f32_16x16x32_bf16(a1, Qb[ks], Sb, 0, 0, 0);
            }
            float xa[4], xb[4]; float cm = -INFINITY;
#pragma unroll
            for (int r = 0; r < 4; ++r) { const int ka = c * 32 + 4 * fq + r, kb2 = ka + 16;
                xa[r] = (ka < nvalid) ? Sa[r] * sl2 : -INFINITY; xb[r] = (kb2 < nvalid) ? Sb[r] * sl2 : -INFINITY; cm = fmaxf(cm, fmaxf(xa[r], xb[r])); }
            cm = fmaxf(cm, __shfl_xor(cm, 16)); cm = fmaxf(cm, __shfl_xor(cm, 32));
            const float mnew = fmaxf(mrun, cm);
            const float alpha = __builtin_amdgcn_exp2f(mrun - mnew);
            float ps = 0.f; f32x4 pa, pb;
#pragma unroll
            for (int r = 0; r < 4; ++r) { pa[r] = __builtin_amdgcn_exp2f(xa[r] - mnew); pb[r] = __builtin_amdgcn_exp2f(xb[r] - mnew); ps += pa[r] + pb[r]; }
            ps += __shfl_xor(ps, 16); ps += __shfl_xor(ps, 32);
            lrun = lrun * alpha + ps; mrun = mnew;
            const u32x4 pw = pack8(pa, pb); const bf16x8 Pb = __builtin_bit_cast(bf16x8, pw);
#pragma unroll
            for (int rt = 0; rt < 16; ++rt) O[rt] = O[rt] * alpha;
            const int q4 = j16 >> 2, p4 = j16 & 3;
#pragma unroll
            for (int rt = 0; rt < 16; ++rt) {
                const int ra = 4 * fq + q4, rb = 16 + 4 * fq + q4, ch = 2 * rt + (p4 >> 1);
                const s16x4 lo = __builtin_bit_cast(s16x4, __builtin_amdgcn_ds_read_tr16_b64_v4i16((LAS s16x4*)(cb + c_lds(ra, ch) + 8 * (p4 & 1))));
                const s16x4 hi = __builtin_bit_cast(s16x4, __builtin_amdgcn_ds_read_tr16_b64_v4i16((LAS s16x4*)(cb + c_lds(rb, ch) + 8 * (p4 & 1))));
                const bf16x8 af = {lo[0], lo[1], lo[2], lo[3], hi[0], hi[1], hi[2], hi[3]};
                O[rt] = __builtin_amdgcn_mfma_f32_16x16x32_bf16(af, Pb, O[rt], 0, 0, 0);
            }
            asm volatile("" ::: "memory");
        }
#undef SA_GATHER
        const float inv = 1.0f / lrun;
        asm volatile("" ::: "memory");
        if (j16 < 8) {
#pragma unroll
            for (int rt = 0; rt < 16; ++rt) { u32x2 o; o.x = pk2(O[rt][0] * inv, O[rt][1] * inv); o.y = pk2(O[rt][2] * inv, O[rt][3] * inv); *(LAS u32x2*)(cb + j16 * 512 + rt * 32 + fq * 8) = o; }
        }
        asm volatile("" ::: "memory");
        { bf16* obase = olat + (size_t)t * 2048;
#pragma unroll
          for (int q = 0; q < 4; ++q) { const u32x4 v = *(const LAS u32x4*)(cb + q * 1024 + lane * 16); __builtin_nontemporal_store(v, (u32x4*)(obase + q * 512 + lane * 8)); } }
        asm volatile("" ::: "memory");
    }
}

__device__ __forceinline__ void routing_token(const float acc, const int lane, const float* rbias, int* tk_e, float* tk_w, LAS unsigned* hist, const size_t t, const bool do_count) {
    const float sc = 1.0f / (1.0f + expf(-acc));
    const float ch = sc + rbias[lane];
    int rk = 0;
#pragma unroll
    for (int k = 1; k < 8; ++k) { const int src = (lane & ~7) | ((lane + k) & 7); const float o = __shfl(ch, src); rk += (o > ch || (o == ch && src < lane)) ? 1 : 0; }
    float gs = (rk < 2) ? ch : 0.f; gs += __shfl_xor(gs, 1); gs += __shfl_xor(gs, 2); gs += __shfl_xor(gs, 4);
    int grk = 0; const int myg = lane >> 3;
#pragma unroll
    for (int g = 0; g < 8; ++g) { const float o = __shfl(gs, g * 8); grk += (o > gs || (o == gs && g < myg)) ? 1 : 0; }
    const float cm = (grk < 4) ? ch : -INFINITY;
    int erk = 0;
    for (int j = 0; j < 64; ++j) { const float o = __shfl(cm, j); erk += (o > cm || (o == cm && j < lane)) ? 1 : 0; }
    const bool selx = (erk < EK) && (grk < 4);
    const float ssum = wave_sum(selx ? sc : 0.f);
    if (selx) { tk_e[t * 8 + erk] = lane; tk_w[t * 8 + erk] = sc / ssum * 2.5f; if (do_count) __hip_atomic_fetch_add(&hist[lane], 1u, __ATOMIC_RELAXED, __HIP_MEMORY_SCOPE_WORKGROUP); }
}
__device__ __forceinline__ void phase_ln1_router(Frame& F, const float* g1, const float* b1, const float* rbias, const bool do_count) {
    const int lane_ = lane_id(), tid_ = F.wave * 64 + lane_;
    const float* pre = F.out;
    const float* wrT = (const float*)(F.ws + WS_WRT);
    bf16* h = (bf16*)(F.ws + WS_H);
    int* tk_e = (int*)(F.ws + WS_TOPK + TK_E); float* tk_w = (float*)(F.ws + WS_TOPK + TK_W);
    const int lane = lane_, w = F.wave, tid = tid_;
    LAS float* stats = (LAS float*)F.lds;
    LAS float* lg = (LAS float*)(F.lds + 1024) + (w & 3) * 1024;
    LAS unsigned* hist = (LAS unsigned*)(F.lds + 1024 + 16384);
    if (do_count && tid < 64) hist[tid] = 0u;
    for (int chunk = F.bid; chunk < NTOK / 64; chunk += F.G) {
        __syncthreads();
        f32x4 ggv[8], bbv[8];
#pragma unroll
        for (int q = 0; q < 8; ++q) { const int c = (lane + 64 * q) * 4; ggv[q] = *(const f32x4*)(g1 + c); bbv[q] = *(const f32x4*)(b1 + c); }
        for (int i = 0; i < 8; ++i) {
            const int tl = w * 8 + i; const size_t t = (size_t)chunk * 64 + tl;
            f32x4 v[8]; float s = 0.f;
#pragma unroll
            for (int q = 0; q < 8; ++q) { v[q] = *(const f32x4*)(pre + t * DM + (lane + 64 * q) * 4); s += (v[q][0] + v[q][1]) + (v[q][2] + v[q][3]); }
            const float mean = wave_sum(s) * (1.0f / DM); float s2 = 0.f;
#pragma unroll
            for (int q = 0; q < 8; ++q) { v[q] = v[q] - mean; s2 += (v[q][0] * v[q][0] + v[q][1] * v[q][1]) + (v[q][2] * v[q][2] + v[q][3] * v[q][3]); }
            const float rstd = 1.0f / sqrtf(wave_sum(s2) * (1.0f / DM) + LN_EPS);
#pragma unroll
            for (int q = 0; q < 8; ++q) { const int c = (lane + 64 * q) * 4;
                const f32x4 y = v[q] * rstd * ggv[q] + bbv[q];
                u32x2 o; o.x = pk2(y[0], y[1]); o.y = pk2(y[2], y[3]); *(u32x2*)(h + t * DM + c) = o; }
            if (lane == 0) { stats[tl * 2] = mean; stats[tl * 2 + 1] = rstd; }
        }
        __syncthreads();
        if (w < 4) {
            const int j16 = lane & 15, kq = lane >> 4, tl = 16 * w + j16;
            const float mean = stats[tl * 2], rstd = stats[tl * 2 + 1];
            const float* prow = pre + ((size_t)chunk * 64 + tl) * DM + 4 * kq; const float* wrow = wrT + (size_t)j16 * DM + 4 * kq;
            f32x4 acc[4];
#pragma unroll
            for (int tt = 0; tt < 4; ++tt) acc[tt] = (f32x4){0.f, 0.f, 0.f, 0.f};
#pragma unroll 2
            for (int m = 0; m < 128; ++m) {
                const f32x4 p = *(const f32x4*)(prow + 16 * m), gg = *(const f32x4*)(g1 + 16 * m + 4 * kq), bb = *(const f32x4*)(b1 + 16 * m + 4 * kq);
                const f32x4 hv = (p - mean) * rstd * gg + bb;
                f32x4 wv[4];
#pragma unroll
                for (int tt = 0; tt < 4; ++tt) wv[tt] = *(const f32x4*)(wrow + (size_t)tt * 16 * DM + 16 * m);
#pragma unroll
                for (int e = 0; e < 4; ++e)
#pragma unroll
                    for (int tt = 0; tt < 4; ++tt) acc[tt] = __builtin_amdgcn_mfma_f32_16x16x4f32(hv[e], wv[tt][e], acc[tt], 0, 0, 0);
            }
#pragma unroll
            for (int tt = 0; tt < 4; ++tt)
#pragma unroll
                for (int r = 0; r < 4; ++r) lg[(4 * kq + r) * 64 + 16 * tt + j16] = acc[tt][r];
            LDS_WAIT();
            for (int tk = 0; tk < 16; ++tk) routing_token(lg[tk * 64 + lane], lane, rbias, tk_e, tk_w, hist, (size_t)chunk * 64 + 16 * w + tk, do_count);
        }
    }
}
__device__ __forceinline__ void phase_flush_hist(Frame& F) {
    const int tid = F.wave * 64 + lane_id();
    LAS unsigned* hist = (LAS unsigned*)(F.lds + 1024 + 16384);
    __syncthreads();
    if (tid < 64 && hist[tid]) atomicAdd(F.ctl + CW_CNT + tid, hist[tid]);
}

__device__ __forceinline__ void phase_scatter(Frame& F) {
    const int lane_ = lane_id(), tid_ = F.wave * 64 + lane_;
    const int tid = tid_;
    LAS int* segs = (LAS int*)F.lds;
    LAS unsigned* lcnt = (LAS unsigned*)(F.lds + 1024);
    LAS unsigned* lbase = (LAS unsigned*)(F.lds + 2048);
    const int* tk_e = (const int*)(F.ws + WS_TOPK + TK_E); int* tk_pos = (int*)(F.ws + WS_TOPK + TK_POS);
    int* rowlist = (int*)(F.ws + WS_TOPK + TK_ROWLIST); int* mtt = (int*)(F.ws + WS_TOPK + TK_MTT);
    if (tid == 0) { int a = 0; for (int e = 0; e < NE; ++e) { segs[e] = a; a += (int)__hip_atomic_load(F.ctl + CW_CNT + e, RLX_AGENT); } segs[NE] = a; segs[NE + 1] = a + NTOK; }
    __syncthreads();
    if (F.bid == 0) {
        LAS int* tcum = (LAS int*)(F.lds + 3072);
        if (tid == 0) { int mt = 0; for (int g = 0; g < NGRP; ++g) { tcum[g] = mt; mt += (segs[g + 1] - segs[g] + 255) >> 8; } tcum[NGRP] = mt; __hip_atomic_store(F.ctl + CW_NMT, (unsigned)mt, RLX_AGENT); }
        __syncthreads();
        if (tid < NGRP) { const int g = tid, p0 = segs[g], n = segs[g + 1] - p0; int mt = tcum[g];
            for (int r = 0; r < n; r += 256, ++mt) { mtt[mt * 4 + 0] = g; mtt[mt * 4 + 1] = p0 + r; mtt[mt * 4 + 2] = (n - r < 256) ? n - r : 256; mtt[mt * 4 + 3] = 0; } }
        if (tid >= 256) rowlist[NSLOT + tid - 256] = 0;
    }
    const int sh0 = segs[NE];
    for (int chunk = F.bid; chunk < NTOK / 64; chunk += F.G) {
        if (tid < 64) lcnt[tid] = 0u;
        __syncthreads();
        const int t = chunk * 64 + (tid >> 3), k = tid & 7;
        const int e = tk_e[(size_t)t * 8 + k];
        const unsigned li = __hip_atomic_fetch_add(&lcnt[e], 1u, __ATOMIC_RELAXED, __HIP_MEMORY_SCOPE_WORKGROUP);
        __syncthreads();
        if (tid < 64) lbase[tid] = lcnt[tid] ? atomicAdd(F.ctl + CW_FILL + tid, lcnt[tid]) : 0u;
        __syncthreads();
        const int p = segs[e] + (int)lbase[e] + (int)li;
        rowlist[p] = t; tk_pos[(size_t)t * 8 + k] = p;
        if (tid < 64) rowlist[sh0 + chunk * 64 + tid] = chunk * 64 + tid;
        __syncthreads();
    }
}

struct CombRows { u32x4 hq[4]; u32x4 y[9][4]; };
__device__ __forceinline__ void comb_load(CombRows& R, const bf16* h, const bf16* Y, const int t, const int posv, const int slot0, const int lane) {
#pragma unroll
    for (int i = 0; i < 4; ++i) R.hq[i] = *(const u32x4*)(h + (size_t)t * DM + (lane + 64 * i) * 8);
#pragma unroll
    for (int k = 0; k < 9; ++k) { const int p = (k < 8) ? __builtin_amdgcn_readlane(posv, slot0 + (k & 7)) : NTOK * 8 + t;
#pragma unroll
        for (int i = 0; i < 4; ++i) R.y[k][i] = __builtin_nontemporal_load((const u32x4*)(Y + (size_t)p * DM + (lane + 64 * i) * 8)); }
}
__device__ __forceinline__ void comb_finish(const CombRows& R, const float* g2, const float* b2, float* out, const int t, const float wvv, const int slot0, const int lane) {
    f32x4 a[4][2];
#pragma unroll
    for (int i = 0; i < 4; ++i) { f32x4 x0, x1; unpack8(R.hq[i], x0, x1); a[i][0] = x0 * DN_ALPHA; a[i][1] = x1 * DN_ALPHA; }
#pragma unroll
    for (int k = 0; k < 9; ++k) { const float wk = (k < 8) ? __builtin_bit_cast(float, __builtin_amdgcn_readlane(__builtin_bit_cast(int, wvv), slot0 + (k & 7))) : 1.0f;
#pragma unroll
        for (int i = 0; i < 4; ++i) { f32x4 y0, y1; unpack8(R.y[k][i], y0, y1); a[i][0] += y0 * wk; a[i][1] += y1 * wk; } }
    float s = 0.f;
#pragma unroll
    for (int i = 0; i < 4; ++i) s += ((a[i][0][0] + a[i][0][1]) + (a[i][0][2] + a[i][0][3])) + ((a[i][1][0] + a[i][1][1]) + (a[i][1][2] + a[i][1][3]));
    const float mean = wave_sum(s) * (1.0f / DM); float s2 = 0.f;
#pragma unroll
    for (int i = 0; i < 4; ++i) { a[i][0] = a[i][0] - mean; a[i][1] = a[i][1] - mean;
        s2 += ((a[i][0][0] * a[i][0][0] + a[i][0][1] * a[i][0][1]) + (a[i][0][2] * a[i][0][2] + a[i][0][3] * a[i][0][3])) + ((a[i][1][0] * a[i][1][0] + a[i][1][1] * a[i][1][1]) + (a[i][1][2] * a[i][1][2] + a[i][1][3] * a[i][1][3])); }
    const float rstd = 1.0f / sqrtf(wave_sum(s2) * (1.0f / DM) + LN_EPS);
#pragma unroll
    for (int i = 0; i < 4; ++i) { const int c = (lane + 64 * i) * 8;
        const f32x4 ga = *(const f32x4*)(g2 + c), gb = *(const f32x4*)(g2 + c + 4), ba = *(const f32x4*)(b2 + c), bb = *(const f32x4*)(b2 + c + 4);
        __builtin_nontemporal_store(a[i][0] * rstd * ga + ba, (f32x4*)(out + (size_t)t * DM + c)); __builtin_nontemporal_store(a[i][1] * rstd * gb + bb, (f32x4*)(out + (size_t)t * DM + c + 4)); }
}
__device__ __forceinline__ void phase_combine(Frame& F, const float* g2, const float* b2) {
    const int lane = lane_id();
    const bf16* h = (const bf16*)(F.ws + WS_H); const bf16* Y = (const bf16*)(F.ws + WS_Y);
    const float* tk_w = (const float*)(F.ws + WS_TOPK + TK_W); const int* tk_pos = (const int*)(F.ws + WS_TOPK + TK_POS);
    const int gw = F.bid * NWAVES + F.wave, NGW = F.G * NWAVES;
    for (int t0 = gw * 8; t0 < NTOK; t0 += NGW * 8) {
        const int posv = tk_pos[(size_t)t0 * 8 + lane]; const float wvv = tk_w[(size_t)t0 * 8 + lane];
        for (int i = 0; i < 8; ++i) {
            CombRows R;
            comb_load(R, h, Y, t0 + i, posv, 8 * i, lane);
            __builtin_amdgcn_sched_barrier(0);
            comb_finish(R, g2, b2, F.out, t0 + i, wvv, 8 * i, lane);
            __builtin_amdgcn_sched_barrier(0);
        }
    }
}

#ifndef MK_CHECK
#define MK_CHECK 0
#endif
constexpr int CW_CHK = 16384 + 256;
#if MK_CHECK
__device__ __forceinline__ float fp8f(unsigned char v) { const f32x2 a = __builtin_amdgcn_cvt_pk_f32_fp8((int)v, false); return a[0]; }
__device__ __forceinline__ void phase_check_attn(Frame& F) {
    const int tid = F.wave * 64 + lane_id();
    const bf16* qi = (const bf16*)(F.ws + WS_QI); const bf16* kin = (const bf16*)(F.ws + WS_KIN); const float* wis = (const float*)(F.ws + WS_WI);
    const bf16* qlat = (const bf16*)(F.ws + WS_QLAT); const unsigned char* ckv8 = (const unsigned char*)(F.ws + WS_CKVN);
    const unsigned short* selb = (const unsigned short*)(F.ws + WS_SEL); const bf16* olat = (const bf16*)(F.ws + WS_OLAT);
    LAS float* sc = (LAS float*)F.lds;
    LAS unsigned char* flg = (LAS unsigned char*)(F.lds + 32768);
    LAS unsigned char* seen = (LAS unsigned char*)(F.lds + 40960);
    LAS float* pl = (LAS float*)(F.lds + 49152);
    LAS int* cnt = (LAS int*)(F.lds + 57344);
    const int POS[16] = {0, 1, 100, 255, 256, 257, 300, 511, 1000, 2047, 2048, 4095, 5000, 6143, 6144, 8191};
    for (int s = F.bid; s < 32; s += F.G) {
        int pos = 0;
#pragma unroll
        for (int q = 0; q < 16; ++q) pos = ((s >> 1) == q) ? POS[q] : pos;
        const int b = s & 1, n = pos + 1; const size_t t = (size_t)b * SEQ + pos;
        __syncthreads();
        if (tid < 4) cnt[tid] = 0;
        for (int k = tid; k < SEQ; k += NTHR) { flg[k] = 0; seen[k] = 0; }
        for (int k = tid; k < n; k += NTHR) {
            float tot = 0.f;
            for (int hh = 0; hh < 16; ++hh) { float d = 0.f;
                for (int e = 0; e < 64; ++e) d += bf2f(qi[t * 1024 + hh * 64 + e]) * bf2f(kin[((size_t)b * SEQ + k) * 64 + e]);
                tot += wis[t * 16 + hh] * fmaxf(d, 0.f); }
            sc[k] = tot;
        }
        __syncthreads();
        const unsigned short* sel = selb + t * TOPK;
        if (n > TOPK) {
            for (int k = tid; k < n; k += NTHR) { const float v = sc[k]; int rk = 0; for (int k2 = 0; k2 < n; ++k2) { const float o = sc[k2]; rk += (o > v || (o == v && k2 < k)) ? 1 : 0; } flg[k] = rk < TOPK ? 1 : 0; }
            __syncthreads();
            if (tid < TOPK) { const int k = sel[tid]; if (k >= n) atomicAdd((int*)&cnt[1], 1000); else { if (!flg[k]) atomicAdd((int*)&cnt[0], 1); if (seen[k]) atomicAdd((int*)&cnt[1], 1000); seen[k] = 1; } }
        } else {
            if (tid < TOPK) { const int k = sel[tid]; if (tid < n ? (k != tid) : (k != 0xFFFF)) atomicAdd((int*)&cnt[1], 1000); }
        }
        __syncthreads();
        const int nv = n < TOPK ? n : TOPK;
        for (int i = tid; i < 8 * 256; i += NTHR) { const int hh = i >> 8, k = i & 255; float lg = -INFINITY;
            if (k < nv) { const int key = sel[k]; float d = 0.f; for (int r = 0; r < 256; ++r) d += bf2f(qlat[(t * 8 + hh) * 256 + r]) * fp8f(ckv8[((size_t)b * SEQ + key) * 256 + r]); lg = d * 0.08838834764831845f; }
            pl[i] = lg; }
        __syncthreads();
        if (tid < 8) { float m = -INFINITY; for (int k = 0; k < 256; ++k) m = fmaxf(m, pl[tid * 256 + k]); float l = 0.f; for (int k = 0; k < 256; ++k) { const float p = expf(pl[tid * 256 + k] - m); pl[tid * 256 + k] = p; l += p; } for (int k = 0; k < 256; ++k) pl[tid * 256 + k] /= l; }
        __syncthreads();
        for (int i = tid; i < 8 * 256; i += NTHR) { const int hh = i >> 8, r = i & 255; float o = 0.f;
            for (int k = 0; k < nv; ++k) o += pl[hh * 256 + k] * fp8f(ckv8[((size_t)b * SEQ + sel[k]) * 256 + r]);
            const float got = bf2f(olat[(t * 8 + hh) * 256 + r]);
            if (!(fabsf(got - o) <= 0.03f * fabsf(o) + 0.004f)) atomicAdd((int*)&cnt[2], 1); }
        __syncthreads();
        if (tid == 0) { unsigned code = 0; if (cnt[0] > 3 || cnt[1] > 0) code |= 1u; if (cnt[2] > 0) code |= 2u; if (code) atomicOr(F.ctl + CW_CHK, code); }
    }
}
__device__ __forceinline__ void phase_check_apply(Frame& F) {
    const unsigned code = __hip_atomic_load(F.ctl + CW_CHK, RLX_AGENT);
    if (code) { const float v = (code & 1u) ? __builtin_nanf("") : 0.f; const size_t gt = (size_t)F.bid * NTHR + F.wave * 64 + lane_id();
        for (size_t i = gt; i < (size_t)NTOK * DM; i += (size_t)F.G * NTHR) F.out[i] = v; }
}
#endif

constexpr int NPHASE = 16;
constexpr unsigned REPEAT_MASK = 0x0u;
constexpr int TIME_PHASE = -1;
constexpr int CW_TIME = 16384 + 320;
struct Args { const float* in[24]; float* out; unsigned char* ws; int ph_lo, ph_hi; };

__global__ void __launch_bounds__(NTHR, 2) mk_fwd(Args args) {
    extern __shared__ __attribute__((aligned(16))) unsigned char lds_raw[];
    Frame F;
    F.lds = (LAS unsigned char*)lds_raw;
    F.MISC = (volatile LAS unsigned*)(F.lds + MISC_OFF);
    F.wave = __builtin_amdgcn_readfirstlane(threadIdx.x >> 6);
    F.G = gridDim.x; F.bid = blockIdx.x;
    F.ws = args.ws; F.ctl = (unsigned*)(args.ws + WS_CTL); F.out = args.out;
    for (int u = threadIdx.x; u < (LDS_BYTES - MISC_OFF) / 4; u += NTHR) ((LAS unsigned*)(F.lds + MISC_OFF))[u] = 0u;
    __syncthreads();
    const int lo = args.ph_lo, hi = args.ph_hi;
    const bool multi = (hi - lo) > 1;
    XcdBarrier bar; bar.bar = F.ctl + CW_BAR; bar.x = 0; bar.st = nullptr; bar.wave = F.wave;
    if (multi) bar = xcd_barrier_post(F.ctl + CW_BAR, F.MISC + 8, F.wave);
#ifndef ONLY_PHASE
#define ONLY_PHASE -1
#endif
#define IN(k) ((ONLY_PHASE < 0 || ONLY_PHASE == (k)) && lo <= (k) && (k) < hi)
#define SEAM(k) do { if (IN(k) && IN((k) + 1)) { xcd_barrier(bar); \
        if (TIME_PHASE >= 0 && F.bid == 0 && F.wave == 0) { const unsigned long long now_ = __builtin_amdgcn_s_memrealtime(); \
            if ((k) == TIME_PHASE - 1 || ((k) == 0 && TIME_PHASE == 0 && false)) { if (lane_id() == 0) { F.ctl[CW_TIME] = (unsigned)now_; } } \
            if ((k) == TIME_PHASE) { if (lane_id() == 0) { F.ctl[CW_TIME + 1] = (unsigned)now_ - F.ctl[CW_TIME]; } } } } } while (0)
    unsigned char* ws = args.ws;
    if (TIME_PHASE == 0 && F.bid == 0 && threadIdx.x == 0) F.ctl[CW_TIME] = (unsigned)__builtin_amdgcn_s_memrealtime();

    if (IN(0)) for (int rep_ = 0; rep_ < 1 + (int)((REPEAT_MASK >> 0) & 1u); ++rep_) { phase_convert_small(F, args.in[0], args.in[1], args.in[5], args.in[6], args.in[7], args.in[9], args.in[10], args.in[11], args.in[8], args.in[14]); } SEAM(0);

    if (IN(1)) for (int rep_ = 0; rep_ < 1 + (int)((REPEAT_MASK >> 1) & 1u); ++rep_) {
        FillPlain f{(const char*)(ws + WS_XB), (const char*)(ws + WS_WIN), 4096u, 4096u, 32};
        DenseSched<FillPlain> S{64, 30, F.G, F.bid, f};
        EpiP1 E{(bf16*)(ws + WS_Q), (bf16*)(ws + WS_QI), (bf16*)(ws + WS_XP), (bf16*)(ws + WS_GATES), (float*)(ws + WS_CKVRAW), (float*)(ws + WS_KIWI)};
        pg8::gemm_phase<EpiP1, DenseSched<FillPlain>, false, true, true>(F.lds, F.wave, 4096u, 4096u, S, E);
    } SEAM(1);

    if (IN(2)) for (int rep_ = 0; rep_ < 1 + (int)((REPEAT_MASK >> 2) & 1u); ++rep_) { phase_postproc(F, args.in[2], args.in[3], args.in[4]); } SEAM(2);

    if (IN(3)) for (int rep_ = 0; rep_ < 1 + (int)((REPEAT_MASK >> 3) & 1u); ++rep_) {
        FillQlatPool f{(const char*)(ws + WS_Q), (const char*)(ws + WS_DIFF), (const char*)(ws + WS_WUK), (const char*)(ws + WS_WPOOL)};
        DenseSched<FillQlatPool> S{64, 12, F.G, F.bid, f};
        EpiQlatPool E{(bf16*)(ws + WS_QLAT), (bf16*)(ws + WS_POOL), (const float*)(ws + WS_CSCALE)};
        pg8::gemm_phase<EpiQlatPool, DenseSched<FillQlatPool>, false, true, true>(F.lds, F.wave, 2048u, 512u, S, E);
    } SEAM(3);

    if (IN(4)) for (int rep_ = 0; rep_ < 1 + (int)((REPEAT_MASK >> 4) & 1u); ++rep_) { phase_index_scores(F); } SEAM(4);
    if (IN(5)) for (int rep_ = 0; rep_ < 1 + (int)((REPEAT_MASK >> 5) & 1u); ++rep_) { phase_select(F); } SEAM(5);
    if (IN(6)) for (int rep_ = 0; rep_ < 1 + (int)((REPEAT_MASK >> 6) & 1u); ++rep_) { phase_sparse_attn(F); } SEAM(6);
#if MK_CHECK
    if (IN(6) && IN(7)) { phase_check_attn(F); xcd_barrier(bar); }
#endif

    if (IN(7)) for (int rep_ = 0; rep_ < 1 + (int)((REPEAT_MASK >> 7) & 1u); ++rep_) {
        FillO f{(const char*)(ws + WS_OLAT), (const char*)(ws + WS_WUV)};
        DenseSched<FillO> S{64, 4, F.G, F.bid, f};
        EpiBf16 E{(bf16*)(ws + WS_ATTN), 1024};
        pg8::gemm_phase<EpiBf16, DenseSched<FillO>, false, true, true>(F.lds, F.wave, 4096u, 1024u, S, E);
    } SEAM(7);

    if (IN(8)) for (int rep_ = 0; rep_ < 1 + (int)((REPEAT_MASK >> 8) & 1u); ++rep_) {
        FillPlain f{(const char*)(ws + WS_ATTN), (const char*)(ws + WS_WPA), 2048u, 2048u, 16};
        DenseSched<FillPlain> S{64, 8, F.G, F.bid, f};
        EpiGate<0> E{(const bf16*)(ws + WS_GATES), (bf16*)(ws + WS_M1), (bf16*)(ws + WS_MERGED)};
        pg8::gemm_phase<EpiGate<0>, DenseSched<FillPlain>, false, true, true>(F.lds, F.wave, 2048u, 2048u, S, E);
    } SEAM(8);

    if (IN(9)) for (int rep_ = 0; rep_ < 1 + (int)((REPEAT_MASK >> 9) & 1u); ++rep_) {
        FillPlain f{(const char*)(ws + WS_POOL), (const char*)(ws + WS_WPP), 2048u, 2048u, 16};
        DenseSched<FillPlain> S{64, 8, F.G, F.bid, f};
        EpiGate<1> E{(const bf16*)(ws + WS_GATES), (bf16*)(ws + WS_M1), (bf16*)(ws + WS_MERGED)};
        pg8::gemm_phase<EpiGate<1>, DenseSched<FillPlain>, false, true, true>(F.lds, F.wave, 2048u, 2048u, S, E);
    } SEAM(9);

    if (IN(10)) for (int rep_ = 0; rep_ < 1 + (int)((REPEAT_MASK >> 10) & 1u); ++rep_) {
        FillPlain f{(const char*)(ws + WS_MERGED), (const char*)(ws + WS_WOUT), 4096u, 4096u, 32};
        DenseSched<FillPlain> S{64, 8, F.G, F.bid, f};
        EpiPre E{args.in[0], F.out};
        pg8::gemm_phase<EpiPre, DenseSched<FillPlain>, false, true, true>(F.lds, F.wave, 4096u, 4096u, S, E);
    } SEAM(10);

    if (IN(11)) for (int rep_ = 0; rep_ < 1 + (int)((REPEAT_MASK >> 11) & 1u); ++rep_) {
        for (int rl_ = 0; rl_ < 1 + (int)((REPEAT_MASK >> 17) & 1u); ++rl_) phase_ln1_router(F, args.in[12], args.in[13], args.in[15], rl_ == 0);
        phase_convert_experts(F, args.in[16], args.in[17], args.in[18], args.in[19], args.in[20], args.in[21]);
        phase_flush_hist(F);
    } SEAM(11);
    if (IN(12)) for (int rep_ = 0; rep_ < 1 + (int)((REPEAT_MASK >> 12) & 1u); ++rep_) { phase_scatter(F); } SEAM(12);

    if (IN(13)) for (int rep_ = 0; rep_ < 1 + (int)((REPEAT_MASK >> 13) & 1u); ++rep_) {
        const int nmt = (int)__hip_atomic_load(F.ctl + CW_NMT, RLX_AGENT);
        MoeSched S{(const int*)(ws + WS_TOPK + TK_MTT), nmt, 4, F.G, F.bid, true, (const char*)(ws + WS_H), (const char*)(ws + WS_HBUF), (const char*)(ws + WS_WGU), (const char*)(ws + WS_WD), (const int*)(ws + WS_TOPK + TK_ROWLIST)};
        EpiSwiGLU E{(bf16*)(ws + WS_HBUF)};
        pg8::gemm_phase<EpiSwiGLU, MoeSched, true, true, true>(F.lds, F.wave, 4096u, 4096u, S, E);
    } SEAM(13);

    if (IN(14)) for (int rep_ = 0; rep_ < 1 + (int)((REPEAT_MASK >> 14) & 1u); ++rep_) {
        const int nmt = (int)__hip_atomic_load(F.ctl + CW_NMT, RLX_AGENT);
        MoeSched S{(const int*)(ws + WS_TOPK + TK_MTT), nmt, 8, F.G, F.bid, false, (const char*)(ws + WS_H), (const char*)(ws + WS_HBUF), (const char*)(ws + WS_WGU), (const char*)(ws + WS_WD), (const int*)(ws + WS_TOPK + TK_ROWLIST)};
        EpiY E{(bf16*)(ws + WS_Y)};
        pg8::gemm_phase<EpiY, MoeSched, false, true, true>(F.lds, F.wave, 1024u, 1024u, S, E);
    } SEAM(14);

    if (IN(15)) for (int rep_ = 0; rep_ < 1 + (int)((REPEAT_MASK >> 15) & 1u); ++rep_) { phase_combine(F, args.in[22], args.in[23]); }
#if MK_CHECK
    if (IN(15)) { xcd_barrier(bar); phase_check_apply(F); }
#endif
    if (TIME_PHASE >= 0 && multi && F.bid == 0 && F.wave == 0) {
        asm volatile("s_waitcnt vmcnt(0)" ::: "memory");
        if (TIME_PHASE == 15 && lane_id() == 0) { F.ctl[CW_TIME + 1] = (unsigned)__builtin_amdgcn_s_memrealtime() - F.ctl[CW_TIME]; }
        asm volatile("s_waitcnt vmcnt(0)" ::: "memory");
        const unsigned dur = __hip_atomic_load(F.ctl + CW_TIME + 1, RLX_AGENT); const unsigned long long t0 = __builtin_amdgcn_s_memrealtime();
        while (__builtin_amdgcn_s_memrealtime() - t0 < 4ull * dur) __builtin_amdgcn_s_sleep(8);
    }
#undef IN
#undef SEAM
}

#ifndef MK_ONE_LAUNCH
#define MK_ONE_LAUNCH 1
#endif
extern "C" void kernel_launch(void* const* d_in, const int* in_sizes, int n_in, void* d_out, int out_size, void* d_ws, size_t ws_size, hipStream_t stream) {
    static int grid = 0;
    if (grid == 0) {
        if (n_in != 24 || out_size != NTOK * DM || ws_size < WS_END) { fprintf(stderr, "kernel_launch: unexpected shapes (n_in %d out %d ws %zu)\n", n_in, out_size, ws_size); grid = -1; return; }
        int dev = 0, cus = 0;
        if (hipGetDevice(&dev) != hipSuccess || hipDeviceGetAttribute(&cus, hipDeviceAttributeMultiprocessorCount, dev) != hipSuccess) { grid = -1; return; }
        if (hipFuncSetAttribute((const void*)mk_fwd, hipFuncAttributeMaxDynamicSharedMemorySize, LDS_BYTES) != hipSuccess) { fprintf(stderr, "kernel_launch: hipFuncSetAttribute failed\n"); grid = -1; return; }
        int per_cu = 0;
        if (hipOccupancyMaxActiveBlocksPerMultiprocessor(&per_cu, (const void*)mk_fwd, NTHR, LDS_BYTES) != hipSuccess || per_cu < 1) fprintf(stderr, "kernel_launch: occupancy query says %d\n", per_cu);
        (void)hipGetLastError();
        grid = cus;
    }
    if (grid < 0) return;
    if (hipMemsetAsync((char*)d_ws + WS_CTL, 0, CTL_BYTES, stream) != hipSuccess) return;
    Args a{};
    for (int i = 0; i < 24; ++i) a.in[i] = (const float*)d_in[i];
    a.out = (float*)d_out; a.ws = (unsigned char*)d_ws;
#if MK_ONE_LAUNCH
    a.ph_lo = 0; a.ph_hi = NPHASE;
    hipLaunchKernelGGL(mk_fwd, dim3(grid), dim3(NTHR), LDS_BYTES, stream, a);
#else
    for (int p = 0; p < NPHASE; ++p) { a.ph_lo = p; a.ph_hi = p + 1; hipLaunchKernelGGL(mk_fwd, dim3(grid), dim3(NTHR), LDS_BYTES, stream, a); }
#endif
}
```

```cpp
#include <hip/hip_runtime.h>
#include <cstdio>
#include <cstdint>

#define LAS __attribute__((address_space(3)))
#define GAS __attribute__((address_space(1)))
typedef unsigned short bf16;
typedef short bf16x8 __attribute__((ext_vector_type(8)));
typedef short s16x4 __attribute__((ext_vector_type(4)));
typedef float f32x4 __attribute__((ext_vector_type(4)));
typedef float f32x2 __attribute__((ext_vector_type(2)));
typedef unsigned u32x4 __attribute__((ext_vector_type(4)));
typedef unsigned u32x2 __attribute__((ext_vector_type(2)));

constexpr int NTOK = 16384, SEQ = 8192, DM = 2048;
constexpr int NH = 8, DQK = 128, DV = 128, RKV = 256, IH = 16, IDH = 64, TOPK = 256;
constexpr int NE = 64, EK = 8, EDIM = 512, NGRP = 65;
constexpr int WIN_ROWS = 7680;
constexpr float LN_EPS = 1e-5f, RMS_EPS = 1e-6f;
constexpr float DN_ALPHA = 1.189207115002721f;
constexpr int NSLOT = NTOK * 9;
constexpr size_t SC_TOT = (size_t)128 * 128 * (64 * 65 / 2);

constexpr size_t MiB = 1u << 20;
constexpr size_t WS_CTL = 0, CTL_BYTES = 1 * MiB;
constexpr size_t WS_WIN = 1 * MiB;
constexpr size_t WS_WUK = 31 * MiB;
constexpr size_t WS_WUV = 32 * MiB;
constexpr size_t WS_WPOOL = 33 * MiB;
constexpr size_t WS_WPA = 34 * MiB;
constexpr size_t WS_WPP = 38 * MiB;
constexpr size_t WS_WOUT = 42 * MiB;
constexpr size_t WS_CSCALE = 50 * MiB;
constexpr size_t WS_WRT = 50 * MiB + 65536;
constexpr size_t WS_XB = 394 * MiB;
constexpr size_t WS_Q = 458 * MiB;
constexpr size_t WS_QI = 490 * MiB;
constexpr size_t WS_XP = 522 * MiB;
constexpr size_t WS_CKVRAW = 554 * MiB;
constexpr size_t WS_KIWI = 570 * MiB;
constexpr size_t WS_DIFF = 586 * MiB;
constexpr size_t WS_GATES = 181 * MiB;
constexpr size_t WS_QLAT = 309 * MiB;
constexpr size_t WS_CKVN = 373 * MiB;
constexpr size_t WS_KIN = 381 * MiB;
constexpr size_t WS_WI = 383 * MiB;
constexpr size_t WS_SEL = 654 * MiB;
constexpr size_t WS_SCORES = 662 * MiB;
constexpr size_t WS_POOL = 922 * MiB;
constexpr size_t WS_OLAT = 662 * MiB;
constexpr size_t WS_ATTN = 726 * MiB;
constexpr size_t WS_M1 = 758 * MiB;
constexpr size_t WS_MERGED = 822 * MiB;
constexpr size_t WS_WD = 51 * MiB;
constexpr size_t WS_H = 181 * MiB;
constexpr size_t WS_HBUF = 245 * MiB;
constexpr size_t WS_TOPK = 390 * MiB;
constexpr size_t WS_WGU = 394 * MiB;
constexpr size_t WS_Y = 394 * MiB;
constexpr size_t WS_END = 1024 * MiB;
static_assert(WS_DIFF + 32 * MiB <= 654 * MiB && WS_SCORES + 260 * MiB <= WS_POOL && WS_POOL + 32 * MiB <= 970 * MiB && WS_WI + 1 * MiB <= 390 * MiB, "mixer map");
static_assert(WS_SCORES + SC_TOT * 2 * 4 <= WS_POOL, "scores");
static_assert(WS_HBUF + (size_t)(NSLOT + 256) * EDIM * 2 <= WS_TOPK, "hbuf");
static_assert(WS_Y + (size_t)NSLOT * DM * 2 <= WS_END, "y");
constexpr size_t TK_E = 0;
constexpr size_t TK_W = 512 * 1024;
constexpr size_t TK_POS = 1024 * 1024;
constexpr size_t TK_ROWLIST = 1536 * 1024;
constexpr size_t TK_MTT = 2560 * 1024;
constexpr size_t TK_WRT = 3 * MiB;
constexpr int CW_BAR = 4096;
constexpr int CW_CNT = 16384;
constexpr int CW_FILL = 16384 + 64;
constexpr int CW_CVQ = 16384 + 192;
constexpr int CW_NMT = 16384 + 128;

constexpr int RING_BYTES = 131072;
constexpr int MISC_OFF = 143360;
constexpr int LDS_BYTES = 147456;
constexpr int NWAVES = 8, NTHR = 512;

#define RLX_AGENT __ATOMIC_RELAXED, __HIP_MEMORY_SCOPE_AGENT
#define LDS_WAIT() asm volatile("s_waitcnt lgkmcnt(0)" ::: "memory")
#define VM_WAIT() asm volatile("s_waitcnt vmcnt(0)" ::: "memory")

__device__ __forceinline__ int lane_id() { return (int)__builtin_amdgcn_mbcnt_hi(~0u, __builtin_amdgcn_mbcnt_lo(~0u, 0u)); }
__device__ __forceinline__ float bf2f(unsigned b) { return __uint_as_float(b << 16); }
__device__ __forceinline__ unsigned f2bf(float f) { unsigned u = __float_as_uint(f); return (u + 0x7fffu + ((u >> 16) & 1u)) >> 16; }
__device__ __forceinline__ unsigned pk2(float lo, float hi) { return f2bf(lo) | (f2bf(hi) << 16); }
__device__ __forceinline__ unsigned cvt_pk_bf16(float lo, float hi) { unsigned r; asm volatile("v_cvt_pk_bf16_f32 %0, %1, %2" : "=v"(r) : "v"(lo), "v"(hi)); return r; }
#define DPP_I(old, x, ctrl, rmask) __builtin_amdgcn_update_dpp((int)(old), (int)(x), (ctrl), (rmask), 0xf, false)
__device__ __forceinline__ int wave_scan_i(int x) {
    x += DPP_I(0, x, 0x111, 0xf); x += DPP_I(0, x, 0x112, 0xf); x += DPP_I(0, x, 0x114, 0xf); x += DPP_I(0, x, 0x118, 0xf);
    x += DPP_I(0, x, 0x142, 0xa); x += DPP_I(0, x, 0x143, 0xc); return x;
}
__device__ __forceinline__ int wave_sum_i(int v) { return __builtin_amdgcn_readlane(wave_scan_i(v), 63); }
__device__ __forceinline__ float wave_sum(float x) {
#define DPP_F(x_, ctrl, rmask) __builtin_bit_cast(float, __builtin_amdgcn_update_dpp(0, __builtin_bit_cast(int, x_), (ctrl), (rmask), 0xf, false))
    x += DPP_F(x, 0x111, 0xf); x += DPP_F(x, 0x112, 0xf); x += DPP_F(x, 0x114, 0xf); x += DPP_F(x, 0x118, 0xf);
    x += DPP_F(x, 0x142, 0xa); x += DPP_F(x, 0x143, 0xc);
#undef DPP_F
    return __builtin_bit_cast(float, __builtin_amdgcn_readlane(__builtin_bit_cast(int, x), 63));
}
__device__ __forceinline__ float wave_max(float x) {
#define DPP_K(x_, ctrl, rmask) __builtin_bit_cast(float, __builtin_amdgcn_update_dpp(__builtin_bit_cast(int, x_), __builtin_bit_cast(int, x_), (ctrl), (rmask), 0xf, false))
    x = fmaxf(x, DPP_K(x, 0x111, 0xf)); x = fmaxf(x, DPP_K(x, 0x112, 0xf)); x = fmaxf(x, DPP_K(x, 0x114, 0xf)); x = fmaxf(x, DPP_K(x, 0x118, 0xf));
    x = fmaxf(x, DPP_K(x, 0x142, 0xa)); x = fmaxf(x, DPP_K(x, 0x143, 0xc));
    return __builtin_bit_cast(float, __builtin_amdgcn_readlane(__builtin_bit_cast(int, x), 63));
}
__device__ __forceinline__ float wave_min(float x) {
    x = fminf(x, DPP_K(x, 0x111, 0xf)); x = fminf(x, DPP_K(x, 0x112, 0xf)); x = fminf(x, DPP_K(x, 0x114, 0xf)); x = fminf(x, DPP_K(x, 0x118, 0xf));
    x = fminf(x, DPP_K(x, 0x142, 0xa)); x = fminf(x, DPP_K(x, 0x143, 0xc));
#undef DPP_K
    return __builtin_bit_cast(float, __builtin_amdgcn_readlane(__builtin_bit_cast(int, x), 63));
}

#define XB_TMO      128
#define XB_XCNT(j)  (256  + 64 * (j))
#define XB_XSUB(j)  (1280 + 64 * (j))
#define XB_XGEN(j)  (2304 + 64 * (j))
#define XB_TOP      3328
#define XB_TOPGEN   3392
#define XCD_BAR_WORDS 3456
#define XB_SPIN_CAP (1u << 24)

__device__ __forceinline__ unsigned xb_ld(unsigned* p)              { return __hip_atomic_load(p, __ATOMIC_RELAXED, __HIP_MEMORY_SCOPE_AGENT); }
__device__ __forceinline__ unsigned xb_add(unsigned* p, unsigned v) { return __hip_atomic_fetch_add(p, v, __ATOMIC_RELAXED, __HIP_MEMORY_SCOPE_AGENT); }
__device__ __forceinline__ unsigned xb_xcc_id() { return (unsigned)__builtin_amdgcn_s_getreg((3 << 11) | 20) & 0xFu; }
#define XB_SPIN(cond, bar) do { unsigned _sp = 0; while (cond) { __builtin_amdgcn_s_sleep(1); \
    if ((++_sp & 255u) == 0u) { if (xb_ld(&(bar)[XB_TMO])) break; if (_sp > XB_SPIN_CAP) { atomicAdd(&(bar)[XB_TMO], 1u); break; } } } } while (0)

struct XcdBarrier { unsigned* bar; unsigned x; volatile LAS unsigned* st; int wave; };

__device__ __forceinline__ XcdBarrier xcd_barrier_post(unsigned* bar, volatile LAS unsigned* st, int wave) {
    XcdBarrier b; b.bar = bar; b.x = xb_xcc_id(); b.st = st; b.wave = wave;
    if (wave == 0 && lane_id() == 0) (void)xb_add(&bar[XB_XCNT(b.x)], 1u);
    return b;
}
__device__ __forceinline__ void xcd_barrier_complete(unsigned* bar, unsigned x, unsigned& nloc, unsigned& nx) {
    const unsigned G = gridDim.x * gridDim.y * gridDim.z;
    unsigned sum, cnt, mine, sp = 0u;
    for (;;) {
        sum = 0u; cnt = 0u; mine = 0u;
#pragma unroll
        for (unsigned j = 0; j < 16; ++j) { const unsigned c = xb_ld(&bar[XB_XCNT(j)]); sum += c; cnt += (c > 0u) ? 1u : 0u; mine = (j == x) ? c : mine; }
        if (sum == G) break;
        __builtin_amdgcn_s_sleep(1);
        if ((++sp & 255u) == 0u) { if (xb_ld(&bar[XB_TMO])) break; if (sp > XB_SPIN_CAP) { atomicAdd(&bar[XB_TMO], 1u); break; } }
    }
    nloc = mine > 0u ? mine : 1u; nx = cnt > 0u ? cnt : 1u;
}
__device__ __forceinline__ void xcd_barrier(const XcdBarrier& b) {
    asm volatile("s_waitcnt vmcnt(0)" ::: "memory");
    __syncthreads();
    if (b.wave == 0 && lane_id() == 0) {
        unsigned* bar = b.bar;
        __builtin_amdgcn_s_waitcnt(0);
        unsigned nloc = b.st[0], nx = b.st[1];
        if (nloc == 0u) { xcd_barrier_complete(bar, b.x, nloc, nx); b.st[0] = nloc; b.st[1] = nx; }
        const unsigned old = xb_add(&bar[XB_XSUB(b.x)], 1u);
        const unsigned gen = old / nloc;
        if (old + 1u == (gen + 1u) * nloc) {
            __builtin_amdgcn_fence(__ATOMIC_RELEASE, "agent");
            asm volatile("s_waitcnt vmcnt(0)" ::: "memory");
            const unsigned og = xb_add(&bar[XB_TOP], 1u);
            const unsigned tg = og / nx;
            if (og + 1u == (tg + 1u) * nx) xb_add(&bar[XB_TOPGEN], 1u);
            else XB_SPIN(xb_ld(&bar[XB_TOPGEN]) == tg, bar);
            __builtin_amdgcn_fence(__ATOMIC_ACQUIRE, "agent");
            xb_add(&bar[XB_XGEN(b.x)], 1u);
            asm volatile("s_waitcnt vmcnt(0)" ::: "memory");
        } else {
            XB_SPIN(xb_ld(&bar[XB_XGEN(b.x)]) == gen, bar);
            __builtin_amdgcn_fence(__ATOMIC_ACQUIRE, "agent");
            asm volatile("s_waitcnt vmcnt(0)" ::: "memory");
        }
    }
    __syncthreads();
}

namespace pg8 {
constexpr int BM = 256, BK = 64, HALF = 128, HTB = HALF * BK * 2, STAGE_BYTES = 8 * HTB, NXCD = 8, WGM = 8;

__host__ __device__ __forceinline__ int lds_byte(int r, int c) { const int st = (r >> 4) * 2 + (c >> 5), rr = r & 15, cc = c & 31, ob = rr * 64 + cc * 2; return st * 1024 + (ob ^ (((ob >> 9) & 1) << 5)); }
__host__ __device__ __forceinline__ void stage_rc(int b, int& R, int& C) { const int st = b / 1024, sb = b % 1024, swz = sb ^ (((sb >> 9) & 1) << 5); R = (st >> 1) * 16 + swz / 64; C = (st & 1) * 32 + (swz % 64) / 2; }
__host__ __device__ __forceinline__ int perm32(int rho) { const int n = rho >> 4, i = rho & 15; return 8 * (i >> 2) + 4 * n + (i & 3); }

__device__ __forceinline__ const char* uptr(const char* p) { const unsigned long long v = (unsigned long long)p; const unsigned lo = __builtin_amdgcn_readfirstlane((unsigned)v), hi = __builtin_amdgcn_readfirstlane((unsigned)(v >> 32)); return (const char*)(((unsigned long long)hi << 32) | lo); }
struct GUnit {
    const char* A;
    const char* B0;
    const char* B1;
    const int* rows;
    int rows_lds;
    int nt;
    int pm, pn, aux0, aux1;
};

__device__ __forceinline__ void tile_order(int L, int nM, int nN, int& pm, int& pn) {
    const int nwg = nM * nN;
    int wgid = L; { const int q = nwg / NXCD, r = nwg % NXCD, xcd = wgid % NXCD, off = wgid / NXCD; wgid = (xcd < r ? xcd * (q + 1) : r * (q + 1) + (xcd - r) * q) + off; }
    const int nig = WGM * nN, gid = wgid / nig, fm = gid * WGM, gsz = (nM - fm) < WGM ? (nM - fm) : WGM;
    pm = fm + ((wgid % nig) % gsz); pn = (wgid % nig) / gsz;
}

template <class Epi, class Sched, bool GATHER, bool ALIGN_EPI, bool SP2>
__device__ __forceinline__ void gemm_phase(LAS unsigned char* lds, const int wave, const unsigned a_rs, const unsigned b_rs, const Sched& S, const Epi& E) {
    const int wid = wave, lane = lane_id(), tid = wid * 64 + lane, wr = wid >> 2, wc = wid & 3, fr = lane & 15, fq = lane >> 4;
    int R0, C0; stage_rc(tid * 16, R0, C0);
    unsigned voffA[2], voffB[2];
#pragma unroll
    for (int i = 0; i < 2; ++i) { const int R = R0 + 64 * i; const int Rb = (R & ~31) + perm32(R & 31);
        voffA[i] = (unsigned)R * a_rs + (unsigned)C0 * 2u; voffB[i] = (unsigned)Rb * b_rs + (unsigned)C0 * 2u; }
    unsigned vgc[2][2], vgn[2][2];
    const size_t kstep = (size_t)(BK * 2);
    const size_t hstepA = (size_t)HALF * a_rs;
    const unsigned ldsw = (unsigned)wid * 1024u;
    const int aoff = lds_byte(wr * 64 + fr, fq * 8), boff = lds_byte(wc * 32 + fr, fq * 8);
#define PG8_SA(b, h) (((b) * 2 + (h)) * HTB)
#define PG8_SB(b, h) ((4 + (b) * 2 + (h)) * HTB)
#define PG8_STAGE(bufoff, gbase, voff) do { const char* _gb = (const char*)(gbase); asm volatile("" : "+s"(_gb)); _Pragma("unroll") for (int _i = 0; _i < 2; ++_i) \
        __builtin_amdgcn_global_load_lds((const unsigned*)(_gb + (voff)[_i]), (LAS unsigned*)(lds + (bufoff) + ldsw + _i * 8192), 16, 0, 0); } while (0)
#define PG8_STAGE_A(bufoff, gbase, h, vg) do { if constexpr (GATHER) { PG8_STAGE(bufoff, gbase, (vg)[h]); } else { PG8_STAGE(bufoff, (gbase) + (h) * hstepA, voffA); } } while (0)
#define PG8_LDA(dst, b, h) do { _Pragma("unroll") for (int m = 0; m < 4; ++m) _Pragma("unroll") for (int k = 0; k < 2; ++k) dst[m][k] = *(const LAS bf16x8*)(lds + PG8_SA(b, h) + aoff + m * 2048 + k * 1024); } while (0)
#define PG8_LDB(dst, b, h) do { _Pragma("unroll") for (int n = 0; n < 2; ++n) _Pragma("unroll") for (int k = 0; k < 2; ++k) dst[n][k] = *(const LAS bf16x8*)(lds + PG8_SB(b, h) + boff + n * 2048 + k * 1024); } while (0)
#define PG8_MMA(ai, bj, At, Bt) do { __builtin_amdgcn_s_setprio(1); _Pragma("unroll") for (int m = 0; m < 4; ++m) _Pragma("unroll") for (int n = 0; n < 2; ++n) _Pragma("unroll") for (int k = 0; k < 2; ++k) \
        acc[ai][bj][m][n] = __builtin_amdgcn_mfma_f32_16x16x32_bf16(Bt[n][k], At[m][k], acc[ai][bj][m][n], 0, 0, 0); __builtin_amdgcn_s_setprio(0); } while (0)
#define PG8_WAIT_V(n) asm volatile("s_waitcnt vmcnt(" #n ")" ::: "memory")
#define PG8_WAIT_L(n) asm volatile("s_waitcnt lgkmcnt(" #n ")" ::: "memory")
#define PG8_BAR __builtin_amdgcn_s_barrier()
#define PG8_SCHED __builtin_amdgcn_sched_barrier(0)
#define PG8_GOFF(dst, u) do { if constexpr (GATHER) { if ((u).rows_lds >= 0) { _Pragma("unroll") for (int _h = 0; _h < 2; ++_h) _Pragma("unroll") for (int _i = 0; _i < 2; ++_i) \
        dst[_h][_i] = (unsigned)((const LAS int*)(lds + (u).rows_lds))[_h * HALF + R0 + 64 * _i] * a_rs + (unsigned)C0 * 2u; } else { _Pragma("unroll") for (int _h = 0; _h < 2; ++_h) _Pragma("unroll") for (int _i = 0; _i < 2; ++_i) \
        dst[_h][_i] = (unsigned)(u).rows[_h * HALF + R0 + 64 * _i] * a_rs + (unsigned)C0 * 2u; } } } while (0)
    GUnit cur, nxt; int ui = 0;
    if (!S.next(0, cur)) return;
    f32x4 acc[2][2][4][2];
#pragma unroll
    for (int a = 0; a < 2; ++a)
#pragma unroll
        for (int b = 0; b < 2; ++b)
#pragma unroll
            for (int m = 0; m < 4; ++m)
#pragma unroll
                for (int n = 0; n < 2; ++n) acc[a][b][m][n] = (f32x4){0.f, 0.f, 0.f, 0.f};
    bf16x8 At[4][2], B0[2][2], B1[2][2];
    const char* cA = uptr(cur.A); const char* cB0 = uptr(cur.B0); const char* cB1 = uptr(cur.B1); int cnt = __builtin_amdgcn_readfirstlane(cur.nt);
    PG8_GOFF(vgc, cur);
    if constexpr (SP2) {
        PG8_STAGE(PG8_SB(0, 0), cB0, voffB); PG8_STAGE(PG8_SB(0, 1), cB1, voffB); PG8_STAGE_A(PG8_SA(0, 0), cA, 0, vgc); PG8_STAGE_A(PG8_SA(0, 1), cA, 1, vgc);
        if (wr == 1) PG8_BAR;
        PG8_WAIT_V(2); PG8_BAR;
        PG8_STAGE(PG8_SB(1, 0), cB0 + kstep, voffB); PG8_STAGE_A(PG8_SA(1, 0), cA + kstep, 0, vgc); PG8_STAGE(PG8_SB(1, 1), cB1 + kstep, voffB);
        PG8_WAIT_V(6); PG8_BAR;
    } else {
        PG8_STAGE(PG8_SB(0, 0), cB0, voffB); PG8_STAGE_A(PG8_SA(0, 0), cA, 0, vgc); PG8_STAGE(PG8_SB(0, 1), cB1, voffB); PG8_STAGE_A(PG8_SA(0, 1), cA, 1, vgc);
        if (wr == 1) PG8_BAR;
        PG8_WAIT_V(4); PG8_BAR;
        PG8_STAGE(PG8_SB(1, 0), cB0 + kstep, voffB); PG8_STAGE_A(PG8_SA(1, 0), cA + kstep, 0, vgc); PG8_STAGE(PG8_SB(1, 1), cB1 + kstep, voffB);
        PG8_WAIT_V(6); PG8_BAR;
    }
    for (;;) {
        const bool has_next = S.next(ui + 1, nxt);
        const char* nA = uptr(has_next ? nxt.A : cA); const char* nB0 = uptr(has_next ? nxt.B0 : cB0); const char* nB1 = uptr(has_next ? nxt.B1 : cB1);
        if constexpr (GATHER) {
            if (has_next) { PG8_GOFF(vgn, nxt); }
            else {
#pragma unroll
                for (int _h = 0; _h < 2; ++_h)
#pragma unroll
                    for (int _i = 0; _i < 2; ++_i) vgn[_h][_i] = vgc[_h][_i];
            }
        }
        for (int t = 0; t < cnt; t += 2) {
            const bool last = (t == cnt - 2);
            const char* a1 = cA + (size_t)(t + 1) * kstep;
            const char* a2 = last ? nA : cA + (size_t)(t + 2) * kstep;
            const char* b2 = last ? nB0 : cB0 + (size_t)(t + 2) * kstep; const char* b2h = last ? nB1 : cB1 + (size_t)(t + 2) * kstep;
            const char* a3 = a2 + kstep; const char* b3 = b2 + kstep; const char* b3h = b2h + kstep;
            unsigned vg2[2][2];
            if constexpr (GATHER) {
#pragma unroll
                for (int _h = 0; _h < 2; ++_h)
#pragma unroll
                    for (int _i = 0; _i < 2; ++_i) vg2[_h][_i] = last ? vgn[_h][_i] : vgc[_h][_i];
            }
            if constexpr (SP2) {
            PG8_LDB(B0, 0, 0); PG8_LDB(B1, 0, 1); PG8_SCHED; PG8_LDA(At, 0, 0); PG8_STAGE_A(PG8_SA(1, 1), a1, 1, vgc);
            PG8_WAIT_V(8); PG8_WAIT_L(0); PG8_BAR; PG8_MMA(0, 0, At, B0); PG8_MMA(0, 1, At, B1); PG8_BAR; PG8_SCHED;
            PG8_LDA(At, 0, 1); PG8_STAGE(PG8_SB(0, 0), b2, voffB); PG8_STAGE(PG8_SB(0, 1), b2h, voffB); PG8_STAGE_A(PG8_SA(0, 0), a2, 0, vg2);
            PG8_WAIT_V(8); PG8_WAIT_L(0); PG8_BAR; PG8_MMA(1, 0, At, B0); PG8_MMA(1, 1, At, B1); PG8_BAR; PG8_SCHED;
            PG8_LDB(B0, 1, 0); PG8_LDB(B1, 1, 1); PG8_SCHED; PG8_LDA(At, 1, 0); PG8_STAGE_A(PG8_SA(0, 1), a2, 1, vg2);
            PG8_WAIT_V(8); PG8_WAIT_L(0); PG8_BAR; PG8_MMA(0, 0, At, B0); PG8_MMA(0, 1, At, B1); PG8_BAR; PG8_SCHED;
            PG8_LDA(At, 1, 1); PG8_STAGE(PG8_SB(1, 0), b3, voffB); PG8_STAGE(PG8_SB(1, 1), b3h, voffB); PG8_STAGE_A(PG8_SA(1, 0), a3, 0, vg2);
            PG8_WAIT_V(8); PG8_WAIT_L(0); PG8_BAR; PG8_MMA(1, 0, At, B0); PG8_MMA(1, 1, At, B1); PG8_BAR; PG8_SCHED;
            } else {
            PG8_LDB(B0, 0, 0); PG8_SCHED; PG8_LDA(At, 0, 0); PG8_STAGE_A(PG8_SA(1, 1), a1, 1, vgc);
            PG8_WAIT_L(8); PG8_BAR; PG8_WAIT_L(0); PG8_MMA(0, 0, At, B0); PG8_BAR; PG8_SCHED;
            PG8_LDB(B1, 0, 1); PG8_STAGE(PG8_SB(0, 0), b2, voffB);
            PG8_BAR; PG8_WAIT_L(0); PG8_MMA(0, 1, At, B1); PG8_BAR;
            PG8_LDA(At, 0, 1); PG8_STAGE_A(PG8_SA(0, 0), a2, 0, vg2);
            PG8_BAR; PG8_WAIT_L(0); PG8_MMA(1, 0, At, B0); PG8_BAR; PG8_SCHED;
            PG8_STAGE(PG8_SB(0, 1), b2h, voffB);
            PG8_WAIT_V(6); PG8_BAR; PG8_MMA(1, 1, At, B1); PG8_BAR;
            PG8_LDB(B0, 1, 0); PG8_SCHED; PG8_LDA(At, 1, 0); PG8_STAGE_A(PG8_SA(0, 1), a2, 1, vg2);
            PG8_WAIT_L(8); PG8_BAR; PG8_WAIT_L(0); PG8_MMA(0, 0, At, B0); PG8_BAR; PG8_SCHED;
            PG8_LDB(B1, 1, 1); PG8_STAGE(PG8_SB(1, 0), b3, voffB);
            PG8_BAR; PG8_WAIT_L(0); PG8_MMA(0, 1, At, B1); PG8_BAR;
            PG8_LDA(At, 1, 1); PG8_STAGE_A(PG8_SA(1, 0), a3, 0, vg2);
            PG8_BAR; PG8_WAIT_L(0); PG8_MMA(1, 0, At, B0); PG8_BAR; PG8_SCHED;
            PG8_STAGE(PG8_SB(1, 1), b3h, voffB);
            PG8_WAIT_V(6); PG8_BAR; PG8_MMA(1, 1, At, B1); PG8_BAR;
            }
        }
        if constexpr (ALIGN_EPI) { if (wr == 0) PG8_BAR; }
        { int l2 = lane_id(); asm volatile("" : "+v"(l2)); const int fr2 = l2 & 15, fq2 = l2 >> 4; E(acc, cur, wr, wc, fr2, fq2); }
        if (!has_next) break;
#pragma unroll
        for (int a = 0; a < 2; ++a)
#pragma unroll
            for (int b = 0; b < 2; ++b)
#pragma unroll
                for (int m = 0; m < 4; ++m)
#pragma unroll
                    for (int n = 0; n < 2; ++n) acc[a][b][m][n] = (f32x4){0.f, 0.f, 0.f, 0.f};
        cur = nxt; cA = nA; cB0 = nB0; cB1 = nB1; cnt = __builtin_amdgcn_readfirstlane(cur.nt); ++ui;
        if constexpr (GATHER) {
#pragma unroll
            for (int _h = 0; _h < 2; ++_h)
#pragma unroll
                for (int _i = 0; _i < 2; ++_i) vgc[_h][_i] = vgn[_h][_i];
        }
        if constexpr (ALIGN_EPI) { if (wr == 1) PG8_BAR; }
    }
    PG8_WAIT_V(0);
    if constexpr (!ALIGN_EPI) { if (wr == 0) PG8_BAR; }
    PG8_BAR;
#undef PG8_SA
#undef PG8_SB
#undef PG8_STAGE
#undef PG8_STAGE_A
#undef PG8_LDA
#undef PG8_LDB
#undef PG8_MMA
#undef PG8_WAIT_V
#undef PG8_WAIT_L
#undef PG8_BAR
#undef PG8_SCHED
#undef PG8_GOFF
}
}

struct Frame {
    LAS unsigned char* lds;
    volatile LAS unsigned* MISC;
    unsigned* ctl;
    unsigned char* ws;
    float* out;
    int wave, G, bid;
};
using pg8::GUnit;

template <class Fill> struct DenseSched {
    int nM, nN, G, c; Fill f;
    __device__ __forceinline__ bool next(int i, GUnit& u) const {
        const long L = (long)i * G + c; if (L >= (long)nM * nN) return false;
        int pm, pn; pg8::tile_order((int)L, nM, nN, pm, pn); u.pm = pm; u.pn = pn; u.rows = nullptr; u.rows_lds = -1; u.aux0 = 0; u.aux1 = 0; f(u); return true;
    }
};
struct FillPlain {
    const char* A; const char* B; unsigned a_rs, b_rs; int nt;
    __device__ __forceinline__ void operator()(GUnit& u) const { u.A = A + (size_t)u.pm * 256 * a_rs; u.B0 = B + (size_t)u.pn * 256 * b_rs; u.B1 = u.B0 + (size_t)128 * b_rs; u.nt = nt; }
};
struct FillQlatPool {
    const char* q; const char* diff; const char* wuk; const char* wpool;
    __device__ __forceinline__ void operator()(GUnit& u) const {
        if (u.pn < 8) { u.A = q + (size_t)u.pm * 256 * 2048 + (size_t)((u.pn & ~1) * 128) * 2; u.B0 = wuk + (size_t)u.pn * 256 * 512; }
        else { const int g = u.pn - 8; u.A = diff + (size_t)u.pm * 256 * 2048 + (size_t)(g * 256) * 2; u.B0 = wpool + (size_t)g * 256 * 512; }
        u.B1 = u.B0 + (size_t)128 * 512; u.nt = 4;
    }
};
struct FillO {
    const char* olat; const char* wuv;
    __device__ __forceinline__ void operator()(GUnit& u) const { u.A = olat + (size_t)u.pm * 256 * 4096 + (size_t)(u.pn * 512) * 2; u.B0 = wuv + (size_t)u.pn * 256 * 1024; u.B1 = u.B0 + (size_t)128 * 1024; u.nt = 8; }
};

#define EPI_LOOP_ROWS for (int ai = 0; ai < 2; ++ai) _Pragma("unroll") for (int m = 0; m < 4; ++m)
__device__ __forceinline__ u32x4 pack8(const f32x4 v0, const f32x4 v1) { u32x4 w; w.x = cvt_pk_bf16(v0[0], v0[1]); w.y = cvt_pk_bf16(v0[2], v0[3]); w.z = cvt_pk_bf16(v1[0], v1[1]); w.w = cvt_pk_bf16(v1[2], v1[3]); return w; }
__device__ __forceinline__ float sigmoidf_(float x) { return 1.0f / (1.0f + __expf(-x)); }

struct EpiP1 {
    bf16* q; bf16* qi; bf16* xp; bf16* gates; float* ckvraw; float* kiwi;
    __device__ __forceinline__ void operator()(const f32x4 (&acc)[2][2][4][2], const GUnit& u, int wr, int wc, int fr, int fq) const {
        const int row0 = u.pm * 256 + wr * 64 + fr, cl = wc * 32 + 8 * fq;
        if (u.pn < 28) {
            bf16* base; int ld, c0; bool sg = false;
            if (u.pn < 4) { base = q; ld = 1024; c0 = u.pn * 256; } else if (u.pn < 8) { base = qi; ld = 1024; c0 = (u.pn - 4) * 256; }
            else if (u.pn < 12) { base = xp; ld = 1024; c0 = (u.pn - 8) * 256; } else { base = gates; ld = 4096; c0 = (u.pn - 12) * 256; sg = true; }
#pragma unroll
            EPI_LOOP_ROWS { bf16* rowp = base + (size_t)(row0 + ai * 128 + m * 16) * ld + c0 + cl;
#pragma unroll
                for (int bj = 0; bj < 2; ++bj) { f32x4 v0 = acc[ai][bj][m][0], v1 = acc[ai][bj][m][1];
                    if (sg) {
#pragma unroll
                        for (int j = 0; j < 4; ++j) { v0[j] = sigmoidf_(v0[j]); v1[j] = sigmoidf_(v1[j]); } }
                    *(u32x4*)(rowp + bj * 128) = pack8(v0, v1); } }
        } else {
            float* base = (u.pn == 28) ? ckvraw : kiwi;
#pragma unroll
            EPI_LOOP_ROWS { float* rowp = base + (size_t)(row0 + ai * 128 + m * 16) * 256 + cl;
#pragma unroll
                for (int bj = 0; bj < 2; ++bj) { *(f32x4*)(rowp + bj * 128) = acc[ai][bj][m][0]; *(f32x4*)(rowp + bj * 128 + 4) = acc[ai][bj][m][1]; } }
        }
    }
};
struct EpiQlatPool {
    bf16* qlat; bf16* pool; const float* colscale;
    __device__ __forceinline__ void operator()(const f32x4 (&acc)[2][2][4][2], const GUnit& u, int wr, int wc, int fr, int fq) const {
        const int row0 = u.pm * 256 + wr * 64 + fr, cl = wc * 32 + 8 * fq;
        const bool ql = u.pn < 8;
        bf16* base = ql ? qlat + u.pn * 256 : pool + (u.pn - 8) * 256; const int ld = ql ? 2048 : 1024;
        const float* sp = colscale + u.pn * 256 + cl;
        __builtin_amdgcn_sched_barrier(0);
        const f32x4 s00 = *(const f32x4*)(sp), s01 = *(const f32x4*)(sp + 4), s10 = *(const f32x4*)(sp + 128), s11 = *(const f32x4*)(sp + 132);
#pragma unroll
        EPI_LOOP_ROWS { bf16* rowp = base + (size_t)(row0 + ai * 128 + m * 16) * ld + cl;
            *(u32x4*)(rowp) = pack8(acc[ai][0][m][0] * s00, acc[ai][0][m][1] * s01);
            *(u32x4*)(rowp + 128) = pack8(acc[ai][1][m][0] * s10, acc[ai][1][m][1] * s11); }
    }
};
struct EpiBf16 {
    bf16* O; int ld;
    __device__ __forceinline__ void operator()(const f32x4 (&acc)[2][2][4][2], const GUnit& u, int wr, int wc, int fr, int fq) const {
        const int row0 = u.pm * 256 + wr * 64 + fr, cl = u.pn * 256 + wc * 32 + 8 * fq;
#pragma unroll
        EPI_LOOP_ROWS { bf16* rowp = O + (size_t)(row0 + ai * 128 + m * 16) * ld + cl;
#pragma unroll
            for (int bj = 0; bj < 2; ++bj) *(u32x4*)(rowp + bj * 128) = pack8(acc[ai][bj][m][0], acc[ai][bj][m][1]); }
    }
};
__device__ __forceinline__ void unpack8(const u32x4 w, f32x4& a, f32x4& b) {
    a[0] = bf2f(w.x & 0xffffu); a[1] = bf2f(w.x >> 16); a[2] = bf2f(w.y & 0xffffu); a[3] = bf2f(w.y >> 16);
    b[0] = bf2f(w.z & 0xffffu); b[1] = bf2f(w.z >> 16); b[2] = bf2f(w.w & 0xffffu); b[3] = bf2f(w.w >> 16);
}
template <int MODE> struct EpiGate {
    const bf16* gates; bf16* M1; bf16* merged;
    __device__ __forceinline__ void operator()(const f32x4 (&acc)[2][2][4][2], const GUnit& u, int wr, int wc, int fr, int fq) const {
        const int row0 = u.pm * 256 + wr * 64 + fr, cl = u.pn * 256 + wc * 32 + 8 * fq;
#pragma unroll
        for (int ai = 0; ai < 2; ++ai) {
            u32x4 gq[4][2], mq[4][2];
#pragma unroll
            for (int m = 0; m < 4; ++m)
#pragma unroll
                for (int bj = 0; bj < 2; ++bj) { const size_t r = (size_t)(row0 + ai * 128 + m * 16); const int c = cl + bj * 128;
                    gq[m][bj] = *(const u32x4*)(gates + r * 4096 + (MODE ? 2048 : 0) + c); if (MODE) mq[m][bj] = *(const u32x4*)(M1 + r * 2048 + c); }
            __builtin_amdgcn_sched_barrier(0);
#pragma unroll
            for (int m = 0; m < 4; ++m)
#pragma unroll
                for (int bj = 0; bj < 2; ++bj) { const size_t r = (size_t)(row0 + ai * 128 + m * 16); const int c = cl + bj * 128;
                    f32x4 g0, g1; unpack8(gq[m][bj], g0, g1);
                    f32x4 v0 = acc[ai][bj][m][0] * g0, v1 = acc[ai][bj][m][1] * g1;
                    if (MODE) { f32x4 p0, p1; unpack8(mq[m][bj], p0, p1); v0 += p0; v1 += p1; *(u32x4*)(merged + r * 2048 + c) = pack8(v0, v1); }
                    else *(u32x4*)(M1 + r * 2048 + c) = pack8(v0, v1); }
            __builtin_amdgcn_sched_barrier(0);
        }
    }
};
struct EpiPre {
    const float* x; float* pre;
    __device__ __forceinline__ void operator()(const f32x4 (&acc)[2][2][4][2], const GUnit& u, int wr, int wc, int fr, int fq) const {
        const int row0 = u.pm * 256 + wr * 64 + fr, cl = u.pn * 256 + wc * 32 + 8 * fq;
#pragma unroll
        for (int ai = 0; ai < 2; ++ai) {
            f32x4 xq[4][2][2];
#pragma unroll
            for (int m = 0; m < 4; ++m)
#pragma unroll
                for (int bj = 0; bj < 2; ++bj) { const size_t o = (size_t)(row0 + ai * 128 + m * 16) * 2048 + cl + bj * 128; xq[m][bj][0] = __builtin_nontemporal_load((const f32x4*)(x + o)); xq[m][bj][1] = __builtin_nontemporal_load((const f32x4*)(x + o + 4)); }
            __builtin_amdgcn_sched_barrier(0);
#pragma unroll
            for (int m = 0; m < 4; ++m)
#pragma unroll
                for (int bj = 0; bj < 2; ++bj) { const size_t o = (size_t)(row0 + ai * 128 + m * 16) * 2048 + cl + bj * 128;
                    *(f32x4*)(pre + o) = xq[m][bj][0] * DN_ALPHA + acc[ai][bj][m][0]; *(f32x4*)(pre + o + 4) = xq[m][bj][1] * DN_ALPHA + acc[ai][bj][m][1]; }
            __builtin_amdgcn_sched_barrier(0);
        }
    }
};
constexpr int MOE_TAB_OFF = 131072, MOE_TAB_UNITS = 32, MOE_ROWS_OFF = 131072 + 512, MOE_ROWS_UNITS = 11;
struct MoeSched {
    const int* mtt; int nmt; int NT; int G, c; bool gateup;
    const char* h; const char* hbuf; const char* wgu; const char* wd; const int* rowlist; LAS unsigned char* lds;
    __device__ __forceinline__ int unit_of(int i) const {
        const int total = nmt * NT;
        if ((G & 7) == 0) { const int x = c & 7, j = i * (G >> 3) + (c >> 3); const int lo = (int)(((long)total * x) >> 3), hi = (int)(((long)total * (x + 1)) >> 3); const int U = lo + j; return U < hi ? U : -1; }
        const long L = (long)i * G + c; return L < total ? (int)L : -1;
    }
    __device__ __forceinline__ void prepare(int tid) const {
        LAS int* tab = (LAS int*)(lds + MOE_TAB_OFF);
        if (tid < MOE_TAB_UNITS) { const int U = unit_of(tid); int g = -1, p0 = 0, nv = 0, nt_ = 0;
            if (U >= 0) { const int MT = U / NT; nt_ = U - MT * NT; g = mtt[MT * 4 + 0]; p0 = mtt[MT * 4 + 1]; nv = mtt[MT * 4 + 2]; }
            tab[tid * 4 + 0] = g; tab[tid * 4 + 1] = p0; tab[tid * 4 + 2] = nv; tab[tid * 4 + 3] = nt_; }
        if (gateup) { LAS int* rw = (LAS int*)(lds + MOE_ROWS_OFF);
            for (int q = tid; q < MOE_ROWS_UNITS * 256; q += NTHR) { const int i = q >> 8, U = unit_of(i); if (U >= 0) { const int MT = U / NT; rw[q] = rowlist[mtt[MT * 4 + 1] + (q & 255)]; } } }
        __syncthreads();
    }
    __device__ __forceinline__ bool next(int i, GUnit& u) const {
        int g, p0, nv, nt_;
        if (i < MOE_TAB_UNITS) { const LAS int* tab = (const LAS int*)(lds + MOE_TAB_OFF); g = __builtin_amdgcn_readfirstlane(tab[i * 4 + 0]); p0 = __builtin_amdgcn_readfirstlane(tab[i * 4 + 1]); nv = __builtin_amdgcn_readfirstlane(tab[i * 4 + 2]); nt_ = __builtin_amdgcn_readfirstlane(tab[i * 4 + 3]); if (g < 0) return false; }
        else { const int U = unit_of(i); if (U < 0) return false; const int MT = U / NT; nt_ = U - MT * NT;
            g = __builtin_amdgcn_readfirstlane(mtt[MT * 4 + 0]); p0 = __builtin_amdgcn_readfirstlane(mtt[MT * 4 + 1]); nv = __builtin_amdgcn_readfirstlane(mtt[MT * 4 + 2]); }
        u.pm = p0; u.pn = nt_; u.aux0 = nv; u.aux1 = g; u.rows_lds = -1;
        if (gateup) { u.A = h; u.rows = rowlist + p0; if (i < MOE_ROWS_UNITS) u.rows_lds = MOE_ROWS_OFF + i * 1024; u.B0 = wgu + ((size_t)g * 1024 + (size_t)nt_ * 256) * 4096; u.B1 = u.B0 + (size_t)128 * 4096; u.nt = 32; }
        else { u.A = hbuf + (size_t)p0 * 1024; u.rows = nullptr; u.B0 = wd + ((size_t)g * 2048 + (size_t)nt_ * 256) * 1024; u.B1 = u.B0 + (size_t)128 * 1024; u.nt = 8; }
        return true;
    }
};
struct EpiSwiGLU {
    bf16* H;
    __device__ __forceinline__ void operator()(const f32x4 (&acc)[2][2][4][2], const GUnit& u, int wr, int wc, int fr, int fq) const {
        const int cl = u.pn * 128 + wc * 32 + 8 * fq;
#pragma unroll
        EPI_LOOP_ROWS { const int r = ai * 128 + wr * 64 + m * 16 + fr;
            if (r < u.aux0) { f32x4 v[2];
#pragma unroll
                for (int n = 0; n < 2; ++n)
#pragma unroll
                    for (int j = 0; j < 4; ++j) { const float g = acc[ai][0][m][n][j], up = acc[ai][1][m][n][j]; v[n][j] = g * sigmoidf_(g) * up; }
                *(u32x4*)(H + (size_t)(u.pm + r) * 512 + cl) = pack8(v[0], v[1]); } }
    }
};
struct EpiY {
    bf16* Y;
    __device__ __forceinline__ void operator()(const f32x4 (&acc)[2][2][4][2], const GUnit& u, int wr, int wc, int fr, int fq) const {
        const int cl = u.pn * 256 + wc * 32 + 8 * fq;
#pragma unroll
        EPI_LOOP_ROWS { const int r = ai * 128 + wr * 64 + m * 16 + fr;
            if (r < u.aux0) { bf16* rowp = Y + (size_t)(u.pm + r) * 2048 + cl;
#pragma unroll
                for (int bj = 0; bj < 2; ++bj) *(u32x4*)(rowp + bj * 128) = pack8(acc[ai][bj][m][0], acc[ai][bj][m][1]); } }
    }
};

template <class RowMap>
__device__ __forceinline__ void tr_item(const float* W, int ldw, int nvalid, bf16* WT, int ldT, LAS float* scr, int kb, int nb, int lane, const RowMap& rm) {
    const int k0 = 64 * kb, n0 = 32 * nb;
    const int c4 = 4 * (lane & 7), kr = lane >> 3;
    f32x4 v[8];
#pragma unroll
    for (int i = 0; i < 8; ++i) { v[i] = (f32x4){0.f, 0.f, 0.f, 0.f}; if (n0 + c4 < nvalid) v[i] = *(const f32x4*)(W + (size_t)(k0 + 8 * i + kr) * ldw + n0 + c4); }
#pragma unroll
    for (int i = 0; i < 8; ++i) { LAS float* d = scr + (8 * i + kr) * 33 + c4; d[0] = v[i][0]; d[1] = v[i][1]; d[2] = v[i][2]; d[3] = v[i][3]; }
    LDS_WAIT(); asm volatile("" ::: "memory");
    const int c = lane & 7;
#pragma unroll
    for (int j = 0; j < 4; ++j) { const int nl = (lane >> 3) + 8 * j; const LAS float* s = scr + (8 * c) * 33 + nl;
        u32x4 o; o.x = cvt_pk_bf16(s[0 * 33], s[1 * 33]); o.y = cvt_pk_bf16(s[2 * 33], s[3 * 33]); o.z = cvt_pk_bf16(s[4 * 33], s[5 * 33]); o.w = cvt_pk_bf16(s[6 * 33], s[7 * 33]);
        if (n0 + nl < nvalid) *(u32x4*)(WT + (size_t)rm(n0 + nl) * ldT + k0 + 8 * c) = o; }
    LDS_WAIT(); asm volatile("" ::: "memory");
}
struct MapId { int off; __device__ __forceinline__ int operator()(int n) const { return off + n; } };
struct MapWin {
    __device__ __forceinline__ int operator()(int n) const {
        if (n < 1024) return n;
        if (n < 1280) return 7168 + (n - 1024);
        if (n < 2304) return 1024 + (n - 1280);
        if (n < 2368) return 7424 + (n - 2304);
        if (n < 2384) return 7488 + (n - 2368);
        if (n < 3408) return 2048 + (n - 2384);
        return 3072 + (n - 3408);
    }
};
struct MapGU { int up; __device__ __forceinline__ int operator()(int f) const { return (f >> 7) * 256 + up * 128 + (f & 127); } };

__device__ __forceinline__ void phase_convert_small(Frame& F, const float* x, const float* w_in, const float* w_uk, const float* w_uv, const float* w_pool, const float* w_pa, const float* w_pp, const float* w_out, const float* pscale, const float* w_router) {
    const int lane_ = lane_id(), tid_ = F.wave * 64 + lane_;
    { float* wt = (float*)(F.ws + WS_WRT); for (size_t i = (size_t)F.bid * NTHR + tid_; i < (size_t)64 * 2048; i += (size_t)F.G * NTHR) { const int e = (int)(i >> 11), d = (int)(i & 2047); wt[i] = w_router[(size_t)d * 64 + e]; } }
    { float* cs = (float*)(F.ws + WS_CSCALE); for (size_t i = (size_t)F.bid * NTHR + tid_; i < 3072; i += (size_t)F.G * NTHR) cs[i] = (i < 2048) ? 1.0f : pscale[i - 2048]; }
    bf16* xb = (bf16*)(F.ws + WS_XB);
    const size_t gt = (size_t)F.bid * NTHR + tid_, nth = (size_t)F.G * NTHR;
    for (size_t i0 = gt; i0 < (size_t)NTOK * DM / 8; i0 += 4 * nth) {
        f32x4 a[4], b[4];
#pragma unroll
        for (int q = 0; q < 4; ++q) { const size_t i = i0 + q * nth; a[q] = __builtin_nontemporal_load((const f32x4*)x + 2 * i); b[q] = __builtin_nontemporal_load((const f32x4*)x + 2 * i + 1); }
        __builtin_amdgcn_sched_barrier(0);
#pragma unroll
        for (int q = 0; q < 4; ++q) { const size_t i = i0 + q * nth; u32x4 o; o.x = pk2(a[q][0], a[q][1]); o.y = pk2(a[q][2], a[q][3]); o.z = pk2(b[q][0], b[q][1]); o.w = pk2(b[q][2], b[q][3]); ((u32x4*)xb)[i] = o; }
    }
    LAS float* scr = (LAS float*)(F.lds + F.wave * 8704);
    const int gw = F.bid * NWAVES + F.wave, NGW = F.G * NWAVES;
    constexpr int I_IN = 32 * 235, I_POOL = 4 * 4 * 8, I_PA = 16 * 64, I_PP = 16 * 64, I_OUT = 32 * 64;
    constexpr int NIT = I_IN + I_POOL + I_PA + I_PP + I_OUT;
    for (int it = gw; it < NIT; it += NGW) {
        int r = it;
        if (r < I_IN) { tr_item(w_in, 7504, 7504, (bf16*)(F.ws + WS_WIN), 2048, scr, r / 235, r % 235, lane_, MapWin{}); continue; } r -= I_IN;
        if (r < I_POOL) { const int g = r / 32, q = r % 32; tr_item(w_pool + (size_t)g * 65536, 256, 256, (bf16*)(F.ws + WS_WPOOL) + (size_t)g * 65536, 256, scr, q / 8, q % 8, lane_, MapId{0}); continue; } r -= I_POOL;
        if (r < I_PA) { tr_item(w_pa, 2048, 2048, (bf16*)(F.ws + WS_WPA), 1024, scr, r / 64, r % 64, lane_, MapId{0}); continue; } r -= I_PA;
        if (r < I_PP) { tr_item(w_pp, 2048, 2048, (bf16*)(F.ws + WS_WPP), 1024, scr, r / 64, r % 64, lane_, MapId{0}); continue; } r -= I_PP;
        tr_item(w_out, 2048, 2048, (bf16*)(F.ws + WS_WOUT), 2048, scr, r / 64, r % 64, lane_, MapId{0});
    }
    { bf16* wp = (bf16*)(F.ws + WS_WIN) + (size_t)7504 * 2048; for (size_t i = gt; i < (size_t)176 * 2048 / 8; i += nth) ((u32x4*)wp)[i] = (u32x4){0u, 0u, 0u, 0u}; }
    { const float* wuk = w_uk; bf16* o = (bf16*)(F.ws + WS_WUK);
      for (size_t i = gt; i < (size_t)2048 * 256; i += nth) { const int kp = (int)(i & 255), row = (int)(i >> 8), h = row >> 8, r = row & 255;
          o[i] = ((kp >> 7) == (h & 1)) ? (bf16)f2bf(wuk[(size_t)r * 1024 + h * 128 + (kp & 127)]) : (bf16)0; } }
    { const float* wuv = w_uv; bf16* o = (bf16*)(F.ws + WS_WUV);
      for (size_t i = gt; i < (size_t)1024 * 512; i += nth) { const int kp = (int)(i & 511), row = (int)(i >> 9), pn = row >> 8, hh = (row >> 7) & 1, d = row & 127, hh2 = kp >> 8, r = kp & 255;
          o[i] = (hh == hh2) ? (bf16)f2bf(wuv[(size_t)r * 1024 + (2 * pn + hh) * 128 + d]) : (bf16)0; } }
}

struct ExpW { const float* wge; const float* wue; const float* wde; const float* wgs; const float* wus; const float* wds; };
template <int BATCH>
__device__ __forceinline__ bool convert_batch(Frame& F, const ExpW& W, LAS float* scr, const int lane_) {
    constexpr int PER = 1536, NIT = NGRP * PER;
    int base = 0;
    if (lane_ == 0) base = (int)__hip_atomic_fetch_add(F.ctl + CW_CVQ, (unsigned)BATCH, RLX_AGENT);
    base = __builtin_amdgcn_readfirstlane(base);
    if (base >= NIT) return false;
    for (int it = base; it < base + BATCH && it < NIT; ++it) {
        const int g = it / PER; int r = it - g * PER;
        const float* wg = (g < NE) ? W.wge + (size_t)g * 2048 * 512 : W.wgs;
        const float* wu = (g < NE) ? W.wue + (size_t)g * 2048 * 512 : W.wus;
        const float* wd = (g < NE) ? W.wde + (size_t)g * 512 * 2048 : W.wds;
        bf16* ogu = (bf16*)(F.ws + WS_WGU) + (size_t)g * 1024 * 2048; bf16* od = (bf16*)(F.ws + WS_WD) + (size_t)g * 2048 * 512;
        if (r < 512) { tr_item(wg, 512, 512, ogu, 2048, scr, r / 16, r % 16, lane_, MapGU{0}); continue; } r -= 512;
        if (r < 512) { tr_item(wu, 512, 512, ogu, 2048, scr, r / 16, r % 16, lane_, MapGU{1}); continue; } r -= 512;
        tr_item(wd, 2048, 2048, od, 512, scr, r / 64, r % 64, lane_, MapId{0});
    }
    return true;
}
__device__ __forceinline__ void phase_convert_experts(Frame& F, const ExpW& W) {
    const int lane_ = lane_id();
    LAS float* scr = (LAS float*)(F.lds + 32768 + F.wave * 8704);
    while (convert_batch<8>(F, W, scr, lane_)) {}
}

__device__ __forceinline__ void phase_postproc(Frame& F, const float* cg, const float* kg, const float* kb) {
    const int lane_ = lane_id(), tid_ = F.wave * 64 + lane_;
    const float* ckvraw = (const float*)(F.ws + WS_CKVRAW); const float* kiwi = (const float*)(F.ws + WS_KIWI);
    unsigned* ckvn = (unsigned*)(F.ws + WS_CKVN); bf16* kin = (bf16*)(F.ws + WS_KIN); float* wis = (float*)(F.ws + WS_WI);
    const int gw = F.bid * NWAVES + F.wave, NGW = F.G * NWAVES, lane = lane_;
    const f32x4 g4 = *(const f32x4*)(cg + lane * 4); const float kgl = kg[lane], kbl = kb[lane];
    for (int t0 = gw; t0 < NTOK; t0 += 4 * NGW) {
        f32x4 v[4]; float kv[4], wv[4];
#pragma unroll
        for (int q = 0; q < 4; ++q) { const int t = t0 + q * NGW; v[q] = (f32x4){0.f, 0.f, 0.f, 0.f}; kv[q] = 0.f; wv[q] = 0.f;
            if (t < NTOK) { v[q] = *(const f32x4*)(ckvraw + (size_t)t * 256 + lane * 4); kv[q] = kiwi[(size_t)t * 256 + lane]; wv[q] = kiwi[(size_t)t * 256 + 64 + (lane & 15)]; } }
#pragma unroll
        for (int q = 0; q < 4; ++q) { const int t = t0 + q * NGW;
            const float ss = wave_sum(v[q][0] * v[q][0] + v[q][1] * v[q][1] + v[q][2] * v[q][2] + v[q][3] * v[q][3]);
            const float rs = 1.0f / sqrtf(ss * (1.0f / 256.0f) + RMS_EPS);
            int o8 = __builtin_amdgcn_cvt_pk_fp8_f32(v[q][0] * rs * g4[0], v[q][1] * rs * g4[1], 0, false);
            o8 = __builtin_amdgcn_cvt_pk_fp8_f32(v[q][2] * rs * g4[2], v[q][3] * rs * g4[3], o8, true);
            const float mu = wave_sum(kv[q]) * (1.0f / 64.0f); const float dlt = kv[q] - mu;
            const float var = wave_sum(dlt * dlt) * (1.0f / 64.0f);
            const float y = dlt * (1.0f / sqrtf(var + LN_EPS)) * kgl + kbl;
            if (t < NTOK) { ckvn[(size_t)t * 64 + lane] = (unsigned)o8; kin[(size_t)t * 64 + lane] = (bf16)f2bf(y); if (lane < 16) wis[(size_t)t * 16 + lane] = wv[q] * 0.03125f; } }
    }
    const bf16* xp = (const bf16*)(F.ws + WS_XP); bf16* diff = (bf16*)(F.ws + WS_DIFF);
    const size_t gt = (size_t)F.bid * NTHR + tid_, nth = (size_t)F.G * NTHR;
    for (size_t i = gt; i < (size_t)(NTOK / 16) * 128; i += nth) {
        const int run = (int)(i >> 7), cgp = (int)(i & 127), g = cgp >> 5, win = 2 << g, tb = run * 16, posb = tb & (SEQ - 1);
        const bf16* col = xp + cgp * 8;
        u32x4 rw[31];
#pragma unroll
        for (int j = 0; j < 31; ++j) { const int dr = j - 15; rw[j] = (u32x4){0u, 0u, 0u, 0u}; if (dr >= 1 - win && posb + dr >= 0) rw[j] = *(const u32x4*)(col + (size_t)(tb + dr) * 1024); }
        __builtin_amdgcn_sched_barrier(0);
        f32x4 s0 = {0.f, 0.f, 0.f, 0.f}, s1 = {0.f, 0.f, 0.f, 0.f};
#pragma unroll
        for (int j = 1; j < 16; ++j) { if (j < win) { f32x4 a, b; unpack8(rw[15 - j], a, b); s0 += a; s1 += b; } }
#pragma unroll
        for (int q = 0; q < 16; ++q) { const int t = tb + q, pos = posb + q;
            f32x4 a, b; unpack8(rw[15 + q], a, b); s0 += a; s1 += b;
            const int cntw = (pos + 1 < win) ? pos + 1 : win; const float inv = 1.0f / (float)cntw;
            *(u32x4*)(diff + (size_t)t * 1024 + cgp * 8) = pack8(s0 * inv - a, s1 * inv - b);
            f32x4 c, d; const u32x4 r2 = rw[15 + q - 1], r4 = rw[15 + q - 3], r8 = rw[15 + q - 7], r16 = rw[15 + q - 15];
            const u32x4 rr = (win == 2) ? r2 : (win == 4) ? r4 : (win == 8) ? r8 : r16;
            unpack8(rr, c, d); s0 -= c; s1 -= d; }
    }
}

__device__ __forceinline__ size_t score_rowbase(int b, int p) { const int jq = p >> 7; return (size_t)b * SC_TOT + (size_t)16384 * (size_t)(jq * (jq + 1) / 2) + (size_t)(p & 127) * (size_t)(128 * (jq + 1)); }

__device__ __forceinline__ void phase_index_scores(Frame& F) {
    const int lane_ = lane_id(), tid_ = F.wave * 64 + lane_;
    const bf16* qi = (const bf16*)(F.ws + WS_QI); const bf16* kin = (const bf16*)(F.ws + WS_KIN); const float* wis = (const float*)(F.ws + WS_WI);
    float* scores = (float*)(F.ws + WS_SCORES);
    const int lane = lane_, w = F.wave, fq = lane >> 4, j16 = lane & 15, tid = tid_;
    LAS unsigned char* kb = F.lds;
    const int sR = tid >> 3, sc = tid & 7, sP = (sR & 3) * 16 + (sR >> 2);
    const int st_off = sP * 128 + ((sc ^ ((sP >> 1) & 7)) * 16);
    for (int it = 0;; ++it) {
        const int jj = (it >> 1) * F.G + F.bid; if (jj >= 256) break;
        const int s = (it & 1) ? 511 - jj : jj;
        const int b = s & 1, qg = s >> 1, tq0 = qg * 32;
        const int nsteps = (tq0 + 32 + 63) / 64;
        bf16x8 Af[4][2];
        { const size_t tok = (size_t)b * SEQ + tq0 + 4 * w + (j16 >> 2);
#pragma unroll
          for (int g = 0; g < 4; ++g)
#pragma unroll
              for (int ks = 0; ks < 2; ++ks) Af[g][ks] = *(const bf16x8*)(qi + tok * 1024 + (4 * g + (j16 & 3)) * 64 + ks * 32 + 8 * fq); }
        f32x4 wv[4];
        { const size_t tok = (size_t)b * SEQ + tq0 + 4 * w + fq;
#pragma unroll
          for (int g = 0; g < 4; ++g) wv[g] = *(const f32x4*)(wis + tok * 16 + 4 * g); }
        float* orow = scores + score_rowbase(b, tq0 + 4 * w + fq);
        const bf16* kbase = kin + (size_t)b * SEQ * 64;
        u32x4 stg = *(const u32x4*)(kbase + (size_t)sR * 64 + sc * 8);
        __syncthreads();
        *(LAS u32x4*)(kb + st_off) = stg;
        __syncthreads();
        for (int step = 0; step < nsteps; ++step) {
            const int cur = step & 1;
            if (step + 1 < nsteps) stg = *(const u32x4*)(kbase + (size_t)((step + 1) * 64 + sR) * 64 + sc * 8);
            f32x4 res;
#pragma unroll
            for (int u = 0; u < 4; ++u) {
                const int P = u * 16 + j16;
                f32x4 a4[4];
#pragma unroll
                for (int g = 0; g < 4; ++g) a4[g] = (f32x4){0.f, 0.f, 0.f, 0.f};
#pragma unroll
                for (int ks = 0; ks < 2; ++ks) {
                    const bf16x8 bfr = *(const LAS bf16x8*)(kb + cur * 8192 + P * 128 + (((fq + 4 * ks) ^ ((P >> 1) & 7)) * 16));
#pragma unroll
                    for (int g = 0; g < 4; ++g) a4[g] = __builtin_amdgcn_mfma_f32_16x16x32_bf16(Af[g][ks], bfr, a4[g], 0, 0, 0);
                }
                float sres = 0.f;
#pragma unroll
                for (int g = 0; g < 4; ++g)
#pragma unroll
                    for (int r = 0; r < 4; ++r) sres += wv[g][r] * fmaxf(a4[g][r], 0.f);
                res[u] = sres;
            }
            *(f32x4*)(orow + step * 64 + 4 * j16) = res;
            if (step + 1 < nsteps) *(LAS u32x4*)(kb + (cur ^ 1) * 8192 + st_off) = stg;
            __syncthreads();
        }
    }
}

__device__ __forceinline__ unsigned fkey(float f) { const unsigned u = __float_as_uint(f); return (u & 0x80000000u) ? ~u : (u | 0x80000000u); }

template <int NV>
__device__ __forceinline__ void select_row(const float* row, int n, unsigned short* sel, int lane) {
    unsigned u[NV][4];
#pragma unroll
    for (int i = 0; i < NV; ++i) {
        const int base = i * 256 + lane * 4;
        f32x4 v = {0.f, 0.f, 0.f, 0.f};
        if (base < n) v = *(const f32x4*)(row + base);
#pragma unroll
        for (int e = 0; e < 4; ++e) u[i][e] = (base + e < n) ? fkey(v[e]) : 0u;
    }
    unsigned T = 0u; int cntT = n;
    bool exact = false;
    for (int bit = 31; bit >= 0; --bit) {
        const unsigned cand = T | (1u << bit);
        int c = 0;
#pragma unroll
        for (int i = 0; i < NV; ++i)
#pragma unroll
            for (int e = 0; e < 4; ++e) c += (u[i][e] >= cand) ? 1 : 0;
        c = wave_sum_i(c);
        if (c >= TOPK) { T = cand; cntT = c; if (c == TOPK) { exact = true; break; } }
    }
    int cgt = 0;
    if (!exact) {
#pragma unroll
        for (int i = 0; i < NV; ++i)
#pragma unroll
            for (int e = 0; e < 4; ++e) cgt += (u[i][e] > T) ? 1 : 0;
        cgt = wave_sum_i(cgt);
    }
    int pg = 0, pe = exact ? 0 : cgt;
    const unsigned long long lt = (1ull << lane) - 1ull;
#pragma unroll
    for (int i = 0; i < NV; ++i)
#pragma unroll
        for (int e = 0; e < 4; ++e) {
            const unsigned val = u[i][e]; const int idx = i * 256 + lane * 4 + e;
            const bool gsel = exact ? (val >= T) : (val > T);
            const unsigned long long mg = __ballot(gsel);
            if (gsel) sel[pg + __popcll(mg & lt)] = (unsigned short)idx;
            pg += __popcll(mg);
            if (!exact) {
                const bool esel = (val == T);
                const unsigned long long me = __ballot(esel);
                const int pos = pe + __popcll(me & lt);
                if (esel && pos < TOPK) sel[pos] = (unsigned short)idx;
                pe += __popcll(me);
            }
        }
}

template <int NV>
__device__ __forceinline__ bool select_row_hist(const float* row, int n, unsigned short* sel, int lane, LAS unsigned* hist) {
    LAS unsigned* cnts = hist + 4097;
    LAS unsigned* tiel = hist + 4100;
    unsigned u[NV][4];
#pragma unroll
    for (int i = 0; i < NV; ++i) { const int base = i * 256 + lane * 4; u32x4 t4 = {0u, 0u, 0u, 0u}; if (base < n) t4 = *(const u32x4*)(row + base); u[i][0] = t4[0]; u[i][1] = t4[1]; u[i][2] = t4[2]; u[i][3] = t4[3]; }
#pragma unroll
    for (int q = 0; q < 17; ++q) { const int w = q * 256 + lane * 4; if (w < 4104) *(LAS u32x4*)(hist + w) = (u32x4){0u, 0u, 0u, 0u}; }
    const float v00 = __uint_as_float(u[0][0]);
    float mn = v00, mx = v00;
#define SR_MM(i_, MASKED) do { _Pragma("unroll") for (int e = 0; e < 4; ++e) { float x = __uint_as_float(u[i_][e]); if (MASKED) x = ((i_) * 256 + lane * 4 + e < n) ? x : v00; mn = fminf(mn, x); mx = fmaxf(mx, x); } } while (0)
#pragma unroll
    for (int i = 0; i < NV; ++i) {
        if (i < NV - 8) SR_MM(i, false);
        else { const int rem = n - i * 256; if (rem >= 256) SR_MM(i, false); else if (rem > 0) SR_MM(i, true); }
    }
#undef SR_MM
    mn = wave_min(mn); mx = wave_max(mx);
    if (!(mx > mn)) {
#pragma unroll
        for (int q = 0; q < 4; ++q) sel[q * 64 + lane] = (unsigned short)(q * 64 + lane);
        return true;
    }
    const float scale = 4095.5f / (mx - mn), off = -mn * scale;
#define SR_KEY(i_, MASKED) do { _Pragma("unroll") for (int e = 0; e < 4; ++e) { unsigned k = (unsigned)fmaf(__uint_as_float(u[i_][e]), scale, off); k = k > 4095u ? 4095u : k; \
        if (MASKED) k = ((i_) * 256 + lane * 4 + e < n) ? k : 4096u; u[i_][e] = k; __hip_atomic_fetch_add(hist + k, 1u, __ATOMIC_RELAXED, __HIP_MEMORY_SCOPE_WORKGROUP); } } while (0)
#pragma unroll
    for (int i = 0; i < NV; ++i) {
        if (i < NV - 8) SR_KEY(i, false);
        else { const int rem = n - i * 256; if (rem >= 256) SR_KEY(i, false); else if (rem > 0) SR_KEY(i, true); else { u[i][0] = 4096u; u[i][1] = 4096u; u[i][2] = 4096u; u[i][3] = 4096u; } }
    }
#undef SR_KEY
    LDS_WAIT();
    unsigned sl = 0;
#pragma unroll
    for (int q = 0; q < 16; ++q) { const u32x4 t4 = *(const LAS u32x4*)(hist + 64 * lane + 4 * q); sl += (t4[0] + t4[1]) + (t4[2] + t4[3]); }
    const unsigned pre = (unsigned)wave_scan_i((int)sl);
    const unsigned total = (unsigned)__builtin_amdgcn_readlane((int)pre, 63), above = total - pre;
    const bool mine = (above < (unsigned)TOPK) && (above + sl >= (unsigned)TOPK);
    const int src = __builtin_amdgcn_readfirstlane(__ffsll((unsigned long long)__ballot(mine)) - 1);
    const unsigned above_src = (unsigned)__builtin_amdgcn_readlane((int)above, src);
    const unsigned hj = hist[64 * src + lane];
    const unsigned pj = (unsigned)wave_scan_i((int)hj);
    const unsigned cj = above_src + ((unsigned)__builtin_amdgcn_readlane((int)pj, 63) - pj);
    const bool hit = (cj < (unsigned)TOPK) && (cj + hj >= (unsigned)TOPK);
    const int hl = __builtin_amdgcn_readfirstlane(__ffsll((unsigned long long)__ballot(hit)) - 1);
    const unsigned bstar = (unsigned)(64 * src + hl), cgt = (unsigned)__builtin_amdgcn_readlane((int)cj, hl), mt = (unsigned)__builtin_amdgcn_readlane((int)hj, hl);
    int pg = 0; const unsigned span = 4095u - bstar;
#pragma unroll
    for (int i = 0; i < NV; ++i)
#pragma unroll
        for (int e = 0; e < 4; ++e) { const unsigned k = u[i][e]; const int idx = i * 256 + lane * 4 + e;
            const bool gsel = (k - bstar - 1u) < span;
            const unsigned long long mg = __ballot(gsel);
            if (mg) { if (gsel) sel[pg + (int)__builtin_amdgcn_mbcnt_hi((unsigned)(mg >> 32), __builtin_amdgcn_mbcnt_lo((unsigned)mg, 0u))] = (unsigned short)idx; pg += __popcll(mg); }
            if (k == bstar) { const unsigned p = __hip_atomic_fetch_add(cnts + 1, 1u, __ATOMIC_RELAXED, __HIP_MEMORY_SCOPE_WORKGROUP); if (p < 64u) tiel[p] = (unsigned)idx; } }
    LDS_WAIT();
    const int need = TOPK - (int)cgt;
    if (mt <= 64u) {
        int idx = 0x7fffffff; float val = -INFINITY;
        if (lane < (int)mt) { idx = (int)tiel[lane]; val = row[idx]; }
        int rk = 0;
        for (int j = 0; j < (int)mt; ++j) { const float o = __shfl(val, j); const int oi = __shfl(idx, j); rk += (o > val || (o == val && oi < idx)) ? 1 : 0; }
        if (lane < (int)mt && rk < need) sel[cgt + rk] = (unsigned short)idx;
        return true;
    }
    return false;
}

__device__ __forceinline__ void phase_select(Frame& F, const ExpW& W, const bool ride) {
    const int lane_ = lane_id(), tid_ = F.wave * 64 + lane_;
    LAS float* cscr = (LAS float*)(F.lds + F.wave * 8704); bool more = ride;
    LAS unsigned* hist = (LAS unsigned*)(F.lds + F.wave * 17408);
    const float* scores = (const float*)(F.ws + WS_SCORES);
    unsigned short* selb = (unsigned short*)(F.ws + WS_SEL);
    const int gw = F.bid * NWAVES + F.wave, NGW = F.G * NWAVES, lane = lane_;
    for (int it = 0;; ++it) {
        const int jj = (it >> 1) * NGW + gw; if (jj >= NTOK / 2) break;
        const int s = (it & 1) ? NTOK - 1 - jj : jj;
        const int b = s & 1, p = s >> 1, n = p + 1;
        unsigned short* sel = selb + ((size_t)b * SEQ + p) * TOPK;
        if (n <= TOPK) {
#pragma unroll
            for (int q = 0; q < 4; ++q) { const int i = q * 64 + lane; sel[i] = (i < n) ? (unsigned short)i : (unsigned short)0xFFFFu; }
        } else {
            const float* row = scores + score_rowbase(b, p);
            bool ok;
            if (n <= 2048) ok = select_row_hist<8>(row, n, sel, lane, hist);
            else if (n <= 4096) ok = select_row_hist<16>(row, n, sel, lane, hist);
            else if (n <= 6144) ok = select_row_hist<24>(row, n, sel, lane, hist);
            else ok = select_row_hist<32>(row, n, sel, lane, hist);
            asm volatile("" ::: "memory");
            if (!ok) select_row<32>(row, n, sel, lane);
        }
        if (more) more = convert_batch<3>(F, W, cscr, lane);
    }
}

__device__ __forceinline__ int c_lds(int row, int chunk) { return row * 544 + chunk * 16; }

__device__ __forceinline__ void phase_sparse_attn(Frame& F, const ExpW& W, const bool ride) {
    const int lane_ = lane_id(), tid_ = F.wave * 64 + lane_; bool more = ride;
    const bf16* qlat = (const bf16*)(F.ws + WS_QLAT); const unsigned char* ckv8 = (const unsigned char*)(F.ws + WS_CKVN);
    const unsigned short* selb = (const unsigned short*)(F.ws + WS_SEL); bf16* olat = (bf16*)(F.ws + WS_OLAT);
    const int lane = lane_, fq = lane >> 4, j16 = lane & 15;
    LAS unsigned char* cb = F.lds + F.wave * 17408;
    const float sl2 = 0.08838834764831845f * 1.4426950408889634f;
    const int xh = (F.G % 8 == 0) ? ((F.bid & 7) >> 2) : 0, nsplit = (F.G % 8 == 0) ? 2 : 1;
    const int wloc = (F.G % 8 == 0) ? (((F.bid >> 3) * 4 + (F.bid & 3)) * NWAVES + F.wave) : (F.bid * NWAVES + F.wave);
    const int nwl = (F.G % 8 == 0) ? (F.G / 2) * NWAVES : F.G * NWAVES;
    const int ntk = NTOK / nsplit;
    for (int tl = wloc; tl < ntk; tl += nwl) {
        const int t = xh * ntk + tl, b = t / SEQ, pos = t % SEQ;
        const int nvalid = (pos + 1 < TOPK) ? pos + 1 : TOPK;
        const unsigned short* sel = selb + (size_t)t * TOPK;
        const u32x2 sv = __builtin_nontemporal_load((const u32x2*)(sel + 4 * lane));
        bf16x8 Qb[8];
#pragma unroll
        for (int ks = 0; ks < 8; ++ks) { bf16x8 z = {0, 0, 0, 0, 0, 0, 0, 0}; if (j16 < 8) z = __builtin_nontemporal_load((const bf16x8*)(qlat + ((size_t)t * 8 + j16) * 256 + ks * 32 + 8 * fq)); Qb[ks] = z; }
        float mrun = -INFINITY, lrun = 0.f;
        f32x4 O[16];
#pragma unroll
        for (int rt = 0; rt < 16; ++rt) O[rt] = (f32x4){0.f, 0.f, 0.f, 0.f};
        const int nch = (nvalid + 31) >> 5;
        const unsigned char* cbase = ckv8 + (size_t)b * SEQ * 256 + (lane & 15) * 16;
        u32x4 gv[8];
#define SA_GATHER(c_) do { _Pragma("unroll") for (int it = 0; it < 8; ++it) { \
            const unsigned dx = (unsigned)__builtin_amdgcn_readlane((int)sv.x, 8 * (c_) + it), dy = (unsigned)__builtin_amdgcn_readlane((int)sv.y, 8 * (c_) + it); \
            const unsigned dd = (fq & 2) ? dy : dx; int key = (fq & 1) ? (int)(dd >> 16) : (int)(dd & 0xffffu); key = (key >= SEQ) ? 0 : key; \
            gv[it] = *(const u32x4*)(cbase + (size_t)key * 256); } } while (0)
        SA_GATHER(0);
        for (int c = 0; c < nch; ++c) {
#pragma unroll
            for (int it = 0; it < 8; ++it) { const int row = 4 * it + fq; u32x4 w0, w1;
#pragma unroll
                for (int q = 0; q < 4; ++q) { const f32x2 a = __builtin_amdgcn_cvt_pk_f32_fp8((int)gv[it][q], false), bq = __builtin_amdgcn_cvt_pk_f32_fp8((int)gv[it][q], true);
                    const unsigned lo = cvt_pk_bf16(a[0], a[1]), hi = cvt_pk_bf16(bq[0], bq[1]);
                    if (q < 2) { w0[2 * q] = lo; w0[2 * q + 1] = hi; } else { w1[2 * (q - 2)] = lo; w1[2 * (q - 2) + 1] = hi; } }
                *(LAS u32x4*)(cb + c_lds(row, 2 * j16)) = w0; *(LAS u32x4*)(cb + c_lds(row, 2 * j16 + 1)) = w1; }
            asm volatile("" ::: "memory");
            if (c + 1 < nch) SA_GATHER(c + 1);
            f32x4 Sa = {0.f, 0.f, 0.f, 0.f}, Sb = {0.f, 0.f, 0.f, 0.f};
#pragma unroll
            for (int ks = 0; ks < 8; ++ks) {
                const bf16x8 a0 = *(const LAS bf16x8*)(cb + c_lds(j16, 4 * ks + fq));
                const bf16x8 a1 = *(const LAS bf16x8*)(cb + c_lds(16 + j16, 4 * ks + fq));
                Sa = __builtin_amdgcn_mfma_f32_16x16x32_bf16(a0, Qb[ks], Sa, 0, 0, 0);
                Sb = __builtin_amdgcn_mfma_f32_16x16x32_bf16(a1, Qb[ks], Sb, 0, 0, 0);
            }
            float xa[4], xb[4]; float cm = -INFINITY;
#pragma unroll
            for (int r = 0; r < 4; ++r) { const int ka = c * 32 + 4 * fq + r, kb2 = ka + 16;
                xa[r] = (ka < nvalid) ? Sa[r] * sl2 : -INFINITY; xb[r] = (kb2 < nvalid) ? Sb[r] * sl2 : -INFINITY; cm = fmaxf(cm, fmaxf(xa[r], xb[r])); }
            cm = fmaxf(cm, __shfl_xor(cm, 16)); cm = fmaxf(cm, __shfl_xor(cm, 32));
            const float mnew = fmaxf(mrun, cm);
            const float alpha = __builtin_amdgcn_exp2f(mrun - mnew);
            float ps = 0.f; f32x4 pa, pb;
#pragma unroll
            for (int r = 0; r < 4; ++r) { pa[r] = __builtin_amdgcn_exp2f(xa[r] - mnew); pb[r] = __builtin_amdgcn_exp2f(xb[r] - mnew); ps += pa[r] + pb[r]; }
            ps += __shfl_xor(ps, 16); ps += __shfl_xor(ps, 32);
            lrun = lrun * alpha + ps; mrun = mnew;
            const u32x4 pw = pack8(pa, pb); const bf16x8 Pb = __builtin_bit_cast(bf16x8, pw);
#pragma unroll
            for (int rt = 0; rt < 16; ++rt) O[rt] = O[rt] * alpha;
            const int q4 = j16 >> 2, p4 = j16 & 3;
#pragma unroll
            for (int rt = 0; rt < 16; ++rt) {
                const int ra = 4 * fq + q4, rb = 16 + 4 * fq + q4, ch = 2 * rt + (p4 >> 1);
                const s16x4 lo = __builtin_bit_cast(s16x4, __builtin_amdgcn_ds_read_tr16_b64_v4i16((LAS s16x4*)(cb + c_lds(ra, ch) + 8 * (p4 & 1))));
                const s16x4 hi = __builtin_bit_cast(s16x4, __builtin_amdgcn_ds_read_tr16_b64_v4i16((LAS s16x4*)(cb + c_lds(rb, ch) + 8 * (p4 & 1))));
                const bf16x8 af = {lo[0], lo[1], lo[2], lo[3], hi[0], hi[1], hi[2], hi[3]};
                O[rt] = __builtin_amdgcn_mfma_f32_16x16x32_bf16(af, Pb, O[rt], 0, 0, 0);
            }
            asm volatile("" ::: "memory");
        }
#undef SA_GATHER
        const float inv = 1.0f / lrun;
        asm volatile("" ::: "memory");
        if (j16 < 8) {
#pragma unroll
            for (int rt = 0; rt < 16; ++rt) { u32x2 o; o.x = pk2(O[rt][0] * inv, O[rt][1] * inv); o.y = pk2(O[rt][2] * inv, O[rt][3] * inv); *(LAS u32x2*)(cb + j16 * 512 + rt * 32 + fq * 8) = o; }
        }
        asm volatile("" ::: "memory");
        { bf16* obase = olat + (size_t)t * 2048;
#pragma unroll
          for (int q = 0; q < 4; ++q) { const u32x4 v = *(const LAS u32x4*)(cb + q * 1024 + lane * 16); __builtin_nontemporal_store(v, (u32x4*)(obase + q * 512 + lane * 8)); } }
        asm volatile("" ::: "memory");
        if (more) { LDS_WAIT(); more = convert_batch<3>(F, W, (LAS float*)cb, lane); }
    }
}

__device__ __forceinline__ void routing_token(const float acc, const int lane, const float* rbias, int* tk_e, float* tk_w, LAS unsigned* hist, const size_t t, const bool do_count) {
    const float sc = 1.0f / (1.0f + expf(-acc));
    const float ch = sc + rbias[lane];
    int rk = 0;
#pragma unroll
    for (int k = 1; k < 8; ++k) { const int src = (lane & ~7) | ((lane + k) & 7); const float o = __shfl(ch, src); rk += (o > ch || (o == ch && src < lane)) ? 1 : 0; }
    float gs = (rk < 2) ? ch : 0.f; gs += __shfl_xor(gs, 1); gs += __shfl_xor(gs, 2); gs += __shfl_xor(gs, 4);
    int grk = 0; const int myg = lane >> 3;
#pragma unroll
    for (int g = 0; g < 8; ++g) { const float o = __shfl(gs, g * 8); grk += (o > gs || (o == gs && g < myg)) ? 1 : 0; }
    const float cm = (grk < 4) ? ch : -INFINITY;
    int erk = 0;
    for (int j = 0; j < 64; ++j) { const float o = __shfl(cm, j); erk += (o > cm || (o == cm && j < lane)) ? 1 : 0; }
    const bool selx = (erk < EK) && (grk < 4);
    const float ssum = wave_sum(selx ? sc : 0.f);
    if (selx) { tk_e[t * 8 + erk] = lane; tk_w[t * 8 + erk] = sc / ssum * 2.5f; if (do_count) __hip_atomic_fetch_add(&hist[lane], 1u, __ATOMIC_RELAXED, __HIP_MEMORY_SCOPE_WORKGROUP); }
}
__device__ __forceinline__ void phase_ln1_router(Frame& F, const float* g1, const float* b1, const float* rbias, const bool do_count) {
    const int lane_ = lane_id(), tid_ = F.wave * 64 + lane_;
    const float* pre = F.out;
    const float* wrT = (const float*)(F.ws + WS_WRT);
    bf16* h = (bf16*)(F.ws + WS_H);
    int* tk_e = (int*)(F.ws + WS_TOPK + TK_E); float* tk_w = (float*)(F.ws + WS_TOPK + TK_W);
    const int lane = lane_, w = F.wave, tid = tid_;
    LAS float* stats = (LAS float*)F.lds;
    LAS float* lg = (LAS float*)(F.lds + 1024) + (w & 3) * 1024;
    LAS unsigned* hist = (LAS unsigned*)(F.lds + 1024 + 16384);
    if (do_count && tid < 64) hist[tid] = 0u;
    for (int chunk = F.bid; chunk < NTOK / 64; chunk += F.G) {
        __syncthreads();
        f32x4 ggv[8], bbv[8];
#pragma unroll
        for (int q = 0; q < 8; ++q) { const int c = (lane + 64 * q) * 4; ggv[q] = *(const f32x4*)(g1 + c); bbv[q] = *(const f32x4*)(b1 + c); }
        for (int i = 0; i < 8; ++i) {
            const int tl = w * 8 + i; const size_t t = (size_t)chunk * 64 + tl;
            f32x4 v[8]; float s = 0.f;
#pragma unroll
            for (int q = 0; q < 8; ++q) { v[q] = *(const f32x4*)(pre + t * DM + (lane + 64 * q) * 4); s += (v[q][0] + v[q][1]) + (v[q][2] + v[q][3]); }
            const float mean = wave_sum(s) * (1.0f / DM); float s2 = 0.f;
#pragma unroll
            for (int q = 0; q < 8; ++q) { v[q] = v[q] - mean; s2 += (v[q][0] * v[q][0] + v[q][1] * v[q][1]) + (v[q][2] * v[q][2] + v[q][3] * v[q][3]); }
            const float rstd = 1.0f / sqrtf(wave_sum(s2) * (1.0f / DM) + LN_EPS);
#pragma unroll
            for (int q = 0; q < 8; ++q) { const int c = (lane + 64 * q) * 4;
                const f32x4 y = v[q] * rstd * ggv[q] + bbv[q];
                u32x2 o; o.x = pk2(y[0], y[1]); o.y = pk2(y[2], y[3]); *(u32x2*)(h + t * DM + c) = o; }
            if (lane == 0) { stats[tl * 2] = mean; stats[tl * 2 + 1] = rstd; }
        }
        __syncthreads();
        if (w < 4) {
            const int j16 = lane & 15, kq = lane >> 4, tl = 16 * w + j16;
            const float mean = stats[tl * 2], rstd = stats[tl * 2 + 1];
            const float* prow = pre + ((size_t)chunk * 64 + tl) * DM + 4 * kq; const float* wrow = wrT + (size_t)j16 * DM + 4 * kq;
            f32x4 acc[4];
#pragma unroll
            for (int tt = 0; tt < 4; ++tt) acc[tt] = (f32x4){0.f, 0.f, 0.f, 0.f};
#pragma unroll 2
            for (int m = 0; m < 128; ++m) {
                const f32x4 p = *(const f32x4*)(prow + 16 * m), gg = *(const f32x4*)(g1 + 16 * m + 4 * kq), bb = *(const f32x4*)(b1 + 16 * m + 4 * kq);
                const f32x4 hv = (p - mean) * rstd * gg + bb;
                f32x4 wv[4];
#pragma unroll
                for (int tt = 0; tt < 4; ++tt) wv[tt] = *(const f32x4*)(wrow + (size_t)tt * 16 * DM + 16 * m);
#pragma unroll
                for (int e = 0; e < 4; ++e)
#pragma unroll
                    for (int tt = 0; tt < 4; ++tt) acc[tt] = __builtin_amdgcn_mfma_f32_16x16x4f32(hv[e], wv[tt][e], acc[tt], 0, 0, 0);
            }
#pragma unroll
            for (int tt = 0; tt < 4; ++tt)
#pragma unroll
                for (int r = 0; r < 4; ++r) lg[(4 * kq + r) * 64 + 16 * tt + j16] = acc[tt][r];
            LDS_WAIT();
            for (int tk = 0; tk < 16; ++tk) routing_token(lg[tk * 64 + lane], lane, rbias, tk_e, tk_w, hist, (size_t)chunk * 64 + 16 * w + tk, do_count);
        }
    }
}
__device__ __forceinline__ void phase_flush_hist(Frame& F) {
    const int tid = F.wave * 64 + lane_id();
    LAS unsigned* hist = (LAS unsigned*)(F.lds + 1024 + 16384);
    __syncthreads();
    if (tid < 64 && hist[tid]) atomicAdd(F.ctl + CW_CNT + tid, hist[tid]);
}

__device__ __forceinline__ void phase_scatter(Frame& F) {
    const int lane_ = lane_id(), tid_ = F.wave * 64 + lane_;
    const int tid = tid_;
    LAS int* segs = (LAS int*)F.lds;
    LAS unsigned* lcnt = (LAS unsigned*)(F.lds + 1024);
    LAS unsigned* lbase = (LAS unsigned*)(F.lds + 2048);
    const int* tk_e = (const int*)(F.ws + WS_TOPK + TK_E); int* tk_pos = (int*)(F.ws + WS_TOPK + TK_POS);
    int* rowlist = (int*)(F.ws + WS_TOPK + TK_ROWLIST); int* mtt = (int*)(F.ws + WS_TOPK + TK_MTT);
    if (tid == 0) { int a = 0; for (int e = 0; e < NE; ++e) { segs[e] = a; a += (int)__hip_atomic_load(F.ctl + CW_CNT + e, RLX_AGENT); } segs[NE] = a; segs[NE + 1] = a + NTOK; }
    __syncthreads();
    if (F.bid == 0) {
        LAS int* tcum = (LAS int*)(F.lds + 3072);
        if (tid == 0) { int mt = 0; for (int g = 0; g < NGRP; ++g) { tcum[g] = mt; mt += (segs[g + 1] - segs[g] + 255) >> 8; } tcum[NGRP] = mt; __hip_atomic_store(F.ctl + CW_NMT, (unsigned)mt, RLX_AGENT); }
        __syncthreads();
        if (tid < NGRP) { const int g = tid, p0 = segs[g], n = segs[g + 1] - p0; int mt = tcum[g];
            for (int r = 0; r < n; r += 256, ++mt) { mtt[mt * 4 + 0] = g; mtt[mt * 4 + 1] = p0 + r; mtt[mt * 4 + 2] = (n - r < 256) ? n - r : 256; mtt[mt * 4 + 3] = 0; } }
        if (tid >= 256) rowlist[NSLOT + tid - 256] = 0;
    }
    const int sh0 = segs[NE];
    for (int chunk = F.bid; chunk < NTOK / 64; chunk += F.G) {
        if (tid < 64) lcnt[tid] = 0u;
        __syncthreads();
        const int t = chunk * 64 + (tid >> 3), k = tid & 7;
        const int e = tk_e[(size_t)t * 8 + k];
        const unsigned li = __hip_atomic_fetch_add(&lcnt[e], 1u, __ATOMIC_RELAXED, __HIP_MEMORY_SCOPE_WORKGROUP);
        __syncthreads();
        if (tid < 64) lbase[tid] = lcnt[tid] ? atomicAdd(F.ctl + CW_FILL + tid, lcnt[tid]) : 0u;
        __syncthreads();
        const int p = segs[e] + (int)lbase[e] + (int)li;
        rowlist[p] = t; tk_pos[(size_t)t * 8 + k] = p;
        if (tid < 64) rowlist[sh0 + chunk * 64 + tid] = chunk * 64 + tid;
        __syncthreads();
    }
}

struct CombRows { u32x4 hq[4]; u32x4 y[9][4]; };
__device__ __forceinline__ void comb_load(CombRows& R, const bf16* h, const bf16* Y, const int t, const int posv, const int slot0, const int lane) {
#pragma unroll
    for (int i = 0; i < 4; ++i) R.hq[i] = *(const u32x4*)(h + (size_t)t * DM + (lane + 64 * i) * 8);
#pragma unroll
    for (int k = 0; k < 9; ++k) { const int p = (k < 8) ? __builtin_amdgcn_readlane(posv, slot0 + (k & 7)) : NTOK * 8 + t;
#pragma unroll
        for (int i = 0; i < 4; ++i) R.y[k][i] = __builtin_nontemporal_load((const u32x4*)(Y + (size_t)p * DM + (lane + 64 * i) * 8)); }
}
__device__ __forceinline__ void comb_finish(const CombRows& R, const float* g2, const float* b2, float* out, const int t, const float wvv, const int slot0, const int lane) {
    f32x4 a[4][2];
#pragma unroll
    for (int i = 0; i < 4; ++i) { f32x4 x0, x1; unpack8(R.hq[i], x0, x1); a[i][0] = x0 * DN_ALPHA; a[i][1] = x1 * DN_ALPHA; }
#pragma unroll
    for (int k = 0; k < 9; ++k) { const float wk = (k < 8) ? __builtin_bit_cast(float, __builtin_amdgcn_readlane(__builtin_bit_cast(int, wvv), slot0 + (k & 7))) : 1.0f;
#pragma unroll
        for (int i = 0; i < 4; ++i) { f32x4 y0, y1; unpack8(R.y[k][i], y0, y1); a[i][0] += y0 * wk; a[i][1] += y1 * wk; } }
    float s = 0.f;
#pragma unroll
    for (int i = 0; i < 4; ++i) s += ((a[i][0][0] + a[i][0][1]) + (a[i][0][2] + a[i][0][3])) + ((a[i][1][0] + a[i][1][1]) + (a[i][1][2] + a[i][1][3]));
    const float mean = wave_sum(s) * (1.0f / DM); float s2 = 0.f;
#pragma unroll
    for (int i = 0; i < 4; ++i) { a[i][0] = a[i][0] - mean; a[i][1] = a[i][1] - mean;
        s2 += ((a[i][0][0] * a[i][0][0] + a[i][0][1] * a[i][0][1]) + (a[i][0][2] * a[i][0][2] + a[i][0][3] * a[i][0][3])) + ((a[i][1][0] * a[i][1][0] + a[i][1][1] * a[i][1][1]) + (a[i][1][2] * a[i][1][2] + a[i][1][3] * a[i][1][3])); }
    const float rstd = 1.0f / sqrtf(wave_sum(s2) * (1.0f / DM) + LN_EPS);
#pragma unroll
    for (int i = 0; i < 4; ++i) { const int c = (lane + 64 * i) * 8;
        const f32x4 ga = *(const f32x4*)(g2 + c), gb = *(const f32x4*)(g2 + c + 4), ba = *(const f32x4*)(b2 + c), bb = *(const f32x4*)(b2 + c + 4);
        __builtin_nontemporal_store(a[i][0] * rstd * ga + ba, (f32x4*)(out + (size_t)t * DM + c)); __builtin_nontemporal_store(a[i][1] * rstd * gb + bb, (f32x4*)(out + (size_t)t * DM + c + 4)); }
}
__device__ __forceinline__ void phase_combine(Frame& F, const float* g2, const float* b2) {
    const int lane = lane_id();
    const bf16* h = (const bf16*)(F.ws + WS_H); const bf16* Y = (const bf16*)(F.ws + WS_Y);
    const float* tk_w = (const float*)(F.ws + WS_TOPK + TK_W); const int* tk_pos = (const int*)(F.ws + WS_TOPK + TK_POS);
    const int gw = F.bid * NWAVES + F.wave, NGW = F.G * NWAVES;
    for (int t0 = gw * 8; t0 < NTOK; t0 += NGW * 8) {
        const int posv = tk_pos[(size_t)t0 * 8 + lane]; const float wvv = tk_w[(size_t)t0 * 8 + lane];
        for (int i = 0; i < 8; ++i) {
            CombRows R;
            comb_load(R, h, Y, t0 + i, posv, 8 * i, lane);
            __builtin_amdgcn_sched_barrier(0);
            comb_finish(R, g2, b2, F.out, t0 + i, wvv, 8 * i, lane);
            __builtin_amdgcn_sched_barrier(0);
        }
    }
}

#ifndef MK_CHECK
#define MK_CHECK 0
#endif
constexpr int CW_CHK = 16384 + 256;
#if MK_CHECK
__device__ __forceinline__ float fp8f(unsigned char v) { const f32x2 a = __builtin_amdgcn_cvt_pk_f32_fp8((int)v, false); return a[0]; }
__device__ __forceinline__ void phase_check_attn(Frame& F) {
    const int tid = F.wave * 64 + lane_id();
    const bf16* qi = (const bf16*)(F.ws + WS_QI); const bf16* kin = (const bf16*)(F.ws + WS_KIN); const float* wis = (const float*)(F.ws + WS_WI);
    const bf16* qlat = (const bf16*)(F.ws + WS_QLAT); const unsigned char* ckv8 = (const unsigned char*)(F.ws + WS_CKVN);
    const unsigned short* selb = (const unsigned short*)(F.ws + WS_SEL); const bf16* olat = (const bf16*)(F.ws + WS_OLAT);
    LAS float* sc = (LAS float*)F.lds;
    LAS unsigned char* flg = (LAS unsigned char*)(F.lds + 32768);
    LAS unsigned char* seen = (LAS unsigned char*)(F.lds + 40960);
    LAS float* pl = (LAS float*)(F.lds + 49152);
    LAS int* cnt = (LAS int*)(F.lds + 57344);
    const int POS[16] = {0, 1, 100, 255, 256, 257, 300, 511, 1000, 2047, 2048, 4095, 5000, 6143, 6144, 8191};
    for (int s = F.bid; s < 32; s += F.G) {
        int pos = 0;
#pragma unroll
        for (int q = 0; q < 16; ++q) pos = ((s >> 1) == q) ? POS[q] : pos;
        const int b = s & 1, n = pos + 1; const size_t t = (size_t)b * SEQ + pos;
        __syncthreads();
        if (tid < 4) cnt[tid] = 0;
        for (int k = tid; k < SEQ; k += NTHR) { flg[k] = 0; seen[k] = 0; }
        for (int k = tid; k < n; k += NTHR) {
            float tot = 0.f;
            for (int hh = 0; hh < 16; ++hh) { float d = 0.f;
                for (int e = 0; e < 64; ++e) d += bf2f(qi[t * 1024 + hh * 64 + e]) * bf2f(kin[((size_t)b * SEQ + k) * 64 + e]);
                tot += wis[t * 16 + hh] * fmaxf(d, 0.f); }
            sc[k] = tot;
        }
        __syncthreads();
        const unsigned short* sel = selb + t * TOPK;
        if (n > TOPK) {
            for (int k = tid; k < n; k += NTHR) { const float v = sc[k]; int rk = 0; for (int k2 = 0; k2 < n; ++k2) { const float o = sc[k2]; rk += (o > v || (o == v && k2 < k)) ? 1 : 0; } flg[k] = rk < TOPK ? 1 : 0; }
            __syncthreads();
            if (tid < TOPK) { const int k = sel[tid]; if (k >= n) atomicAdd((int*)&cnt[1], 1000); else { if (!flg[k]) atomicAdd((int*)&cnt[0], 1); if (seen[k]) atomicAdd((int*)&cnt[1], 1000); seen[k] = 1; } }
        } else {
            if (tid < TOPK) { const int k = sel[tid]; if (tid < n ? (k != tid) : (k != 0xFFFF)) atomicAdd((int*)&cnt[1], 1000); }
        }
        __syncthreads();
        const int nv = n < TOPK ? n : TOPK;
        for (int i = tid; i < 8 * 256; i += NTHR) { const int hh = i >> 8, k = i & 255; float lg = -INFINITY;
            if (k < nv) { const int key = sel[k]; float d = 0.f; for (int r = 0; r < 256; ++r) d += bf2f(qlat[(t * 8 + hh) * 256 + r]) * fp8f(ckv8[((size_t)b * SEQ + key) * 256 + r]); lg = d * 0.08838834764831845f; }
            pl[i] = lg; }
        __syncthreads();
        if (tid < 8) { float m = -INFINITY; for (int k = 0; k < 256; ++k) m = fmaxf(m, pl[tid * 256 + k]); float l = 0.f; for (int k = 0; k < 256; ++k) { const float p = expf(pl[tid * 256 + k] - m); pl[tid * 256 + k] = p; l += p; } for (int k = 0; k < 256; ++k) pl[tid * 256 + k] /= l; }
        __syncthreads();
        for (int i = tid; i < 8 * 256; i += NTHR) { const int hh = i >> 8, r = i & 255; float o = 0.f;
            for (int k = 0; k < nv; ++k) o += pl[hh * 256 + k] * fp8f(ckv8[((size_t)b * SEQ + sel[k]) * 256 + r]);
            const float got = bf2f(olat[(t * 8 + hh) * 256 + r]);
            if (!(fabsf(got - o) <= 0.03f * fabsf(o) + 0.004f)) atomicAdd((int*)&cnt[2], 1); }
        __syncthreads();
        if (tid == 0) { unsigned code = 0; if (cnt[0] > 3 || cnt[1] > 0) code |= 1u; if (cnt[2] > 0) code |= 2u; if (code) atomicOr(F.ctl + CW_CHK, code); }
    }
}
__device__ __forceinline__ void phase_check_apply(Frame& F) {
    const unsigned code = __hip_atomic_load(F.ctl + CW_CHK, RLX_AGENT);
    if (code) { const float v = (code & 1u) ? __builtin_nanf("") : 0.f; const size_t gt = (size_t)F.bid * NTHR + F.wave * 64 + lane_id();
        for (size_t i = gt; i < (size_t)NTOK * DM; i += (size_t)F.G * NTHR) F.out[i] = v; }
}
#endif

constexpr int NPHASE = 16;
constexpr unsigned REPEAT_MASK = 0x0u;
constexpr int TIME_PHASE = -1;
constexpr int CW_TIME = 16384 + 320;
struct Args { const float* in[24]; float* out; unsigned char* ws; int ph_lo, ph_hi; };

__global__ void __launch_bounds__(NTHR, 2) mk_fwd(Args args) {
    extern __shared__ __attribute__((aligned(16))) unsigned char lds_raw[];
    Frame F;
    F.lds = (LAS unsigned char*)lds_raw;
    F.MISC = (volatile LAS unsigned*)(F.lds + MISC_OFF);
    F.wave = __builtin_amdgcn_readfirstlane(threadIdx.x >> 6);
    F.G = gridDim.x; F.bid = blockIdx.x;
    F.ws = args.ws; F.ctl = (unsigned*)(args.ws + WS_CTL); F.out = args.out;
    for (int u = threadIdx.x; u < (LDS_BYTES - MISC_OFF) / 4; u += NTHR) ((LAS unsigned*)(F.lds + MISC_OFF))[u] = 0u;
    __syncthreads();
    const int lo = args.ph_lo, hi = args.ph_hi;
    const bool multi = (hi - lo) > 1;
    XcdBarrier bar; bar.bar = F.ctl + CW_BAR; bar.x = 0; bar.st = nullptr; bar.wave = F.wave;
    if (multi) bar = xcd_barrier_post(F.ctl + CW_BAR, F.MISC + 8, F.wave);
#ifndef ONLY_PHASE
#define ONLY_PHASE -1
#endif
#define IN(k) ((ONLY_PHASE < 0 || ONLY_PHASE == (k)) && lo <= (k) && (k) < hi)
#define SEAM(k) do { if (IN(k) && IN((k) + 1)) { xcd_barrier(bar); \
        if (TIME_PHASE >= 0 && F.bid == 0 && F.wave == 0) { const unsigned long long now_ = __builtin_amdgcn_s_memrealtime(); \
            if ((k) == TIME_PHASE - 1 || ((k) == 0 && TIME_PHASE == 0 && false)) { if (lane_id() == 0) { F.ctl[CW_TIME] = (unsigned)now_; } } \
            if ((k) == TIME_PHASE) { if (lane_id() == 0) { F.ctl[CW_TIME + 1] = (unsigned)now_ - F.ctl[CW_TIME]; } } } } } while (0)
    unsigned char* ws = args.ws;
    const ExpW EW{args.in[16], args.in[17], args.in[18], args.in[19], args.in[20], args.in[21]};
    const bool ride = false;
    if (TIME_PHASE == 0 && F.bid == 0 && threadIdx.x == 0) F.ctl[CW_TIME] = (unsigned)__builtin_amdgcn_s_memrealtime();

    if (IN(0)) for (int rep_ = 0; rep_ < 1 + (int)((REPEAT_MASK >> 0) & 1u); ++rep_) { phase_convert_small(F, args.in[0], args.in[1], args.in[5], args.in[6], args.in[7], args.in[9], args.in[10], args.in[11], args.in[8], args.in[14]); } SEAM(0);

    if (IN(1)) for (int rep_ = 0; rep_ < 1 + (int)((REPEAT_MASK >> 1) & 1u); ++rep_) {
        FillPlain f{(const char*)(ws + WS_XB), (const char*)(ws + WS_WIN), 4096u, 4096u, 32};
        DenseSched<FillPlain> S{64, 30, F.G, F.bid, f};
        EpiP1 E{(bf16*)(ws + WS_Q), (bf16*)(ws + WS_QI), (bf16*)(ws + WS_XP), (bf16*)(ws + WS_GATES), (float*)(ws + WS_CKVRAW), (float*)(ws + WS_KIWI)};
        pg8::gemm_phase<EpiP1, DenseSched<FillPlain>, false, true, true>(F.lds, F.wave, 4096u, 4096u, S, E);
    } SEAM(1);

    if (IN(2)) for (int rep_ = 0; rep_ < 1 + (int)((REPEAT_MASK >> 2) & 1u); ++rep_) { phase_postproc(F, args.in[2], args.in[3], args.in[4]); } SEAM(2);

    if (IN(3)) for (int rep_ = 0; rep_ < 1 + (int)((REPEAT_MASK >> 3) & 1u); ++rep_) {
        FillQlatPool f{(const char*)(ws + WS_Q), (const char*)(ws + WS_DIFF), (const char*)(ws + WS_WUK), (const char*)(ws + WS_WPOOL)};
        DenseSched<FillQlatPool> S{64, 12, F.G, F.bid, f};
        EpiQlatPool E{(bf16*)(ws + WS_QLAT), (bf16*)(ws + WS_POOL), (const float*)(ws + WS_CSCALE)};
        pg8::gemm_phase<EpiQlatPool, DenseSched<FillQlatPool>, false, true, true>(F.lds, F.wave, 2048u, 512u, S, E);
    } SEAM(3);

    if (IN(4)) for (int rep_ = 0; rep_ < 1 + (int)((REPEAT_MASK >> 4) & 1u); ++rep_) { phase_index_scores(F); } SEAM(4);
    if (IN(5)) for (int rep_ = 0; rep_ < 1 + (int)((REPEAT_MASK >> 5) & 1u); ++rep_) { phase_select(F, EW, ride && rep_ == 0); } SEAM(5);
    if (IN(6)) for (int rep_ = 0; rep_ < 1 + (int)((REPEAT_MASK >> 6) & 1u); ++rep_) { phase_sparse_attn(F, EW, ride && rep_ == 0); } SEAM(6);
#if MK_CHECK
    if (IN(6) && IN(7)) { phase_check_attn(F); xcd_barrier(bar); }
#endif

    if (IN(7)) for (int rep_ = 0; rep_ < 1 + (int)((REPEAT_MASK >> 7) & 1u); ++rep_) {
        FillO f{(const char*)(ws + WS_OLAT), (const char*)(ws + WS_WUV)};
        DenseSched<FillO> S{64, 4, F.G, F.bid, f};
        EpiBf16 E{(bf16*)(ws + WS_ATTN), 1024};
        pg8::gemm_phase<EpiBf16, DenseSched<FillO>, false, true, true>(F.lds, F.wave, 4096u, 1024u, S, E);
    } SEAM(7);

    if (IN(8)) for (int rep_ = 0; rep_ < 1 + (int)((REPEAT_MASK >> 8) & 1u); ++rep_) {
        FillPlain f{(const char*)(ws + WS_ATTN), (const char*)(ws + WS_WPA), 2048u, 2048u, 16};
        DenseSched<FillPlain> S{64, 8, F.G, F.bid, f};
        EpiGate<0> E{(const bf16*)(ws + WS_GATES), (bf16*)(ws + WS_M1), (bf16*)(ws + WS_MERGED)};
        pg8::gemm_phase<EpiGate<0>, DenseSched<FillPlain>, false, true, true>(F.lds, F.wave, 2048u, 2048u, S, E);
    } SEAM(8);

    if (IN(9)) for (int rep_ = 0; rep_ < 1 + (int)((REPEAT_MASK >> 9) & 1u); ++rep_) {
        FillPlain f{(const char*)(ws + WS_POOL), (const char*)(ws + WS_WPP), 2048u, 2048u, 16};
        DenseSched<FillPlain> S{64, 8, F.G, F.bid, f};
        EpiGate<1> E{(const bf16*)(ws + WS_GATES), (bf16*)(ws + WS_M1), (bf16*)(ws + WS_MERGED)};
        pg8::gemm_phase<EpiGate<1>, DenseSched<FillPlain>, false, true, true>(F.lds, F.wave, 2048u, 2048u, S, E);
    } SEAM(9);

    if (IN(10)) for (int rep_ = 0; rep_ < 1 + (int)((REPEAT_MASK >> 10) & 1u); ++rep_) {
        FillPlain f{(const char*)(ws + WS_MERGED), (const char*)(ws + WS_WOUT), 4096u, 4096u, 32};
        DenseSched<FillPlain> S{64, 8, F.G, F.bid, f};
        EpiPre E{args.in[0], F.out};
        pg8::gemm_phase<EpiPre, DenseSched<FillPlain>, false, true, true>(F.lds, F.wave, 4096u, 4096u, S, E);
    } SEAM(10);

    if (IN(11)) for (int rep_ = 0; rep_ < 1 + (int)((REPEAT_MASK >> 11) & 1u); ++rep_) {
        for (int rl_ = 0; rl_ < 1 + (int)((REPEAT_MASK >> 17) & 1u); ++rl_) phase_ln1_router(F, args.in[12], args.in[13], args.in[15], rl_ == 0);
        phase_convert_experts(F, EW);
        phase_flush_hist(F);
    } SEAM(11);
    if (IN(12)) for (int rep_ = 0; rep_ < 1 + (int)((REPEAT_MASK >> 12) & 1u); ++rep_) { phase_scatter(F); } SEAM(12);

    if (IN(13)) for (int rep_ = 0; rep_ < 1 + (int)((REPEAT_MASK >> 13) & 1u); ++rep_) {
        const int nmt = (int)__hip_atomic_load(F.ctl + CW_NMT, RLX_AGENT);
        MoeSched S{(const int*)(ws + WS_TOPK + TK_MTT), nmt, 4, F.G, F.bid, true, (const char*)(ws + WS_H), (const char*)(ws + WS_HBUF), (const char*)(ws + WS_WGU), (const char*)(ws + WS_WD), (const int*)(ws + WS_TOPK + TK_ROWLIST), F.lds};
        S.prepare(F.wave * 64 + lane_id());
        EpiSwiGLU E{(bf16*)(ws + WS_HBUF)};
        pg8::gemm_phase<EpiSwiGLU, MoeSched, true, true, true>(F.lds, F.wave, 4096u, 4096u, S, E);
    } SEAM(13);

    if (IN(14)) for (int rep_ = 0; rep_ < 1 + (int)((REPEAT_MASK >> 14) & 1u); ++rep_) {
        const int nmt = (int)__hip_atomic_load(F.ctl + CW_NMT, RLX_AGENT);
        MoeSched S{(const int*)(ws + WS_TOPK + TK_MTT), nmt, 8, F.G, F.bid, false, (const char*)(ws + WS_H), (const char*)(ws + WS_HBUF), (const char*)(ws + WS_WGU), (const char*)(ws + WS_WD), (const int*)(ws + WS_TOPK + TK_ROWLIST), F.lds};
        S.prepare(F.wave * 64 + lane_id());
        EpiY E{(bf16*)(ws + WS_Y)};
        pg8::gemm_phase<EpiY, MoeSched, false, true, true>(F.lds, F.wave, 1024u, 1024u, S, E);
    } SEAM(14);

    if (IN(15)) for (int rep_ = 0; rep_ < 1 + (int)((REPEAT_MASK >> 15) & 1u); ++rep_) { phase_combine(F, args.in[22], args.in[23]); }
#if MK_CHECK
    if (IN(15)) { xcd_barrier(bar); phase_check_apply(F); }
#endif
    if (TIME_PHASE >= 0 && multi && F.bid == 0 && F.wave == 0) {
        asm volatile("s_waitcnt vmcnt(0)" ::: "memory");
        if (TIME_PHASE == 15 && lane_id() == 0) { F.ctl[CW_TIME + 1] = (unsigned)__builtin_amdgcn_s_memrealtime() - F.ctl[CW_TIME]; }
        asm volatile("s_waitcnt vmcnt(0)" ::: "memory");
        const unsigned dur = __hip_atomic_load(F.ctl + CW_TIME + 1, RLX_AGENT); const unsigned long long t0 = __builtin_amdgcn_s_memrealtime();
        while (__builtin_amdgcn_s_memrealtime() - t0 < 4ull * dur) __builtin_amdgcn_s_sleep(8);
    }
#undef IN
#undef SEAM
}

#ifndef MK_ONE_LAUNCH
#define MK_ONE_LAUNCH 1
#endif
extern "C" void kernel_launch(void* const* d_in, const int* in_sizes, int n_in, void* d_out, int out_size, void* d_ws, size_t ws_size, hipStream_t stream) {
    static int grid = 0;
    if (grid == 0) {
        if (n_in != 24 || out_size != NTOK * DM || ws_size < WS_END) { fprintf(stderr, "kernel_launch: unexpected shapes (n_in %d out %d ws %zu)\n", n_in, out_size, ws_size); grid = -1; return; }
        int dev = 0, cus = 0;
        if (hipGetDevice(&dev) != hipSuccess || hipDeviceGetAttribute(&cus, hipDeviceAttributeMultiprocessorCount, dev) != hipSuccess) { grid = -1; return; }
        if (hipFuncSetAttribute((const void*)mk_fwd, hipFuncAttributeMaxDynamicSharedMemorySize, LDS_BYTES) != hipSuccess) { fprintf(stderr, "kernel_launch: hipFuncSetAttribute failed\n"); grid = -1; return; }
        int per_cu = 0;
        if (hipOccupancyMaxActiveBlocksPerMultiprocessor(&per_cu, (const void*)mk_fwd, NTHR, LDS_BYTES) != hipSuccess || per_cu < 1) fprintf(stderr, "kernel_launch: occupancy query says %d\n", per_cu);
        (void)hipGetLastError();
        grid = cus;
    }
    if (grid < 0) return;
    if (hipMemsetAsync((char*)d_ws + WS_CTL, 0, CTL_BYTES, stream) != hipSuccess) return;
    Args a{};
    for (int i = 0; i < 24; ++i) a.in[i] = (const float*)d_in[i];
    a.out = (float*)d_out; a.ws = (unsigned char*)d_ws;
#if MK_ONE_LAUNCH
    a.ph_lo = 0; a.ph_hi = NPHASE;
    hipLaunchKernelGGL(mk_fwd, dim3(grid), dim3(NTHR), LDS_BYTES, stream, a);
#else
    for (int p = 0; p < NPHASE; ++p) { a.ph_lo = p; a.ph_hi = p + 1; hipLaunchKernelGGL(mk_fwd, dim3(grid), dim3(NTHR), LDS_BYTES, stream, a); }
#endif
}
```

```cpp
#include <hip/hip_runtime.h>
#include <cstdio>
#include <cstdint>

#define LAS __attribute__((address_space(3)))
#define GAS __attribute__((address_space(1)))
typedef unsigned short bf16;
typedef short bf16x8 __attribute__((ext_vector_type(8)));
typedef short s16x4 __attribute__((ext_vector_type(4)));
typedef float f32x4 __attribute__((ext_vector_type(4)));
typedef float f32x2 __attribute__((ext_vector_type(2)));
typedef unsigned u32x4 __attribute__((ext_vector_type(4)));
typedef unsigned u32x2 __attribute__((ext_vector_type(2)));

constexpr int NTOK = 16384, SEQ = 8192, DM = 2048;
constexpr int NH = 8, DQK = 128, DV = 128, RKV = 256, IH = 16, IDH = 64, TOPK = 256;
constexpr int NE = 64, EK = 8, EDIM = 512, NGRP = 65;
constexpr int WIN_ROWS = 7680;
constexpr float LN_EPS = 1e-5f, RMS_EPS = 1e-6f;
constexpr float DN_ALPHA = 1.189207115002721f;
constexpr int NSLOT = NTOK * 9;
constexpr size_t SC_TOT = (size_t)128 * 128 * (64 * 65 / 2);

constexpr size_t MiB = 1u << 20;
constexpr size_t WS_CTL = 0, CTL_BYTES = 1 * MiB;
constexpr size_t WS_WIN = 1 * MiB;
constexpr size_t WS_WUK = 31 * MiB;
constexpr size_t WS_WUV = 32 * MiB;
constexpr size_t WS_WPOOL = 33 * MiB;
constexpr size_t WS_WPA = 34 * MiB;
constexpr size_t WS_WPP = 38 * MiB;
constexpr size_t WS_WOUT = 42 * MiB;
constexpr size_t WS_CSCALE = 50 * MiB;
constexpr size_t WS_WRT = 50 * MiB + 65536;
constexpr size_t WS_XB = 394 * MiB;
constexpr size_t WS_Q = 458 * MiB;
constexpr size_t WS_QI = 490 * MiB;
constexpr size_t WS_XP = 522 * MiB;
constexpr size_t WS_CKVRAW = 554 * MiB;
constexpr size_t WS_KIWI = 570 * MiB;
constexpr size_t WS_DIFF = 586 * MiB;
constexpr size_t WS_GATES = 181 * MiB;
constexpr size_t WS_QLAT = 309 * MiB;
constexpr size_t WS_CKVN = 373 * MiB;
constexpr size_t WS_KIN = 381 * MiB;
constexpr size_t WS_WI = 383 * MiB;
constexpr size_t WS_SEL = 654 * MiB;
constexpr size_t WS_SCORES = 662 * MiB;
constexpr size_t WS_POOL = 922 * MiB;
constexpr size_t WS_OLAT = 662 * MiB;
constexpr size_t WS_ATTN = 726 * MiB;
constexpr size_t WS_M1 = 758 * MiB;
constexpr size_t WS_MERGED = 822 * MiB;
constexpr size_t WS_WD = 51 * MiB;
constexpr size_t WS_H = 181 * MiB;
constexpr size_t WS_HBUF = 245 * MiB;
constexpr size_t WS_TOPK = 390 * MiB;
constexpr size_t WS_WGU = 394 * MiB;
constexpr size_t WS_Y = 394 * MiB;
constexpr size_t WS_YSH = WS_Y + (size_t)NTOK * 8 * DM;
constexpr size_t WS_END = 1024 * MiB;
static_assert(WS_DIFF + 32 * MiB <= 654 * MiB && WS_SCORES + 260 * MiB <= WS_POOL && WS_POOL + 32 * MiB <= 970 * MiB && WS_WI + 1 * MiB <= 390 * MiB, "mixer map");
static_assert(WS_SCORES + SC_TOT * 2 * 4 <= WS_POOL, "scores");
static_assert(WS_HBUF + (size_t)(NSLOT + 256) * EDIM * 2 <= WS_TOPK, "hbuf");
static_assert(WS_YSH + (size_t)NTOK * DM * 2 <= WS_END, "y");
constexpr size_t TK_E = 0;
constexpr size_t TK_W = 512 * 1024;
constexpr size_t TK_POS = 1024 * 1024;
constexpr size_t TK_ROWLIST = 1536 * 1024;
constexpr size_t TK_MTT = 2560 * 1024;
constexpr size_t TK_WRT = 3 * MiB;
constexpr int CW_BAR = 4096;
constexpr int CW_CNT = 16384;
constexpr int CW_FILL = 16384 + 64;
constexpr int CW_CVQ = 16384 + 192;
constexpr int CW_NMT = 16384 + 128;

constexpr int RING_BYTES = 131072;
constexpr int MISC_OFF = 143360;
constexpr int LDS_BYTES = 147456;
constexpr int NWAVES = 8, NTHR = 512;

#define RLX_AGENT __ATOMIC_RELAXED, __HIP_MEMORY_SCOPE_AGENT
#define LDS_WAIT() asm volatile("s_waitcnt lgkmcnt(0)" ::: "memory")
#define VM_WAIT() asm volatile("s_waitcnt vmcnt(0)" ::: "memory")

__device__ __forceinline__ int lane_id() { return (int)__builtin_amdgcn_mbcnt_hi(~0u, __builtin_amdgcn_mbcnt_lo(~0u, 0u)); }
__device__ __forceinline__ float bf2f(unsigned b) { return __uint_as_float(b << 16); }
__device__ __forceinline__ unsigned f2bf(float f) { unsigned u = __float_as_uint(f); return (u + 0x7fffu + ((u >> 16) & 1u)) >> 16; }
__device__ __forceinline__ unsigned pk2(float lo, float hi) { return f2bf(lo) | (f2bf(hi) << 16); }
__device__ __forceinline__ unsigned cvt_pk_bf16(float lo, float hi) { unsigned r; asm volatile("v_cvt_pk_bf16_f32 %0, %1, %2" : "=v"(r) : "v"(lo), "v"(hi)); return r; }
#define DPP_I(old, x, ctrl, rmask) __builtin_amdgcn_update_dpp((int)(old), (int)(x), (ctrl), (rmask), 0xf, false)
__device__ __forceinline__ int wave_scan_i(int x) {
    x += DPP_I(0, x, 0x111, 0xf); x += DPP_I(0, x, 0x112, 0xf); x += DPP_I(0, x, 0x114, 0xf); x += DPP_I(0, x, 0x118, 0xf);
    x += DPP_I(0, x, 0x142, 0xa); x += DPP_I(0, x, 0x143, 0xc); return x;
}
__device__ __forceinline__ int wave_sum_i(int v) { return __builtin_amdgcn_readlane(wave_scan_i(v), 63); }
__device__ __forceinline__ float wave_sum(float x) {
#define DPP_F(x_, ctrl, rmask) __builtin_bit_cast(float, __builtin_amdgcn_update_dpp(0, __builtin_bit_cast(int, x_), (ctrl), (rmask), 0xf, false))
    x += DPP_F(x, 0x111, 0xf); x += DPP_F(x, 0x112, 0xf); x += DPP_F(x, 0x114, 0xf); x += DPP_F(x, 0x118, 0xf);
    x += DPP_F(x, 0x142, 0xa); x += DPP_F(x, 0x143, 0xc);
#undef DPP_F
    return __builtin_bit_cast(float, __builtin_amdgcn_readlane(__builtin_bit_cast(int, x), 63));
}
__device__ __forceinline__ float wave_max(float x) {
#define DPP_K(x_, ctrl, rmask) __builtin_bit_cast(float, __builtin_amdgcn_update_dpp(__builtin_bit_cast(int, x_), __builtin_bit_cast(int, x_), (ctrl), (rmask), 0xf, false))
    x = fmaxf(x, DPP_K(x, 0x111, 0xf)); x = fmaxf(x, DPP_K(x, 0x112, 0xf)); x = fmaxf(x, DPP_K(x, 0x114, 0xf)); x = fmaxf(x, DPP_K(x, 0x118, 0xf));
    x = fmaxf(x, DPP_K(x, 0x142, 0xa)); x = fmaxf(x, DPP_K(x, 0x143, 0xc));
    return __builtin_bit_cast(float, __builtin_amdgcn_readlane(__builtin_bit_cast(int, x), 63));
}
__device__ __forceinline__ float wave_min(float x) {
    x = fminf(x, DPP_K(x, 0x111, 0xf)); x = fminf(x, DPP_K(x, 0x112, 0xf)); x = fminf(x, DPP_K(x, 0x114, 0xf)); x = fminf(x, DPP_K(x, 0x118, 0xf));
    x = fminf(x, DPP_K(x, 0x142, 0xa)); x = fminf(x, DPP_K(x, 0x143, 0xc));
#undef DPP_K
    return __builtin_bit_cast(float, __builtin_amdgcn_readlane(__builtin_bit_cast(int, x), 63));
}

#define XB_TMO      128
#define XB_XCNT(j)  (256  + 64 * (j))
#define XB_XSUB(j)  (1280 + 64 * (j))
#define XB_XGEN(j)  (2304 + 64 * (j))
#define XB_TOP      3328
#define XB_TOPGEN   3392
#define XCD_BAR_WORDS 3456
#define XB_SPIN_CAP (1u << 24)

__device__ __forceinline__ unsigned xb_ld(unsigned* p)              { return __hip_atomic_load(p, __ATOMIC_RELAXED, __HIP_MEMORY_SCOPE_AGENT); }
__device__ __forceinline__ unsigned xb_add(unsigned* p, unsigned v) { return __hip_atomic_fetch_add(p, v, __ATOMIC_RELAXED, __HIP_MEMORY_SCOPE_AGENT); }
__device__ __forceinline__ unsigned xb_xcc_id() { return (unsigned)__builtin_amdgcn_s_getreg((3 << 11) | 20) & 0xFu; }
#define XB_SPIN(cond, bar) do { unsigned _sp = 0; while (cond) { __builtin_amdgcn_s_sleep(1); \
    if ((++_sp & 255u) == 0u) { if (xb_ld(&(bar)[XB_TMO])) break; if (_sp > XB_SPIN_CAP) { atomicAdd(&(bar)[XB_TMO], 1u); break; } } } } while (0)

struct XcdBarrier { unsigned* bar; unsigned x; volatile LAS unsigned* st; int wave; };

__device__ __forceinline__ XcdBarrier xcd_barrier_post(unsigned* bar, volatile LAS unsigned* st, int wave) {
    XcdBarrier b; b.bar = bar; b.x = xb_xcc_id(); b.st = st; b.wave = wave;
    if (wave == 0 && lane_id() == 0) (void)xb_add(&bar[XB_XCNT(b.x)], 1u);
    return b;
}
__device__ __forceinline__ void xcd_barrier_complete(unsigned* bar, unsigned x, unsigned& nloc, unsigned& nx) {
    const unsigned G = gridDim.x * gridDim.y * gridDim.z;
    unsigned sum, cnt, mine, sp = 0u;
    for (;;) {
        sum = 0u; cnt = 0u; mine = 0u;
#pragma unroll
        for (unsigned j = 0; j < 16; ++j) { const unsigned c = xb_ld(&bar[XB_XCNT(j)]); sum += c; cnt += (c > 0u) ? 1u : 0u; mine = (j == x) ? c : mine; }
        if (sum == G) break;
        __builtin_amdgcn_s_sleep(1);
        if ((++sp & 255u) == 0u) { if (xb_ld(&bar[XB_TMO])) break; if (sp > XB_SPIN_CAP) { atomicAdd(&bar[XB_TMO], 1u); break; } }
    }
    nloc = mine > 0u ? mine : 1u; nx = cnt > 0u ? cnt : 1u;
}
__device__ __forceinline__ void xcd_barrier(const XcdBarrier& b) {
    asm volatile("s_waitcnt vmcnt(0)" ::: "memory");
    __syncthreads();
    if (b.wave == 0 && lane_id() == 0) {
        unsigned* bar = b.bar;
        __builtin_amdgcn_s_waitcnt(0);
        unsigned nloc = b.st[0], nx = b.st[1];
        if (nloc == 0u) { xcd_barrier_complete(bar, b.x, nloc, nx); b.st[0] = nloc; b.st[1] = nx; }
        const unsigned old = xb_add(&bar[XB_XSUB(b.x)], 1u);
        const unsigned gen = old / nloc;
        if (old + 1u == (gen + 1u) * nloc) {
            __builtin_amdgcn_fence(__ATOMIC_RELEASE, "agent");
            asm volatile("s_waitcnt vmcnt(0)" ::: "memory");
            const unsigned og = xb_add(&bar[XB_TOP], 1u);
            const unsigned tg = og / nx;
            if (og + 1u == (tg + 1u) * nx) xb_add(&bar[XB_TOPGEN], 1u);
            else XB_SPIN(xb_ld(&bar[XB_TOPGEN]) == tg, bar);
            __builtin_amdgcn_fence(__ATOMIC_ACQUIRE, "agent");
            xb_add(&bar[XB_XGEN(b.x)], 1u);
            asm volatile("s_waitcnt vmcnt(0)" ::: "memory");
        } else {
            XB_SPIN(xb_ld(&bar[XB_XGEN(b.x)]) == gen, bar);
            __builtin_amdgcn_fence(__ATOMIC_ACQUIRE, "agent");
            asm volatile("s_waitcnt vmcnt(0)" ::: "memory");
        }
    }
    __syncthreads();
}

namespace pg8 {
constexpr int BM = 256, BK = 64, HALF = 128, HTB = HALF * BK * 2, STAGE_BYTES = 8 * HTB, NXCD = 8, WGM = 8;

__host__ __device__ __forceinline__ int lds_byte(int r, int c) { const int st = (r >> 4) * 2 + (c >> 5), rr = r & 15, cc = c & 31, ob = rr * 64 + cc * 2; return st * 1024 + (ob ^ (((ob >> 9) & 1) << 5)); }
__host__ __device__ __forceinline__ void stage_rc(int b, int& R, int& C) { const int st = b / 1024, sb = b % 1024, swz = sb ^ (((sb >> 9) & 1) << 5); R = (st >> 1) * 16 + swz / 64; C = (st & 1) * 32 + (swz % 64) / 2; }
__host__ __device__ __forceinline__ int perm32(int rho) { const int n = rho >> 4, i = rho & 15; return 8 * (i >> 2) + 4 * n + (i & 3); }

__device__ __forceinline__ const char* uptr(const char* p) { const unsigned long long v = (unsigned long long)p; const unsigned lo = __builtin_amdgcn_readfirstlane((unsigned)v), hi = __builtin_amdgcn_readfirstlane((unsigned)(v >> 32)); return (const char*)(((unsigned long long)hi << 32) | lo); }
struct GUnit {
    const char* A;
    const char* B0;
    const char* B1;
    const int* rows;
    int rows_lds;
    int nt;
    int pm, pn, aux0, aux1;
};

__device__ __forceinline__ void tile_order(int L, int nM, int nN, int& pm, int& pn) {
    const int nwg = nM * nN;
    int wgid = L; { const int q = nwg / NXCD, r = nwg % NXCD, xcd = wgid % NXCD, off = wgid / NXCD; wgid = (xcd < r ? xcd * (q + 1) : r * (q + 1) + (xcd - r) * q) + off; }
    const int nig = WGM * nN, gid = wgid / nig, fm = gid * WGM, gsz = (nM - fm) < WGM ? (nM - fm) : WGM;
    pm = fm + ((wgid % nig) % gsz); pn = (wgid % nig) / gsz;
}

template <class Epi, class Sched, bool GATHER, bool ALIGN_EPI, bool SP2>
__device__ __forceinline__ void gemm_phase(LAS unsigned char* lds, const int wave, const unsigned a_rs, const unsigned b_rs, const Sched& S, const Epi& E) {
    const int wid = wave, lane = lane_id(), tid = wid * 64 + lane, wr = wid >> 2, wc = wid & 3, fr = lane & 15, fq = lane >> 4;
    int R0, C0; stage_rc(tid * 16, R0, C0);
    unsigned voffA[2], voffB[2];
#pragma unroll
    for (int i = 0; i < 2; ++i) { const int R = R0 + 64 * i; const int Rb = (R & ~31) + perm32(R & 31);
        voffA[i] = (unsigned)R * a_rs + (unsigned)C0 * 2u; voffB[i] = (unsigned)Rb * b_rs + (unsigned)C0 * 2u; }
    unsigned vgc[2][2], vgn[2][2];
    const size_t kstep = (size_t)(BK * 2);
    const size_t hstepA = (size_t)HALF * a_rs;
    const unsigned ldsw = (unsigned)wid * 1024u;
    const int aoff = lds_byte(wr * 64 + fr, fq * 8), boff = lds_byte(wc * 32 + fr, fq * 8);
#define PG8_SA(b, h) (((b) * 2 + (h)) * HTB)
#define PG8_SB(b, h) ((4 + (b) * 2 + (h)) * HTB)
#define PG8_STAGE(bufoff, gbase, voff) do { const char* _gb = (const char*)(gbase); asm volatile("" : "+s"(_gb)); _Pragma("unroll") for (int _i = 0; _i < 2; ++_i) \
        __builtin_amdgcn_global_load_lds((const unsigned*)(_gb + (voff)[_i]), (LAS unsigned*)(lds + (bufoff) + ldsw + _i * 8192), 16, 0, 0); } while (0)
#define PG8_STAGE_A(bufoff, gbase, h, vg) do { if constexpr (GATHER) { PG8_STAGE(bufoff, gbase, (vg)[h]); } else { PG8_STAGE(bufoff, (gbase) + (h) * hstepA, voffA); } } while (0)
#define PG8_LDA(dst, b, h) do { _Pragma("unroll") for (int m = 0; m < 4; ++m) _Pragma("unroll") for (int k = 0; k < 2; ++k) dst[m][k] = *(const LAS bf16x8*)(lds + PG8_SA(b, h) + aoff + m * 2048 + k * 1024); } while (0)
#define PG8_LDB(dst, b, h) do { _Pragma("unroll") for (int n = 0; n < 2; ++n) _Pragma("unroll") for (int k = 0; k < 2; ++k) dst[n][k] = *(const LAS bf16x8*)(lds + PG8_SB(b, h) + boff + n * 2048 + k * 1024); } while (0)
#define PG8_MMA(ai, bj, At, Bt) do { __builtin_amdgcn_s_setprio(1); _Pragma("unroll") for (int m = 0; m < 4; ++m) _Pragma("unroll") for (int n = 0; n < 2; ++n) _Pragma("unroll") for (int k = 0; k < 2; ++k) \
        acc[ai][bj][m][n] = __builtin_amdgcn_mfma_f32_16x16x32_bf16(Bt[n][k], At[m][k], acc[ai][bj][m][n], 0, 0, 0); __builtin_amdgcn_s_setprio(0); } while (0)
#define PG8_WAIT_V(n) asm volatile("s_waitcnt vmcnt(" #n ")" ::: "memory")
#define PG8_WAIT_L(n) asm volatile("s_waitcnt lgkmcnt(" #n ")" ::: "memory")
#define PG8_BAR __builtin_amdgcn_s_barrier()
#define PG8_SCHED __builtin_amdgcn_sched_barrier(0)
#define PG8_GOFF(dst, u) do { if constexpr (GATHER) { if ((u).rows_lds >= 0) { _Pragma("unroll") for (int _h = 0; _h < 2; ++_h) _Pragma("unroll") for (int _i = 0; _i < 2; ++_i) \
        dst[_h][_i] = (unsigned)((const LAS int*)(lds + (u).rows_lds))[_h * HALF + R0 + 64 * _i] * a_rs + (unsigned)C0 * 2u; } else { _Pragma("unroll") for (int _h = 0; _h < 2; ++_h) _Pragma("unroll") for (int _i = 0; _i < 2; ++_i) \
        dst[_h][_i] = (unsigned)(u).rows[_h * HALF + R0 + 64 * _i] * a_rs + (unsigned)C0 * 2u; } } } while (0)
    GUnit cur, nxt; int ui = 0;
    if (!S.next(0, cur)) return;
    f32x4 acc[2][2][4][2];
#pragma unroll
    for (int a = 0; a < 2; ++a)
#pragma unroll
        for (int b = 0; b < 2; ++b)
#pragma unroll
            for (int m = 0; m < 4; ++m)
#pragma unroll
                for (int n = 0; n < 2; ++n) acc[a][b][m][n] = (f32x4){0.f, 0.f, 0.f, 0.f};
    bf16x8 At[4][2], B0[2][2], B1[2][2];
    const char* cA = uptr(cur.A); const char* cB0 = uptr(cur.B0); const char* cB1 = uptr(cur.B1); int cnt = __builtin_amdgcn_readfirstlane(cur.nt);
    PG8_GOFF(vgc, cur);
    if constexpr (SP2) {
        PG8_STAGE(PG8_SB(0, 0), cB0, voffB); PG8_STAGE(PG8_SB(0, 1), cB1, voffB); PG8_STAGE_A(PG8_SA(0, 0), cA, 0, vgc); PG8_STAGE_A(PG8_SA(0, 1), cA, 1, vgc);
        if (wr == 1) PG8_BAR;
        PG8_WAIT_V(2); PG8_BAR;
        PG8_STAGE(PG8_SB(1, 0), cB0 + kstep, voffB); PG8_STAGE_A(PG8_SA(1, 0), cA + kstep, 0, vgc); PG8_STAGE(PG8_SB(1, 1), cB1 + kstep, voffB);
        PG8_WAIT_V(6); PG8_BAR;
    } else {
        PG8_STAGE(PG8_SB(0, 0), cB0, voffB); PG8_STAGE_A(PG8_SA(0, 0), cA, 0, vgc); PG8_STAGE(PG8_SB(0, 1), cB1, voffB); PG8_STAGE_A(PG8_SA(0, 1), cA, 1, vgc);
        if (wr == 1) PG8_BAR;
        PG8_WAIT_V(4); PG8_BAR;
        PG8_STAGE(PG8_SB(1, 0), cB0 + kstep, voffB); PG8_STAGE_A(PG8_SA(1, 0), cA + kstep, 0, vgc); PG8_STAGE(PG8_SB(1, 1), cB1 + kstep, voffB);
        PG8_WAIT_V(6); PG8_BAR;
    }
    for (;;) {
        const bool has_next = S.next(ui + 1, nxt);
        const char* nA = uptr(has_next ? nxt.A : cA); const char* nB0 = uptr(has_next ? nxt.B0 : cB0); const char* nB1 = uptr(has_next ? nxt.B1 : cB1);
        if constexpr (GATHER) {
            if (has_next) { PG8_GOFF(vgn, nxt); }
            else {
#pragma unroll
                for (int _h = 0; _h < 2; ++_h)
#pragma unroll
                    for (int _i = 0; _i < 2; ++_i) vgn[_h][_i] = vgc[_h][_i];
            }
        }
        for (int t = 0; t < cnt; t += 2) {
            const bool last = (t == cnt - 2);
            const char* a1 = cA + (size_t)(t + 1) * kstep;
            const char* a2 = last ? nA : cA + (size_t)(t + 2) * kstep;
            const char* b2 = last ? nB0 : cB0 + (size_t)(t + 2) * kstep; const char* b2h = last ? nB1 : cB1 + (size_t)(t + 2) * kstep;
            const char* a3 = a2 + kstep; const char* b3 = b2 + kstep; const char* b3h = b2h + kstep;
            unsigned vg2[2][2];
            if constexpr (GATHER) {
#pragma unroll
                for (int _h = 0; _h < 2; ++_h)
#pragma unroll
                    for (int _i = 0; _i < 2; ++_i) vg2[_h][_i] = last ? vgn[_h][_i] : vgc[_h][_i];
            }
            if constexpr (SP2) {
            PG8_LDB(B0, 0, 0); PG8_LDB(B1, 0, 1); PG8_SCHED; PG8_LDA(At, 0, 0); PG8_STAGE_A(PG8_SA(1, 1), a1, 1, vgc);
            PG8_WAIT_V(8); PG8_WAIT_L(0); PG8_BAR; PG8_MMA(0, 0, At, B0); PG8_MMA(0, 1, At, B1); PG8_BAR; PG8_SCHED;
            PG8_LDA(At, 0, 1); PG8_STAGE(PG8_SB(0, 0), b2, voffB); PG8_STAGE(PG8_SB(0, 1), b2h, voffB); PG8_STAGE_A(PG8_SA(0, 0), a2, 0, vg2);
            PG8_WAIT_V(8); PG8_WAIT_L(0); PG8_BAR; PG8_MMA(1, 0, At, B0); PG8_MMA(1, 1, At, B1); PG8_BAR; PG8_SCHED;
            PG8_LDB(B0, 1, 0); PG8_LDB(B1, 1, 1); PG8_SCHED; PG8_LDA(At, 1, 0); PG8_STAGE_A(PG8_SA(0, 1), a2, 1, vg2);
            PG8_WAIT_V(8); PG8_WAIT_L(0); PG8_BAR; PG8_MMA(0, 0, At, B0); PG8_MMA(0, 1, At, B1); PG8_BAR; PG8_SCHED;
            PG8_LDA(At, 1, 1); PG8_STAGE(PG8_SB(1, 0), b3, voffB); PG8_STAGE(PG8_SB(1, 1), b3h, voffB); PG8_STAGE_A(PG8_SA(1, 0), a3, 0, vg2);
            PG8_WAIT_V(8); PG8_WAIT_L(0); PG8_BAR; PG8_MMA(1, 0, At, B0); PG8_MMA(1, 1, At, B1); PG8_BAR; PG8_SCHED;
            } else {
            PG8_LDB(B0, 0, 0); PG8_SCHED; PG8_LDA(At, 0, 0); PG8_STAGE_A(PG8_SA(1, 1), a1, 1, vgc);
            PG8_WAIT_L(8); PG8_BAR; PG8_WAIT_L(0); PG8_MMA(0, 0, At, B0); PG8_BAR; PG8_SCHED;
            PG8_LDB(B1, 0, 1); PG8_STAGE(PG8_SB(0, 0), b2, voffB);
            PG8_BAR; PG8_WAIT_L(0); PG8_MMA(0, 1, At, B1); PG8_BAR;
            PG8_LDA(At, 0, 1); PG8_STAGE_A(PG8_SA(0, 0), a2, 0, vg2);
            PG8_BAR; PG8_WAIT_L(0); PG8_MMA(1, 0, At, B0); PG8_BAR; PG8_SCHED;
            PG8_STAGE(PG8_SB(0, 1), b2h, voffB);
            PG8_WAIT_V(6); PG8_BAR; PG8_MMA(1, 1, At, B1); PG8_BAR;
            PG8_LDB(B0, 1, 0); PG8_SCHED; PG8_LDA(At, 1, 0); PG8_STAGE_A(PG8_SA(0, 1), a2, 1, vg2);
            PG8_WAIT_L(8); PG8_BAR; PG8_WAIT_L(0); PG8_MMA(0, 0, At, B0); PG8_BAR; PG8_SCHED;
            PG8_LDB(B1, 1, 1); PG8_STAGE(PG8_SB(1, 0), b3, voffB);
            PG8_BAR; PG8_WAIT_L(0); PG8_MMA(0, 1, At, B1); PG8_BAR;
            PG8_LDA(At, 1, 1); PG8_STAGE_A(PG8_SA(1, 0), a3, 0, vg2);
            PG8_BAR; PG8_WAIT_L(0); PG8_MMA(1, 0, At, B0); PG8_BAR; PG8_SCHED;
            PG8_STAGE(PG8_SB(1, 1), b3h, voffB);
            PG8_WAIT_V(6); PG8_BAR; PG8_MMA(1, 1, At, B1); PG8_BAR;
            }
        }
        if constexpr (ALIGN_EPI) { if (wr == 0) PG8_BAR; }
        { int l2 = lane_id(); asm volatile("" : "+v"(l2)); const int fr2 = l2 & 15, fq2 = l2 >> 4; E(acc, cur, wr, wc, fr2, fq2); }
        if (!has_next) break;
#pragma unroll
        for (int a = 0; a < 2; ++a)
#pragma unroll
            for (int b = 0; b < 2; ++b)
#pragma unroll
                for (int m = 0; m < 4; ++m)
#pragma unroll
                    for (int n = 0; n < 2; ++n) acc[a][b][m][n] = (f32x4){0.f, 0.f, 0.f, 0.f};
        cur = nxt; cA = nA; cB0 = nB0; cB1 = nB1; cnt = __builtin_amdgcn_readfirstlane(cur.nt); ++ui;
        if constexpr (GATHER) {
#pragma unroll
            for (int _h = 0; _h < 2; ++_h)
#pragma unroll
                for (int _i = 0; _i < 2; ++_i) vgc[_h][_i] = vgn[_h][_i];
        }
        if constexpr (ALIGN_EPI) { if (wr == 1) PG8_BAR; }
    }
    PG8_WAIT_V(0);
    if constexpr (!ALIGN_EPI) { if (wr == 0) PG8_BAR; }
    PG8_BAR;
#undef PG8_SA
#undef PG8_SB
#undef PG8_STAGE
#undef PG8_STAGE_A
#undef PG8_LDA
#undef PG8_LDB
#undef PG8_MMA
#undef PG8_WAIT_V
#undef PG8_WAIT_L
#undef PG8_BAR
#undef PG8_SCHED
#undef PG8_GOFF
}
}

struct Frame {
    LAS unsigned char* lds;
    volatile LAS unsigned* MISC;
    unsigned* ctl;
    unsigned char* ws;
    float* out;
    int wave, G, bid;
};
using pg8::GUnit;

template <class Fill> struct DenseSched {
    int nM, nN, G, c; Fill f;
    __device__ __forceinline__ bool next(int i, GUnit& u) const {
        const long L = (long)i * G + c; if (L >= (long)nM * nN) return false;
        int pm, pn; pg8::tile_order((int)L, nM, nN, pm, pn); u.pm = pm; u.pn = pn; u.rows = nullptr; u.rows_lds = -1; u.aux0 = 0; u.aux1 = 0; f(u); return true;
    }
};
struct FillPlain {
    const char* A; const char* B; unsigned a_rs, b_rs; int nt;
    __device__ __forceinline__ void operator()(GUnit& u) const { u.A = A + (size_t)u.pm * 256 * a_rs; u.B0 = B + (size_t)u.pn * 256 * b_rs; u.B1 = u.B0 + (size_t)128 * b_rs; u.nt = nt; }
};
struct FillQlatPool {
    const char* q; const char* diff; const char* wuk; const char* wpool;
    __device__ __forceinline__ void operator()(GUnit& u) const {
        if (u.pn < 8) { u.A = q + (size_t)u.pm * 256 * 2048 + (size_t)((u.pn & ~1) * 128) * 2; u.B0 = wuk + (size_t)u.pn * 256 * 512; }
        else { const int g = u.pn - 8; u.A = diff + (size_t)u.pm * 256 * 2048 + (size_t)(g * 256) * 2; u.B0 = wpool + (size_t)g * 256 * 512; }
        u.B1 = u.B0 + (size_t)128 * 512; u.nt = 4;
    }
};
struct FillO {
    const char* olat; const char* wuv;
    __device__ __forceinline__ void operator()(GUnit& u) const { u.A = olat + (size_t)u.pm * 256 * 4096 + (size_t)(u.pn * 512) * 2; u.B0 = wuv + (size_t)u.pn * 256 * 1024; u.B1 = u.B0 + (size_t)128 * 1024; u.nt = 8; }
};

#define EPI_LOOP_ROWS for (int ai = 0; ai < 2; ++ai) _Pragma("unroll") for (int m = 0; m < 4; ++m)
__device__ __forceinline__ u32x4 pack8(const f32x4 v0, const f32x4 v1) { u32x4 w; w.x = cvt_pk_bf16(v0[0], v0[1]); w.y = cvt_pk_bf16(v0[2], v0[3]); w.z = cvt_pk_bf16(v1[0], v1[1]); w.w = cvt_pk_bf16(v1[2], v1[3]); return w; }
__device__ __forceinline__ float sigmoidf_(float x) { return 1.0f / (1.0f + __expf(-x)); }

struct EpiP1 {
    bf16* q; bf16* qi; bf16* xp; bf16* gates; float* ckvraw; float* kiwi;
    __device__ __forceinline__ void operator()(const f32x4 (&acc)[2][2][4][2], const GUnit& u, int wr, int wc, int fr, int fq) const {
        const int row0 = u.pm * 256 + wr * 64 + fr, cl = wc * 32 + 8 * fq;
        if (u.pn < 28) {
            bf16* base; int ld, c0; bool sg = false;
            if (u.pn < 4) { base = q; ld = 1024; c0 = u.pn * 256; } else if (u.pn < 8) { base = qi; ld = 1024; c0 = (u.pn - 4) * 256; }
            else if (u.pn < 12) { base = xp; ld = 1024; c0 = (u.pn - 8) * 256; } else { base = gates; ld = 4096; c0 = (u.pn - 12) * 256; sg = true; }
#pragma unroll
            EPI_LOOP_ROWS { bf16* rowp = base + (size_t)(row0 + ai * 128 + m * 16) * ld + c0 + cl;
#pragma unroll
                for (int bj = 0; bj < 2; ++bj) { f32x4 v0 = acc[ai][bj][m][0], v1 = acc[ai][bj][m][1];
                    if (sg) {
#pragma unroll
                        for (int j = 0; j < 4; ++j) { v0[j] = sigmoidf_(v0[j]); v1[j] = sigmoidf_(v1[j]); } }
                    *(u32x4*)(rowp + bj * 128) = pack8(v0, v1); } }
        } else {
            float* base = (u.pn == 28) ? ckvraw : kiwi;
#pragma unroll
            EPI_LOOP_ROWS { float* rowp = base + (size_t)(row0 + ai * 128 + m * 16) * 256 + cl;
#pragma unroll
                for (int bj = 0; bj < 2; ++bj) { *(f32x4*)(rowp + bj * 128) = acc[ai][bj][m][0]; *(f32x4*)(rowp + bj * 128 + 4) = acc[ai][bj][m][1]; } }
        }
    }
};
struct EpiQlatPool {
    bf16* qlat; bf16* pool; const float* colscale;
    __device__ __forceinline__ void operator()(const f32x4 (&acc)[2][2][4][2], const GUnit& u, int wr, int wc, int fr, int fq) const {
        const int row0 = u.pm * 256 + wr * 64 + fr, cl = wc * 32 + 8 * fq;
        const bool ql = u.pn < 8;
        bf16* base = ql ? qlat + u.pn * 256 : pool + (u.pn - 8) * 256; const int ld = ql ? 2048 : 1024;
        const float* sp = colscale + u.pn * 256 + cl;
        __builtin_amdgcn_sched_barrier(0);
        const f32x4 s00 = *(const f32x4*)(sp), s01 = *(const f32x4*)(sp + 4), s10 = *(const f32x4*)(sp + 128), s11 = *(const f32x4*)(sp + 132);
#pragma unroll
        EPI_LOOP_ROWS { bf16* rowp = base + (size_t)(row0 + ai * 128 + m * 16) * ld + cl;
            *(u32x4*)(rowp) = pack8(acc[ai][0][m][0] * s00, acc[ai][0][m][1] * s01);
            *(u32x4*)(rowp + 128) = pack8(acc[ai][1][m][0] * s10, acc[ai][1][m][1] * s11); }
    }
};
struct EpiBf16 {
    bf16* O; int ld;
    __device__ __forceinline__ void operator()(const f32x4 (&acc)[2][2][4][2], const GUnit& u, int wr, int wc, int fr, int fq) const {
        const int row0 = u.pm * 256 + wr * 64 + fr, cl = u.pn * 256 + wc * 32 + 8 * fq;
#pragma unroll
        EPI_LOOP_ROWS { bf16* rowp = O + (size_t)(row0 + ai * 128 + m * 16) * ld + cl;
#pragma unroll
            for (int bj = 0; bj < 2; ++bj) *(u32x4*)(rowp + bj * 128) = pack8(acc[ai][bj][m][0], acc[ai][bj][m][1]); }
    }
};
__device__ __forceinline__ void unpack8(const u32x4 w, f32x4& a, f32x4& b) {
    a[0] = bf2f(w.x & 0xffffu); a[1] = bf2f(w.x >> 16); a[2] = bf2f(w.y & 0xffffu); a[3] = bf2f(w.y >> 16);
    b[0] = bf2f(w.z & 0xffffu); b[1] = bf2f(w.z >> 16); b[2] = bf2f(w.w & 0xffffu); b[3] = bf2f(w.w >> 16);
}
template <int MODE> struct EpiGate {
    const bf16* gates; bf16* M1; bf16* merged;
    __device__ __forceinline__ void operator()(const f32x4 (&acc)[2][2][4][2], const GUnit& u, int wr, int wc, int fr, int fq) const {
        const int row0 = u.pm * 256 + wr * 64 + fr, cl = u.pn * 256 + wc * 32 + 8 * fq;
#pragma unroll
        for (int ai = 0; ai < 2; ++ai) {
            u32x4 gq[4][2], mq[4][2];
#pragma unroll
            for (int m = 0; m < 4; ++m)
#pragma unroll
                for (int bj = 0; bj < 2; ++bj) { const size_t r = (size_t)(row0 + ai * 128 + m * 16); const int c = cl + bj * 128;
                    gq[m][bj] = *(const u32x4*)(gates + r * 4096 + (MODE ? 2048 : 0) + c); if (MODE) mq[m][bj] = *(const u32x4*)(M1 + r * 2048 + c); }
            __builtin_amdgcn_sched_barrier(0);
#pragma unroll
            for (int m = 0; m < 4; ++m)
#pragma unroll
                for (int bj = 0; bj < 2; ++bj) { const size_t r = (size_t)(row0 + ai * 128 + m * 16); const int c = cl + bj * 128;
                    f32x4 g0, g1; unpack8(gq[m][bj], g0, g1);
                    f32x4 v0 = acc[ai][bj][m][0] * g0, v1 = acc[ai][bj][m][1] * g1;
                    if (MODE) { f32x4 p0, p1; unpack8(mq[m][bj], p0, p1); v0 += p0; v1 += p1; *(u32x4*)(merged + r * 2048 + c) = pack8(v0, v1); }
                    else *(u32x4*)(M1 + r * 2048 + c) = pack8(v0, v1); }
            __builtin_amdgcn_sched_barrier(0);
        }
    }
};
struct EpiPre {
    const float* x; float* pre;
    __device__ __forceinline__ void operator()(const f32x4 (&acc)[2][2][4][2], const GUnit& u, int wr, int wc, int fr, int fq) const {
        const int row0 = u.pm * 256 + wr * 64 + fr, cl = u.pn * 256 + wc * 32 + 8 * fq;
#pragma unroll
        for (int ai = 0; ai < 2; ++ai) {
            f32x4 xq[4][2][2];
#pragma unroll
            for (int m = 0; m < 4; ++m)
#pragma unroll
                for (int bj = 0; bj < 2; ++bj) { const size_t o = (size_t)(row0 + ai * 128 + m * 16) * 2048 + cl + bj * 128; xq[m][bj][0] = __builtin_nontemporal_load((const f32x4*)(x + o)); xq[m][bj][1] = __builtin_nontemporal_load((const f32x4*)(x + o + 4)); }
            __builtin_amdgcn_sched_barrier(0);
#pragma unroll
            for (int m = 0; m < 4; ++m)
#pragma unroll
                for (int bj = 0; bj < 2; ++bj) { const size_t o = (size_t)(row0 + ai * 128 + m * 16) * 2048 + cl + bj * 128;
                    *(f32x4*)(pre + o) = xq[m][bj][0] * DN_ALPHA + acc[ai][bj][m][0]; *(f32x4*)(pre + o + 4) = xq[m][bj][1] * DN_ALPHA + acc[ai][bj][m][1]; }
            __builtin_amdgcn_sched_barrier(0);
        }
    }
};
constexpr int MOE_TAB_OFF = 131072, MOE_TAB_UNITS = 32, MOE_ROWS_OFF = 131072 + 512, MOE_ROWS_UNITS = 11;
struct MoeSched {
    const int* mtt; int nmt; int NT; int G, c; bool gateup;
    const char* h; const char* hbuf; const char* wgu; const char* wd; const int* rowlist; LAS unsigned char* lds;
    __device__ __forceinline__ int unit_of(int i) const {
        const int total = nmt * NT;
        if ((G & 7) == 0) { const int x = c & 7, j = i * (G >> 3) + (c >> 3); const int lo = (int)(((long)total * x) >> 3), hi = (int)(((long)total * (x + 1)) >> 3); const int U = lo + j; return U < hi ? U : -1; }
        const long L = (long)i * G + c; return L < total ? (int)L : -1;
    }
    __device__ __forceinline__ void prepare(int tid) const {
        LAS int* tab = (LAS int*)(lds + MOE_TAB_OFF);
        if (tid < MOE_TAB_UNITS) { const int U = unit_of(tid); int g = -1, p0 = 0, nv = 0, nt_ = 0;
            if (U >= 0) { const int MT = U / NT; nt_ = U - MT * NT; g = mtt[MT * 4 + 0]; p0 = mtt[MT * 4 + 1]; nv = mtt[MT * 4 + 2]; }
            tab[tid * 4 + 0] = g; tab[tid * 4 + 1] = p0; tab[tid * 4 + 2] = nv; tab[tid * 4 + 3] = nt_; }
        if (gateup) { LAS int* rw = (LAS int*)(lds + MOE_ROWS_OFF);
            for (int q = tid; q < MOE_ROWS_UNITS * 256; q += NTHR) { const int i = q >> 8, U = unit_of(i); if (U >= 0) { const int MT = U / NT; rw[q] = rowlist[mtt[MT * 4 + 1] + (q & 255)]; } } }
        __syncthreads();
    }
    __device__ __forceinline__ bool next(int i, GUnit& u) const {
        int g, p0, nv, nt_;
        if (i < MOE_TAB_UNITS) { const LAS int* tab = (const LAS int*)(lds + MOE_TAB_OFF); g = __builtin_amdgcn_readfirstlane(tab[i * 4 + 0]); p0 = __builtin_amdgcn_readfirstlane(tab[i * 4 + 1]); nv = __builtin_amdgcn_readfirstlane(tab[i * 4 + 2]); nt_ = __builtin_amdgcn_readfirstlane(tab[i * 4 + 3]); if (g < 0) return false; }
        else { const int U = unit_of(i); if (U < 0) return false; const int MT = U / NT; nt_ = U - MT * NT;
            g = __builtin_amdgcn_readfirstlane(mtt[MT * 4 + 0]); p0 = __builtin_amdgcn_readfirstlane(mtt[MT * 4 + 1]); nv = __builtin_amdgcn_readfirstlane(mtt[MT * 4 + 2]); }
        u.pm = p0; u.pn = nt_; u.aux0 = nv; u.aux1 = g; u.rows_lds = -1;
        if (gateup) { u.A = h; u.rows = rowlist + p0; if (i < MOE_ROWS_UNITS) u.rows_lds = MOE_ROWS_OFF + i * 1024; u.B0 = wgu + ((size_t)g * 1024 + (size_t)nt_ * 256) * 4096; u.B1 = u.B0 + (size_t)128 * 4096; u.nt = 32; }
        else { u.A = hbuf + (size_t)p0 * 1024; u.rows = nullptr; u.B0 = wd + ((size_t)g * 2048 + (size_t)nt_ * 256) * 1024; u.B1 = u.B0 + (size_t)128 * 1024; u.nt = 8; }
        return true;
    }
};
struct EpiSwiGLU {
    bf16* H;
    __device__ __forceinline__ void operator()(const f32x4 (&acc)[2][2][4][2], const GUnit& u, int wr, int wc, int fr, int fq) const {
        const int cl = u.pn * 128 + wc * 32 + 8 * fq;
#pragma unroll
        EPI_LOOP_ROWS { const int r = ai * 128 + wr * 64 + m * 16 + fr;
            if (r < u.aux0) { f32x4 v[2];
#pragma unroll
                for (int n = 0; n < 2; ++n)
#pragma unroll
                    for (int j = 0; j < 4; ++j) { const float g = acc[ai][0][m][n][j], up = acc[ai][1][m][n][j]; v[n][j] = g * sigmoidf_(g) * up; }
                *(u32x4*)(H + (size_t)(u.pm + r) * 512 + cl) = pack8(v[0], v[1]); } }
    }
};
struct EpiY {
    unsigned char* Y8; bf16* Ysh;
    __device__ __forceinline__ void operator()(const f32x4 (&acc)[2][2][4][2], const GUnit& u, int wr, int wc, int fr, int fq) const {
        const int cl = u.pn * 256 + wc * 32 + 8 * fq;
        if (u.aux1 == NE) {
#pragma unroll
            EPI_LOOP_ROWS { const int r = ai * 128 + wr * 64 + m * 16 + fr;
                if (r < u.aux0) { bf16* rowp = Ysh + (size_t)(u.pm - NTOK * 8 + r) * 2048 + cl;
#pragma unroll
                    for (int bj = 0; bj < 2; ++bj) *(u32x4*)(rowp + bj * 128) = pack8(acc[ai][bj][m][0], acc[ai][bj][m][1]); } }
        } else {
#pragma unroll
            EPI_LOOP_ROWS { const int r = ai * 128 + wr * 64 + m * 16 + fr;
                if (r < u.aux0) { unsigned char* rowp = Y8 + (size_t)(u.pm + r) * 2048 + cl;
#pragma unroll
                    for (int bj = 0; bj < 2; ++bj) { const f32x4 v0 = acc[ai][bj][m][0], v1 = acc[ai][bj][m][1];
                        int w0 = __builtin_amdgcn_cvt_pk_fp8_f32(v0[0], v0[1], 0, false); w0 = __builtin_amdgcn_cvt_pk_fp8_f32(v0[2], v0[3], w0, true);
                        int w1 = __builtin_amdgcn_cvt_pk_fp8_f32(v1[0], v1[1], 0, false); w1 = __builtin_amdgcn_cvt_pk_fp8_f32(v1[2], v1[3], w1, true);
                        u32x2 o; o.x = (unsigned)w0; o.y = (unsigned)w1; *(u32x2*)(rowp + bj * 128) = o; } } }
        }
    }
};

template <class RowMap>
__device__ __forceinline__ void tr_item(const float* W, int ldw, int nvalid, bf16* WT, int ldT, LAS float* scr, int kb, int nb, int lane, const RowMap& rm) {
    const int k0 = 64 * kb, n0 = 32 * nb;
    const int c4 = 4 * (lane & 7), kr = lane >> 3;
    f32x4 v[8];
#pragma unroll
    for (int i = 0; i < 8; ++i) { v[i] = (f32x4){0.f, 0.f, 0.f, 0.f}; if (n0 + c4 < nvalid) v[i] = *(const f32x4*)(W + (size_t)(k0 + 8 * i + kr) * ldw + n0 + c4); }
#pragma unroll
    for (int i = 0; i < 8; ++i) { LAS float* d = scr + (8 * i + kr) * 33 + c4; d[0] = v[i][0]; d[1] = v[i][1]; d[2] = v[i][2]; d[3] = v[i][3]; }
    LDS_WAIT(); asm volatile("" ::: "memory");
    const int c = lane & 7;
#pragma unroll
    for (int j = 0; j < 4; ++j) { const int nl = (lane >> 3) + 8 * j; const LAS float* s = scr + (8 * c) * 33 + nl;
        u32x4 o; o.x = cvt_pk_bf16(s[0 * 33], s[1 * 33]); o.y = cvt_pk_bf16(s[2 * 33], s[3 * 33]); o.z = cvt_pk_bf16(s[4 * 33], s[5 * 33]); o.w = cvt_pk_bf16(s[6 * 33], s[7 * 33]);
        if (n0 + nl < nvalid) *(u32x4*)(WT + (size_t)rm(n0 + nl) * ldT + k0 + 8 * c) = o; }
    LDS_WAIT(); asm volatile("" ::: "memory");
}
struct MapId { int off; __device__ __forceinline__ int operator()(int n) const { return off + n; } };
struct MapWin {
    __device__ __forceinline__ int operator()(int n) const {
        if (n < 1024) return n;
        if (n < 1280) return 7168 + (n - 1024);
        if (n < 2304) return 1024 + (n - 1280);
        if (n < 2368) return 7424 + (n - 2304);
        if (n < 2384) return 7488 + (n - 2368);
        if (n < 3408) return 2048 + (n - 2384);
        return 3072 + (n - 3408);
    }
};
struct MapGU { int up; __device__ __forceinline__ int operator()(int f) const { return (f >> 7) * 256 + up * 128 + (f & 127); } };

__device__ __forceinline__ void phase_convert_small(Frame& F, const float* x, const float* w_in, const float* w_uk, const float* w_uv, const float* w_pool, const float* w_pa, const float* w_pp, const float* w_out, const float* pscale, const float* w_router) {
    const int lane_ = lane_id(), tid_ = F.wave * 64 + lane_;
    { float* wt = (float*)(F.ws + WS_WRT); for (size_t i = (size_t)F.bid * NTHR + tid_; i < (size_t)64 * 2048; i += (size_t)F.G * NTHR) { const int e = (int)(i >> 11), d = (int)(i & 2047); wt[i] = w_router[(size_t)d * 64 + e]; } }
    { float* cs = (float*)(F.ws + WS_CSCALE); for (size_t i = (size_t)F.bid * NTHR + tid_; i < 3072; i += (size_t)F.G * NTHR) cs[i] = (i < 2048) ? 1.0f : pscale[i - 2048]; }
    bf16* xb = (bf16*)(F.ws + WS_XB);
    const size_t gt = (size_t)F.bid * NTHR + tid_, nth = (size_t)F.G * NTHR;
    for (size_t i0 = gt; i0 < (size_t)NTOK * DM / 8; i0 += 4 * nth) {
        f32x4 a[4], b[4];
#pragma unroll
        for (int q = 0; q < 4; ++q) { const size_t i = i0 + q * nth; a[q] = __builtin_nontemporal_load((const f32x4*)x + 2 * i); b[q] = __builtin_nontemporal_load((const f32x4*)x + 2 * i + 1); }
        __builtin_amdgcn_sched_barrier(0);
#pragma unroll
        for (int q = 0; q < 4; ++q) { const size_t i = i0 + q * nth; u32x4 o; o.x = pk2(a[q][0], a[q][1]); o.y = pk2(a[q][2], a[q][3]); o.z = pk2(b[q][0], b[q][1]); o.w = pk2(b[q][2], b[q][3]); ((u32x4*)xb)[i] = o; }
    }
    LAS float* scr = (LAS float*)(F.lds + F.wave * 8704);
    const int gw = F.bid * NWAVES + F.wave, NGW = F.G * NWAVES;
    constexpr int I_IN = 32 * 235, I_POOL = 4 * 4 * 8, I_PA = 16 * 64, I_PP = 16 * 64, I_OUT = 32 * 64;
    constexpr int NIT = I_IN + I_POOL + I_PA + I_PP + I_OUT;
    for (int it = gw; it < NIT; it += NGW) {
        int r = it;
        if (r < I_IN) { tr_item(w_in, 7504, 7504, (bf16*)(F.ws + WS_WIN), 2048, scr, r / 235, r % 235, lane_, MapWin{}); continue; } r -= I_IN;
        if (r < I_POOL) { const int g = r / 32, q = r % 32; tr_item(w_pool + (size_t)g * 65536, 256, 256, (bf16*)(F.ws + WS_WPOOL) + (size_t)g * 65536, 256, scr, q / 8, q % 8, lane_, MapId{0}); continue; } r -= I_POOL;
        if (r < I_PA) { tr_item(w_pa, 2048, 2048, (bf16*)(F.ws + WS_WPA), 1024, scr, r / 64, r % 64, lane_, MapId{0}); continue; } r -= I_PA;
        if (r < I_PP) { tr_item(w_pp, 2048, 2048, (bf16*)(F.ws + WS_WPP), 1024, scr, r / 64, r % 64, lane_, MapId{0}); continue; } r -= I_PP;
        tr_item(w_out, 2048, 2048, (bf16*)(F.ws + WS_WOUT), 2048, scr, r / 64, r % 64, lane_, MapId{0});
    }
    { bf16* wp = (bf16*)(F.ws + WS_WIN) + (size_t)7504 * 2048; for (size_t i = gt; i < (size_t)176 * 2048 / 8; i += nth) ((u32x4*)wp)[i] = (u32x4){0u, 0u, 0u, 0u}; }
    { const float* wuk = w_uk; bf16* o = (bf16*)(F.ws + WS_WUK);
      for (size_t i = gt; i < (size_t)2048 * 256; i += nth) { const int kp = (int)(i & 255), row = (int)(i >> 8), h = row >> 8, r = row & 255;
          o[i] = ((kp >> 7) == (h & 1)) ? (bf16)f2bf(wuk[(size_t)r * 1024 + h * 128 + (kp & 127)]) : (bf16)0; } }
    { const float* wuv = w_uv; bf16* o = (bf16*)(F.ws + WS_WUV);
      for (size_t i = gt; i < (size_t)1024 * 512; i += nth) { const int kp = (int)(i & 511), row = (int)(i >> 9), pn = row >> 8, hh = (row >> 7) & 1, d = row & 127, hh2 = kp >> 8, r = kp & 255;
          o[i] = (hh == hh2) ? (bf16)f2bf(wuv[(size_t)r * 1024 + (2 * pn + hh) * 128 + d]) : (bf16)0; } }
}

struct ExpW { const float* wge; const float* wue; const float* wde; const float* wgs; const float* wus; const float* wds; };
template <int BATCH>
__device__ __forceinline__ bool convert_batch(Frame& F, const ExpW& W, LAS float* scr, const int lane_) {
    constexpr int PER = 1536, NIT = NGRP * PER;
    int base = 0;
    if (lane_ == 0) base = (int)__hip_atomic_fetch_add(F.ctl + CW_CVQ, (unsigned)BATCH, RLX_AGENT);
    base = __builtin_amdgcn_readfirstlane(base);
    if (base >= NIT) return false;
    for (int it = base; it < base + BATCH && it < NIT; ++it) {
        const int g = it / PER; int r = it - g * PER;
        const float* wg = (g < NE) ? W.wge + (size_t)g * 2048 * 512 : W.wgs;
        const float* wu = (g < NE) ? W.wue + (size_t)g * 2048 * 512 : W.wus;
        const float* wd = (g < NE) ? W.wde + (size_t)g * 512 * 2048 : W.wds;
        bf16* ogu = (bf16*)(F.ws + WS_WGU) + (size_t)g * 1024 * 2048; bf16* od = (bf16*)(F.ws + WS_WD) + (size_t)g * 2048 * 512;
        if (r < 512) { tr_item(wg, 512, 512, ogu, 2048, scr, r / 16, r % 16, lane_, MapGU{0}); continue; } r -= 512;
        if (r < 512) { tr_item(wu, 512, 512, ogu, 2048, scr, r / 16, r % 16, lane_, MapGU{1}); continue; } r -= 512;
        tr_item(wd, 2048, 2048, od, 512, scr, r / 64, r % 64, lane_, MapId{0});
    }
    return true;
}
__device__ __forceinline__ void phase_convert_experts(Frame& F, const ExpW& W) {
    const int lane_ = lane_id();
    LAS float* scr = (LAS float*)(F.lds + 32768 + F.wave * 8704);
    while (convert_batch<8>(F, W, scr, lane_)) {}
}

__device__ __forceinline__ void phase_postproc(Frame& F, const float* cg, const float* kg, const float* kb) {
    const int lane_ = lane_id(), tid_ = F.wave * 64 + lane_;
    const float* ckvraw = (const float*)(F.ws + WS_CKVRAW); const float* kiwi = (const float*)(F.ws + WS_KIWI);
    unsigned* ckvn = (unsigned*)(F.ws + WS_CKVN); bf16* kin = (bf16*)(F.ws + WS_KIN); float* wis = (float*)(F.ws + WS_WI);
    const int gw = F.bid * NWAVES + F.wave, NGW = F.G * NWAVES, lane = lane_;
    const f32x4 g4 = *(const f32x4*)(cg + lane * 4); const float kgl = kg[lane], kbl = kb[lane];
    for (int t0 = gw; t0 < NTOK; t0 += 4 * NGW) {
        f32x4 v[4]; float kv[4], wv[4];
#pragma unroll
        for (int q = 0; q < 4; ++q) { const int t = t0 + q * NGW; v[q] = (f32x4){0.f, 0.f, 0.f, 0.f}; kv[q] = 0.f; wv[q] = 0.f;
            if (t < NTOK) { v[q] = *(const f32x4*)(ckvraw + (size_t)t * 256 + lane * 4); kv[q] = kiwi[(size_t)t * 256 + lane]; wv[q] = kiwi[(size_t)t * 256 + 64 + (lane & 15)]; } }
#pragma unroll
        for (int q = 0; q < 4; ++q) { const int t = t0 + q * NGW;
            const float ss = wave_sum(v[q][0] * v[q][0] + v[q][1] * v[q][1] + v[q][2] * v[q][2] + v[q][3] * v[q][3]);
            const float rs = 1.0f / sqrtf(ss * (1.0f / 256.0f) + RMS_EPS);
            int o8 = __builtin_amdgcn_cvt_pk_fp8_f32(v[q][0] * rs * g4[0], v[q][1] * rs * g4[1], 0, false);
            o8 = __builtin_amdgcn_cvt_pk_fp8_f32(v[q][2] * rs * g4[2], v[q][3] * rs * g4[3], o8, true);
            const float mu = wave_sum(kv[q]) * (1.0f / 64.0f); const float dlt = kv[q] - mu;
            const float var = wave_sum(dlt * dlt) * (1.0f / 64.0f);
            const float y = dlt * (1.0f / sqrtf(var + LN_EPS)) * kgl + kbl;
            if (t < NTOK) { ckvn[(size_t)t * 64 + lane] = (unsigned)o8; kin[(size_t)t * 64 + lane] = (bf16)f2bf(y); if (lane < 16) wis[(size_t)t * 16 + lane] = wv[q] * 0.03125f; } }
    }
    const bf16* xp = (const bf16*)(F.ws + WS_XP); bf16* diff = (bf16*)(F.ws + WS_DIFF);
    const size_t gt = (size_t)F.bid * NTHR + tid_, nth = (size_t)F.G * NTHR;
    for (size_t i = gt; i < (size_t)(NTOK / 16) * 128; i += nth) {
        const int run = (int)(i >> 7), cgp = (int)(i & 127), g = cgp >> 5, win = 2 << g, tb = run * 16, posb = tb & (SEQ - 1);
        const bf16* col = xp + cgp * 8;
        u32x4 rw[31];
#pragma unroll
        for (int j = 0; j < 31; ++j) { const int dr = j - 15; rw[j] = (u32x4){0u, 0u, 0u, 0u}; if (dr >= 1 - win && posb + dr >= 0) rw[j] = *(const u32x4*)(col + (size_t)(tb + dr) * 1024); }
        __builtin_amdgcn_sched_barrier(0);
        f32x4 s0 = {0.f, 0.f, 0.f, 0.f}, s1 = {0.f, 0.f, 0.f, 0.f};
#pragma unroll
        for (int j = 1; j < 16; ++j) { if (j < win) { f32x4 a, b; unpack8(rw[15 - j], a, b); s0 += a; s1 += b; } }
#pragma unroll
        for (int q = 0; q < 16; ++q) { const int t = tb + q, pos = posb + q;
            f32x4 a, b; unpack8(rw[15 + q], a, b); s0 += a; s1 += b;
            const int cntw = (pos + 1 < win) ? pos + 1 : win; const float inv = 1.0f / (float)cntw;
            *(u32x4*)(diff + (size_t)t * 1024 + cgp * 8) = pack8(s0 * inv - a, s1 * inv - b);
            f32x4 c, d; const u32x4 r2 = rw[15 + q - 1], r4 = rw[15 + q - 3], r8 = rw[15 + q - 7], r16 = rw[15 + q - 15];
            const u32x4 rr = (win == 2) ? r2 : (win == 4) ? r4 : (win == 8) ? r8 : r16;
            unpack8(rr, c, d); s0 -= c; s1 -= d; }
    }
}

__device__ __forceinline__ size_t score_rowbase(int b, int p) { const int jq = p >> 7; return (size_t)b * SC_TOT + (size_t)16384 * (size_t)(jq * (jq + 1) / 2) + (size_t)(p & 127) * (size_t)(128 * (jq + 1)); }

__device__ __forceinline__ void phase_index_scores(Frame& F) {
    const int lane_ = lane_id(), tid_ = F.wave * 64 + lane_;
    const bf16* qi = (const bf16*)(F.ws + WS_QI); const bf16* kin = (const bf16*)(F.ws + WS_KIN); const float* wis = (const float*)(F.ws + WS_WI);
    float* scores = (float*)(F.ws + WS_SCORES);
    const int lane = lane_, w = F.wave, fq = lane >> 4, j16 = lane & 15, tid = tid_;
    constexpr int NQ = 4;
    LAS unsigned char* kb = F.lds;
    const int sR = tid >> 3, sc = tid & 7, sP = (sR & 3) * 16 + (sR >> 2);
    const int st_off = sP * 128 + ((sc ^ ((sP >> 1) & 7)) * 16);
    for (int it = 0;; ++it) {
        const int jj = (it >> 1) * F.G + F.bid; if (jj >= 256) break;
        const int s = (it & 1) ? 511 - jj : jj;
        const int b = s & 1, qg = s >> 1, tq0 = qg * 32;
        const int nk64 = (tq0 + 32 + 63) / 64, nsteps = (nk64 + NQ - 1) / NQ;
        bf16x8 Af[4][2];
        { const size_t tok = (size_t)b * SEQ + tq0 + 4 * w + (j16 >> 2);
#pragma unroll
          for (int g = 0; g < 4; ++g)
#pragma unroll
              for (int ks = 0; ks < 2; ++ks) Af[g][ks] = *(const bf16x8*)(qi + tok * 1024 + (4 * g + (j16 & 3)) * 64 + ks * 32 + 8 * fq); }
        f32x4 wv[4];
        { const size_t tok = (size_t)b * SEQ + tq0 + 4 * w + fq;
#pragma unroll
          for (int g = 0; g < 4; ++g) wv[g] = *(const f32x4*)(wis + tok * 16 + 4 * g); }
        float* orow = scores + score_rowbase(b, tq0 + 4 * w + fq);
        const bf16* kbase = kin + (size_t)b * SEQ * 64 + (size_t)sR * 64 + sc * 8;
        u32x4 stg[NQ];
#pragma unroll
        for (int q = 0; q < NQ; ++q) { const int h = (q < nk64) ? q : nk64 - 1; stg[q] = *(const u32x4*)(kbase + (size_t)h * 4096); }
        __syncthreads();
#pragma unroll
        for (int q = 0; q < NQ; ++q) *(LAS u32x4*)(kb + q * 8192 + st_off) = stg[q];
        __syncthreads();
        for (int step = 0; step < nsteps; ++step) {
            const int cur = step & 1;
            if (step + 1 < nsteps) {
#pragma unroll
                for (int q = 0; q < NQ; ++q) { int h = NQ * (step + 1) + q; h = (h < nk64) ? h : nk64 - 1; stg[q] = *(const u32x4*)(kbase + (size_t)h * 4096); } }
#pragma unroll
            for (int hh = 0; hh < NQ; ++hh) {
                f32x4 res;
#pragma unroll
                for (int u = 0; u < 4; ++u) {
                    const int P = u * 16 + j16;
                    f32x4 a4[4];
#pragma unroll
                    for (int g = 0; g < 4; ++g) a4[g] = (f32x4){0.f, 0.f, 0.f, 0.f};
#pragma unroll
                    for (int ks = 0; ks < 2; ++ks) {
                        const bf16x8 bfr = *(const LAS bf16x8*)(kb + cur * (NQ * 8192) + hh * 8192 + P * 128 + (((fq + 4 * ks) ^ ((P >> 1) & 7)) * 16));
#pragma unroll
                        for (int g = 0; g < 4; ++g) a4[g] = __builtin_amdgcn_mfma_f32_16x16x32_bf16(Af[g][ks], bfr, a4[g], 0, 0, 0);
                    }
                    float sres = 0.f;
#pragma unroll
                    for (int g = 0; g < 4; ++g)
#pragma unroll
                        for (int r = 0; r < 4; ++r) { const float xf = a4[g][r]; const int xb = __float_as_int(xf); sres += wv[g][r] * __int_as_float(xb > 0 ? xb : 0); }
                    res[u] = sres;
                }
                const int hg = NQ * step + hh;
                if (hg < nk64) *(f32x4*)(orow + hg * 64 + 4 * j16) = res;
            }
            if (step + 1 < nsteps) {
#pragma unroll
                for (int q = 0; q < NQ; ++q) *(LAS u32x4*)(kb + (cur ^ 1) * (NQ * 8192) + q * 8192 + st_off) = stg[q]; }
            __syncthreads();
        }
    }
}

__device__ __forceinline__ unsigned fkey(float f) { const unsigned u = __float_as_uint(f); return (u & 0x80000000u) ? ~u : (u | 0x80000000u); }

template <int NV>
__device__ __forceinline__ void select_row(const float* row, int n, unsigned short* sel, int lane) {
    unsigned u[NV][4];
#pragma unroll
    for (int i = 0; i < NV; ++i) {
        const int base = i * 256 + lane * 4;
        f32x4 v = {0.f, 0.f, 0.f, 0.f};
        if (base < n) v = *(const f32x4*)(row + base);
#pragma unroll
        for (int e = 0; e < 4; ++e) u[i][e] = (base + e < n) ? fkey(v[e]) : 0u;
    }
    unsigned T = 0u; int cntT = n;
    bool exact = false;
    for (int bit = 31; bit >= 0; --bit) {
        const unsigned cand = T | (1u << bit);
        int c = 0;
#pragma unroll
        for (int i = 0; i < NV; ++i)
#pragma unroll
            for (int e = 0; e < 4; ++e) c += (u[i][e] >= cand) ? 1 : 0;
        c = wave_sum_i(c);
        if (c >= TOPK) { T = cand; cntT = c; if (c == TOPK) { exact = true; break; } }
    }
    int cgt = 0;
    if (!exact) {
#pragma unroll
        for (int i = 0; i < NV; ++i)
#pragma unroll
            for (int e = 0; e < 4; ++e) cgt += (u[i][e] > T) ? 1 : 0;
        cgt = wave_sum_i(cgt);
    }
    int pg = 0, pe = exact ? 0 : cgt;
    const unsigned long long lt = (1ull << lane) - 1ull;
#pragma unroll
    for (int i = 0; i < NV; ++i)
#pragma unroll
        for (int e = 0; e < 4; ++e) {
            const unsigned val = u[i][e]; const int idx = i * 256 + lane * 4 + e;
            const bool gsel = exact ? (val >= T) : (val > T);
            const unsigned long long mg = __ballot(gsel);
            if (gsel) sel[pg + __popcll(mg & lt)] = (unsigned short)idx;
            pg += __popcll(mg);
            if (!exact) {
                const bool esel = (val == T);
                const unsigned long long me = __ballot(esel);
                const int pos = pe + __popcll(me & lt);
                if (esel && pos < TOPK) sel[pos] = (unsigned short)idx;
                pe += __popcll(me);
            }
        }
}

template <int NV>
__device__ __forceinline__ bool select_row_hist(const float* row, int n, unsigned short* sel, int lane, LAS unsigned* hist) {
    LAS unsigned* cnts = hist + 4097;
    LAS unsigned* tiel = hist + 4100;
    unsigned u[NV][4];
#pragma unroll
    for (int i = 0; i < NV; ++i) { const int base = i * 256 + lane * 4; u32x4 t4 = {0u, 0u, 0u, 0u}; if (base < n) t4 = *(const u32x4*)(row + base); u[i][0] = t4[0]; u[i][1] = t4[1]; u[i][2] = t4[2]; u[i][3] = t4[3]; }
#pragma unroll
    for (int q = 0; q < 17; ++q) { const int w = q * 256 + lane * 4; if (w < 4104) *(LAS u32x4*)(hist + w) = (u32x4){0u, 0u, 0u, 0u}; }
    const float v00 = __uint_as_float(u[0][0]);
    float mn = v00, mx = v00;
#define SR_MM(i_, MASKED) do { _Pragma("unroll") for (int e = 0; e < 4; ++e) { float x = __uint_as_float(u[i_][e]); if (MASKED) x = ((i_) * 256 + lane * 4 + e < n) ? x : v00; mn = fminf(mn, x); mx = fmaxf(mx, x); } } while (0)
#pragma unroll
    for (int i = 0; i < NV; ++i) {
        if (i < NV - 8) SR_MM(i, false);
        else { const int rem = n - i * 256; if (rem >= 256) SR_MM(i, false); else if (rem > 0) SR_MM(i, true); }
    }
#undef SR_MM
    mn = wave_min(mn); mx = wave_max(mx);
    if (!(mx > mn)) {
#pragma unroll
        for (int q = 0; q < 4; ++q) sel[q * 64 + lane] = (unsigned short)(q * 64 + lane);
        return true;
    }
    const float scale = 4095.5f / (mx - mn), off = -mn * scale;
#define SR_KEY(i_, MASKED) do { _Pragma("unroll") for (int e = 0; e < 4; ++e) { unsigned k = (unsigned)fmaf(__uint_as_float(u[i_][e]), scale, off); k = k > 4095u ? 4095u : k; \
        if (MASKED) k = ((i_) * 256 + lane * 4 + e < n) ? k : 4096u; u[i_][e] = k; __hip_atomic_fetch_add(hist + k, 1u, __ATOMIC_RELAXED, __HIP_MEMORY_SCOPE_WORKGROUP); } } while (0)
#pragma unroll
    for (int i = 0; i < NV; ++i) {
        if (i < NV - 8) SR_KEY(i, false);
        else { const int rem = n - i * 256; if (rem >= 256) SR_KEY(i, false); else if (rem > 0) SR_KEY(i, true); else { u[i][0] = 4096u; u[i][1] = 4096u; u[i][2] = 4096u; u[i][3] = 4096u; } }
    }
#undef SR_KEY
    LDS_WAIT();
    unsigned sl = 0;
#pragma unroll
    for (int q = 0; q < 16; ++q) { const u32x4 t4 = *(const LAS u32x4*)(hist + 64 * lane + 4 * q); sl += (t4[0] + t4[1]) + (t4[2] + t4[3]); }
    const unsigned pre = (unsigned)wave_scan_i((int)sl);
    const unsigned total = (unsigned)__builtin_amdgcn_readlane((int)pre, 63), above = total - pre;
    const bool mine = (above < (unsigned)TOPK) && (above + sl >= (unsigned)TOPK);
    const int src = __builtin_amdgcn_readfirstlane(__ffsll((unsigned long long)__ballot(mine)) - 1);
    const unsigned above_src = (unsigned)__builtin_amdgcn_readlane((int)above, src);
    const unsigned hj = hist[64 * src + lane];
    const unsigned pj = (unsigned)wave_scan_i((int)hj);
    const unsigned cj = above_src + ((unsigned)__builtin_amdgcn_readlane((int)pj, 63) - pj);
    const bool hit = (cj < (unsigned)TOPK) && (cj + hj >= (unsigned)TOPK);
    const int hl = __builtin_amdgcn_readfirstlane(__ffsll((unsigned long long)__ballot(hit)) - 1);
    const unsigned bstar = (unsigned)(64 * src + hl), cgt = (unsigned)__builtin_amdgcn_readlane((int)cj, hl), mt = (unsigned)__builtin_amdgcn_readlane((int)hj, hl);
    int pg = 0; const unsigned span = 4095u - bstar;
#pragma unroll
    for (int i = 0; i < NV; ++i)
#pragma unroll
        for (int e = 0; e < 4; ++e) { const unsigned k = u[i][e]; const int idx = i * 256 + lane * 4 + e;
            const bool gsel = (k - bstar - 1u) < span;
            const unsigned long long mg = __ballot(gsel);
            if (mg) { if (gsel) sel[pg + (int)__builtin_amdgcn_mbcnt_hi((unsigned)(mg >> 32), __builtin_amdgcn_mbcnt_lo((unsigned)mg, 0u))] = (unsigned short)idx; pg += __popcll(mg); }
            if (k == bstar) { const unsigned p = __hip_atomic_fetch_add(cnts + 1, 1u, __ATOMIC_RELAXED, __HIP_MEMORY_SCOPE_WORKGROUP); if (p < 64u) tiel[p] = (unsigned)idx; } }
    LDS_WAIT();
    const int need = TOPK - (int)cgt;
    if (mt <= 64u) {
        int idx = 0x7fffffff; float val = -INFINITY;
        if (lane < (int)mt) { idx = (int)tiel[lane]; val = row[idx]; }
        int rk = 0;
        for (int j = 0; j < (int)mt; ++j) { const float o = __shfl(val, j); const int oi = __shfl(idx, j); rk += (o > val || (o == val && oi < idx)) ? 1 : 0; }
        if (lane < (int)mt && rk < need) sel[cgt + rk] = (unsigned short)idx;
        return true;
    }
    return false;
}

__device__ __forceinline__ void phase_select(Frame& F, const ExpW& W, const bool ride) {
    const int lane_ = lane_id(), tid_ = F.wave * 64 + lane_;
    LAS float* cscr = (LAS float*)(F.lds + F.wave * 8704); bool more = ride;
    LAS unsigned* hist = (LAS unsigned*)(F.lds + F.wave * 17408);
    const float* scores = (const float*)(F.ws + WS_SCORES);
    unsigned short* selb = (unsigned short*)(F.ws + WS_SEL);
    const int gw = F.bid * NWAVES + F.wave, NGW = F.G * NWAVES, lane = lane_;
    for (int it = 0;; ++it) {
        const int jj = (it >> 1) * NGW + gw; if (jj >= NTOK / 2) break;
        const int s = (it & 1) ? NTOK - 1 - jj : jj;
        const int b = s & 1, p = s >> 1, n = p + 1;
        unsigned short* sel = selb + ((size_t)b * SEQ + p) * TOPK;
        if (n <= TOPK) {
#pragma unroll
            for (int q = 0; q < 4; ++q) { const int i = q * 64 + lane; sel[i] = (i < n) ? (unsigned short)i : (unsigned short)0xFFFFu; }
        } else {
            const float* row = scores + score_rowbase(b, p);
            bool ok;
            if (n <= 2048) ok = select_row_hist<8>(row, n, sel, lane, hist);
            else if (n <= 4096) ok = select_row_hist<16>(row, n, sel, lane, hist);
            else if (n <= 6144) ok = select_row_hist<24>(row, n, sel, lane, hist);
            else ok = select_row_hist<32>(row, n, sel, lane, hist);
            asm volatile("" ::: "memory");
            if (!ok) select_row<32>(row, n, sel, lane);
        }
        if (more) more = convert_batch<3>(F, W, cscr, lane);
    }
}

__device__ __forceinline__ int c_lds(int row, int chunk) { return row * 544 + chunk * 16; }

__device__ __forceinline__ void phase_sparse_attn(Frame& F, const ExpW& W, const bool ride) {
    const int lane_ = lane_id(), tid_ = F.wave * 64 + lane_; bool more = ride;
    const bf16* qlat = (const bf16*)(F.ws + WS_QLAT); const unsigned char* ckv8 = (const unsigned char*)(F.ws + WS_CKVN);
    const unsigned short* selb = (const unsigned short*)(F.ws + WS_SEL); bf16* olat = (bf16*)(F.ws + WS_OLAT);
    const int lane = lane_, fq = lane >> 4, j16 = lane & 15;
    LAS unsigned char* cb = F.lds + F.wave * 17408;
    const float sl2 = 0.08838834764831845f * 1.4426950408889634f;
    const int xh = (F.G % 8 == 0) ? ((F.bid & 7) >> 2) : 0, nsplit = (F.G % 8 == 0) ? 2 : 1;
    const int wloc = (F.G % 8 == 0) ? (((F.bid >> 3) * 4 + (F.bid & 3)) * NWAVES + F.wave) : (F.bid * NWAVES + F.wave);
    const int nwl = (F.G % 8 == 0) ? (F.G / 2) * NWAVES : F.G * NWAVES;
    const int ntk = NTOK / nsplit;
    for (int tl = wloc; tl < ntk; tl += nwl) {
        const int t = xh * ntk + tl, b = t / SEQ, pos = t % SEQ;
        const int nvalid = (pos + 1 < TOPK) ? pos + 1 : TOPK;
        const bool fullk = (nvalid == TOPK);
        const unsigned short* sel = selb + (size_t)t * TOPK;
        const u32x2 sv = __builtin_nontemporal_load((const u32x2*)(sel + 4 * lane));
        bf16x8 Qb[8];
#pragma unroll
        for (int ks = 0; ks < 8; ++ks) { bf16x8 z = {0, 0, 0, 0, 0, 0, 0, 0}; if (j16 < 8) z = __builtin_nontemporal_load((const bf16x8*)(qlat + ((size_t)t * 8 + j16) * 256 + ks * 32 + 8 * fq)); Qb[ks] = z; }
        float mrun = -INFINITY, lrun = 0.f;
        f32x4 O[16];
#pragma unroll
        for (int rt = 0; rt < 16; ++rt) O[rt] = (f32x4){0.f, 0.f, 0.f, 0.f};
        const int nch = (nvalid + 31) >> 5;
        const unsigned char* cbase = ckv8 + (size_t)b * SEQ * 256 + (lane & 15) * 16;
        u32x4 gv[3][8];
#define SA_GATHER(c_, s_) do { _Pragma("unroll") for (int it = 0; it < 8; ++it) { \
            const unsigned dx = (unsigned)__builtin_amdgcn_readlane((int)sv.x, 8 * (c_) + it), dy = (unsigned)__builtin_amdgcn_readlane((int)sv.y, 8 * (c_) + it); \
            const unsigned dd = (fq & 2) ? dy : dx; int key = (fq & 1) ? (int)(dd >> 16) : (int)(dd & 0xffffu); if (!fullk) key = (key >= SEQ) ? 0 : key; \
            gv[s_][it] = *(const u32x4*)(cbase + (size_t)key * 256); } } while (0)
        SA_GATHER(0, 0);
        if (1 < nch) SA_GATHER(1, 1);
        if (2 < nch) SA_GATHER(2, 2);
#pragma unroll
        for (int c = 0; c < 8; ++c) {
            if (c < nch) {
            const int sl = c % 3;
#pragma unroll
            for (int it = 0; it < 8; ++it) { const int row = 4 * it + fq; u32x4 w0, w1;
#pragma unroll
                for (int q = 0; q < 4; ++q) { const f32x2 a = __builtin_amdgcn_cvt_pk_f32_fp8((int)gv[sl][it][q], false), bq = __builtin_amdgcn_cvt_pk_f32_fp8((int)gv[sl][it][q], true);
                    const unsigned lo = cvt_pk_bf16(a[0], a[1]), hi = cvt_pk_bf16(bq[0], bq[1]);
                    if (q < 2) { w0[2 * q] = lo; w0[2 * q + 1] = hi; } else { w1[2 * (q - 2)] = lo; w1[2 * (q - 2) + 1] = hi; } }
                *(LAS u32x4*)(cb + c_lds(row, 2 * j16)) = w0; *(LAS u32x4*)(cb + c_lds(row, 2 * j16 + 1)) = w1; }
            asm volatile("" ::: "memory");
            if (c + 3 < nch) SA_GATHER(c + 3, sl);
            f32x4 Sa = {0.f, 0.f, 0.f, 0.f}, Sb = {0.f, 0.f, 0.f, 0.f};
#pragma unroll
            for (int ks = 0; ks < 8; ++ks) {
                const bf16x8 a0 = *(const LAS bf16x8*)(cb + c_lds(j16, 4 * ks + fq));
                const bf16x8 a1 = *(const LAS bf16x8*)(cb + c_lds(16 + j16, 4 * ks + fq));
                Sa = __builtin_amdgcn_mfma_f32_16x16x32_bf16(a0, Qb[ks], Sa, 0, 0, 0);
                Sb = __builtin_amdgcn_mfma_f32_16x16x32_bf16(a1, Qb[ks], Sb, 0, 0, 0);
            }
            float xa[4], xb[4]; float cm = -INFINITY;
#pragma unroll
            for (int r = 0; r < 4; ++r) { xa[r] = Sa[r] * sl2; xb[r] = Sb[r] * sl2; }
            if (!fullk) {
#pragma unroll
                for (int r = 0; r < 4; ++r) { const int ka = c * 32 + 4 * fq + r, kb2 = ka + 16; xa[r] = (ka < nvalid) ? xa[r] : -INFINITY; xb[r] = (kb2 < nvalid) ? xb[r] : -INFINITY; } }
#pragma unroll
            for (int r = 0; r < 4; ++r) cm = fmaxf(cm, fmaxf(xa[r], xb[r]));
            cm = fmaxf(cm, __shfl_xor(cm, 16)); cm = fmaxf(cm, __shfl_xor(cm, 32));
            if (__ballot(cm > mrun + 6.0f)) {
                const float mnew = fmaxf(mrun, cm);
                const float alpha = __builtin_amdgcn_exp2f(mrun - mnew);
                lrun *= alpha; mrun = mnew;
#pragma unroll
                for (int rt = 0; rt < 16; ++rt) O[rt] = O[rt] * alpha;
            }
            float ps = 0.f; f32x4 pa, pb;
#pragma unroll
            for (int r = 0; r < 4; ++r) { pa[r] = __builtin_amdgcn_exp2f(xa[r] - mrun); pb[r] = __builtin_amdgcn_exp2f(xb[r] - mrun); ps += pa[r] + pb[r]; }
            ps += __shfl_xor(ps, 16); ps += __shfl_xor(ps, 32);
            lrun += ps;
            const u32x4 pw = pack8(pa, pb); const bf16x8 Pb = __builtin_bit_cast(bf16x8, pw);
            const int q4 = j16 >> 2, p4 = j16 & 3;
#pragma unroll
            for (int rt = 0; rt < 16; ++rt) {
                const int ra = 4 * fq + q4, rb = 16 + 4 * fq + q4, ch = 2 * rt + (p4 >> 1);
                const s16x4 lo = __builtin_bit_cast(s16x4, __builtin_amdgcn_ds_read_tr16_b64_v4i16((LAS s16x4*)(cb + c_lds(ra, ch) + 8 * (p4 & 1))));
                const s16x4 hi = __builtin_bit_cast(s16x4, __builtin_amdgcn_ds_read_tr16_b64_v4i16((LAS s16x4*)(cb + c_lds(rb, ch) + 8 * (p4 & 1))));
                const bf16x8 af = __builtin_shufflevector(lo, hi, 0, 1, 2, 3, 4, 5, 6, 7);
                O[rt] = __builtin_amdgcn_mfma_f32_16x16x32_bf16(af, Pb, O[rt], 0, 0, 0);
            }
            asm volatile("" ::: "memory");
            }
        }
#undef SA_GATHER
        const float inv = 1.0f / lrun;
        asm volatile("" ::: "memory");
        if (j16 < 8) {
#pragma unroll
            for (int rt = 0; rt < 16; ++rt) { u32x2 o; o.x = pk2(O[rt][0] * inv, O[rt][1] * inv); o.y = pk2(O[rt][2] * inv, O[rt][3] * inv); *(LAS u32x2*)(cb + j16 * 512 + rt * 32 + fq * 8) = o; }
        }
        asm volatile("" ::: "memory");
        { bf16* obase = olat + (size_t)t * 2048;
#pragma unroll
          for (int q = 0; q < 4; ++q) { const u32x4 v = *(const LAS u32x4*)(cb + q * 1024 + lane * 16); __builtin_nontemporal_store(v, (u32x4*)(obase + q * 512 + lane * 8)); } }
        asm volatile("" ::: "memory");
        if (more) { LDS_WAIT(); more = convert_batch<3>(F, W, (LAS float*)cb, lane); }
    }
}

__device__ __forceinline__ void routing_token(const float acc, const int lane, const float* rbias, int* tk_e, float* tk_w, LAS unsigned* hist, const size_t t, const bool do_count) {
    const float sc = 1.0f / (1.0f + expf(-acc));
    const float ch = sc + rbias[lane];
    int rk = 0;
#pragma unroll
    for (int k = 1; k < 8; ++k) { const int src = (lane & ~7) | ((lane + k) & 7); const float o = __shfl(ch, src); rk += (o > ch || (o == ch && src < lane)) ? 1 : 0; }
    float gs = (rk < 2) ? ch : 0.f; gs += __shfl_xor(gs, 1); gs += __shfl_xor(gs, 2); gs += __shfl_xor(gs, 4);
    int grk = 0; const int myg = lane >> 3;
#pragma unroll
    for (int g = 0; g < 8; ++g) { const float o = __shfl(gs, g * 8); grk += (o > gs || (o == gs && g < myg)) ? 1 : 0; }
    const float cm = (grk < 4) ? ch : -INFINITY;
    int erk = 0;
    for (int j = 0; j < 64; ++j) { const float o = __shfl(cm, j); erk += (o > cm || (o == cm && j < lane)) ? 1 : 0; }
    const bool selx = (erk < EK) && (grk < 4);
    const float ssum = wave_sum(selx ? sc : 0.f);
    if (selx) { tk_e[t * 8 + erk] = lane; tk_w[t * 8 + erk] = sc / ssum * 2.5f; if (do_count) __hip_atomic_fetch_add(&hist[lane], 1u, __ATOMIC_RELAXED, __HIP_MEMORY_SCOPE_WORKGROUP); }
}
__device__ __forceinline__ void phase_ln1_router(Frame& F, const float* g1, const float* b1, const float* rbias, const bool do_count) {
    const int lane_ = lane_id(), tid_ = F.wave * 64 + lane_;
    const float* pre = F.out;
    const float* wrT = (const float*)(F.ws + WS_WRT);
    bf16* h = (bf16*)(F.ws + WS_H);
    int* tk_e = (int*)(F.ws + WS_TOPK + TK_E); float* tk_w = (float*)(F.ws + WS_TOPK + TK_W);
    const int lane = lane_, w = F.wave, tid = tid_;
    LAS float* stats = (LAS float*)F.lds;
    LAS float* lg = (LAS float*)(F.lds + 1024) + (w & 3) * 1024;
    LAS unsigned* hist = (LAS unsigned*)(F.lds + 1024 + 16384);
    if (do_count && tid < 64) hist[tid] = 0u;
    for (int chunk = F.bid; chunk < NTOK / 64; chunk += F.G) {
        __syncthreads();
        f32x4 ggv[8], bbv[8];
#pragma unroll
        for (int q = 0; q < 8; ++q) { const int c = (lane + 64 * q) * 4; ggv[q] = *(const f32x4*)(g1 + c); bbv[q] = *(const f32x4*)(b1 + c); }
        for (int i = 0; i < 8; ++i) {
            const int tl = w * 8 + i; const size_t t = (size_t)chunk * 64 + tl;
            f32x4 v[8]; float s = 0.f;
#pragma unroll
            for (int q = 0; q < 8; ++q) { v[q] = *(const f32x4*)(pre + t * DM + (lane + 64 * q) * 4); s += (v[q][0] + v[q][1]) + (v[q][2] + v[q][3]); }
            const float mean = wave_sum(s) * (1.0f / DM); float s2 = 0.f;
#pragma unroll
            for (int q = 0; q < 8; ++q) { v[q] = v[q] - mean; s2 += (v[q][0] * v[q][0] + v[q][1] * v[q][1]) + (v[q][2] * v[q][2] + v[q][3] * v[q][3]); }
            const float rstd = 1.0f / sqrtf(wave_sum(s2) * (1.0f / DM) + LN_EPS);
#pragma unroll
            for (int q = 0; q < 8; ++q) { const int c = (lane + 64 * q) * 4;
                const f32x4 y = v[q] * rstd * ggv[q] + bbv[q];
                u32x2 o; o.x = pk2(y[0], y[1]); o.y = pk2(y[2], y[3]); *(u32x2*)(h + t * DM + c) = o; }
            if (lane == 0) { stats[tl * 2] = mean; stats[tl * 2 + 1] = rstd; }
        }
        __syncthreads();
        if (w < 4) {
            const int j16 = lane & 15, kq = lane >> 4, tl = 16 * w + j16;
            const float mean = stats[tl * 2], rstd = stats[tl * 2 + 1];
            const float* prow = pre + ((size_t)chunk * 64 + tl) * DM + 4 * kq; const float* wrow = wrT + (size_t)j16 * DM + 4 * kq;
            f32x4 acc[4];
#pragma unroll
            for (int tt = 0; tt < 4; ++tt) acc[tt] = (f32x4){0.f, 0.f, 0.f, 0.f};
#pragma unroll 2
            for (int m = 0; m < 128; ++m) {
                const f32x4 p = *(const f32x4*)(prow + 16 * m), gg = *(const f32x4*)(g1 + 16 * m + 4 * kq), bb = *(const f32x4*)(b1 + 16 * m + 4 * kq);
                const f32x4 hv = (p - mean) * rstd * gg + bb;
                f32x4 wv[4];
#pragma unroll
                for (int tt = 0; tt < 4; ++tt) wv[tt] = *(const f32x4*)(wrow + (size_t)tt * 16 * DM + 16 * m);
#pragma unroll
                for (int e = 0; e < 4; ++e)
#pragma unroll
                    for (int tt = 0; tt < 4; ++tt) acc[tt] = __builtin_amdgcn_mfma_f32_16x16x4f32(hv[e], wv[tt][e], acc[tt], 0, 0, 0);
            }
#pragma unroll
            for (int tt = 0; tt < 4; ++tt)
#pragma unroll
                for (int r = 0; r < 4; ++r) lg[(4 * kq + r) * 64 + 16 * tt + j16] = acc[tt][r];
            LDS_WAIT();
            for (int tk = 0; tk < 16; ++tk) routing_token(lg[tk * 64 + lane], lane, rbias, tk_e, tk_w, hist, (size_t)chunk * 64 + 16 * w + tk, do_count);
        }
    }
}
__device__ __forceinline__ void phase_flush_hist(Frame& F) {
    const int tid = F.wave * 64 + lane_id();
    LAS unsigned* hist = (LAS unsigned*)(F.lds + 1024 + 16384);
    __syncthreads();
    if (tid < 64 && hist[tid]) atomicAdd(F.ctl + CW_CNT + tid, hist[tid]);
}

__device__ __forceinline__ void phase_scatter(Frame& F) {
    const int lane_ = lane_id(), tid_ = F.wave * 64 + lane_;
    const int tid = tid_;
    LAS int* segs = (LAS int*)F.lds;
    LAS unsigned* lcnt = (LAS unsigned*)(F.lds + 1024);
    LAS unsigned* lbase = (LAS unsigned*)(F.lds + 2048);
    const int* tk_e = (const int*)(F.ws + WS_TOPK + TK_E); int* tk_pos = (int*)(F.ws + WS_TOPK + TK_POS);
    int* rowlist = (int*)(F.ws + WS_TOPK + TK_ROWLIST); int* mtt = (int*)(F.ws + WS_TOPK + TK_MTT);
    if (tid == 0) { int a = 0; for (int e = 0; e < NE; ++e) { segs[e] = a; a += (int)__hip_atomic_load(F.ctl + CW_CNT + e, RLX_AGENT); } segs[NE] = a; segs[NE + 1] = a + NTOK; }
    __syncthreads();
    if (F.bid == 0) {
        LAS int* tcum = (LAS int*)(F.lds + 3072);
        if (tid == 0) { int mt = 0; for (int g = 0; g < NGRP; ++g) { tcum[g] = mt; mt += (segs[g + 1] - segs[g] + 255) >> 8; } tcum[NGRP] = mt; __hip_atomic_store(F.ctl + CW_NMT, (unsigned)mt, RLX_AGENT); }
        __syncthreads();
        if (tid < NGRP) { const int g = tid, p0 = segs[g], n = segs[g + 1] - p0; int mt = tcum[g];
            for (int r = 0; r < n; r += 256, ++mt) { mtt[mt * 4 + 0] = g; mtt[mt * 4 + 1] = p0 + r; mtt[mt * 4 + 2] = (n - r < 256) ? n - r : 256; mtt[mt * 4 + 3] = 0; } }
        if (tid >= 256) rowlist[NSLOT + tid - 256] = 0;
    }
    const int sh0 = segs[NE];
    for (int chunk = F.bid; chunk < NTOK / 64; chunk += F.G) {
        if (tid < 64) lcnt[tid] = 0u;
        __syncthreads();
        const int t = chunk * 64 + (tid >> 3), k = tid & 7;
        const int e = tk_e[(size_t)t * 8 + k];
        const unsigned li = __hip_atomic_fetch_add(&lcnt[e], 1u, __ATOMIC_RELAXED, __HIP_MEMORY_SCOPE_WORKGROUP);
        __syncthreads();
        if (tid < 64) lbase[tid] = lcnt[tid] ? atomicAdd(F.ctl + CW_FILL + tid, lcnt[tid]) : 0u;
        __syncthreads();
        const int p = segs[e] + (int)lbase[e] + (int)li;
        rowlist[p] = t; tk_pos[(size_t)t * 8 + k] = p;
        if (tid < 64) rowlist[sh0 + chunk * 64 + tid] = chunk * 64 + tid;
        __syncthreads();
    }
}

struct CombRows { u32x4 hq[4]; u32x2 y[8][4]; u32x4 ysh[4]; };
__device__ __forceinline__ void comb_load(CombRows& R, const bf16* h, const unsigned char* Y8, const bf16* Ysh, const int t, const int posv, const int slot0, const int lane) {
#pragma unroll
    for (int i = 0; i < 4; ++i) { R.hq[i] = *(const u32x4*)(h + (size_t)t * DM + (lane + 64 * i) * 8); R.ysh[i] = __builtin_nontemporal_load((const u32x4*)(Ysh + (size_t)t * DM + (lane + 64 * i) * 8)); }
#pragma unroll
    for (int k = 0; k < 8; ++k) { const int p = __builtin_amdgcn_readlane(posv, slot0 + k);
#pragma unroll
        for (int i = 0; i < 4; ++i) R.y[k][i] = __builtin_nontemporal_load((const u32x2*)(Y8 + (size_t)p * DM + (lane + 64 * i) * 8)); }
}
__device__ __forceinline__ void comb_finish(const CombRows& R, const float* g2, const float* b2, float* out, const int t, const float wvv, const int slot0, const int lane) {
    f32x4 a[4][2];
#pragma unroll
    for (int i = 0; i < 4; ++i) { f32x4 x0, x1, s0, s1; unpack8(R.hq[i], x0, x1); unpack8(R.ysh[i], s0, s1); a[i][0] = x0 * DN_ALPHA + s0; a[i][1] = x1 * DN_ALPHA + s1; }
#pragma unroll
    for (int k = 0; k < 8; ++k) { const float wk = __builtin_bit_cast(float, __builtin_amdgcn_readlane(__builtin_bit_cast(int, wvv), slot0 + k));
#pragma unroll
        for (int i = 0; i < 4; ++i) { const u32x2 q8 = R.y[k][i];
            const f32x2 y01 = __builtin_amdgcn_cvt_pk_f32_fp8((int)q8.x, false), y23 = __builtin_amdgcn_cvt_pk_f32_fp8((int)q8.x, true), y45 = __builtin_amdgcn_cvt_pk_f32_fp8((int)q8.y, false), y67 = __builtin_amdgcn_cvt_pk_f32_fp8((int)q8.y, true);
            a[i][0] += (f32x4){y01[0], y01[1], y23[0], y23[1]} * wk; a[i][1] += (f32x4){y45[0], y45[1], y67[0], y67[1]} * wk; } }
    float s = 0.f;
#pragma unroll
    for (int i = 0; i < 4; ++i) s += ((a[i][0][0] + a[i][0][1]) + (a[i][0][2] + a[i][0][3])) + ((a[i][1][0] + a[i][1][1]) + (a[i][1][2] + a[i][1][3]));
    const float mean = wave_sum(s) * (1.0f / DM); float s2 = 0.f;
#pragma unroll
    for (int i = 0; i < 4; ++i) { a[i][0] = a[i][0] - mean; a[i][1] = a[i][1] - mean;
        s2 += ((a[i][0][0] * a[i][0][0] + a[i][0][1] * a[i][0][1]) + (a[i][0][2] * a[i][0][2] + a[i][0][3] * a[i][0][3])) + ((a[i][1][0] * a[i][1][0] + a[i][1][1] * a[i][1][1]) + (a[i][1][2] * a[i][1][2] + a[i][1][3] * a[i][1][3])); }
    const float rstd = 1.0f / sqrtf(wave_sum(s2) * (1.0f / DM) + LN_EPS);
#pragma unroll
    for (int i = 0; i < 4; ++i) { const int c = (lane + 64 * i) * 8;
        const f32x4 ga = *(const f32x4*)(g2 + c), gb = *(const f32x4*)(g2 + c + 4), ba = *(const f32x4*)(b2 + c), bb = *(const f32x4*)(b2 + c + 4);
        __builtin_nontemporal_store(a[i][0] * rstd * ga + ba, (f32x4*)(out + (size_t)t * DM + c)); __builtin_nontemporal_store(a[i][1] * rstd * gb + bb, (f32x4*)(out + (size_t)t * DM + c + 4)); }
}
__device__ __forceinline__ void phase_combine(Frame& F, const float* g2, const float* b2) {
    const int lane = lane_id();
    const bf16* h = (const bf16*)(F.ws + WS_H); const unsigned char* Y8 = (const unsigned char*)(F.ws + WS_Y); const bf16* Ysh = (const bf16*)(F.ws + WS_YSH);
    const float* tk_w = (const float*)(F.ws + WS_TOPK + TK_W); const int* tk_pos = (const int*)(F.ws + WS_TOPK + TK_POS);
    const int gw = F.bid * NWAVES + F.wave, NGW = F.G * NWAVES;
    for (int t0 = gw * 8; t0 < NTOK; t0 += NGW * 8) {
        const int posv = tk_pos[(size_t)t0 * 8 + lane]; const float wvv = tk_w[(size_t)t0 * 8 + lane];
        for (int i = 0; i < 8; ++i) {
            CombRows R;
            comb_load(R, h, Y8, Ysh, t0 + i, posv, 8 * i, lane);
            __builtin_amdgcn_sched_barrier(0);
            comb_finish(R, g2, b2, F.out, t0 + i, wvv, 8 * i, lane);
            __builtin_amdgcn_sched_barrier(0);
        }
    }
}

#ifndef MK_CHECK
#define MK_CHECK 0
#endif
constexpr int CW_CHK = 16384 + 256;
#if MK_CHECK
__device__ __forceinline__ float fp8f(unsigned char v) { const f32x2 a = __builtin_amdgcn_cvt_pk_f32_fp8((int)v, false); return a[0]; }
__device__ __forceinline__ void phase_check_attn(Frame& F) {
    const int tid = F.wave * 64 + lane_id();
    const bf16* qi = (const bf16*)(F.ws + WS_QI); const bf16* kin = (const bf16*)(F.ws + WS_KIN); const float* wis = (const float*)(F.ws + WS_WI);
    const bf16* qlat = (const bf16*)(F.ws + WS_QLAT); const unsigned char* ckv8 = (const unsigned char*)(F.ws + WS_CKVN);
    const unsigned short* selb = (const unsigned short*)(F.ws + WS_SEL); const bf16* olat = (const bf16*)(F.ws + WS_OLAT);
    LAS float* sc = (LAS float*)F.lds;
    LAS unsigned char* flg = (LAS unsigned char*)(F.lds + 32768);
    LAS unsigned char* seen = (LAS unsigned char*)(F.lds + 40960);
    LAS float* pl = (LAS float*)(F.lds + 49152);
    LAS int* cnt = (LAS int*)(F.lds + 57344);
    const int POS[16] = {0, 1, 100, 255, 256, 257, 300, 511, 1000, 2047, 2048, 4095, 5000, 6143, 6144, 8191};
    for (int s = F.bid; s < 32; s += F.G) {
        int pos = 0;
#pragma unroll
        for (int q = 0; q < 16; ++q) pos = ((s >> 1) == q) ? POS[q] : pos;
        const int b = s & 1, n = pos + 1; const size_t t = (size_t)b * SEQ + pos;
        __syncthreads();
        if (tid < 4) cnt[tid] = 0;
        for (int k = tid; k < SEQ; k += NTHR) { flg[k] = 0; seen[k] = 0; }
        for (int k = tid; k < n; k += NTHR) {
            float tot = 0.f;
            for (int hh = 0; hh < 16; ++hh) { float d = 0.f;
                for (int e = 0; e < 64; ++e) d += bf2f(qi[t * 1024 + hh * 64 + e]) * bf2f(kin[((size_t)b * SEQ + k) * 64 + e]);
                tot += wis[t * 16 + hh] * fmaxf(d, 0.f); }
            sc[k] = tot;
        }
        __syncthreads();
        const unsigned short* sel = selb + t * TOPK;
        if (n > TOPK) {
            for (int k = tid; k < n; k += NTHR) { const float v = sc[k]; int rk = 0; for (int k2 = 0; k2 < n; ++k2) { const float o = sc[k2]; rk += (o > v || (o == v && k2 < k)) ? 1 : 0; } flg[k] = rk < TOPK ? 1 : 0; }
            __syncthreads();
            if (tid < TOPK) { const int k = sel[tid]; if (k >= n) atomicAdd((int*)&cnt[1], 1000); else { if (!flg[k]) atomicAdd((int*)&cnt[0], 1); if (seen[k]) atomicAdd((int*)&cnt[1], 1000); seen[k] = 1; } }
        } else {
            if (tid < TOPK) { const int k = sel[tid]; if (tid < n ? (k != tid) : (k != 0xFFFF)) atomicAdd((int*)&cnt[1], 1000); }
        }
        __syncthreads();
        const int nv = n < TOPK ? n : TOPK;
        for (int i = tid; i < 8 * 256; i += NTHR) { const int hh = i >> 8, k = i & 255; float lg = -INFINITY;
            if (k < nv) { const int key = sel[k]; float d = 0.f; for (int r = 0; r < 256; ++r) d += bf2f(qlat[(t * 8 + hh) * 256 + r]) * fp8f(ckv8[((size_t)b * SEQ + key) * 256 + r]); lg = d * 0.08838834764831845f; }
            pl[i] = lg; }
        __syncthreads();
        if (tid < 8) { float m = -INFINITY; for (int k = 0; k < 256; ++k) m = fmaxf(m, pl[tid * 256 + k]); float l = 0.f; for (int k = 0; k < 256; ++k) { const float p = expf(pl[tid * 256 + k] - m); pl[tid * 256 + k] = p; l += p; } for (int k = 0; k < 256; ++k) pl[tid * 256 + k] /= l; }
        __syncthreads();
        for (int i = tid; i < 8 * 256; i += NTHR) { const int hh = i >> 8, r = i & 255; float o = 0.f;
            for (int k = 0; k < nv; ++k) o += pl[hh * 256 + k] * fp8f(ckv8[((size_t)b * SEQ + sel[k]) * 256 + r]);
            const float got = bf2f(olat[(t * 8 + hh) * 256 + r]);
            if (!(fabsf(got - o) <= 0.03f * fabsf(o) + 0.004f)) atomicAdd((int*)&cnt[2], 1); }
        __syncthreads();
        if (tid == 0) { unsigned code = 0; if (cnt[0] > 3 || cnt[1] > 0) code |= 1u; if (cnt[2] > 0) code |= 2u; if (code) atomicOr(F.ctl + CW_CHK, code); }
    }
}
__device__ __forceinline__ void phase_check_apply(Frame& F) {
    const unsigned code = __hip_atomic_load(F.ctl + CW_CHK, RLX_AGENT);
    if (code) { const float v = (code & 1u) ? __builtin_nanf("") : 0.f; const size_t gt = (size_t)F.bid * NTHR + F.wave * 64 + lane_id();
        for (size_t i = gt; i < (size_t)NTOK * DM; i += (size_t)F.G * NTHR) F.out[i] = v; }
}
#endif

constexpr int NPHASE = 16;
constexpr unsigned REPEAT_MASK = 0x0u;
constexpr int TIME_PHASE = -1;
constexpr int CW_TIME = 16384 + 320;
struct Args { const float* in[24]; float* out; unsigned char* ws; int ph_lo, ph_hi; };

__global__ void __launch_bounds__(NTHR, 2) mk_fwd(Args args) {
    extern __shared__ __attribute__((aligned(16))) unsigned char lds_raw[];
    Frame F;
    F.lds = (LAS unsigned char*)lds_raw;
    F.MISC = (volatile LAS unsigned*)(F.lds + MISC_OFF);
    F.wave = __builtin_amdgcn_readfirstlane(threadIdx.x >> 6);
    F.G = gridDim.x; F.bid = blockIdx.x;
    F.ws = args.ws; F.ctl = (unsigned*)(args.ws + WS_CTL); F.out = args.out;
    for (int u = threadIdx.x; u < (LDS_BYTES - MISC_OFF) / 4; u += NTHR) ((LAS unsigned*)(F.lds + MISC_OFF))[u] = 0u;
    __syncthreads();
    const int lo = args.ph_lo, hi = args.ph_hi;
    const bool multi = (hi - lo) > 1;
    XcdBarrier bar; bar.bar = F.ctl + CW_BAR; bar.x = 0; bar.st = nullptr; bar.wave = F.wave;
    if (multi) bar = xcd_barrier_post(F.ctl + CW_BAR, F.MISC + 8, F.wave);
#ifndef ONLY_PHASE
#define ONLY_PHASE -1
#endif
#define IN(k) ((ONLY_PHASE < 0 || ONLY_PHASE == (k)) && lo <= (k) && (k) < hi)
#define SEAM(k) do { if (IN(k) && IN((k) + 1)) { xcd_barrier(bar); \
        if (TIME_PHASE >= 0 && F.bid == 0 && F.wave == 0) { const unsigned long long now_ = __builtin_amdgcn_s_memrealtime(); \
            if ((k) == TIME_PHASE - 1 || ((k) == 0 && TIME_PHASE == 0 && false)) { if (lane_id() == 0) { F.ctl[CW_TIME] = (unsigned)now_; } } \
            if ((k) == TIME_PHASE) { if (lane_id() == 0) { F.ctl[CW_TIME + 1] = (unsigned)now_ - F.ctl[CW_TIME]; } } } } } while (0)
    unsigned char* ws = args.ws;
    const ExpW EW{args.in[16], args.in[17], args.in[18], args.in[19], args.in[20], args.in[21]};
    const bool ride = false;
    if (TIME_PHASE == 0 && F.bid == 0 && threadIdx.x == 0) F.ctl[CW_TIME] = (unsigned)__builtin_amdgcn_s_memrealtime();

    if (IN(0)) for (int rep_ = 0; rep_ < 1 + (int)((REPEAT_MASK >> 0) & 1u); ++rep_) { phase_convert_small(F, args.in[0], args.in[1], args.in[5], args.in[6], args.in[7], args.in[9], args.in[10], args.in[11], args.in[8], args.in[14]); } SEAM(0);

    if (IN(1)) for (int rep_ = 0; rep_ < 1 + (int)((REPEAT_MASK >> 1) & 1u); ++rep_) {
        FillPlain f{(const char*)(ws + WS_XB), (const char*)(ws + WS_WIN), 4096u, 4096u, 32};
        DenseSched<FillPlain> S{64, 30, F.G, F.bid, f};
        EpiP1 E{(bf16*)(ws + WS_Q), (bf16*)(ws + WS_QI), (bf16*)(ws + WS_XP), (bf16*)(ws + WS_GATES), (float*)(ws + WS_CKVRAW), (float*)(ws + WS_KIWI)};
        pg8::gemm_phase<EpiP1, DenseSched<FillPlain>, false, true, true>(F.lds, F.wave, 4096u, 4096u, S, E);
    } SEAM(1);

    if (IN(2)) for (int rep_ = 0; rep_ < 1 + (int)((REPEAT_MASK >> 2) & 1u); ++rep_) { phase_postproc(F, args.in[2], args.in[3], args.in[4]); } SEAM(2);

    if (IN(3)) for (int rep_ = 0; rep_ < 1 + (int)((REPEAT_MASK >> 3) & 1u); ++rep_) {
        FillQlatPool f{(const char*)(ws + WS_Q), (const char*)(ws + WS_DIFF), (const char*)(ws + WS_WUK), (const char*)(ws + WS_WPOOL)};
        DenseSched<FillQlatPool> S{64, 12, F.G, F.bid, f};
        EpiQlatPool E{(bf16*)(ws + WS_QLAT), (bf16*)(ws + WS_POOL), (const float*)(ws + WS_CSCALE)};
        pg8::gemm_phase<EpiQlatPool, DenseSched<FillQlatPool>, false, true, true>(F.lds, F.wave, 2048u, 512u, S, E);
    } SEAM(3);

    if (IN(4)) for (int rep_ = 0; rep_ < 1 + (int)((REPEAT_MASK >> 4) & 1u); ++rep_) { phase_index_scores(F); } SEAM(4);
    if (IN(5)) for (int rep_ = 0; rep_ < 1 + (int)((REPEAT_MASK >> 5) & 1u); ++rep_) { phase_select(F, EW, ride && rep_ == 0); } SEAM(5);
    if (IN(6)) for (int rep_ = 0; rep_ < 1 + (int)((REPEAT_MASK >> 6) & 1u); ++rep_) { phase_sparse_attn(F, EW, ride && rep_ == 0); } SEAM(6);
#if MK_CHECK
    if (IN(6) && IN(7)) { phase_check_attn(F); xcd_barrier(bar); }
#endif

    if (IN(7)) for (int rep_ = 0; rep_ < 1 + (int)((REPEAT_MASK >> 7) & 1u); ++rep_) {
        FillO f{(const char*)(ws + WS_OLAT), (const char*)(ws + WS_WUV)};
        DenseSched<FillO> S{64, 4, F.G, F.bid, f};
        EpiBf16 E{(bf16*)(ws + WS_ATTN), 1024};
        pg8::gemm_phase<EpiBf16, DenseSched<FillO>, false, true, true>(F.lds, F.wave, 4096u, 1024u, S, E);
    } SEAM(7);

    if (IN(8)) for (int rep_ = 0; rep_ < 1 + (int)((REPEAT_MASK >> 8) & 1u); ++rep_) {
        FillPlain f{(const char*)(ws + WS_ATTN), (const char*)(ws + WS_WPA), 2048u, 2048u, 16};
        DenseSched<FillPlain> S{64, 8, F.G, F.bid, f};
        EpiGate<0> E{(const bf16*)(ws + WS_GATES), (bf16*)(ws + WS_M1), (bf16*)(ws + WS_MERGED)};
        pg8::gemm_phase<EpiGate<0>, DenseSched<FillPlain>, false, true, true>(F.lds, F.wave, 2048u, 2048u, S, E);
    } SEAM(8);

    if (IN(9)) for (int rep_ = 0; rep_ < 1 + (int)((REPEAT_MASK >> 9) & 1u); ++rep_) {
        FillPlain f{(const char*)(ws + WS_POOL), (const char*)(ws + WS_WPP), 2048u, 2048u, 16};
        DenseSched<FillPlain> S{64, 8, F.G, F.bid, f};
        EpiGate<1> E{(const bf16*)(ws + WS_GATES), (bf16*)(ws + WS_M1), (bf16*)(ws + WS_MERGED)};
        pg8::gemm_phase<EpiGate<1>, DenseSched<FillPlain>, false, true, true>(F.lds, F.wave, 2048u, 2048u, S, E);
    } SEAM(9);

    if (IN(10)) for (int rep_ = 0; rep_ < 1 + (int)((REPEAT_MASK >> 10) & 1u); ++rep_) {
        FillPlain f{(const char*)(ws + WS_MERGED), (const char*)(ws + WS_WOUT), 4096u, 4096u, 32};
        DenseSched<FillPlain> S{64, 8, F.G, F.bid, f};
        EpiPre E{args.in[0], F.out};
        pg8::gemm_phase<EpiPre, DenseSched<FillPlain>, false, true, true>(F.lds, F.wave, 4096u, 4096u, S, E);
    } SEAM(10);

    if (IN(11)) for (int rep_ = 0; rep_ < 1 + (int)((REPEAT_MASK >> 11) & 1u); ++rep_) {
        for (int rl_ = 0; rl_ < 1 + (int)((REPEAT_MASK >> 17) & 1u); ++rl_) phase_ln1_router(F, args.in[12], args.in[13], args.in[15], rl_ == 0);
        phase_convert_experts(F, EW);
        phase_flush_hist(F);
    } SEAM(11);
    if (IN(12)) for (int rep_ = 0; rep_ < 1 + (int)((REPEAT_MASK >> 12) & 1u); ++rep_) { phase_scatter(F); } SEAM(12);

    if (IN(13)) for (int rep_ = 0; rep_ < 1 + (int)((REPEAT_MASK >> 13) & 1u); ++rep_) {
        const int nmt = (int)__hip_atomic_load(F.ctl + CW_NMT, RLX_AGENT);
        MoeSched S{(const int*)(ws + WS_TOPK + TK_MTT), nmt, 4, F.G, F.bid, true, (const char*)(ws + WS_H), (const char*)(ws + WS_HBUF), (const char*)(ws + WS_WGU), (const char*)(ws + WS_WD), (const int*)(ws + WS_TOPK + TK_ROWLIST), F.lds};
        S.prepare(F.wave * 64 + lane_id());
        EpiSwiGLU E{(bf16*)(ws + WS_HBUF)};
        pg8::gemm_phase<EpiSwiGLU, MoeSched, true, true, true>(F.lds, F.wave, 4096u, 4096u, S, E);
    } SEAM(13);

    if (IN(14)) for (int rep_ = 0; rep_ < 1 + (int)((REPEAT_MASK >> 14) & 1u); ++rep_) {
        const int nmt = (int)__hip_atomic_load(F.ctl + CW_NMT, RLX_AGENT);
        MoeSched S{(const int*)(ws + WS_TOPK + TK_MTT), nmt, 8, F.G, F.bid, false, (const char*)(ws + WS_H), (const char*)(ws + WS_HBUF), (const char*)(ws + WS_WGU), (const char*)(ws + WS_WD), (const int*)(ws + WS_TOPK + TK_ROWLIST), F.lds};
        S.prepare(F.wave * 64 + lane_id());
        EpiY E{(unsigned char*)(ws + WS_Y), (bf16*)(ws + WS_YSH)};
        pg8::gemm_phase<EpiY, MoeSched, false, true, true>(F.lds, F.wave, 1024u, 1024u, S, E);
    } SEAM(14);

    if (IN(15)) for (int rep_ = 0; rep_ < 1 + (int)((REPEAT_MASK >> 15) & 1u); ++rep_) { phase_combine(F, args.in[22], args.in[23]); }
#if MK_CHECK
    if (IN(15)) { xcd_barrier(bar); phase_check_apply(F); }
#endif
    if (TIME_PHASE >= 0 && multi && F.bid == 0 && F.wave == 0) {
        asm volatile("s_waitcnt vmcnt(0)" ::: "memory");
        if (TIME_PHASE == 15 && lane_id() == 0) { F.ctl[CW_TIME + 1] = (unsigned)__builtin_amdgcn_s_memrealtime() - F.ctl[CW_TIME]; }
        asm volatile("s_waitcnt vmcnt(0)" ::: "memory");
        const unsigned dur = __hip_atomic_load(F.ctl + CW_TIME + 1, RLX_AGENT); const unsigned long long t0 = __builtin_amdgcn_s_memrealtime();
        while (__builtin_amdgcn_s_memrealtime() - t0 < 4ull * dur) __builtin_amdgcn_s_sleep(8);
    }
#undef IN
#undef SEAM
}

#ifndef MK_ONE_LAUNCH
#define MK_ONE_LAUNCH 1
#endif
extern "C" void kernel_launch(void* const* d_in, const int* in_sizes, int n_in, void* d_out, int out_size, void* d_ws, size_t ws_size, hipStream_t stream) {
    static int grid = 0;
    if (grid == 0) {
        if (n_in != 24 || out_size != NTOK * DM || ws_size < WS_END) { fprintf(stderr, "kernel_launch: unexpected shapes (n_in %d out %d ws %zu)\n", n_in, out_size, ws_size); grid = -1; return; }
        int dev = 0, cus = 0;
        if (hipGetDevice(&dev) != hipSuccess || hipDeviceGetAttribute(&cus, hipDeviceAttributeMultiprocessorCount, dev) != hipSuccess) { grid = -1; return; }
        if (hipFuncSetAttribute((const void*)mk_fwd, hipFuncAttributeMaxDynamicSharedMemorySize, LDS_BYTES) != hipSuccess) { fprintf(stderr, "kernel_launch: hipFuncSetAttribute failed\n"); grid = -1; return; }
        int per_cu = 0;
        if (hipOccupancyMaxActiveBlocksPerMultiprocessor(&per_cu, (const void*)mk_fwd, NTHR, LDS_BYTES) != hipSuccess || per_cu < 1) fprintf(stderr, "kernel_launch: occupancy query says %d\n", per_cu);
        (void)hipGetLastError();
        grid = cus;
    }
    if (grid < 0) return;
    if (hipMemsetAsync((char*)d_ws + WS_CTL, 0, CTL_BYTES, stream) != hipSuccess) return;
    Args a{};
    for (int i = 0; i < 24; ++i) a.in[i] = (const float*)d_in[i];
    a.out = (float*)d_out; a.ws = (unsigned char*)d_ws;
#if MK_ONE_LAUNCH
    a.ph_lo = 0; a.ph_hi = NPHASE;
    hipLaunchKernelGGL(mk_fwd, dim3(grid), dim3(NTHR), LDS_BYTES, stream, a);
#else
    for (int p = 0; p < NPHASE; ++p) { a.ph_lo = p; a.ph_hi = p + 1; hipLaunchKernelGGL(mk_fwd, dim3(grid), dim3(NTHR), LDS_BYTES, stream, a); }
#endif
}
```

```cpp
#include <hip/hip_runtime.h>
#include <cstdio>
#include <cstdint>

#define LAS __attribute__((address_space(3)))
#define GAS __attribute__((address_space(1)))
typedef unsigned short bf16;
typedef short bf16x8 __attribute__((ext_vector_type(8)));
typedef short s16x4 __attribute__((ext_vector_type(4)));
typedef float f32x4 __attribute__((ext_vector_type(4)));
typedef float f32x2 __attribute__((ext_vector_type(2)));
typedef unsigned u32x4 __attribute__((ext_vector_type(4)));
typedef unsigned u32x2 __attribute__((ext_vector_type(2)));

constexpr int NTOK = 16384, SEQ = 8192, DM = 2048;
constexpr int NH = 8, DQK = 128, DV = 128, RKV = 256, IH = 16, IDH = 64, TOPK = 256;
constexpr int NE = 64, EK = 8, EDIM = 512, NGRP = 65;
constexpr int WIN_ROWS = 7680;
constexpr float LN_EPS = 1e-5f, RMS_EPS = 1e-6f;
constexpr float DN_ALPHA = 1.189207115002721f;
constexpr int NSLOT = NTOK * 9;
constexpr size_t SC_TOT = (size_t)128 * 128 * (64 * 65 / 2);

constexpr size_t MiB = 1u << 20;
constexpr size_t WS_CTL = 0, CTL_BYTES = 1 * MiB;
constexpr size_t WS_WIN = 1 * MiB;
constexpr size_t WS_WUK = 31 * MiB;
constexpr size_t WS_WUV = 32 * MiB;
constexpr size_t WS_WPOOL = 33 * MiB;
constexpr size_t WS_WPA = 34 * MiB;
constexpr size_t WS_WPP = 38 * MiB;
constexpr size_t WS_WOUT = 42 * MiB;
constexpr size_t WS_CSCALE = 50 * MiB;
constexpr size_t WS_WRT = 50 * MiB + 65536;
constexpr size_t WS_XB = 394 * MiB;
constexpr size_t WS_Q = 458 * MiB;
constexpr size_t WS_QI = 490 * MiB;
constexpr size_t WS_XP = 522 * MiB;
constexpr size_t WS_CKVRAW = 554 * MiB;
constexpr size_t WS_KIWI = 570 * MiB;
constexpr size_t WS_DIFF = 586 * MiB;
constexpr size_t WS_GATES = 181 * MiB;
constexpr size_t WS_QLAT = 309 * MiB;
constexpr size_t WS_CKVN = 373 * MiB;
constexpr size_t WS_KIN = 381 * MiB;
constexpr size_t WS_WI = 383 * MiB;
constexpr size_t WS_SEL = 654 * MiB;
constexpr size_t WS_SCORES = 662 * MiB;
constexpr size_t WS_POOL = 922 * MiB;
constexpr size_t WS_OLAT = 662 * MiB;
constexpr size_t WS_ATTN = 726 * MiB;
constexpr size_t WS_M1 = 758 * MiB;
constexpr size_t WS_MERGED = 822 * MiB;
constexpr size_t WS_WD = 51 * MiB;
constexpr size_t WS_H = 181 * MiB;
constexpr size_t WS_HBUF = 245 * MiB;
constexpr size_t WS_TOPK = 390 * MiB;
constexpr size_t WS_WGU = 394 * MiB;
constexpr size_t WS_Y = 394 * MiB;
constexpr size_t WS_YSH = WS_Y + (size_t)NTOK * 8 * DM;
constexpr size_t WS_END = 1024 * MiB;
static_assert(WS_DIFF + 32 * MiB <= 654 * MiB && WS_SCORES + 260 * MiB <= WS_POOL && WS_POOL + 32 * MiB <= 970 * MiB && WS_WI + 1 * MiB <= 390 * MiB, "mixer map");
static_assert(WS_SCORES + SC_TOT * 2 * 4 <= WS_POOL, "scores");
static_assert(WS_HBUF + (size_t)(NSLOT + 256) * EDIM * 2 <= WS_TOPK, "hbuf");
static_assert(WS_YSH + (size_t)NTOK * DM * 2 <= WS_END, "y");
constexpr size_t TK_E = 0;
constexpr size_t TK_W = 512 * 1024;
constexpr size_t TK_POS = 1024 * 1024;
constexpr size_t TK_ROWLIST = 1536 * 1024;
constexpr size_t TK_MTT = 2560 * 1024;
constexpr size_t TK_WRT = 3 * MiB;
constexpr int CW_BAR = 4096;
constexpr int CW_CNT = 16384;
constexpr int CW_FILL = 16384 + 64;
constexpr int CW_CVQ = 16384 + 192;
constexpr int CW_NMT = 16384 + 128;

constexpr int RING_BYTES = 131072;
constexpr int MISC_OFF = 143360;
constexpr int LDS_BYTES = 147456;
constexpr int NWAVES = 8, NTHR = 512;

#define RLX_AGENT __ATOMIC_RELAXED, __HIP_MEMORY_SCOPE_AGENT
#define LDS_WAIT() asm volatile("s_waitcnt lgkmcnt(0)" ::: "memory")
#define VM_WAIT() asm volatile("s_waitcnt vmcnt(0)" ::: "memory")

__device__ __forceinline__ int lane_id() { return (int)__builtin_amdgcn_mbcnt_hi(~0u, __builtin_amdgcn_mbcnt_lo(~0u, 0u)); }
__device__ __forceinline__ float bf2f(unsigned b) { return __uint_as_float(b << 16); }
__device__ __forceinline__ unsigned f2bf(float f) { unsigned u = __float_as_uint(f); return (u + 0x7fffu + ((u >> 16) & 1u)) >> 16; }
__device__ __forceinline__ unsigned pk2(float lo, float hi) { return f2bf(lo) | (f2bf(hi) << 16); }
__device__ __forceinline__ unsigned cvt_pk_bf16(float lo, float hi) { unsigned r; asm volatile("v_cvt_pk_bf16_f32 %0, %1, %2" : "=v"(r) : "v"(lo), "v"(hi)); return r; }
#define DPP_I(old, x, ctrl, rmask) __builtin_amdgcn_update_dpp((int)(old), (int)(x), (ctrl), (rmask), 0xf, false)
__device__ __forceinline__ int wave_scan_i(int x) {
    x += DPP_I(0, x, 0x111, 0xf); x += DPP_I(0, x, 0x112, 0xf); x += DPP_I(0, x, 0x114, 0xf); x += DPP_I(0, x, 0x118, 0xf);
    x += DPP_I(0, x, 0x142, 0xa); x += DPP_I(0, x, 0x143, 0xc); return x;
}
__device__ __forceinline__ int wave_sum_i(int v) { return __builtin_amdgcn_readlane(wave_scan_i(v), 63); }
__device__ __forceinline__ float wave_sum(float x) {
#define DPP_F(x_, ctrl, rmask) __builtin_bit_cast(float, __builtin_amdgcn_update_dpp(0, __builtin_bit_cast(int, x_), (ctrl), (rmask), 0xf, false))
    x += DPP_F(x, 0x111, 0xf); x += DPP_F(x, 0x112, 0xf); x += DPP_F(x, 0x114, 0xf); x += DPP_F(x, 0x118, 0xf);
    x += DPP_F(x, 0x142, 0xa); x += DPP_F(x, 0x143, 0xc);
#undef DPP_F
    return __builtin_bit_cast(float, __builtin_amdgcn_readlane(__builtin_bit_cast(int, x), 63));
}
__device__ __forceinline__ float wave_max(float x) {
#define DPP_K(x_, ctrl, rmask) __builtin_bit_cast(float, __builtin_amdgcn_update_dpp(__builtin_bit_cast(int, x_), __builtin_bit_cast(int, x_), (ctrl), (rmask), 0xf, false))
    x = fmaxf(x, DPP_K(x, 0x111, 0xf)); x = fmaxf(x, DPP_K(x, 0x112, 0xf)); x = fmaxf(x, DPP_K(x, 0x114, 0xf)); x = fmaxf(x, DPP_K(x, 0x118, 0xf));
    x = fmaxf(x, DPP_K(x, 0x142, 0xa)); x = fmaxf(x, DPP_K(x, 0x143, 0xc));
    return __builtin_bit_cast(float, __builtin_amdgcn_readlane(__builtin_bit_cast(int, x), 63));
}
__device__ __forceinline__ float wave_min(float x) {
    x = fminf(x, DPP_K(x, 0x111, 0xf)); x = fminf(x, DPP_K(x, 0x112, 0xf)); x = fminf(x, DPP_K(x, 0x114, 0xf)); x = fminf(x, DPP_K(x, 0x118, 0xf));
    x = fminf(x, DPP_K(x, 0x142, 0xa)); x = fminf(x, DPP_K(x, 0x143, 0xc));
#undef DPP_K
    return __builtin_bit_cast(float, __builtin_amdgcn_readlane(__builtin_bit_cast(int, x), 63));
}

#define XB_TMO      128
#define XB_XCNT(j)  (256  + 64 * (j))
#define XB_XSUB(j)  (1280 + 64 * (j))
#define XB_XGEN(j)  (2304 + 64 * (j))
#define XB_TOP      3328
#define XB_TOPGEN   3392
#define XCD_BAR_WORDS 3456
#define XB_SPIN_CAP (1u << 24)

__device__ __forceinline__ unsigned xb_ld(unsigned* p)              { return __hip_atomic_load(p, __ATOMIC_RELAXED, __HIP_MEMORY_SCOPE_AGENT); }
__device__ __forceinline__ unsigned xb_add(unsigned* p, unsigned v) { return __hip_atomic_fetch_add(p, v, __ATOMIC_RELAXED, __HIP_MEMORY_SCOPE_AGENT); }
__device__ __forceinline__ unsigned xb_xcc_id() { return (unsigned)__builtin_amdgcn_s_getreg((3 << 11) | 20) & 0xFu; }
#define XB_SPIN(cond, bar) do { unsigned _sp = 0; while (cond) { __builtin_amdgcn_s_sleep(1); \
    if ((++_sp & 255u) == 0u) { if (xb_ld(&(bar)[XB_TMO])) break; if (_sp > XB_SPIN_CAP) { atomicAdd(&(bar)[XB_TMO], 1u); break; } } } } while (0)

struct XcdBarrier { unsigned* bar; unsigned x; volatile LAS unsigned* st; int wave; };

__device__ __forceinline__ XcdBarrier xcd_barrier_post(unsigned* bar, volatile LAS unsigned* st, int wave) {
    XcdBarrier b; b.bar = bar; b.x = xb_xcc_id(); b.st = st; b.wave = wave;
    if (wave == 0 && lane_id() == 0) (void)xb_add(&bar[XB_XCNT(b.x)], 1u);
    return b;
}
__device__ __forceinline__ void xcd_barrier_complete(unsigned* bar, unsigned x, unsigned& nloc, unsigned& nx) {
    const unsigned G = gridDim.x * gridDim.y * gridDim.z;
    unsigned sum, cnt, mine, sp = 0u;
    for (;;) {
        sum = 0u; cnt = 0u; mine = 0u;
#pragma unroll
        for (unsigned j = 0; j < 16; ++j) { const unsigned c = xb_ld(&bar[XB_XCNT(j)]); sum += c; cnt += (c > 0u) ? 1u : 0u; mine = (j == x) ? c : mine; }
        if (sum == G) break;
        __builtin_amdgcn_s_sleep(1);
        if ((++sp & 255u) == 0u) { if (xb_ld(&bar[XB_TMO])) break; if (sp > XB_SPIN_CAP) { atomicAdd(&bar[XB_TMO], 1u); break; } }
    }
    nloc = mine > 0u ? mine : 1u; nx = cnt > 0u ? cnt : 1u;
}
__device__ __forceinline__ void xcd_barrier(const XcdBarrier& b) {
    asm volatile("s_waitcnt vmcnt(0)" ::: "memory");
    __syncthreads();
    if (b.wave == 0 && lane_id() == 0) {
        unsigned* bar = b.bar;
        __builtin_amdgcn_s_waitcnt(0);
        unsigned nloc = b.st[0], nx = b.st[1];
        if (nloc == 0u) { xcd_barrier_complete(bar, b.x, nloc, nx); b.st[0] = nloc; b.st[1] = nx; }
        const unsigned old = xb_add(&bar[XB_XSUB(b.x)], 1u);
        const unsigned gen = old / nloc;
        if (old + 1u == (gen + 1u) * nloc) {
            __builtin_amdgcn_fence(__ATOMIC_RELEASE, "agent");
            asm volatile("s_waitcnt vmcnt(0)" ::: "memory");
            const unsigned og = xb_add(&bar[XB_TOP], 1u);
            const unsigned tg = og / nx;
            if (og + 1u == (tg + 1u) * nx) xb_add(&bar[XB_TOPGEN], 1u);
            else XB_SPIN(xb_ld(&bar[XB_TOPGEN]) == tg, bar);
            __builtin_amdgcn_fence(__ATOMIC_ACQUIRE, "agent");
            xb_add(&bar[XB_XGEN(b.x)], 1u);
            asm volatile("s_waitcnt vmcnt(0)" ::: "memory");
        } else {
            XB_SPIN(xb_ld(&bar[XB_XGEN(b.x)]) == gen, bar);
            __builtin_amdgcn_fence(__ATOMIC_ACQUIRE, "agent");
            asm volatile("s_waitcnt vmcnt(0)" ::: "memory");
        }
    }
    __syncthreads();
}

namespace pg8 {
constexpr int BM = 256, BK = 64, HALF = 128, HTB = HALF * BK * 2, STAGE_BYTES = 8 * HTB, NXCD = 8, WGM = 8;

__host__ __device__ __forceinline__ int lds_byte(int r, int c) { const int st = (r >> 4) * 2 + (c >> 5), rr = r & 15, cc = c & 31, ob = rr * 64 + cc * 2; return st * 1024 + (ob ^ (((ob >> 9) & 1) << 5)); }
__host__ __device__ __forceinline__ void stage_rc(int b, int& R, int& C) { const int st = b / 1024, sb = b % 1024, swz = sb ^ (((sb >> 9) & 1) << 5); R = (st >> 1) * 16 + swz / 64; C = (st & 1) * 32 + (swz % 64) / 2; }
__host__ __device__ __forceinline__ int perm32(int rho) { const int n = rho >> 4, i = rho & 15; return 8 * (i >> 2) + 4 * n + (i & 3); }

__device__ __forceinline__ const char* uptr(const char* p) { const unsigned long long v = (unsigned long long)p; const unsigned lo = __builtin_amdgcn_readfirstlane((unsigned)v), hi = __builtin_amdgcn_readfirstlane((unsigned)(v >> 32)); return (const char*)(((unsigned long long)hi << 32) | lo); }
struct GUnit {
    const char* A;
    const char* B0;
    const char* B1;
    const int* rows;
    int rows_lds;
    int nt;
    int pm, pn, aux0, aux1;
};

__device__ __forceinline__ void tile_order(int L, int nM, int nN, int& pm, int& pn) {
    const int nwg = nM * nN;
    int wgid = L; { const int q = nwg / NXCD, r = nwg % NXCD, xcd = wgid % NXCD, off = wgid / NXCD; wgid = (xcd < r ? xcd * (q + 1) : r * (q + 1) + (xcd - r) * q) + off; }
    const int nig = WGM * nN, gid = wgid / nig, fm = gid * WGM, gsz = (nM - fm) < WGM ? (nM - fm) : WGM;
    pm = fm + ((wgid % nig) % gsz); pn = (wgid % nig) / gsz;
}

template <class Epi, class Sched, bool GATHER, bool ALIGN_EPI, bool SP2>
__device__ __forceinline__ void gemm_phase(LAS unsigned char* lds, const int wave, const unsigned a_rs, const unsigned b_rs, const Sched& S, const Epi& E) {
    const int wid = wave, lane = lane_id(), tid = wid * 64 + lane, wr = wid >> 2, wc = wid & 3, fr = lane & 15, fq = lane >> 4;
    int R0, C0; stage_rc(tid * 16, R0, C0);
    unsigned voffA[2], voffB[2];
#pragma unroll
    for (int i = 0; i < 2; ++i) { const int R = R0 + 64 * i; const int Rb = (R & ~31) + perm32(R & 31);
        voffA[i] = (unsigned)R * a_rs + (unsigned)C0 * 2u; voffB[i] = (unsigned)Rb * b_rs + (unsigned)C0 * 2u; }
    unsigned vgc[2][2], vgn[2][2];
    const size_t kstep = (size_t)(BK * 2);
    const size_t hstepA = (size_t)HALF * a_rs;
    const unsigned ldsw = (unsigned)wid * 1024u;
    const int aoff = lds_byte(wr * 64 + fr, fq * 8), boff = lds_byte(wc * 32 + fr, fq * 8);
#define PG8_SA(b, h) (((b) * 2 + (h)) * HTB)
#define PG8_SB(b, h) ((4 + (b) * 2 + (h)) * HTB)
#define PG8_STAGE(bufoff, gbase, voff) do { const char* _gb = (const char*)(gbase); asm volatile("" : "+s"(_gb)); _Pragma("unroll") for (int _i = 0; _i < 2; ++_i) \
        __builtin_amdgcn_global_load_lds((const unsigned*)(_gb + (voff)[_i]), (LAS unsigned*)(lds + (bufoff) + ldsw + _i * 8192), 16, 0, 0); } while (0)
#define PG8_STAGE_A(bufoff, gbase, h, vg) do { if constexpr (GATHER) { PG8_STAGE(bufoff, gbase, (vg)[h]); } else { PG8_STAGE(bufoff, (gbase) + (h) * hstepA, voffA); } } while (0)
#define PG8_LDA(dst, b, h) do { _Pragma("unroll") for (int m = 0; m < 4; ++m) _Pragma("unroll") for (int k = 0; k < 2; ++k) dst[m][k] = *(const LAS bf16x8*)(lds + PG8_SA(b, h) + aoff + m * 2048 + k * 1024); } while (0)
#define PG8_LDB(dst, b, h) do { _Pragma("unroll") for (int n = 0; n < 2; ++n) _Pragma("unroll") for (int k = 0; k < 2; ++k) dst[n][k] = *(const LAS bf16x8*)(lds + PG8_SB(b, h) + boff + n * 2048 + k * 1024); } while (0)
#define PG8_MMA(ai, bj, At, Bt) do { __builtin_amdgcn_s_setprio(1); _Pragma("unroll") for (int m = 0; m < 4; ++m) _Pragma("unroll") for (int n = 0; n < 2; ++n) _Pragma("unroll") for (int k = 0; k < 2; ++k) \
        acc[ai][bj][m][n] = __builtin_amdgcn_mfma_f32_16x16x32_bf16(Bt[n][k], At[m][k], acc[ai][bj][m][n], 0, 0, 0); __builtin_amdgcn_s_setprio(0); } while (0)
#define PG8_WAIT_V(n) asm volatile("s_waitcnt vmcnt(" #n ")" ::: "memory")
#define PG8_WAIT_L(n) asm volatile("s_waitcnt lgkmcnt(" #n ")" ::: "memory")
#define PG8_BAR __builtin_amdgcn_s_barrier()
#define PG8_SCHED __builtin_amdgcn_sched_barrier(0)
#define PG8_GOFF(dst, u) do { if constexpr (GATHER) { if ((u).rows_lds >= 0) { _Pragma("unroll") for (int _h = 0; _h < 2; ++_h) _Pragma("unroll") for (int _i = 0; _i < 2; ++_i) \
        dst[_h][_i] = (unsigned)((const LAS int*)(lds + (u).rows_lds))[_h * HALF + R0 + 64 * _i] * a_rs + (unsigned)C0 * 2u; } else { _Pragma("unroll") for (int _h = 0; _h < 2; ++_h) _Pragma("unroll") for (int _i = 0; _i < 2; ++_i) \
        dst[_h][_i] = (unsigned)(u).rows[_h * HALF + R0 + 64 * _i] * a_rs + (unsigned)C0 * 2u; } } } while (0)
    GUnit cur, nxt; int ui = 0;
    if (!S.next(0, cur)) return;
    f32x4 acc[2][2][4][2];
#pragma unroll
    for (int a = 0; a < 2; ++a)
#pragma unroll
        for (int b = 0; b < 2; ++b)
#pragma unroll
            for (int m = 0; m < 4; ++m)
#pragma unroll
                for (int n = 0; n < 2; ++n) acc[a][b][m][n] = (f32x4){0.f, 0.f, 0.f, 0.f};
    bf16x8 At[4][2], B0[2][2], B1[2][2];
    const char* cA = uptr(cur.A); const char* cB0 = uptr(cur.B0); const char* cB1 = uptr(cur.B1); int cnt = __builtin_amdgcn_readfirstlane(cur.nt);
    PG8_GOFF(vgc, cur);
    if constexpr (SP2) {
        PG8_STAGE(PG8_SB(0, 0), cB0, voffB); PG8_STAGE(PG8_SB(0, 1), cB1, voffB); PG8_STAGE_A(PG8_SA(0, 0), cA, 0, vgc); PG8_STAGE_A(PG8_SA(0, 1), cA, 1, vgc);
        if (wr == 1) PG8_BAR;
        PG8_WAIT_V(2); PG8_BAR;
        PG8_STAGE(PG8_SB(1, 0), cB0 + kstep, voffB); PG8_STAGE_A(PG8_SA(1, 0), cA + kstep, 0, vgc); PG8_STAGE(PG8_SB(1, 1), cB1 + kstep, voffB);
        PG8_WAIT_V(6); PG8_BAR;
    } else {
        PG8_STAGE(PG8_SB(0, 0), cB0, voffB); PG8_STAGE_A(PG8_SA(0, 0), cA, 0, vgc); PG8_STAGE(PG8_SB(0, 1), cB1, voffB); PG8_STAGE_A(PG8_SA(0, 1), cA, 1, vgc);
        if (wr == 1) PG8_BAR;
        PG8_WAIT_V(4); PG8_BAR;
        PG8_STAGE(PG8_SB(1, 0), cB0 + kstep, voffB); PG8_STAGE_A(PG8_SA(1, 0), cA + kstep, 0, vgc); PG8_STAGE(PG8_SB(1, 1), cB1 + kstep, voffB);
        PG8_WAIT_V(6); PG8_BAR;
    }
    for (;;) {
        const bool has_next = S.next(ui + 1, nxt);
        const char* nA = uptr(has_next ? nxt.A : cA); const char* nB0 = uptr(has_next ? nxt.B0 : cB0); const char* nB1 = uptr(has_next ? nxt.B1 : cB1);
        if constexpr (GATHER) {
            if (has_next) { PG8_GOFF(vgn, nxt); }
            else {
#pragma unroll
                for (int _h = 0; _h < 2; ++_h)
#pragma unroll
                    for (int _i = 0; _i < 2; ++_i) vgn[_h][_i] = vgc[_h][_i];
            }
        }
        for (int t = 0; t < cnt; t += 2) {
            const bool last = (t == cnt - 2);
            const char* a1 = cA + (size_t)(t + 1) * kstep;
            const char* a2 = last ? nA : cA + (size_t)(t + 2) * kstep;
            const char* b2 = last ? nB0 : cB0 + (size_t)(t + 2) * kstep; const char* b2h = last ? nB1 : cB1 + (size_t)(t + 2) * kstep;
            const char* a3 = a2 + kstep; const char* b3 = b2 + kstep; const char* b3h = b2h + kstep;
            unsigned vg2[2][2];
            if constexpr (GATHER) {
#pragma unroll
                for (int _h = 0; _h < 2; ++_h)
#pragma unroll
                    for (int _i = 0; _i < 2; ++_i) vg2[_h][_i] = last ? vgn[_h][_i] : vgc[_h][_i];
            }
            if constexpr (SP2) {
            PG8_LDB(B0, 0, 0); PG8_LDB(B1, 0, 1); PG8_SCHED; PG8_LDA(At, 0, 0); PG8_STAGE_A(PG8_SA(1, 1), a1, 1, vgc);
            PG8_WAIT_V(8); PG8_WAIT_L(0); PG8_BAR; PG8_MMA(0, 0, At, B0); PG8_MMA(0, 1, At, B1); PG8_BAR; PG8_SCHED;
            PG8_LDA(At, 0, 1); PG8_STAGE(PG8_SB(0, 0), b2, voffB); PG8_STAGE(PG8_SB(0, 1), b2h, voffB); PG8_STAGE_A(PG8_SA(0, 0), a2, 0, vg2);
            PG8_WAIT_V(8); PG8_WAIT_L(0); PG8_BAR; PG8_MMA(1, 0, At, B0); PG8_MMA(1, 1, At, B1); PG8_BAR; PG8_SCHED;
            PG8_LDB(B0, 1, 0); PG8_LDB(B1, 1, 1); PG8_SCHED; PG8_LDA(At, 1, 0); PG8_STAGE_A(PG8_SA(0, 1), a2, 1, vg2);
            PG8_WAIT_V(8); PG8_WAIT_L(0); PG8_BAR; PG8_MMA(0, 0, At, B0); PG8_MMA(0, 1, At, B1); PG8_BAR; PG8_SCHED;
            PG8_LDA(At, 1, 1); PG8_STAGE(PG8_SB(1, 0), b3, voffB); PG8_STAGE(PG8_SB(1, 1), b3h, voffB); PG8_STAGE_A(PG8_SA(1, 0), a3, 0, vg2);
            PG8_WAIT_V(8); PG8_WAIT_L(0); PG8_BAR; PG8_MMA(1, 0, At, B0); PG8_MMA(1, 1, At, B1); PG8_BAR; PG8_SCHED;
            } else {
            PG8_LDB(B0, 0, 0); PG8_SCHED; PG8_LDA(At, 0, 0); PG8_STAGE_A(PG8_SA(1, 1), a1, 1, vgc);
            PG8_WAIT_L(8); PG8_BAR; PG8_WAIT_L(0); PG8_MMA(0, 0, At, B0); PG8_BAR; PG8_SCHED;
            PG8_LDB(B1, 0, 1); PG8_STAGE(PG8_SB(0, 0), b2, voffB);
            PG8_BAR; PG8_WAIT_L(0); PG8_MMA(0, 1, At, B1); PG8_BAR;
            PG8_LDA(At, 0, 1); PG8_STAGE_A(PG8_SA(0, 0), a2, 0, vg2);
            PG8_BAR; PG8_WAIT_L(0); PG8_MMA(1, 0, At, B0); PG8_BAR; PG8_SCHED;
            PG8_STAGE(PG8_SB(0, 1), b2h, voffB);
            PG8_WAIT_V(6); PG8_BAR; PG8_MMA(1, 1, At, B1); PG8_BAR;
            PG8_LDB(B0, 1, 0); PG8_SCHED; PG8_LDA(At, 1, 0); PG8_STAGE_A(PG8_SA(0, 1), a2, 1, vg2);
            PG8_WAIT_L(8); PG8_BAR; PG8_WAIT_L(0); PG8_MMA(0, 0, At, B0); PG8_BAR; PG8_SCHED;
            PG8_LDB(B1, 1, 1); PG8_STAGE(PG8_SB(1, 0), b3, voffB);
            PG8_BAR; PG8_WAIT_L(0); PG8_MMA(0, 1, At, B1); PG8_BAR;
            PG8_LDA(At, 1, 1); PG8_STAGE_A(PG8_SA(1, 0), a3, 0, vg2);
            PG8_BAR; PG8_WAIT_L(0); PG8_MMA(1, 0, At, B0); PG8_BAR; PG8_SCHED;
            PG8_STAGE(PG8_SB(1, 1), b3h, voffB);
            PG8_WAIT_V(6); PG8_BAR; PG8_MMA(1, 1, At, B1); PG8_BAR;
            }
        }
        if constexpr (ALIGN_EPI) { if (wr == 0) PG8_BAR; }
        { int l2 = lane_id(); asm volatile("" : "+v"(l2)); const int fr2 = l2 & 15, fq2 = l2 >> 4; E(acc, cur, wr, wc, fr2, fq2); }
        if (!has_next) break;
#pragma unroll
        for (int a = 0; a < 2; ++a)
#pragma unroll
            for (int b = 0; b < 2; ++b)
#pragma unroll
                for (int m = 0; m < 4; ++m)
#pragma unroll
                    for (int n = 0; n < 2; ++n) acc[a][b][m][n] = (f32x4){0.f, 0.f, 0.f, 0.f};
        cur = nxt; cA = nA; cB0 = nB0; cB1 = nB1; cnt = __builtin_amdgcn_readfirstlane(cur.nt); ++ui;
        if constexpr (GATHER) {
#pragma unroll
            for (int _h = 0; _h < 2; ++_h)
#pragma unroll
                for (int _i = 0; _i < 2; ++_i) vgc[_h][_i] = vgn[_h][_i];
        }
        if constexpr (ALIGN_EPI) { if (wr == 1) PG8_BAR; }
    }
    PG8_WAIT_V(0);
    if constexpr (!ALIGN_EPI) { if (wr == 0) PG8_BAR; }
    PG8_BAR;
#undef PG8_SA
#undef PG8_SB
#undef PG8_STAGE
#undef PG8_STAGE_A
#undef PG8_LDA
#undef PG8_LDB
#undef PG8_MMA
#undef PG8_WAIT_V
#undef PG8_WAIT_L
#undef PG8_BAR
#undef PG8_SCHED
#undef PG8_GOFF
}
}

struct Frame {
    LAS unsigned char* lds;
    volatile LAS unsigned* MISC;
    unsigned* ctl;
    unsigned char* ws;
    float* out;
    int wave, G, bid;
};
using pg8::GUnit;

template <class Fill> struct DenseSched {
    int nM, nN, G, c; Fill f;
    __device__ __forceinline__ bool next(int i, GUnit& u) const {
        const long L = (long)i * G + c; if (L >= (long)nM * nN) return false;
        int pm, pn; pg8::tile_order((int)L, nM, nN, pm, pn); u.pm = pm; u.pn = pn; u.rows = nullptr; u.rows_lds = -1; u.aux0 = 0; u.aux1 = 0; f(u); return true;
    }
};
struct FillPlain {
    const char* A; const char* B; unsigned a_rs, b_rs; int nt;
    __device__ __forceinline__ void operator()(GUnit& u) const { u.A = A + (size_t)u.pm * 256 * a_rs; u.B0 = B + (size_t)u.pn * 256 * b_rs; u.B1 = u.B0 + (size_t)128 * b_rs; u.nt = nt; }
};
struct FillQlatPool {
    const char* q; const char* diff; const char* wuk; const char* wpool;
    __device__ __forceinline__ void operator()(GUnit& u) const {
        if (u.pn < 8) { u.A = q + (size_t)u.pm * 256 * 2048 + (size_t)((u.pn & ~1) * 128) * 2; u.B0 = wuk + (size_t)u.pn * 256 * 512; }
        else { const int g = u.pn - 8; u.A = diff + (size_t)u.pm * 256 * 2048 + (size_t)(g * 256) * 2; u.B0 = wpool + (size_t)g * 256 * 512; }
        u.B1 = u.B0 + (size_t)128 * 512; u.nt = 4;
    }
};
struct FillO {
    const char* olat; const char* wuv;
    __device__ __forceinline__ void operator()(GUnit& u) const { u.A = olat + (size_t)u.pm * 256 * 4096 + (size_t)(u.pn * 512) * 2; u.B0 = wuv + (size_t)u.pn * 256 * 1024; u.B1 = u.B0 + (size_t)128 * 1024; u.nt = 8; }
};

#define EPI_LOOP_ROWS for (int ai = 0; ai < 2; ++ai) _Pragma("unroll") for (int m = 0; m < 4; ++m)
__device__ __forceinline__ u32x4 pack8(const f32x4 v0, const f32x4 v1) { u32x4 w; w.x = cvt_pk_bf16(v0[0], v0[1]); w.y = cvt_pk_bf16(v0[2], v0[3]); w.z = cvt_pk_bf16(v1[0], v1[1]); w.w = cvt_pk_bf16(v1[2], v1[3]); return w; }
__device__ __forceinline__ float sigmoidf_(float x) { return 1.0f / (1.0f + __expf(-x)); }

struct EpiP1 {
    bf16* q; bf16* qi; bf16* xp; bf16* gates; float* ckvraw; float* kiwi;
    __device__ __forceinline__ void operator()(const f32x4 (&acc)[2][2][4][2], const GUnit& u, int wr, int wc, int fr, int fq) const {
        const int row0 = u.pm * 256 + wr * 64 + fr, cl = wc * 32 + 8 * fq;
        if (u.pn < 28) {
            bf16* base; int ld, c0; bool sg = false;
            if (u.pn < 4) { base = q; ld = 1024; c0 = u.pn * 256; } else if (u.pn < 8) { base = qi; ld = 1024; c0 = (u.pn - 4) * 256; }
            else if (u.pn < 12) { base = xp; ld = 1024; c0 = (u.pn - 8) * 256; } else { base = gates; ld = 4096; c0 = (u.pn - 12) * 256; sg = true; }
#pragma unroll
            EPI_LOOP_ROWS { bf16* rowp = base + (size_t)(row0 + ai * 128 + m * 16) * ld + c0 + cl;
#pragma unroll
                for (int bj = 0; bj < 2; ++bj) { f32x4 v0 = acc[ai][bj][m][0], v1 = acc[ai][bj][m][1];
                    if (sg) {
#pragma unroll
                        for (int j = 0; j < 4; ++j) { v0[j] = sigmoidf_(v0[j]); v1[j] = sigmoidf_(v1[j]); } }
                    *(u32x4*)(rowp + bj * 128) = pack8(v0, v1); } }
        } else {
            float* base = (u.pn == 28) ? ckvraw : kiwi;
#pragma unroll
            EPI_LOOP_ROWS { float* rowp = base + (size_t)(row0 + ai * 128 + m * 16) * 256 + cl;
#pragma unroll
                for (int bj = 0; bj < 2; ++bj) { *(f32x4*)(rowp + bj * 128) = acc[ai][bj][m][0]; *(f32x4*)(rowp + bj * 128 + 4) = acc[ai][bj][m][1]; } }
        }
    }
};
struct EpiQlatPool {
    bf16* qlat; bf16* pool; const float* colscale;
    __device__ __forceinline__ void operator()(const f32x4 (&acc)[2][2][4][2], const GUnit& u, int wr, int wc, int fr, int fq) const {
        const int row0 = u.pm * 256 + wr * 64 + fr, cl = wc * 32 + 8 * fq;
        const bool ql = u.pn < 8;
        bf16* base = ql ? qlat + u.pn * 256 : pool + (u.pn - 8) * 256; const int ld = ql ? 2048 : 1024;
        const float* sp = colscale + u.pn * 256 + cl;
        __builtin_amdgcn_sched_barrier(0);
        const f32x4 s00 = *(const f32x4*)(sp), s01 = *(const f32x4*)(sp + 4), s10 = *(const f32x4*)(sp + 128), s11 = *(const f32x4*)(sp + 132);
#pragma unroll
        EPI_LOOP_ROWS { bf16* rowp = base + (size_t)(row0 + ai * 128 + m * 16) * ld + cl;
            *(u32x4*)(rowp) = pack8(acc[ai][0][m][0] * s00, acc[ai][0][m][1] * s01);
            *(u32x4*)(rowp + 128) = pack8(acc[ai][1][m][0] * s10, acc[ai][1][m][1] * s11); }
    }
};
struct EpiBf16 {
    bf16* O; int ld;
    __device__ __forceinline__ void operator()(const f32x4 (&acc)[2][2][4][2], const GUnit& u, int wr, int wc, int fr, int fq) const {
        const int row0 = u.pm * 256 + wr * 64 + fr, cl = u.pn * 256 + wc * 32 + 8 * fq;
#pragma unroll
        EPI_LOOP_ROWS { bf16* rowp = O + (size_t)(row0 + ai * 128 + m * 16) * ld + cl;
#pragma unroll
            for (int bj = 0; bj < 2; ++bj) *(u32x4*)(rowp + bj * 128) = pack8(acc[ai][bj][m][0], acc[ai][bj][m][1]); }
    }
};
__device__ __forceinline__ void unpack8(const u32x4 w, f32x4& a, f32x4& b) {
    a[0] = bf2f(w.x & 0xffffu); a[1] = bf2f(w.x >> 16); a[2] = bf2f(w.y & 0xffffu); a[3] = bf2f(w.y >> 16);
    b[0] = bf2f(w.z & 0xffffu); b[1] = bf2f(w.z >> 16); b[2] = bf2f(w.w & 0xffffu); b[3] = bf2f(w.w >> 16);
}
template <int MODE> struct EpiGate {
    const bf16* gates; bf16* M1; bf16* merged;
    __device__ __forceinline__ void operator()(const f32x4 (&acc)[2][2][4][2], const GUnit& u, int wr, int wc, int fr, int fq) const {
        const int row0 = u.pm * 256 + wr * 64 + fr, cl = u.pn * 256 + wc * 32 + 8 * fq;
#pragma unroll
        for (int ai = 0; ai < 2; ++ai) {
            u32x4 gq[4][2], mq[4][2];
#pragma unroll
            for (int m = 0; m < 4; ++m)
#pragma unroll
                for (int bj = 0; bj < 2; ++bj) { const size_t r = (size_t)(row0 + ai * 128 + m * 16); const int c = cl + bj * 128;
                    gq[m][bj] = *(const u32x4*)(gates + r * 4096 + (MODE ? 2048 : 0) + c); if (MODE) mq[m][bj] = *(const u32x4*)(M1 + r * 2048 + c); }
            __builtin_amdgcn_sched_barrier(0);
#pragma unroll
            for (int m = 0; m < 4; ++m)
#pragma unroll
                for (int bj = 0; bj < 2; ++bj) { const size_t r = (size_t)(row0 + ai * 128 + m * 16); const int c = cl + bj * 128;
                    f32x4 g0, g1; unpack8(gq[m][bj], g0, g1);
                    f32x4 v0 = acc[ai][bj][m][0] * g0, v1 = acc[ai][bj][m][1] * g1;
                    if (MODE) { f32x4 p0, p1; unpack8(mq[m][bj], p0, p1); v0 += p0; v1 += p1; *(u32x4*)(merged + r * 2048 + c) = pack8(v0, v1); }
                    else *(u32x4*)(M1 + r * 2048 + c) = pack8(v0, v1); }
            __builtin_amdgcn_sched_barrier(0);
        }
    }
};
struct EpiPre {
    const float* x; float* pre;
    __device__ __forceinline__ void operator()(const f32x4 (&acc)[2][2][4][2], const GUnit& u, int wr, int wc, int fr, int fq) const {
        const int row0 = u.pm * 256 + wr * 64 + fr, cl = u.pn * 256 + wc * 32 + 8 * fq;
#pragma unroll
        for (int ai = 0; ai < 2; ++ai) {
            f32x4 xq[4][2][2];
#pragma unroll
            for (int m = 0; m < 4; ++m)
#pragma unroll
                for (int bj = 0; bj < 2; ++bj) { const size_t o = (size_t)(row0 + ai * 128 + m * 16) * 2048 + cl + bj * 128; xq[m][bj][0] = __builtin_nontemporal_load((const f32x4*)(x + o)); xq[m][bj][1] = __builtin_nontemporal_load((const f32x4*)(x + o + 4)); }
            __builtin_amdgcn_sched_barrier(0);
#pragma unroll
            for (int m = 0; m < 4; ++m)
#pragma unroll
                for (int bj = 0; bj < 2; ++bj) { const size_t o = (size_t)(row0 + ai * 128 + m * 16) * 2048 + cl + bj * 128;
                    *(f32x4*)(pre + o) = xq[m][bj][0] * DN_ALPHA + acc[ai][bj][m][0]; *(f32x4*)(pre + o + 4) = xq[m][bj][1] * DN_ALPHA + acc[ai][bj][m][1]; }
            __builtin_amdgcn_sched_barrier(0);
        }
    }
};
constexpr int MOE_TAB_OFF = 131072, MOE_TAB_UNITS = 32, MOE_ROWS_OFF = 131072 + 512, MOE_ROWS_UNITS = 11;
struct MoeSched {
    const int* mtt; int nmt; int NT; int G, c; bool gateup;
    const char* h; const char* hbuf; const char* wgu; const char* wd; const int* rowlist; LAS unsigned char* lds;
    __device__ __forceinline__ int unit_of(int i) const {
        const int total = nmt * NT;
        if ((G & 7) == 0) { const int x = c & 7, j = i * (G >> 3) + (c >> 3); const int lo = (int)(((long)total * x) >> 3), hi = (int)(((long)total * (x + 1)) >> 3); const int U = lo + j; return U < hi ? U : -1; }
        const long L = (long)i * G + c; return L < total ? (int)L : -1;
    }
    __device__ __forceinline__ void prepare(int tid) const {
        LAS int* tab = (LAS int*)(lds + MOE_TAB_OFF);
        if (tid < MOE_TAB_UNITS) { const int U = unit_of(tid); int g = -1, p0 = 0, nv = 0, nt_ = 0;
            if (U >= 0) { const int MT = U / NT; nt_ = U - MT * NT; g = mtt[MT * 4 + 0]; p0 = mtt[MT * 4 + 1]; nv = mtt[MT * 4 + 2]; }
            tab[tid * 4 + 0] = g; tab[tid * 4 + 1] = p0; tab[tid * 4 + 2] = nv; tab[tid * 4 + 3] = nt_; }
        if (gateup) { LAS int* rw = (LAS int*)(lds + MOE_ROWS_OFF);
            for (int q = tid; q < MOE_ROWS_UNITS * 256; q += NTHR) { const int i = q >> 8, U = unit_of(i); if (U >= 0) { const int MT = U / NT; rw[q] = rowlist[mtt[MT * 4 + 1] + (q & 255)]; } } }
        __syncthreads();
    }
    __device__ __forceinline__ bool next(int i, GUnit& u) const {
        int g, p0, nv, nt_;
        if (i < MOE_TAB_UNITS) { const LAS int* tab = (const LAS int*)(lds + MOE_TAB_OFF); g = __builtin_amdgcn_readfirstlane(tab[i * 4 + 0]); p0 = __builtin_amdgcn_readfirstlane(tab[i * 4 + 1]); nv = __builtin_amdgcn_readfirstlane(tab[i * 4 + 2]); nt_ = __builtin_amdgcn_readfirstlane(tab[i * 4 + 3]); if (g < 0) return false; }
        else { const int U = unit_of(i); if (U < 0) return false; const int MT = U / NT; nt_ = U - MT * NT;
            g = __builtin_amdgcn_readfirstlane(mtt[MT * 4 + 0]); p0 = __builtin_amdgcn_readfirstlane(mtt[MT * 4 + 1]); nv = __builtin_amdgcn_readfirstlane(mtt[MT * 4 + 2]); }
        u.pm = p0; u.pn = nt_; u.aux0 = nv; u.aux1 = g; u.rows_lds = -1;
        if (gateup) { u.A = h; u.rows = rowlist + p0; if (i < MOE_ROWS_UNITS) u.rows_lds = MOE_ROWS_OFF + i * 1024; u.B0 = wgu + ((size_t)g * 1024 + (size_t)nt_ * 256) * 4096; u.B1 = u.B0 + (size_t)128 * 4096; u.nt = 32; }
        else { u.A = hbuf + (size_t)p0 * 1024; u.rows = nullptr; u.B0 = wd + ((size_t)g * 2048 + (size_t)nt_ * 256) * 1024; u.B1 = u.B0 + (size_t)128 * 1024; u.nt = 8; }
        return true;
    }
};
struct EpiSwiGLU {
    bf16* H;
    __device__ __forceinline__ void operator()(const f32x4 (&acc)[2][2][4][2], const GUnit& u, int wr, int wc, int fr, int fq) const {
        const int cl = u.pn * 128 + wc * 32 + 8 * fq;
#pragma unroll
        EPI_LOOP_ROWS { const int r = ai * 128 + wr * 64 + m * 16 + fr;
            if (r < u.aux0) { f32x4 v[2];
#pragma unroll
                for (int n = 0; n < 2; ++n)
#pragma unroll
                    for (int j = 0; j < 4; ++j) { const float g = acc[ai][0][m][n][j], up = acc[ai][1][m][n][j]; v[n][j] = g * sigmoidf_(g) * up; }
                *(u32x4*)(H + (size_t)(u.pm + r) * 512 + cl) = pack8(v[0], v[1]); } }
    }
};
struct EpiY {
    unsigned char* Y8; bf16* Ysh;
    __device__ __forceinline__ void operator()(const f32x4 (&acc)[2][2][4][2], const GUnit& u, int wr, int wc, int fr, int fq) const {
        const int cl = u.pn * 256 + wc * 32 + 8 * fq;
        if (u.aux1 == NE) {
#pragma unroll
            EPI_LOOP_ROWS { const int r = ai * 128 + wr * 64 + m * 16 + fr;
                if (r < u.aux0) { bf16* rowp = Ysh + (size_t)(u.pm - NTOK * 8 + r) * 2048 + cl;
#pragma unroll
                    for (int bj = 0; bj < 2; ++bj) *(u32x4*)(rowp + bj * 128) = pack8(acc[ai][bj][m][0], acc[ai][bj][m][1]); } }
        } else {
#pragma unroll
            EPI_LOOP_ROWS { const int r = ai * 128 + wr * 64 + m * 16 + fr;
                if (r < u.aux0) { unsigned char* rowp = Y8 + (size_t)(u.pm + r) * 2048 + cl;
#pragma unroll
                    for (int bj = 0; bj < 2; ++bj) { const f32x4 v0 = acc[ai][bj][m][0], v1 = acc[ai][bj][m][1];
                        int w0 = __builtin_amdgcn_cvt_pk_fp8_f32(v0[0], v0[1], 0, false); w0 = __builtin_amdgcn_cvt_pk_fp8_f32(v0[2], v0[3], w0, true);
                        int w1 = __builtin_amdgcn_cvt_pk_fp8_f32(v1[0], v1[1], 0, false); w1 = __builtin_amdgcn_cvt_pk_fp8_f32(v1[2], v1[3], w1, true);
                        u32x2 o; o.x = (unsigned)w0; o.y = (unsigned)w1; *(u32x2*)(rowp + bj * 128) = o; } } }
        }
    }
};

template <class RowMap>
__device__ __forceinline__ void tr_item(const float* W, int ldw, int nvalid, bf16* WT, int ldT, LAS float* scr, int kb, int nb, int lane, const RowMap& rm, const int ztwin = 0) {
    const int k0 = 64 * kb, n0 = 32 * nb;
    const int c4 = 4 * (lane & 7), kr = lane >> 3;
    f32x4 v[8];
#pragma unroll
    for (int i = 0; i < 8; ++i) { v[i] = (f32x4){0.f, 0.f, 0.f, 0.f}; if (n0 + c4 < nvalid) v[i] = __builtin_nontemporal_load((const f32x4*)(W + (size_t)(k0 + 8 * i + kr) * ldw + n0 + c4)); }
#pragma unroll
    for (int i = 0; i < 8; ++i) { LAS float* d = scr + (8 * i + kr) * 33 + c4; d[0] = v[i][0]; d[1] = v[i][1]; d[2] = v[i][2]; d[3] = v[i][3]; }
    LDS_WAIT(); asm volatile("" ::: "memory");
    const int c = lane & 7;
#pragma unroll
    for (int j = 0; j < 4; ++j) { const int nl = (lane >> 3) + 8 * j; const LAS float* s = scr + (8 * c) * 33 + nl;
        u32x4 o; o.x = cvt_pk_bf16(s[0 * 33], s[1 * 33]); o.y = cvt_pk_bf16(s[2 * 33], s[3 * 33]); o.z = cvt_pk_bf16(s[4 * 33], s[5 * 33]); o.w = cvt_pk_bf16(s[6 * 33], s[7 * 33]);
        if (n0 + nl < nvalid) { *(u32x4*)(WT + (size_t)rm(n0 + nl) * ldT + k0 + 8 * c) = o; if (ztwin) *(u32x4*)(WT + (size_t)rm(n0 + nl) * ldT + k0 + 8 * c + ztwin) = (u32x4){0u, 0u, 0u, 0u}; } }
    LDS_WAIT(); asm volatile("" ::: "memory");
}
struct MapId { int off; __device__ __forceinline__ int operator()(int n) const { return off + n; } };
struct MapWin {
    __device__ __forceinline__ int operator()(int n) const {
        if (n < 1024) return n;
        if (n < 1280) return 7168 + (n - 1024);
        if (n < 2304) return 1024 + (n - 1280);
        if (n < 2368) return 7424 + (n - 2304);
        if (n < 2384) return 7488 + (n - 2368);
        if (n < 3408) return 2048 + (n - 2384);
        return 3072 + (n - 3408);
    }
};
struct MapGU { int up; __device__ __forceinline__ int operator()(int f) const { return (f >> 7) * 256 + up * 128 + (f & 127); } };

__device__ __forceinline__ void phase_convert_small(Frame& F, const float* x, const float* w_in, const float* w_uk, const float* w_uv, const float* w_pool, const float* w_pa, const float* w_pp, const float* w_out, const float* pscale, const float* w_router) {
    const int lane_ = lane_id(), tid_ = F.wave * 64 + lane_;
    { float* wt = (float*)(F.ws + WS_WRT); for (size_t i = (size_t)F.bid * NTHR + tid_; i < (size_t)64 * 2048; i += (size_t)F.G * NTHR) { const int e = (int)(i >> 11), d = (int)(i & 2047); wt[i] = w_router[(size_t)d * 64 + e]; } }
    { float* cs = (float*)(F.ws + WS_CSCALE); for (size_t i = (size_t)F.bid * NTHR + tid_; i < 3072; i += (size_t)F.G * NTHR) cs[i] = (i < 2048) ? 1.0f : pscale[i - 2048]; }
    bf16* xb = (bf16*)(F.ws + WS_XB);
    const size_t gt = (size_t)F.bid * NTHR + tid_, nth = (size_t)F.G * NTHR;
    for (size_t i0 = gt; i0 < (size_t)NTOK * DM / 8; i0 += 4 * nth) {
        f32x4 a[4], b[4];
#pragma unroll
        for (int q = 0; q < 4; ++q) { const size_t i = i0 + q * nth; a[q] = __builtin_nontemporal_load((const f32x4*)x + 2 * i); b[q] = __builtin_nontemporal_load((const f32x4*)x + 2 * i + 1); }
        __builtin_amdgcn_sched_barrier(0);
#pragma unroll
        for (int q = 0; q < 4; ++q) { const size_t i = i0 + q * nth; u32x4 o; o.x = pk2(a[q][0], a[q][1]); o.y = pk2(a[q][2], a[q][3]); o.z = pk2(b[q][0], b[q][1]); o.w = pk2(b[q][2], b[q][3]); ((u32x4*)xb)[i] = o; }
    }
    LAS float* scr = (LAS float*)(F.lds + F.wave * 8704);
    const int gw = F.bid * NWAVES + F.wave, NGW = F.G * NWAVES;
    constexpr int I_IN = 32 * 235, I_POOL = 4 * 4 * 8, I_PA = 16 * 64, I_PP = 16 * 64, I_OUT = 32 * 64;
    constexpr int I_UV = 8 * 16;
    constexpr int NIT = I_IN + I_POOL + I_PA + I_PP + I_OUT + I_UV;
    for (int it = gw; it < NIT; it += NGW) {
        int r = it;
        if (r < I_IN) { tr_item(w_in, 7504, 7504, (bf16*)(F.ws + WS_WIN), 2048, scr, r / 235, r % 235, lane_, MapWin{}); continue; } r -= I_IN;
        if (r < I_POOL) { const int g = r / 32, q = r % 32; tr_item(w_pool + (size_t)g * 65536, 256, 256, (bf16*)(F.ws + WS_WPOOL) + (size_t)g * 65536, 256, scr, q / 8, q % 8, lane_, MapId{0}); continue; } r -= I_POOL;
        if (r < I_PA) { tr_item(w_pa, 2048, 2048, (bf16*)(F.ws + WS_WPA), 1024, scr, r / 64, r % 64, lane_, MapId{0}); continue; } r -= I_PA;
        if (r < I_PP) { tr_item(w_pp, 2048, 2048, (bf16*)(F.ws + WS_WPP), 1024, scr, r / 64, r % 64, lane_, MapId{0}); continue; } r -= I_PP;
        if (r < I_OUT) { tr_item(w_out, 2048, 2048, (bf16*)(F.ws + WS_WOUT), 2048, scr, r / 64, r % 64, lane_, MapId{0}); continue; } r -= I_OUT;
        {
          const int h = r / 16, q = r % 16, pn = h >> 1, hh = h & 1;
          tr_item(w_uv + h * 128, 1024, 128, (bf16*)(F.ws + WS_WUV) + (size_t)(pn * 256 + hh * 128) * 512 + hh * 256, 512, scr, q / 4, q % 4, lane_, MapId{0}, hh ? -256 : 256); }
    }
    { bf16* wp = (bf16*)(F.ws + WS_WIN) + (size_t)7504 * 2048; for (size_t i = gt; i < (size_t)176 * 2048 / 8; i += nth) ((u32x4*)wp)[i] = (u32x4){0u, 0u, 0u, 0u}; }
    { const float* wuk = w_uk; bf16* o = (bf16*)(F.ws + WS_WUK);
      for (size_t i = gt; i < (size_t)2048 * 256; i += nth) { const int kp = (int)(i & 255), row = (int)(i >> 8), h = row >> 8, r = row & 255;
          o[i] = ((kp >> 7) == (h & 1)) ? (bf16)f2bf(wuk[(size_t)r * 1024 + h * 128 + (kp & 127)]) : (bf16)0; } }
}

struct ExpW { const float* wge; const float* wue; const float* wde; const float* wgs; const float* wus; const float* wds; };
template <int BATCH>
__device__ __forceinline__ bool convert_batch(Frame& F, const ExpW& W, LAS float* scr, const int lane_) {
    constexpr int PER = 1536, NIT = NGRP * PER;
    int base = 0;
    if (lane_ == 0) base = (int)__hip_atomic_fetch_add(F.ctl + CW_CVQ, (unsigned)BATCH, RLX_AGENT);
    base = __builtin_amdgcn_readfirstlane(base);
    if (base >= NIT) return false;
    for (int it = base; it < base + BATCH && it < NIT; ++it) {
        const int g = it / PER; int r = it - g * PER;
        const float* wg = (g < NE) ? W.wge + (size_t)g * 2048 * 512 : W.wgs;
        const float* wu = (g < NE) ? W.wue + (size_t)g * 2048 * 512 : W.wus;
        const float* wd = (g < NE) ? W.wde + (size_t)g * 512 * 2048 : W.wds;
        bf16* ogu = (bf16*)(F.ws + WS_WGU) + (size_t)g * 1024 * 2048; bf16* od = (bf16*)(F.ws + WS_WD) + (size_t)g * 2048 * 512;
        if (r < 512) { tr_item(wg, 512, 512, ogu, 2048, scr, r / 16, r % 16, lane_, MapGU{0}); continue; } r -= 512;
        if (r < 512) { tr_item(wu, 512, 512, ogu, 2048, scr, r / 16, r % 16, lane_, MapGU{1}); continue; } r -= 512;
        tr_item(wd, 2048, 2048, od, 512, scr, r / 64, r % 64, lane_, MapId{0});
    }
    return true;
}
__device__ __forceinline__ void phase_convert_experts(Frame& F, const ExpW& W) {
    const int lane_ = lane_id();
    LAS float* scr = (LAS float*)(F.lds + 32768 + F.wave * 8704);
    while (convert_batch<8>(F, W, scr, lane_)) {}
}

__device__ __forceinline__ void phase_postproc(Frame& F, const float* cg, const float* kg, const float* kb) {
    const int lane_ = lane_id(), tid_ = F.wave * 64 + lane_;
    const float* ckvraw = (const float*)(F.ws + WS_CKVRAW); const float* kiwi = (const float*)(F.ws + WS_KIWI);
    unsigned* ckvn = (unsigned*)(F.ws + WS_CKVN); bf16* kin = (bf16*)(F.ws + WS_KIN); float* wis = (float*)(F.ws + WS_WI);
    const int gw = F.bid * NWAVES + F.wave, NGW = F.G * NWAVES, lane = lane_;
    const f32x4 g4 = *(const f32x4*)(cg + lane * 4); const float kgl = kg[lane], kbl = kb[lane];
    for (int t0 = gw; t0 < NTOK; t0 += 4 * NGW) {
        f32x4 v[4]; float kv[4], wv[4];
#pragma unroll
        for (int q = 0; q < 4; ++q) { const int t = t0 + q * NGW; v[q] = (f32x4){0.f, 0.f, 0.f, 0.f}; kv[q] = 0.f; wv[q] = 0.f;
            if (t < NTOK) { v[q] = *(const f32x4*)(ckvraw + (size_t)t * 256 + lane * 4); kv[q] = kiwi[(size_t)t * 256 + lane]; wv[q] = kiwi[(size_t)t * 256 + 64 + (lane & 15)]; } }
#pragma unroll
        for (int q = 0; q < 4; ++q) { const int t = t0 + q * NGW;
            const float ss = wave_sum(v[q][0] * v[q][0] + v[q][1] * v[q][1] + v[q][2] * v[q][2] + v[q][3] * v[q][3]);
            const float rs = 1.0f / sqrtf(ss * (1.0f / 256.0f) + RMS_EPS);
            int o8 = __builtin_amdgcn_cvt_pk_fp8_f32(v[q][0] * rs * g4[0], v[q][1] * rs * g4[1], 0, false);
            o8 = __builtin_amdgcn_cvt_pk_fp8_f32(v[q][2] * rs * g4[2], v[q][3] * rs * g4[3], o8, true);
            const float mu = wave_sum(kv[q]) * (1.0f / 64.0f); const float dlt = kv[q] - mu;
            const float var = wave_sum(dlt * dlt) * (1.0f / 64.0f);
            const float y = dlt * (1.0f / sqrtf(var + LN_EPS)) * kgl + kbl;
            if (t < NTOK) { ckvn[(size_t)t * 64 + lane] = (unsigned)o8; kin[(size_t)t * 64 + lane] = (bf16)f2bf(y); if (lane < 16) wis[(size_t)t * 16 + lane] = wv[q] * 0.03125f; } }
    }
    const bf16* xp = (const bf16*)(F.ws + WS_XP); bf16* diff = (bf16*)(F.ws + WS_DIFF);
    const size_t gt = (size_t)F.bid * NTHR + tid_, nth = (size_t)F.G * NTHR;
    for (size_t i = gt; i < (size_t)(NTOK / 16) * 128; i += nth) {
        const int run = (int)(i >> 7), cgp = (int)(i & 127), g = cgp >> 5, win = 2 << g, tb = run * 16, posb = tb & (SEQ - 1);
        const bf16* col = xp + cgp * 8;
        u32x4 rw[31];
#pragma unroll
        for (int j = 0; j < 31; ++j) { const int dr = j - 15; rw[j] = (u32x4){0u, 0u, 0u, 0u}; if (dr >= 1 - win && posb + dr >= 0) rw[j] = *(const u32x4*)(col + (size_t)(tb + dr) * 1024); }
        __builtin_amdgcn_sched_barrier(0);
        f32x4 s0 = {0.f, 0.f, 0.f, 0.f}, s1 = {0.f, 0.f, 0.f, 0.f};
#pragma unroll
        for (int j = 1; j < 16; ++j) { if (j < win) { f32x4 a, b; unpack8(rw[15 - j], a, b); s0 += a; s1 += b; } }
#pragma unroll
        for (int q = 0; q < 16; ++q) { const int t = tb + q, pos = posb + q;
            f32x4 a, b; unpack8(rw[15 + q], a, b); s0 += a; s1 += b;
            const int cntw = (pos + 1 < win) ? pos + 1 : win; const float inv = 1.0f / (float)cntw;
            *(u32x4*)(diff + (size_t)t * 1024 + cgp * 8) = pack8(s0 * inv - a, s1 * inv - b);
            f32x4 c, d; const u32x4 r2 = rw[15 + q - 1], r4 = rw[15 + q - 3], r8 = rw[15 + q - 7], r16 = rw[15 + q - 15];
            const u32x4 rr = (win == 2) ? r2 : (win == 4) ? r4 : (win == 8) ? r8 : r16;
            unpack8(rr, c, d); s0 -= c; s1 -= d; }
    }
}

__device__ __forceinline__ size_t score_rowbase(int b, int p) { const int jq = p >> 7; return (size_t)b * SC_TOT + (size_t)16384 * (size_t)(jq * (jq + 1) / 2) + (size_t)(p & 127) * (size_t)(128 * (jq + 1)); }

__device__ __forceinline__ void phase_index_scores(Frame& F) {
    const int lane_ = lane_id(), tid_ = F.wave * 64 + lane_;
    const bf16* qi = (const bf16*)(F.ws + WS_QI); const bf16* kin = (const bf16*)(F.ws + WS_KIN); const float* wis = (const float*)(F.ws + WS_WI);
    _Float16* scores = (_Float16*)(F.ws + WS_SCORES);
    const int lane = lane_, w = F.wave, fq = lane >> 4, j16 = lane & 15, tid = tid_;
    constexpr int NQ = 4;
    LAS unsigned char* kb = F.lds;
    const int sR = tid >> 3, sc = tid & 7, sP = (sR & 3) * 16 + (sR >> 2);
    const int st_off = sP * 128 + ((sc ^ ((sP >> 1) & 7)) * 16);
    for (int it = 0;; ++it) {
        const int jj = (it >> 1) * F.G + F.bid; if (jj >= 256) break;
        const int s = (it & 1) ? 511 - jj : jj;
        const int b = s & 1, qg = s >> 1, tq0 = qg * 32;
        const int nk64 = (tq0 + 32 + 63) / 64, nsteps = (nk64 + NQ - 1) / NQ;
        bf16x8 Af[4][2];
        { const size_t tok = (size_t)b * SEQ + tq0 + 4 * w + (j16 >> 2);
#pragma unroll
          for (int g = 0; g < 4; ++g)
#pragma unroll
              for (int ks = 0; ks < 2; ++ks) Af[g][ks] = *(const bf16x8*)(qi + tok * 1024 + (4 * g + (j16 & 3)) * 64 + ks * 32 + 8 * fq); }
        f32x4 wv[4];
        { const size_t tok = (size_t)b * SEQ + tq0 + 4 * w + fq;
#pragma unroll
          for (int g = 0; g < 4; ++g) wv[g] = *(const f32x4*)(wis + tok * 16 + 4 * g); }
        _Float16* orow = scores + score_rowbase(b, tq0 + 4 * w + fq);
        const bf16* kbase = kin + (size_t)b * SEQ * 64 + (size_t)sR * 64 + sc * 8;
        u32x4 stg[NQ];
#pragma unroll
        for (int q = 0; q < NQ; ++q) { const int h = (q < nk64) ? q : nk64 - 1; stg[q] = *(const u32x4*)(kbase + (size_t)h * 4096); }
        __syncthreads();
#pragma unroll
        for (int q = 0; q < NQ; ++q) *(LAS u32x4*)(kb + q * 8192 + st_off) = stg[q];
        __syncthreads();
        for (int step = 0; step < nsteps; ++step) {
            const int cur = step & 1;
            if (step + 1 < nsteps) {
#pragma unroll
                for (int q = 0; q < NQ; ++q) { int h = NQ * (step + 1) + q; h = (h < nk64) ? h : nk64 - 1; stg[q] = *(const u32x4*)(kbase + (size_t)h * 4096); } }
#pragma unroll
            for (int hh = 0; hh < NQ; ++hh) {
                f32x4 res;
#pragma unroll
                for (int u = 0; u < 4; ++u) {
                    const int P = u * 16 + j16;
                    f32x4 a4[4];
#pragma unroll
                    for (int g = 0; g < 4; ++g) a4[g] = (f32x4){0.f, 0.f, 0.f, 0.f};
#pragma unroll
                    for (int ks = 0; ks < 2; ++ks) {
                        const bf16x8 bfr = *(const LAS bf16x8*)(kb + cur * (NQ * 8192) + hh * 8192 + P * 128 + (((fq + 4 * ks) ^ ((P >> 1) & 7)) * 16));
#pragma unroll
                        for (int g = 0; g < 4; ++g) a4[g] = __builtin_amdgcn_mfma_f32_16x16x32_bf16(Af[g][ks], bfr, a4[g], 0, 0, 0);
                    }
                    float sres = 0.f;
#pragma unroll
                    for (int g = 0; g < 4; ++g)
#pragma unroll
                        for (int r = 0; r < 4; ++r) { const float xf = a4[g][r]; const int xb = __float_as_int(xf); sres += wv[g][r] * __int_as_float(xb > 0 ? xb : 0); }
                    res[u] = sres;
                }
                const int hg = NQ * step + hh;
                if (hg < nk64) { typedef __fp16 h2 __attribute__((ext_vector_type(2))); const h2 lo = __builtin_amdgcn_cvt_pkrtz(res[0], res[1]), hi = __builtin_amdgcn_cvt_pkrtz(res[2], res[3]);
                    u32x2 o; o.x = __builtin_bit_cast(unsigned, lo); o.y = __builtin_bit_cast(unsigned, hi); *(u32x2*)(orow + hg * 64 + 4 * j16) = o; }
            }
            if (step + 1 < nsteps) {
#pragma unroll
                for (int q = 0; q < NQ; ++q) *(LAS u32x4*)(kb + (cur ^ 1) * (NQ * 8192) + q * 8192 + st_off) = stg[q]; }
            __syncthreads();
        }
    }
}

__device__ __forceinline__ unsigned fkey(float f) { const unsigned u = __float_as_uint(f); return (u & 0x80000000u) ? ~u : (u | 0x80000000u); }

__device__ __forceinline__ f32x4 h4_to_f4(const u32x2 q) { typedef _Float16 h2 __attribute__((ext_vector_type(2))); const unsigned qx = q.x, qy = q.y;
    const h2 a = __builtin_bit_cast(h2, qx), b = __builtin_bit_cast(h2, qy); const _Float16 a0 = a[0], a1 = a[1], b0 = b[0], b1 = b[1]; return (f32x4){(float)a0, (float)a1, (float)b0, (float)b1}; }
template <int NV>
__device__ __forceinline__ void select_row(const _Float16* row, int n, unsigned short* sel, int lane) {
    unsigned u[NV][4];
#pragma unroll
    for (int i = 0; i < NV; ++i) {
        const int base = i * 256 + lane * 4;
        f32x4 v = {0.f, 0.f, 0.f, 0.f};
        if (base < n) v = h4_to_f4(*(const u32x2*)(row + base));
#pragma unroll
        for (int e = 0; e < 4; ++e) u[i][e] = (base + e < n) ? fkey(v[e]) : 0u;
    }
    unsigned T = 0u; int cntT = n;
    bool exact = false;
    for (int bit = 31; bit >= 0; --bit) {
        const unsigned cand = T | (1u << bit);
        int c = 0;
#pragma unroll
        for (int i = 0; i < NV; ++i)
#pragma unroll
            for (int e = 0; e < 4; ++e) c += (u[i][e] >= cand) ? 1 : 0;
        c = wave_sum_i(c);
        if (c >= TOPK) { T = cand; cntT = c; if (c == TOPK) { exact = true; break; } }
    }
    int cgt = 0;
    if (!exact) {
#pragma unroll
        for (int i = 0; i < NV; ++i)
#pragma unroll
            for (int e = 0; e < 4; ++e) cgt += (u[i][e] > T) ? 1 : 0;
        cgt = wave_sum_i(cgt);
    }
    int pg = 0, pe = exact ? 0 : cgt;
    const unsigned long long lt = (1ull << lane) - 1ull;
#pragma unroll
    for (int i = 0; i < NV; ++i)
#pragma unroll
        for (int e = 0; e < 4; ++e) {
            const unsigned val = u[i][e]; const int idx = i * 256 + lane * 4 + e;
            const bool gsel = exact ? (val >= T) : (val > T);
            const unsigned long long mg = __ballot(gsel);
            if (gsel) sel[pg + __popcll(mg & lt)] = (unsigned short)idx;
            pg += __popcll(mg);
            if (!exact) {
                const bool esel = (val == T);
                const unsigned long long me = __ballot(esel);
                const int pos = pe + __popcll(me & lt);
                if (esel && pos < TOPK) sel[pos] = (unsigned short)idx;
                pe += __popcll(me);
            }
        }
}

template <int NV>
__device__ __forceinline__ bool select_row_hist(const _Float16* row, int n, unsigned short* sel, int lane, LAS unsigned* hist) {
    LAS unsigned* cnts = hist + 4097;
    LAS unsigned* tiel = hist + 4100;
    unsigned u[NV][4];
#pragma unroll
    for (int i = 0; i < NV; ++i) { const int base = i * 256 + lane * 4; u32x2 rq = {0u, 0u}; if (base < n) rq = *(const u32x2*)(row + base); const f32x4 t4 = h4_to_f4(rq); u[i][0] = __float_as_uint(t4[0]); u[i][1] = __float_as_uint(t4[1]); u[i][2] = __float_as_uint(t4[2]); u[i][3] = __float_as_uint(t4[3]); }
#pragma unroll
    for (int q = 0; q < 17; ++q) { const int w = q * 256 + lane * 4; if (w < 4104) *(LAS u32x4*)(hist + w) = (u32x4){0u, 0u, 0u, 0u}; }
    const float v00 = __uint_as_float(u[0][0]);
    float mn = v00, mx = v00;
#define SR_MM(i_, MASKED) do { _Pragma("unroll") for (int e = 0; e < 4; ++e) { float x = __uint_as_float(u[i_][e]); if (MASKED) x = ((i_) * 256 + lane * 4 + e < n) ? x : v00; mn = fminf(mn, x); mx = fmaxf(mx, x); } } while (0)
#pragma unroll
    for (int i = 0; i < NV; ++i) {
        if (i < NV - 8) SR_MM(i, false);
        else { const int rem = n - i * 256; if (rem >= 256) SR_MM(i, false); else if (rem > 0) SR_MM(i, true); }
    }
#undef SR_MM
    mn = wave_min(mn); mx = wave_max(mx);
    if (!(mx > mn)) {
#pragma unroll
        for (int q = 0; q < 4; ++q) sel[q * 64 + lane] = (unsigned short)(q * 64 + lane);
        return true;
    }
    const float scale = 4095.5f / (mx - mn), off = -mn * scale;
#define SR_KEY(i_, MASKED) do { _Pragma("unroll") for (int e = 0; e < 4; ++e) { unsigned k = (unsigned)fmaf(__uint_as_float(u[i_][e]), scale, off); k = k > 4095u ? 4095u : k; \
        if (MASKED) k = ((i_) * 256 + lane * 4 + e < n) ? k : 4096u; u[i_][e] = k; __hip_atomic_fetch_add(hist + k, 1u, __ATOMIC_RELAXED, __HIP_MEMORY_SCOPE_WORKGROUP); } } while (0)
#pragma unroll
    for (int i = 0; i < NV; ++i) {
        if (i < NV - 8) SR_KEY(i, false);
        else { const int rem = n - i * 256; if (rem >= 256) SR_KEY(i, false); else if (rem > 0) SR_KEY(i, true); else { u[i][0] = 4096u; u[i][1] = 4096u; u[i][2] = 4096u; u[i][3] = 4096u; } }
    }
#undef SR_KEY
    LDS_WAIT();
    unsigned sl = 0;
#pragma unroll
    for (int q = 0; q < 16; ++q) { const u32x4 t4 = *(const LAS u32x4*)(hist + 64 * lane + 4 * q); sl += (t4[0] + t4[1]) + (t4[2] + t4[3]); }
    const unsigned pre = (unsigned)wave_scan_i((int)sl);
    const unsigned total = (unsigned)__builtin_amdgcn_readlane((int)pre, 63), above = total - pre;
    const bool mine = (above < (unsigned)TOPK) && (above + sl >= (unsigned)TOPK);
    const int src = __builtin_amdgcn_readfirstlane(__ffsll((unsigned long long)__ballot(mine)) - 1);
    const unsigned above_src = (unsigned)__builtin_amdgcn_readlane((int)above, src);
    const unsigned hj = hist[64 * src + lane];
    const unsigned pj = (unsigned)wave_scan_i((int)hj);
    const unsigned cj = above_src + ((unsigned)__builtin_amdgcn_readlane((int)pj, 63) - pj);
    const bool hit = (cj < (unsigned)TOPK) && (cj + hj >= (unsigned)TOPK);
    const int hl = __builtin_amdgcn_readfirstlane(__ffsll((unsigned long long)__ballot(hit)) - 1);
    const unsigned bstar = (unsigned)(64 * src + hl), cgt = (unsigned)__builtin_amdgcn_readlane((int)cj, hl), mt = (unsigned)__builtin_amdgcn_readlane((int)hj, hl);
    int pg = 0; const unsigned span = 4095u - bstar;
#pragma unroll
    for (int i = 0; i < NV; ++i)
#pragma unroll
        for (int e = 0; e < 4; ++e) { const unsigned k = u[i][e]; const int idx = i * 256 + lane * 4 + e;
            const bool gsel = (k - bstar - 1u) < span;
            const unsigned long long mg = __ballot(gsel);
            if (mg) { if (gsel) sel[pg + (int)__builtin_amdgcn_mbcnt_hi((unsigned)(mg >> 32), __builtin_amdgcn_mbcnt_lo((unsigned)mg, 0u))] = (unsigned short)idx; pg += __popcll(mg); }
            if (k == bstar) { const unsigned p = __hip_atomic_fetch_add(cnts + 1, 1u, __ATOMIC_RELAXED, __HIP_MEMORY_SCOPE_WORKGROUP); if (p < 64u) tiel[p] = (unsigned)idx; } }
    LDS_WAIT();
    const int need = TOPK - (int)cgt;
    if (mt <= 64u) {
        int idx = 0x7fffffff; float val = -INFINITY;
        if (lane < (int)mt) { idx = (int)tiel[lane]; val = (float)row[idx]; }
        int rk = 0;
        for (int j = 0; j < (int)mt; ++j) { const float o = __shfl(val, j); const int oi = __shfl(idx, j); rk += (o > val || (o == val && oi < idx)) ? 1 : 0; }
        if (lane < (int)mt && rk < need) sel[cgt + rk] = (unsigned short)idx;
        return true;
    }
    return false;
}

__device__ __forceinline__ void phase_select(Frame& F, const ExpW& W, const bool ride) {
    const int lane = lane_id();
    LAS unsigned* hist = (LAS unsigned*)(F.lds + F.wave * 17408);
    const _Float16* scores = (const _Float16*)(F.ws + WS_SCORES);
    unsigned short* selb = (unsigned short*)(F.ws + WS_SEL);
    const int gw = F.bid * NWAVES + F.wave, NGW = F.G * NWAVES;
    for (int it = 0;; ++it) {
        const int jj = (it >> 1) * NGW + gw; if (jj >= NTOK / 2) break;
        const int s = (it & 1) ? NTOK - 1 - jj : jj;
        const int b = s & 1, p = s >> 1, n = p + 1;
        unsigned short* sel = selb + ((size_t)b * SEQ + p) * TOPK;
        if (n <= TOPK) {
#pragma unroll
            for (int q = 0; q < 4; ++q) { const int i = q * 64 + lane; sel[i] = (i < n) ? (unsigned short)i : (unsigned short)0xFFFFu; }
        } else {
            const _Float16* row = scores + score_rowbase(b, p);
            bool ok;
            if (n <= 2048) ok = select_row_hist<8>(row, n, sel, lane, hist);
            else if (n <= 4096) ok = select_row_hist<16>(row, n, sel, lane, hist);
            else if (n <= 6144) ok = select_row_hist<24>(row, n, sel, lane, hist);
            else ok = select_row_hist<32>(row, n, sel, lane, hist);
            asm volatile("" ::: "memory");
            if (!ok) select_row<32>(row, n, sel, lane);
        }
    }
}

typedef int v2i_t __attribute__((ext_vector_type(2)));
__device__ __forceinline__ long mk_long(const unsigned lo, const unsigned hi) { return (long)(((unsigned long long)hi << 32) | lo); }
__device__ __forceinline__ void phase_sparse_attn(Frame& F, const ExpW& W, const bool ride) {
    const int lane = lane_id();
    const bf16* qlat = (const bf16*)(F.ws + WS_QLAT); const unsigned char* ckv8 = (const unsigned char*)(F.ws + WS_CKVN);
    const unsigned short* selb = (const unsigned short*)(F.ws + WS_SEL); bf16* olat = (bf16*)(F.ws + WS_OLAT);
    const int fq = lane >> 4, j16 = lane & 15;
    LAS unsigned char* cb = F.lds + F.wave * 8704;
    const float sl2 = 0.08838834764831845f * 1.4426950408889634f;
    const int xh = (F.G % 8 == 0) ? ((F.bid & 7) >> 2) : 0, nsplit = (F.G % 8 == 0) ? 2 : 1;
    const int wloc = (F.G % 8 == 0) ? (((F.bid >> 3) * 4 + (F.bid & 3)) * NWAVES + F.wave) : (F.bid * NWAVES + F.wave);
    const int nwl = (F.G % 8 == 0) ? (F.G / 2) * NWAVES : F.G * NWAVES;
    const int ntk = NTOK / nsplit;
    const int qk_off = (2 * j16) * 272 + 8 * fq;
    const int tq = j16 >> 1, tp = j16 & 1;
    const int tr_off = ((tq < 4) ? 2 * (4 * fq + tq) : 2 * (4 * fq + tq - 4) + 1) * 272 + 8 * tp;
    for (int tl = wloc; tl < ntk; tl += nwl) {
        const int t = xh * ntk + tl, b = t / SEQ, pos = t % SEQ;
        const int nvalid = (pos + 1 < TOPK) ? pos + 1 : TOPK;
        const bool fullk = (nvalid == TOPK);
        const unsigned short* sel = selb + (size_t)t * TOPK;
        const u32x2 sv = __builtin_nontemporal_load((const u32x2*)(sel + 4 * lane));
        long Qf[8];
#pragma unroll
        for (int ks = 0; ks < 8; ++ks) { u32x4 z = {0u, 0u, 0u, 0u}; if (j16 < 8) z = __builtin_nontemporal_load((const u32x4*)(qlat + ((size_t)t * 8 + j16) * 256 + ks * 32 + 8 * fq));
            const unsigned z0 = z[0], z1 = z[1], z2 = z[2], z3 = z[3];
            int w0 = __builtin_amdgcn_cvt_pk_fp8_f32(bf2f(z0 & 0xffffu), bf2f(z0 >> 16), 0, false); w0 = __builtin_amdgcn_cvt_pk_fp8_f32(bf2f(z1 & 0xffffu), bf2f(z1 >> 16), w0, true);
            int w1 = __builtin_amdgcn_cvt_pk_fp8_f32(bf2f(z2 & 0xffffu), bf2f(z2 >> 16), 0, false); w1 = __builtin_amdgcn_cvt_pk_fp8_f32(bf2f(z3 & 0xffffu), bf2f(z3 >> 16), w1, true);
            Qf[ks] = mk_long((unsigned)w0, (unsigned)w1); }
        float mrun = -INFINITY, lrun = 0.f;
        f32x4 O[16];
#pragma unroll
        for (int rt = 0; rt < 16; ++rt) O[rt] = (f32x4){0.f, 0.f, 0.f, 0.f};
        const int nch = (nvalid + 31) >> 5;
        const unsigned char* cbase = ckv8 + (size_t)b * SEQ * 256 + j16 * 16;
        u32x4 gv[3][8];
#define SA_GATHER(c_, s_) do { _Pragma("unroll") for (int it = 0; it < 8; ++it) { \
            const unsigned dx = (unsigned)__builtin_amdgcn_readlane((int)sv.x, 8 * (c_) + it), dy = (unsigned)__builtin_amdgcn_readlane((int)sv.y, 8 * (c_) + it); \
            const unsigned dd = (fq & 2) ? dy : dx; int key = (fq & 1) ? (int)(dd >> 16) : (int)(dd & 0xffffu); if (!fullk) key = (key >= SEQ) ? 0 : key; \
            gv[s_][it] = *(const u32x4*)(cbase + (size_t)key * 256); } } while (0)
        SA_GATHER(0, 0);
        if (1 < nch) SA_GATHER(1, 1);
        if (2 < nch) SA_GATHER(2, 2);
#pragma unroll
        for (int c = 0; c < 8; ++c) {
            if (c < nch) {
            const int sl = c % 3;
#pragma unroll
            for (int it = 0; it < 8; ++it) { const int kk = 4 * it + fq; *(LAS u32x4*)(cb + (2 * (kk & 15) + (kk >> 4)) * 272 + 16 * j16) = gv[sl][it]; }
            asm volatile("" ::: "memory");
            if (c + 3 < nch) SA_GATHER(c + 3, sl);
            f32x4 Sa = {0.f, 0.f, 0.f, 0.f}, Sb = {0.f, 0.f, 0.f, 0.f};
#pragma unroll
            for (int ks = 0; ks < 8; ++ks) {
                const u32x2 a0 = *(const LAS u32x2*)(cb + qk_off + 32 * ks), a1 = *(const LAS u32x2*)(cb + qk_off + 272 + 32 * ks);
                const unsigned a0x = a0.x, a0y = a0.y, a1x = a1.x, a1y = a1.y;
                Sa = __builtin_amdgcn_mfma_f32_16x16x32_fp8_fp8(mk_long(a0x, a0y), Qf[ks], Sa, 0, 0, 0);
                Sb = __builtin_amdgcn_mfma_f32_16x16x32_fp8_fp8(mk_long(a1x, a1y), Qf[ks], Sb, 0, 0, 0);
            }
            float xa[4], xb[4]; float cm = -INFINITY;
#pragma unroll
            for (int r = 0; r < 4; ++r) { xa[r] = Sa[r] * sl2; xb[r] = Sb[r] * sl2; }
            if (!fullk) {
#pragma unroll
                for (int r = 0; r < 4; ++r) { const int ka = c * 32 + 4 * fq + r, kb2 = ka + 16; xa[r] = (ka < nvalid) ? xa[r] : -INFINITY; xb[r] = (kb2 < nvalid) ? xb[r] : -INFINITY; } }
#pragma unroll
            for (int r = 0; r < 4; ++r) cm = fmaxf(cm, fmaxf(xa[r], xb[r]));
            cm = fmaxf(cm, __shfl_xor(cm, 16)); cm = fmaxf(cm, __shfl_xor(cm, 32));
            if (__ballot(cm > mrun + 6.0f)) {
                const float mnew = fmaxf(mrun, cm);
                const float alpha = __builtin_amdgcn_exp2f(mrun - mnew);
                lrun *= alpha; mrun = mnew;
#pragma unroll
                for (int rt = 0; rt < 16; ++rt) O[rt] = O[rt] * alpha;
            }
            float ps = 0.f; float pa[4], pb[4];
#pragma unroll
            for (int r = 0; r < 4; ++r) { pa[r] = __builtin_amdgcn_exp2f(xa[r] - mrun); pb[r] = __builtin_amdgcn_exp2f(xb[r] - mrun); ps += pa[r] + pb[r]; }
            ps += __shfl_xor(ps, 16); ps += __shfl_xor(ps, 32);
            lrun += ps;
            int pw0 = __builtin_amdgcn_cvt_pk_fp8_f32(pa[0], pa[1], 0, false); pw0 = __builtin_amdgcn_cvt_pk_fp8_f32(pa[2], pa[3], pw0, true);
            int pw1 = __builtin_amdgcn_cvt_pk_fp8_f32(pb[0], pb[1], 0, false); pw1 = __builtin_amdgcn_cvt_pk_fp8_f32(pb[2], pb[3], pw1, true);
            const long Pf = mk_long((unsigned)pw0, (unsigned)pw1);
#pragma unroll
            for (int rt = 0; rt < 16; ++rt) {
                const v2i_t tv = __builtin_amdgcn_ds_read_tr8_b64_v2i32((LAS v2i_t*)(cb + tr_off + 16 * rt));
                const int t0 = tv[0], t1 = tv[1];
                O[rt] = __builtin_amdgcn_mfma_f32_16x16x32_fp8_fp8(mk_long((unsigned)t0, (unsigned)t1), Pf, O[rt], 0, 0, 0);
            }
            asm volatile("" ::: "memory");
            }
        }
#undef SA_GATHER
        const float inv = 1.0f / lrun;
        asm volatile("" ::: "memory");
        if (j16 < 8) {
#pragma unroll
            for (int rt = 0; rt < 16; ++rt) { u32x2 o; o.x = pk2(O[rt][0] * inv, O[rt][1] * inv); o.y = pk2(O[rt][2] * inv, O[rt][3] * inv); *(LAS u32x2*)(cb + j16 * 512 + rt * 32 + fq * 8) = o; }
        }
        asm volatile("" ::: "memory");
        { bf16* obase = olat + (size_t)t * 2048;
#pragma unroll
          for (int q = 0; q < 4; ++q) { const u32x4 v = *(const LAS u32x4*)(cb + q * 1024 + lane * 16); __builtin_nontemporal_store(v, (u32x4*)(obase + q * 512 + lane * 8)); } }
        asm volatile("" ::: "memory");
    }
}

__device__ __forceinline__ void routing_token(const float acc, const int lane, const float* rbias, int* tk_e, float* tk_w, LAS unsigned* hist, const size_t t, const bool do_count) {
    const float sc = 1.0f / (1.0f + expf(-acc));
    const float ch = sc + rbias[lane];
    int rk = 0;
#pragma unroll
    for (int k = 1; k < 8; ++k) { const int src = (lane & ~7) | ((lane + k) & 7); const float o = __shfl(ch, src); rk += (o > ch || (o == ch && src < lane)) ? 1 : 0; }
    float gs = (rk < 2) ? ch : 0.f; gs += __shfl_xor(gs, 1); gs += __shfl_xor(gs, 2); gs += __shfl_xor(gs, 4);
    int grk = 0; const int myg = lane >> 3;
#pragma unroll
    for (int g = 0; g < 8; ++g) { const float o = __shfl(gs, g * 8); grk += (o > gs || (o == gs && g < myg)) ? 1 : 0; }
    const float cm = (grk < 4) ? ch : -INFINITY;
    int erk = 0;
    for (int j = 0; j < 64; ++j) { const float o = __shfl(cm, j); erk += (o > cm || (o == cm && j < lane)) ? 1 : 0; }
    const bool selx = (erk < EK) && (grk < 4);
    const float ssum = wave_sum(selx ? sc : 0.f);
    if (selx) { tk_e[t * 8 + erk] = lane; tk_w[t * 8 + erk] = sc / ssum * 2.5f; if (do_count) __hip_atomic_fetch_add(&hist[lane], 1u, __ATOMIC_RELAXED, __HIP_MEMORY_SCOPE_WORKGROUP); }
}
__device__ __forceinline__ void phase_ln1_router(Frame& F, const float* g1, const float* b1, const float* rbias, const bool do_count) {
    const int lane_ = lane_id(), tid_ = F.wave * 64 + lane_;
    const float* pre = F.out;
    const float* wrT = (const float*)(F.ws + WS_WRT);
    bf16* h = (bf16*)(F.ws + WS_H);
    int* tk_e = (int*)(F.ws + WS_TOPK + TK_E); float* tk_w = (float*)(F.ws + WS_TOPK + TK_W);
    const int lane = lane_, w = F.wave, tid = tid_;
    LAS float* stats = (LAS float*)F.lds;
    LAS float* lg = (LAS float*)(F.lds + 1024) + (w & 3) * 1024;
    LAS unsigned* hist = (LAS unsigned*)(F.lds + 1024 + 16384);
    if (do_count && tid < 64) hist[tid] = 0u;
    for (int chunk = F.bid; chunk < NTOK / 64; chunk += F.G) {
        __syncthreads();
        f32x4 ggv[8], bbv[8];
#pragma unroll
        for (int q = 0; q < 8; ++q) { const int c = (lane + 64 * q) * 4; ggv[q] = *(const f32x4*)(g1 + c); bbv[q] = *(const f32x4*)(b1 + c); }
        for (int i = 0; i < 8; ++i) {
            const int tl = w * 8 + i; const size_t t = (size_t)chunk * 64 + tl;
            f32x4 v[8]; float s = 0.f;
#pragma unroll
            for (int q = 0; q < 8; ++q) { v[q] = *(const f32x4*)(pre + t * DM + (lane + 64 * q) * 4); s += (v[q][0] + v[q][1]) + (v[q][2] + v[q][3]); }
            const float mean = wave_sum(s) * (1.0f / DM); float s2 = 0.f;
#pragma unroll
            for (int q = 0; q < 8; ++q) { v[q] = v[q] - mean; s2 += (v[q][0] * v[q][0] + v[q][1] * v[q][1]) + (v[q][2] * v[q][2] + v[q][3] * v[q][3]); }
            const float rstd = 1.0f / sqrtf(wave_sum(s2) * (1.0f / DM) + LN_EPS);
#pragma unroll
            for (int q = 0; q < 8; ++q) { const int c = (lane + 64 * q) * 4;
                const f32x4 y = v[q] * rstd * ggv[q] + bbv[q];
                u32x2 o; o.x = pk2(y[0], y[1]); o.y = pk2(y[2], y[3]); *(u32x2*)(h + t * DM + c) = o; }
            if (lane == 0) { stats[tl * 2] = mean; stats[tl * 2 + 1] = rstd; }
        }
        __syncthreads();
        if (w < 4) {
            const int j16 = lane & 15, kq = lane >> 4, tl = 16 * w + j16;
            const float mean = stats[tl * 2], rstd = stats[tl * 2 + 1];
            const float* prow = pre + ((size_t)chunk * 64 + tl) * DM + 4 * kq; const float* wrow = wrT + (size_t)j16 * DM + 4 * kq;
            f32x4 acc[4];
#pragma unroll
            for (int tt = 0; tt < 4; ++tt) acc[tt] = (f32x4){0.f, 0.f, 0.f, 0.f};
#pragma unroll 2
            for (int m = 0; m < 128; ++m) {
                const f32x4 p = *(const f32x4*)(prow + 16 * m), gg = *(const f32x4*)(g1 + 16 * m + 4 * kq), bb = *(const f32x4*)(b1 + 16 * m + 4 * kq);
                const f32x4 hv = (p - mean) * rstd * gg + bb;
                f32x4 wv[4];
#pragma unroll
                for (int tt = 0; tt < 4; ++tt) wv[tt] = *(const f32x4*)(wrow + (size_t)tt * 16 * DM + 16 * m);
#pragma unroll
                for (int e = 0; e < 4; ++e)
#pragma unroll
                    for (int tt = 0; tt < 4; ++tt) acc[tt] = __builtin_amdgcn_mfma_f32_16x16x4f32(hv[e], wv[tt][e], acc[tt], 0, 0, 0);
            }
#pragma unroll
            for (int tt = 0; tt < 4; ++tt)
#pragma unroll
                for (int r = 0; r < 4; ++r) lg[(4 * kq + r) * 64 + 16 * tt + j16] = acc[tt][r];
            LDS_WAIT();
            for (int tk = 0; tk < 16; ++tk) routing_token(lg[tk * 64 + lane], lane, rbias, tk_e, tk_w, hist, (size_t)chunk * 64 + 16 * w + tk, do_count);
        }
    }
}
__device__ __forceinline__ void phase_flush_hist(Frame& F) {
    const int tid = F.wave * 64 + lane_id();
    LAS unsigned* hist = (LAS unsigned*)(F.lds + 1024 + 16384);
    __syncthreads();
    if (tid < 64 && hist[tid]) atomicAdd(F.ctl + CW_CNT + tid, hist[tid]);
}

__device__ __forceinline__ void phase_scatter(Frame& F) {
    const int lane_ = lane_id(), tid_ = F.wave * 64 + lane_;
    const int tid = tid_;
    LAS int* segs = (LAS int*)F.lds;
    LAS unsigned* lcnt = (LAS unsigned*)(F.lds + 1024);
    LAS unsigned* lbase = (LAS unsigned*)(F.lds + 2048);
    const int* tk_e = (const int*)(F.ws + WS_TOPK + TK_E); int* tk_pos = (int*)(F.ws + WS_TOPK + TK_POS);
    int* rowlist = (int*)(F.ws + WS_TOPK + TK_ROWLIST); int* mtt = (int*)(F.ws + WS_TOPK + TK_MTT);
    if (tid == 0) { int a = 0; for (int e = 0; e < NE; ++e) { segs[e] = a; a += (int)__hip_atomic_load(F.ctl + CW_CNT + e, RLX_AGENT); } segs[NE] = a; segs[NE + 1] = a + NTOK; }
    __syncthreads();
    if (F.bid == 0) {
        LAS int* tcum = (LAS int*)(F.lds + 3072);
        if (tid == 0) { int mt = 0; for (int g = 0; g < NGRP; ++g) { tcum[g] = mt; mt += (segs[g + 1] - segs[g] + 255) >> 8; } tcum[NGRP] = mt; __hip_atomic_store(F.ctl + CW_NMT, (unsigned)mt, RLX_AGENT); }
        __syncthreads();
        if (tid < NGRP) { const int g = tid, p0 = segs[g], n = segs[g + 1] - p0; int mt = tcum[g];
            for (int r = 0; r < n; r += 256, ++mt) { mtt[mt * 4 + 0] = g; mtt[mt * 4 + 1] = p0 + r; mtt[mt * 4 + 2] = (n - r < 256) ? n - r : 256; mtt[mt * 4 + 3] = 0; } }
        if (tid >= 256) rowlist[NSLOT + tid - 256] = 0;
    }
    const int sh0 = segs[NE];
    for (int chunk = F.bid; chunk < NTOK / 64; chunk += F.G) {
        if (tid < 64) lcnt[tid] = 0u;
        __syncthreads();
        const int t = chunk * 64 + (tid >> 3), k = tid & 7;
        const int e = tk_e[(size_t)t * 8 + k];
        const unsigned li = __hip_atomic_fetch_add(&lcnt[e], 1u, __ATOMIC_RELAXED, __HIP_MEMORY_SCOPE_WORKGROUP);
        __syncthreads();
        if (tid < 64) lbase[tid] = lcnt[tid] ? atomicAdd(F.ctl + CW_FILL + tid, lcnt[tid]) : 0u;
        __syncthreads();
        const int p = segs[e] + (int)lbase[e] + (int)li;
        rowlist[p] = t; tk_pos[(size_t)t * 8 + k] = p;
        if (tid < 64) rowlist[sh0 + chunk * 64 + tid] = chunk * 64 + tid;
        __syncthreads();
    }
}

struct CombRows { u32x4 hq[4]; u32x2 y[8][4]; u32x4 ysh[4]; };
__device__ __forceinline__ void comb_load(CombRows& R, const bf16* h, const unsigned char* Y8, const bf16* Ysh, const int t, const int posv, const int slot0, const int lane) {
#pragma unroll
    for (int i = 0; i < 4; ++i) { R.hq[i] = *(const u32x4*)(h + (size_t)t * DM + (lane + 64 * i) * 8); R.ysh[i] = __builtin_nontemporal_load((const u32x4*)(Ysh + (size_t)t * DM + (lane + 64 * i) * 8)); }
#pragma unroll
    for (int k = 0; k < 8; ++k) { const int p = __builtin_amdgcn_readlane(posv, slot0 + k);
#pragma unroll
        for (int i = 0; i < 4; ++i) R.y[k][i] = __builtin_nontemporal_load((const u32x2*)(Y8 + (size_t)p * DM + (lane + 64 * i) * 8)); }
}
__device__ __forceinline__ void comb_finish(const CombRows& R, const float* g2, const float* b2, float* out, const int t, const float wvv, const int slot0, const int lane) {
    f32x4 a[4][2];
#pragma unroll
    for (int i = 0; i < 4; ++i) { f32x4 x0, x1, s0, s1; unpack8(R.hq[i], x0, x1); unpack8(R.ysh[i], s0, s1); a[i][0] = x0 * DN_ALPHA + s0; a[i][1] = x1 * DN_ALPHA + s1; }
#pragma unroll
    for (int k = 0; k < 8; ++k) { const float wk = __builtin_bit_cast(float, __builtin_amdgcn_readlane(__builtin_bit_cast(int, wvv), slot0 + k));
#pragma unroll
        for (int i = 0; i < 4; ++i) { const u32x2 q8 = R.y[k][i];
            const f32x2 y01 = __builtin_amdgcn_cvt_pk_f32_fp8((int)q8.x, false), y23 = __builtin_amdgcn_cvt_pk_f32_fp8((int)q8.x, true), y45 = __builtin_amdgcn_cvt_pk_f32_fp8((int)q8.y, false), y67 = __builtin_amdgcn_cvt_pk_f32_fp8((int)q8.y, true);
            a[i][0] += (f32x4){y01[0], y01[1], y23[0], y23[1]} * wk; a[i][1] += (f32x4){y45[0], y45[1], y67[0], y67[1]} * wk; } }
    float s = 0.f;
#pragma unroll
    for (int i = 0; i < 4; ++i) s += ((a[i][0][0] + a[i][0][1]) + (a[i][0][2] + a[i][0][3])) + ((a[i][1][0] + a[i][1][1]) + (a[i][1][2] + a[i][1][3]));
    const float mean = wave_sum(s) * (1.0f / DM); float s2 = 0.f;
#pragma unroll
    for (int i = 0; i < 4; ++i) { a[i][0] = a[i][0] - mean; a[i][1] = a[i][1] - mean;
        s2 += ((a[i][0][0] * a[i][0][0] + a[i][0][1] * a[i][0][1]) + (a[i][0][2] * a[i][0][2] + a[i][0][3] * a[i][0][3])) + ((a[i][1][0] * a[i][1][0] + a[i][1][1] * a[i][1][1]) + (a[i][1][2] * a[i][1][2] + a[i][1][3] * a[i][1][3])); }
    const float rstd = 1.0f / sqrtf(wave_sum(s2) * (1.0f / DM) + LN_EPS);
#pragma unroll
    for (int i = 0; i < 4; ++i) { const int c = (lane + 64 * i) * 8;
        const f32x4 ga = *(const f32x4*)(g2 + c), gb = *(const f32x4*)(g2 + c + 4), ba = *(const f32x4*)(b2 + c), bb = *(const f32x4*)(b2 + c + 4);
        __builtin_nontemporal_store(a[i][0] * rstd * ga + ba, (f32x4*)(out + (size_t)t * DM + c)); __builtin_nontemporal_store(a[i][1] * rstd * gb + bb, (f32x4*)(out + (size_t)t * DM + c + 4)); }
}
__device__ __forceinline__ void phase_combine(Frame& F, const float* g2, const float* b2) {
    const int lane = lane_id();
    const bf16* h = (const bf16*)(F.ws + WS_H); const unsigned char* Y8 = (const unsigned char*)(F.ws + WS_Y); const bf16* Ysh = (const bf16*)(F.ws + WS_YSH);
    const float* tk_w = (const float*)(F.ws + WS_TOPK + TK_W); const int* tk_pos = (const int*)(F.ws + WS_TOPK + TK_POS);
    const int gw = F.bid * NWAVES + F.wave, NGW = F.G * NWAVES;
    for (int t0 = gw * 8; t0 < NTOK; t0 += NGW * 8) {
        const int posv = tk_pos[(size_t)t0 * 8 + lane]; const float wvv = tk_w[(size_t)t0 * 8 + lane];
        for (int i = 0; i < 8; ++i) {
            CombRows R;
            comb_load(R, h, Y8, Ysh, t0 + i, posv, 8 * i, lane);
            __builtin_amdgcn_sched_barrier(0);
            comb_finish(R, g2, b2, F.out, t0 + i, wvv, 8 * i, lane);
            __builtin_amdgcn_sched_barrier(0);
        }
    }
}

#ifndef MK_CHECK
#define MK_CHECK 0
#endif
constexpr int CW_CHK = 16384 + 256;
#if MK_CHECK
__device__ __forceinline__ float fp8f(unsigned char v) { const f32x2 a = __builtin_amdgcn_cvt_pk_f32_fp8((int)v, false); return a[0]; }
__device__ __forceinline__ void phase_check_attn(Frame& F) {
    const int tid = F.wave * 64 + lane_id();
    const bf16* qi = (const bf16*)(F.ws + WS_QI); const bf16* kin = (const bf16*)(F.ws + WS_KIN); const float* wis = (const float*)(F.ws + WS_WI);
    const bf16* qlat = (const bf16*)(F.ws + WS_QLAT); const unsigned char* ckv8 = (const unsigned char*)(F.ws + WS_CKVN);
    const unsigned short* selb = (const unsigned short*)(F.ws + WS_SEL); const bf16* olat = (const bf16*)(F.ws + WS_OLAT);
    LAS float* sc = (LAS float*)F.lds;
    LAS unsigned char* flg = (LAS unsigned char*)(F.lds + 32768);
    LAS unsigned char* seen = (LAS unsigned char*)(F.lds + 40960);
    LAS float* pl = (LAS float*)(F.lds + 49152);
    LAS int* cnt = (LAS int*)(F.lds + 57344);
    LAS float* errs = (LAS float*)(F.lds + 57344 + 64);
    const int POS[16] = {0, 1, 100, 255, 256, 257, 300, 511, 1000, 2047, 2048, 4095, 5000, 6143, 6144, 8191};
    for (int s = F.bid; s < 32; s += F.G) {
        int pos = 0;
#pragma unroll
        for (int q = 0; q < 16; ++q) pos = ((s >> 1) == q) ? POS[q] : pos;
        const int b = s & 1, n = pos + 1; const size_t t = (size_t)b * SEQ + pos;
        __syncthreads();
        if (tid < 4) cnt[tid] = 0;
        if (tid < 2) errs[tid] = 0.f;
        for (int k = tid; k < SEQ; k += NTHR) { flg[k] = 0; seen[k] = 0; }
        for (int k = tid; k < n; k += NTHR) {
            float tot = 0.f;
            for (int hh = 0; hh < 16; ++hh) { float d = 0.f;
                for (int e = 0; e < 64; ++e) d += bf2f(qi[t * 1024 + hh * 64 + e]) * bf2f(kin[((size_t)b * SEQ + k) * 64 + e]);
                tot += wis[t * 16 + hh] * fmaxf(d, 0.f); }
            sc[k] = tot;
        }
        __syncthreads();
        const unsigned short* sel = selb + t * TOPK;
        if (n > TOPK) {
            for (int k = tid; k < n; k += NTHR) { const float v = sc[k]; int rk = 0; for (int k2 = 0; k2 < n; ++k2) { const float o = sc[k2]; rk += (o > v || (o == v && k2 < k)) ? 1 : 0; } flg[k] = rk < TOPK ? 1 : 0; }
            __syncthreads();
            if (tid < TOPK) { const int k = sel[tid]; if (k >= n) atomicAdd((int*)&cnt[1], 1000); else { if (!flg[k]) atomicAdd((int*)&cnt[0], 1); if (seen[k]) atomicAdd((int*)&cnt[1], 1000); seen[k] = 1; } }
        } else {
            if (tid < TOPK) { const int k = sel[tid]; if (tid < n ? (k != tid) : (k != 0xFFFF)) atomicAdd((int*)&cnt[1], 1000); }
        }
        __syncthreads();
        const int nv = n < TOPK ? n : TOPK;
        for (int i = tid; i < 8 * 256; i += NTHR) { const int hh = i >> 8, k = i & 255; float lg = -INFINITY;
            if (k < nv) { const int key = sel[k]; float d = 0.f; for (int r = 0; r < 256; ++r) d += bf2f(qlat[(t * 8 + hh) * 256 + r]) * fp8f(ckv8[((size_t)b * SEQ + key) * 256 + r]); lg = d * 0.08838834764831845f; }
            pl[i] = lg; }
        __syncthreads();
        if (tid < 8) { float m = -INFINITY; for (int k = 0; k < 256; ++k) m = fmaxf(m, pl[tid * 256 + k]); float l = 0.f; for (int k = 0; k < 256; ++k) { const float p = expf(pl[tid * 256 + k] - m); pl[tid * 256 + k] = p; l += p; } for (int k = 0; k < 256; ++k) pl[tid * 256 + k] /= l; }
        __syncthreads();
        for (int i = tid; i < 8 * 256; i += NTHR) { const int hh = i >> 8, r = i & 255; float o = 0.f;
            for (int k = 0; k < nv; ++k) o += pl[hh * 256 + k] * fp8f(ckv8[((size_t)b * SEQ + sel[k]) * 256 + r]);
            const float got = bf2f(olat[(t * 8 + hh) * 256 + r]);
            __hip_atomic_fetch_add(&errs[0], (got - o) * (got - o), __ATOMIC_RELAXED, __HIP_MEMORY_SCOPE_WORKGROUP); __hip_atomic_fetch_add(&errs[1], o * o, __ATOMIC_RELAXED, __HIP_MEMORY_SCOPE_WORKGROUP); if (!(got == got)) atomicAdd((int*)&cnt[2], 1); }
        __syncthreads();
        if (tid == 0) { unsigned code = 0; if (cnt[0] > 8 || cnt[1] > 0) code |= 1u; if (cnt[2] > 0 || !(errs[0] <= 0.12f * 0.12f * errs[1])) code |= 2u; if (code) atomicOr(F.ctl + CW_CHK, code); }
    }
}
__device__ __forceinline__ void phase_check_apply(Frame& F) {
    const unsigned code = __hip_atomic_load(F.ctl + CW_CHK, RLX_AGENT);
    if (code) { const float v = (code & 1u) ? __builtin_nanf("") : 0.f; const size_t gt = (size_t)F.bid * NTHR + F.wave * 64 + lane_id();
        for (size_t i = gt; i < (size_t)NTOK * DM; i += (size_t)F.G * NTHR) F.out[i] = v; }
}
#endif

constexpr int NPHASE = 16;
constexpr unsigned REPEAT_MASK = 0x0u;
constexpr int TIME_PHASE = -1;
constexpr int CW_TIME = 16384 + 320;
struct Args { const float* in[24]; float* out; unsigned char* ws; int ph_lo, ph_hi; };

__global__ void __launch_bounds__(NTHR, 2) mk_fwd(Args args) {
    extern __shared__ __attribute__((aligned(16))) unsigned char lds_raw[];
    Frame F;
    F.lds = (LAS unsigned char*)lds_raw;
    F.MISC = (volatile LAS unsigned*)(F.lds + MISC_OFF);
    F.wave = __builtin_amdgcn_readfirstlane(threadIdx.x >> 6);
    F.G = gridDim.x; F.bid = blockIdx.x;
    F.ws = args.ws; F.ctl = (unsigned*)(args.ws + WS_CTL); F.out = args.out;
    for (int u = threadIdx.x; u < (LDS_BYTES - MISC_OFF) / 4; u += NTHR) ((LAS unsigned*)(F.lds + MISC_OFF))[u] = 0u;
    __syncthreads();
    const int lo = args.ph_lo, hi = args.ph_hi;
    const bool multi = (hi - lo) > 1;
    XcdBarrier bar; bar.bar = F.ctl + CW_BAR; bar.x = 0; bar.st = nullptr; bar.wave = F.wave;
    if (multi) bar = xcd_barrier_post(F.ctl + CW_BAR, F.MISC + 8, F.wave);
#ifndef ONLY_PHASE
#define ONLY_PHASE -1
#endif
#define IN(k) ((ONLY_PHASE < 0 || ONLY_PHASE == (k)) && lo <= (k) && (k) < hi)
#define SEAM(k) do { if (IN(k) && IN((k) + 1)) { xcd_barrier(bar); \
        if (TIME_PHASE >= 0 && F.bid == 0 && F.wave == 0) { const unsigned long long now_ = __builtin_amdgcn_s_memrealtime(); \
            if ((k) == TIME_PHASE - 1 || ((k) == 0 && TIME_PHASE == 0 && false)) { if (lane_id() == 0) { F.ctl[CW_TIME] = (unsigned)now_; } } \
            if ((k) == TIME_PHASE) { if (lane_id() == 0) { F.ctl[CW_TIME + 1] = (unsigned)now_ - F.ctl[CW_TIME]; } } } } } while (0)
    unsigned char* ws = args.ws;
    const ExpW EW{args.in[16], args.in[17], args.in[18], args.in[19], args.in[20], args.in[21]};
    const bool ride = false;
    if (TIME_PHASE == 0 && F.bid == 0 && threadIdx.x == 0) F.ctl[CW_TIME] = (unsigned)__builtin_amdgcn_s_memrealtime();

    if (IN(0)) for (int rep_ = 0; rep_ < 1 + (int)((REPEAT_MASK >> 0) & 1u); ++rep_) { phase_convert_small(F, args.in[0], args.in[1], args.in[5], args.in[6], args.in[7], args.in[9], args.in[10], args.in[11], args.in[8], args.in[14]); } SEAM(0);

    if (IN(1)) for (int rep_ = 0; rep_ < 1 + (int)((REPEAT_MASK >> 1) & 1u); ++rep_) {
        FillPlain f{(const char*)(ws + WS_XB), (const char*)(ws + WS_WIN), 4096u, 4096u, 32};
        DenseSched<FillPlain> S{64, 30, F.G, F.bid, f};
        EpiP1 E{(bf16*)(ws + WS_Q), (bf16*)(ws + WS_QI), (bf16*)(ws + WS_XP), (bf16*)(ws + WS_GATES), (float*)(ws + WS_CKVRAW), (float*)(ws + WS_KIWI)};
        pg8::gemm_phase<EpiP1, DenseSched<FillPlain>, false, true, true>(F.lds, F.wave, 4096u, 4096u, S, E);
    } SEAM(1);

    if (IN(2)) for (int rep_ = 0; rep_ < 1 + (int)((REPEAT_MASK >> 2) & 1u); ++rep_) { phase_postproc(F, args.in[2], args.in[3], args.in[4]); } SEAM(2);

    if (IN(3)) for (int rep_ = 0; rep_ < 1 + (int)((REPEAT_MASK >> 3) & 1u); ++rep_) {
        FillQlatPool f{(const char*)(ws + WS_Q), (const char*)(ws + WS_DIFF), (const char*)(ws + WS_WUK), (const char*)(ws + WS_WPOOL)};
        DenseSched<FillQlatPool> S{64, 12, F.G, F.bid, f};
        EpiQlatPool E{(bf16*)(ws + WS_QLAT), (bf16*)(ws + WS_POOL), (const float*)(ws + WS_CSCALE)};
        pg8::gemm_phase<EpiQlatPool, DenseSched<FillQlatPool>, false, true, true>(F.lds, F.wave, 2048u, 512u, S, E);
    } SEAM(3);

    if (IN(4)) for (int rep_ = 0; rep_ < 1 + (int)((REPEAT_MASK >> 4) & 1u); ++rep_) { phase_index_scores(F); } SEAM(4);
    if (IN(5)) for (int rep_ = 0; rep_ < 1 + (int)((REPEAT_MASK >> 5) & 1u); ++rep_) { phase_select(F, EW, ride && rep_ == 0); } SEAM(5);
    if (IN(6)) for (int rep_ = 0; rep_ < 1 + (int)((REPEAT_MASK >> 6) & 1u); ++rep_) { phase_sparse_attn(F, EW, ride && rep_ == 0); } SEAM(6);
#if MK_CHECK
    if (IN(6) && IN(7)) { phase_check_attn(F); xcd_barrier(bar); }
#endif

    if (IN(7)) for (int rep_ = 0; rep_ < 1 + (int)((REPEAT_MASK >> 7) & 1u); ++rep_) {
        FillO f{(const char*)(ws + WS_OLAT), (const char*)(ws + WS_WUV)};
        DenseSched<FillO> S{64, 4, F.G, F.bid, f};
        EpiBf16 E{(bf16*)(ws + WS_ATTN), 1024};
        pg8::gemm_phase<EpiBf16, DenseSched<FillO>, false, true, true>(F.lds, F.wave, 4096u, 1024u, S, E);
    } SEAM(7);

    if (IN(8)) for (int rep_ = 0; rep_ < 1 + (int)((REPEAT_MASK >> 8) & 1u); ++rep_) {
        FillPlain f{(const char*)(ws + WS_ATTN), (const char*)(ws + WS_WPA), 2048u, 2048u, 16};
        DenseSched<FillPlain> S{64, 8, F.G, F.bid, f};
        EpiGate<0> E{(const bf16*)(ws + WS_GATES), (bf16*)(ws + WS_M1), (bf16*)(ws + WS_MERGED)};
        pg8::gemm_phase<EpiGate<0>, DenseSched<FillPlain>, false, true, true>(F.lds, F.wave, 2048u, 2048u, S, E);
    } SEAM(8);

    if (IN(9)) for (int rep_ = 0; rep_ < 1 + (int)((REPEAT_MASK >> 9) & 1u); ++rep_) {
        FillPlain f{(const char*)(ws + WS_POOL), (const char*)(ws + WS_WPP), 2048u, 2048u, 16};
        DenseSched<FillPlain> S{64, 8, F.G, F.bid, f};
        EpiGate<1> E{(const bf16*)(ws + WS_GATES), (bf16*)(ws + WS_M1), (bf16*)(ws + WS_MERGED)};
        pg8::gemm_phase<EpiGate<1>, DenseSched<FillPlain>, false, true, true>(F.lds, F.wave, 2048u, 2048u, S, E);
    } SEAM(9);

    if (IN(10)) for (int rep_ = 0; rep_ < 1 + (int)((REPEAT_MASK >> 10) & 1u); ++rep_) {
        FillPlain f{(const char*)(ws + WS_MERGED), (const char*)(ws + WS_WOUT), 4096u, 4096u, 32};
        DenseSched<FillPlain> S{64, 8, F.G, F.bid, f};
        EpiPre E{args.in[0], F.out};
        pg8::gemm_phase<EpiPre, DenseSched<FillPlain>, false, true, true>(F.lds, F.wave, 4096u, 4096u, S, E);
    } SEAM(10);

    if (IN(11)) for (int rep_ = 0; rep_ < 1 + (int)((REPEAT_MASK >> 11) & 1u); ++rep_) {
        for (int rl_ = 0; rl_ < 1 + (int)((REPEAT_MASK >> 17) & 1u); ++rl_) phase_ln1_router(F, args.in[12], args.in[13], args.in[15], rl_ == 0);
        phase_convert_experts(F, EW);
        phase_flush_hist(F);
    } SEAM(11);
    if (IN(12)) for (int rep_ = 0; rep_ < 1 + (int)((REPEAT_MASK >> 12) & 1u); ++rep_) { phase_scatter(F); } SEAM(12);

    if (IN(13)) for (int rep_ = 0; rep_ < 1 + (int)((REPEAT_MASK >> 13) & 1u); ++rep_) {
        const int nmt = (int)__hip_atomic_load(F.ctl + CW_NMT, RLX_AGENT);
        MoeSched S{(const int*)(ws + WS_TOPK + TK_MTT), nmt, 4, F.G, F.bid, true, (const char*)(ws + WS_H), (const char*)(ws + WS_HBUF), (const char*)(ws + WS_WGU), (const char*)(ws + WS_WD), (const int*)(ws + WS_TOPK + TK_ROWLIST), F.lds};
        S.prepare(F.wave * 64 + lane_id());
        EpiSwiGLU E{(bf16*)(ws + WS_HBUF)};
        pg8::gemm_phase<EpiSwiGLU, MoeSched, true, true, true>(F.lds, F.wave, 4096u, 4096u, S, E);
    } SEAM(13);

    if (IN(14)) for (int rep_ = 0; rep_ < 1 + (int)((REPEAT_MASK >> 14) & 1u); ++rep_) {
        const int nmt = (int)__hip_atomic_load(F.ctl + CW_NMT, RLX_AGENT);
        MoeSched S{(const int*)(ws + WS_TOPK + TK_MTT), nmt, 8, F.G, F.bid, false, (const char*)(ws + WS_H), (const char*)(ws + WS_HBUF), (const char*)(ws + WS_WGU), (const char*)(ws + WS_WD), (const int*)(ws + WS_TOPK + TK_ROWLIST), F.lds};
        S.prepare(F.wave * 64 + lane_id());
        EpiY E{(unsigned char*)(ws + WS_Y), (bf16*)(ws + WS_YSH)};
        pg8::gemm_phase<EpiY, MoeSched, false, true, true>(F.lds, F.wave, 1024u, 1024u, S, E);
    } SEAM(14);

    if (IN(15)) for (int rep_ = 0; rep_ < 1 + (int)((REPEAT_MASK >> 15) & 1u); ++rep_) { phase_combine(F, args.in[22], args.in[23]); }
#if MK_CHECK
    if (IN(15)) { xcd_barrier(bar); phase_check_apply(F); }
#endif
    if (TIME_PHASE >= 0 && multi && F.bid == 0 && F.wave == 0) {
        asm volatile("s_waitcnt vmcnt(0)" ::: "memory");
        if (TIME_PHASE == 15 && lane_id() == 0) { F.ctl[CW_TIME + 1] = (unsigned)__builtin_amdgcn_s_memrealtime() - F.ctl[CW_TIME]; }
        asm volatile("s_waitcnt vmcnt(0)" ::: "memory");
        const unsigned dur = __hip_atomic_load(F.ctl + CW_TIME + 1, RLX_AGENT); const unsigned long long t0 = __builtin_amdgcn_s_memrealtime();
        while (__builtin_amdgcn_s_memrealtime() - t0 < 4ull * dur) __builtin_amdgcn_s_sleep(8);
    }
#undef IN
#undef SEAM
}

#ifndef MK_ONE_LAUNCH
#define MK_ONE_LAUNCH 1
#endif
extern "C" void kernel_launch(void* const* d_in, const int* in_sizes, int n_in, void* d_out, int out_size, void* d_ws, size_t ws_size, hipStream_t stream) {
    static int grid = 0;
    if (grid == 0) {
        if (n_in != 24 || out_size != NTOK * DM || ws_size < WS_END) { fprintf(stderr, "kernel_launch: unexpected shapes (n_in %d out %d ws %zu)\n", n_in, out_size, ws_size); grid = -1; return; }
        int dev = 0, cus = 0;
        if (hipGetDevice(&dev) != hipSuccess || hipDeviceGetAttribute(&cus, hipDeviceAttributeMultiprocessorCount, dev) != hipSuccess) { grid = -1; return; }
        if (hipFuncSetAttribute((const void*)mk_fwd, hipFuncAttributeMaxDynamicSharedMemorySize, LDS_BYTES) != hipSuccess) { fprintf(stderr, "kernel_launch: hipFuncSetAttribute failed\n"); grid = -1; return; }
        int per_cu = 0;
        if (hipOccupancyMaxActiveBlocksPerMultiprocessor(&per_cu, (const void*)mk_fwd, NTHR, LDS_BYTES) != hipSuccess || per_cu < 1) fprintf(stderr, "kernel_launch: occupancy query says %d\n", per_cu);
        (void)hipGetLastError();
        grid = cus;
    }
    if (grid < 0) return;
    if (hipMemsetAsync((char*)d_ws + WS_CTL, 0, CTL_BYTES, stream) != hipSuccess) return;
    Args a{};
    for (int i = 0; i < 24; ++i) a.in[i] = (const float*)d_in[i];
    a.out = (float*)d_out; a.ws = (unsigned char*)d_ws;
#if MK_ONE_LAUNCH
    a.ph_lo = 0; a.ph_hi = NPHASE;
    hipLaunchKernelGGL(mk_fwd, dim3(grid), dim3(NTHR), LDS_BYTES, stream, a);
#else
    for (int p = 0; p < NPHASE; ++p) { a.ph_lo = p; a.ph_hi = p + 1; hipLaunchKernelGGL(mk_fwd, dim3(grid), dim3(NTHR), LDS_BYTES, stream, a); }
#endif
}
```

```cpp
#include <hip/hip_runtime.h>
#include <cstdio>
#include <cstdint>

#define LAS __attribute__((address_space(3)))
#define GAS __attribute__((address_space(1)))
typedef unsigned short bf16;
typedef short bf16x8 __attribute__((ext_vector_type(8)));
typedef short s16x4 __attribute__((ext_vector_type(4)));
typedef float f32x4 __attribute__((ext_vector_type(4)));
typedef float f32x2 __attribute__((ext_vector_type(2)));
typedef unsigned u32x4 __attribute__((ext_vector_type(4)));
typedef unsigned u32x2 __attribute__((ext_vector_type(2)));

constexpr int NTOK = 16384, SEQ = 8192, DM = 2048;
constexpr int NH = 8, DQK = 128, DV = 128, RKV = 256, IH = 16, IDH = 64, TOPK = 256;
constexpr int NE = 64, EK = 8, EDIM = 512, NGRP = 65;
constexpr int WIN_ROWS = 7680;
constexpr float LN_EPS = 1e-5f, RMS_EPS = 1e-6f;
constexpr float DN_ALPHA = 1.189207115002721f;
constexpr int NSLOT = NTOK * 9;
constexpr size_t SC_TOT = (size_t)128 * 128 * (64 * 65 / 2);

constexpr size_t MiB = 1u << 20;
constexpr size_t WS_CTL = 0, CTL_BYTES = 1 * MiB;
constexpr size_t WS_WIN = 1 * MiB;
constexpr size_t WS_WUK = 31 * MiB;
constexpr size_t WS_WUV = 32 * MiB;
constexpr size_t WS_WPOOL = 33 * MiB;
constexpr size_t WS_WPA = 34 * MiB;
constexpr size_t WS_WPP = 38 * MiB;
constexpr size_t WS_WOUT = 42 * MiB;
constexpr size_t WS_CSCALE = 50 * MiB;
constexpr size_t WS_WRT = 50 * MiB + 65536;
constexpr size_t WS_XB = 394 * MiB;
constexpr size_t WS_Q = 458 * MiB;
constexpr size_t WS_QI = 490 * MiB;
constexpr size_t WS_XP = 522 * MiB;
constexpr size_t WS_CKVRAW = 554 * MiB;
constexpr size_t WS_KIWI = 570 * MiB;
constexpr size_t WS_DIFF = 586 * MiB;
constexpr size_t WS_GATES = 181 * MiB;
constexpr size_t WS_QLAT = 309 * MiB;
constexpr size_t WS_CKVN = 373 * MiB;
constexpr size_t WS_KIN = 381 * MiB;
constexpr size_t WS_WI = 383 * MiB;
constexpr size_t WS_SEL = 654 * MiB;
constexpr size_t WS_SCORES = 662 * MiB;
constexpr size_t WS_POOL = 922 * MiB;
constexpr size_t WS_OLAT = 662 * MiB;
constexpr size_t WS_ATTN = 726 * MiB;
constexpr size_t WS_M1 = 758 * MiB;
constexpr size_t WS_MERGED = 822 * MiB;
constexpr size_t WS_WD = 51 * MiB;
constexpr size_t WS_H = 181 * MiB;
constexpr size_t WS_HBUF = 245 * MiB;
constexpr size_t WS_TOPK = 390 * MiB;
constexpr size_t WS_WGU = 394 * MiB;
constexpr size_t WS_Y = 394 * MiB;
constexpr size_t WS_YSH = WS_Y + (size_t)NTOK * 8 * DM;
constexpr size_t WS_END = 1024 * MiB;
static_assert(WS_DIFF + 32 * MiB <= 654 * MiB && WS_SCORES + 260 * MiB <= WS_POOL && WS_POOL + 32 * MiB <= 970 * MiB && WS_WI + 1 * MiB <= 390 * MiB, "mixer map");
static_assert(WS_SCORES + SC_TOT * 2 * 4 <= WS_POOL, "scores");
static_assert(WS_HBUF + (size_t)(NSLOT + 256) * EDIM * 2 <= WS_TOPK, "hbuf");
static_assert(WS_YSH + (size_t)NTOK * DM * 2 <= WS_END, "y");
constexpr size_t TK_E = 0;
constexpr size_t TK_W = 512 * 1024;
constexpr size_t TK_POS = 1024 * 1024;
constexpr size_t TK_ROWLIST = 1536 * 1024;
constexpr size_t TK_MTT = 2560 * 1024;
constexpr size_t TK_WRT = 3 * MiB;
constexpr int CW_BAR = 4096;
constexpr int CW_CNT = 16384;
constexpr int CW_FILL = 16384 + 64;
constexpr int CW_CVQ = 16384 + 192;
constexpr int CW_NMT = 16384 + 128;

constexpr int RING_BYTES = 131072;
constexpr int MISC_OFF = 143360;
constexpr int LDS_BYTES = 147456;
constexpr int NWAVES = 8, NTHR = 512;

#define RLX_AGENT __ATOMIC_RELAXED, __HIP_MEMORY_SCOPE_AGENT
#define LDS_WAIT() asm volatile("s_waitcnt lgkmcnt(0)" ::: "memory")
#define VM_WAIT() asm volatile("s_waitcnt vmcnt(0)" ::: "memory")

__device__ __forceinline__ int lane_id() { return (int)__builtin_amdgcn_mbcnt_hi(~0u, __builtin_amdgcn_mbcnt_lo(~0u, 0u)); }
__device__ __forceinline__ float bf2f(unsigned b) { return __uint_as_float(b << 16); }
__device__ __forceinline__ unsigned f2bf(float f) { unsigned u = __float_as_uint(f); return (u + 0x7fffu + ((u >> 16) & 1u)) >> 16; }
__device__ __forceinline__ unsigned pk2(float lo, float hi) { return f2bf(lo) | (f2bf(hi) << 16); }
__device__ __forceinline__ unsigned cvt_pk_bf16(float lo, float hi) { unsigned r; asm volatile("v_cvt_pk_bf16_f32 %0, %1, %2" : "=v"(r) : "v"(lo), "v"(hi)); return r; }
#define DPP_I(old, x, ctrl, rmask) __builtin_amdgcn_update_dpp((int)(old), (int)(x), (ctrl), (rmask), 0xf, false)
__device__ __forceinline__ int wave_scan_i(int x) {
    x += DPP_I(0, x, 0x111, 0xf); x += DPP_I(0, x, 0x112, 0xf); x += DPP_I(0, x, 0x114, 0xf); x += DPP_I(0, x, 0x118, 0xf);
    x += DPP_I(0, x, 0x142, 0xa); x += DPP_I(0, x, 0x143, 0xc); return x;
}
__device__ __forceinline__ int wave_sum_i(int v) { return __builtin_amdgcn_readlane(wave_scan_i(v), 63); }
__device__ __forceinline__ float wave_sum(float x) {
#define DPP_F(x_, ctrl, rmask) __builtin_bit_cast(float, __builtin_amdgcn_update_dpp(0, __builtin_bit_cast(int, x_), (ctrl), (rmask), 0xf, false))
    x += DPP_F(x, 0x111, 0xf); x += DPP_F(x, 0x112, 0xf); x += DPP_F(x, 0x114, 0xf); x += DPP_F(x, 0x118, 0xf);
    x += DPP_F(x, 0x142, 0xa); x += DPP_F(x, 0x143, 0xc);
#undef DPP_F
    return __builtin_bit_cast(float, __builtin_amdgcn_readlane(__builtin_bit_cast(int, x), 63));
}
__device__ __forceinline__ float wave_max(float x) {
#define DPP_K(x_, ctrl, rmask) __builtin_bit_cast(float, __builtin_amdgcn_update_dpp(__builtin_bit_cast(int, x_), __builtin_bit_cast(int, x_), (ctrl), (rmask), 0xf, false))
    x = fmaxf(x, DPP_K(x, 0x111, 0xf)); x = fmaxf(x, DPP_K(x, 0x112, 0xf)); x = fmaxf(x, DPP_K(x, 0x114, 0xf)); x = fmaxf(x, DPP_K(x, 0x118, 0xf));
    x = fmaxf(x, DPP_K(x, 0x142, 0xa)); x = fmaxf(x, DPP_K(x, 0x143, 0xc));
    return __builtin_bit_cast(float, __builtin_amdgcn_readlane(__builtin_bit_cast(int, x), 63));
}
__device__ __forceinline__ float wave_min(float x) {
    x = fminf(x, DPP_K(x, 0x111, 0xf)); x = fminf(x, DPP_K(x, 0x112, 0xf)); x = fminf(x, DPP_K(x, 0x114, 0xf)); x = fminf(x, DPP_K(x, 0x118, 0xf));
    x = fminf(x, DPP_K(x, 0x142, 0xa)); x = fminf(x, DPP_K(x, 0x143, 0xc));
#undef DPP_K
    return __builtin_bit_cast(float, __builtin_amdgcn_readlane(__builtin_bit_cast(int, x), 63));
}

#define XB_TMO      128
#define XB_XCNT(j)  (256  + 64 * (j))
#define XB_XSUB(j)  (1280 + 64 * (j))
#define XB_XGEN(j)  (2304 + 64 * (j))
#define XB_TOP      3328
#define XB_TOPGEN   3392
#define XCD_BAR_WORDS 3456
#define XB_SPIN_CAP (1u << 24)

__device__ __forceinline__ unsigned xb_ld(unsigned* p)              { return __hip_atomic_load(p, __ATOMIC_RELAXED, __HIP_MEMORY_SCOPE_AGENT); }
__device__ __forceinline__ unsigned xb_add(unsigned* p, unsigned v) { return __hip_atomic_fetch_add(p, v, __ATOMIC_RELAXED, __HIP_MEMORY_SCOPE_AGENT); }
__device__ __forceinline__ unsigned xb_xcc_id() { return (unsigned)__builtin_amdgcn_s_getreg((3 << 11) | 20) & 0xFu; }
#define XB_SPIN(cond, bar) do { unsigned _sp = 0; while (cond) { __builtin_amdgcn_s_sleep(1); \
    if ((++_sp & 255u) == 0u) { if (xb_ld(&(bar)[XB_TMO])) break; if (_sp > XB_SPIN_CAP) { atomicAdd(&(bar)[XB_TMO], 1u); break; } } } } while (0)

struct XcdBarrier { unsigned* bar; unsigned x; volatile LAS unsigned* st; int wave; };

__device__ __forceinline__ XcdBarrier xcd_barrier_post(unsigned* bar, volatile LAS unsigned* st, int wave) {
    XcdBarrier b; b.bar = bar; b.x = xb_xcc_id(); b.st = st; b.wave = wave;
    if (wave == 0 && lane_id() == 0) (void)xb_add(&bar[XB_XCNT(b.x)], 1u);
    return b;
}
__device__ __forceinline__ void xcd_barrier_complete(unsigned* bar, unsigned x, unsigned& nloc, unsigned& nx) {
    const unsigned G = gridDim.x * gridDim.y * gridDim.z;
    unsigned sum, cnt, mine, sp = 0u;
    for (;;) {
        sum = 0u; cnt = 0u; mine = 0u;
#pragma unroll
        for (unsigned j = 0; j < 16; ++j) { const unsigned c = xb_ld(&bar[XB_XCNT(j)]); sum += c; cnt += (c > 0u) ? 1u : 0u; mine = (j == x) ? c : mine; }
        if (sum == G) break;
        __builtin_amdgcn_s_sleep(1);
        if ((++sp & 255u) == 0u) { if (xb_ld(&bar[XB_TMO])) break; if (sp > XB_SPIN_CAP) { atomicAdd(&bar[XB_TMO], 1u); break; } }
    }
    nloc = mine > 0u ? mine : 1u; nx = cnt > 0u ? cnt : 1u;
}
__device__ __forceinline__ void xcd_barrier(const XcdBarrier& b) {
    asm volatile("s_waitcnt vmcnt(0)" ::: "memory");
    __syncthreads();
    if (b.wave == 0 && lane_id() == 0) {
        unsigned* bar = b.bar;
        __builtin_amdgcn_s_waitcnt(0);
        unsigned nloc = b.st[0], nx = b.st[1];
        if (nloc == 0u) { xcd_barrier_complete(bar, b.x, nloc, nx); b.st[0] = nloc; b.st[1] = nx; }
        const unsigned old = xb_add(&bar[XB_XSUB(b.x)], 1u);
        const unsigned gen = old / nloc;
        if (old + 1u == (gen + 1u) * nloc) {
            __builtin_amdgcn_fence(__ATOMIC_RELEASE, "agent");
            asm volatile("s_waitcnt vmcnt(0)" ::: "memory");
            const unsigned og = xb_add(&bar[XB_TOP], 1u);
            const unsigned tg = og / nx;
            if (og + 1u == (tg + 1u) * nx) xb_add(&bar[XB_TOPGEN], 1u);
            else XB_SPIN(xb_ld(&bar[XB_TOPGEN]) == tg, bar);
            __builtin_amdgcn_fence(__ATOMIC_ACQUIRE, "agent");
            xb_add(&bar[XB_XGEN(b.x)], 1u);
            asm volatile("s_waitcnt vmcnt(0)" ::: "memory");
        } else {
            XB_SPIN(xb_ld(&bar[XB_XGEN(b.x)]) == gen, bar);
            __builtin_amdgcn_fence(__ATOMIC_ACQUIRE, "agent");
            asm volatile("s_waitcnt vmcnt(0)" ::: "memory");
        }
    }
    __syncthreads();
}

namespace pg8 {
constexpr int BM = 256, BK = 64, HALF = 128, HTB = HALF * BK * 2, STAGE_BYTES = 8 * HTB, NXCD = 8, WGM = 8;

__host__ __device__ __forceinline__ int lds_byte(int r, int c) { const int st = (r >> 4) * 2 + (c >> 5), rr = r & 15, cc = c & 31, ob = rr * 64 + cc * 2; return st * 1024 + (ob ^ (((ob >> 9) & 1) << 5)); }
__host__ __device__ __forceinline__ void stage_rc(int b, int& R, int& C) { const int st = b / 1024, sb = b % 1024, swz = sb ^ (((sb >> 9) & 1) << 5); R = (st >> 1) * 16 + swz / 64; C = (st & 1) * 32 + (swz % 64) / 2; }
__host__ __device__ __forceinline__ int perm32(int rho) { const int n = rho >> 4, i = rho & 15; return 8 * (i >> 2) + 4 * n + (i & 3); }

__device__ __forceinline__ const char* uptr(const char* p) { const unsigned long long v = (unsigned long long)p; const unsigned lo = __builtin_amdgcn_readfirstlane((unsigned)v), hi = __builtin_amdgcn_readfirstlane((unsigned)(v >> 32)); return (const char*)(((unsigned long long)hi << 32) | lo); }
struct GUnit {
    const char* A;
    const char* B0;
    const char* B1;
    const int* rows;
    int rows_lds;
    int nt;
    int pm, pn, aux0, aux1;
};

__device__ __forceinline__ void tile_order(int L, int nM, int nN, int& pm, int& pn) {
    const int nwg = nM * nN;
    int wgid = L; { const int q = nwg / NXCD, r = nwg % NXCD, xcd = wgid % NXCD, off = wgid / NXCD; wgid = (xcd < r ? xcd * (q + 1) : r * (q + 1) + (xcd - r) * q) + off; }
    const int nig = WGM * nN, gid = wgid / nig, fm = gid * WGM, gsz = (nM - fm) < WGM ? (nM - fm) : WGM;
    pm = fm + ((wgid % nig) % gsz); pn = (wgid % nig) / gsz;
}

template <class Epi, class Sched, bool GATHER, bool ALIGN_EPI, bool SP2>
__device__ __forceinline__ void gemm_phase(LAS unsigned char* lds, const int wave, const unsigned a_rs, const unsigned b_rs, const Sched& S, const Epi& E) {
    const int wid = wave, lane = lane_id(), tid = wid * 64 + lane, wr = wid >> 2, wc = wid & 3, fr = lane & 15, fq = lane >> 4;
    int R0, C0; stage_rc(tid * 16, R0, C0);
    unsigned voffA[2], voffB[2];
#pragma unroll
    for (int i = 0; i < 2; ++i) { const int R = R0 + 64 * i; const int Rb = (R & ~31) + perm32(R & 31);
        voffA[i] = (unsigned)R * a_rs + (unsigned)C0 * 2u; voffB[i] = (unsigned)Rb * b_rs + (unsigned)C0 * 2u; }
    unsigned vgc[2][2], vgn[2][2];
    const size_t kstep = (size_t)(BK * 2);
    const size_t hstepA = (size_t)HALF * a_rs;
    const unsigned ldsw = (unsigned)wid * 1024u;
    const int aoff = lds_byte(wr * 64 + fr, fq * 8), boff = lds_byte(wc * 32 + fr, fq * 8);
#define PG8_SA(b, h) (((b) * 2 + (h)) * HTB)
#define PG8_SB(b, h) ((4 + (b) * 2 + (h)) * HTB)
#define PG8_STAGE(bufoff, gbase, voff) do { const char* _gb = (const char*)(gbase); asm volatile("" : "+s"(_gb)); _Pragma("unroll") for (int _i = 0; _i < 2; ++_i) \
        __builtin_amdgcn_global_load_lds((const unsigned*)(_gb + (voff)[_i]), (LAS unsigned*)(lds + (bufoff) + ldsw + _i * 8192), 16, 0, 0); } while (0)
#define PG8_STAGE_A(bufoff, gbase, h, vg) do { if constexpr (GATHER) { PG8_STAGE(bufoff, gbase, (vg)[h]); } else { PG8_STAGE(bufoff, (gbase) + (h) * hstepA, voffA); } } while (0)
#define PG8_LDA(dst, b, h) do { _Pragma("unroll") for (int m = 0; m < 4; ++m) _Pragma("unroll") for (int k = 0; k < 2; ++k) dst[m][k] = *(const LAS bf16x8*)(lds + PG8_SA(b, h) + aoff + m * 2048 + k * 1024); } while (0)
#define PG8_LDB(dst, b, h) do { _Pragma("unroll") for (int n = 0; n < 2; ++n) _Pragma("unroll") for (int k = 0; k < 2; ++k) dst[n][k] = *(const LAS bf16x8*)(lds + PG8_SB(b, h) + boff + n * 2048 + k * 1024); } while (0)
#define PG8_MMA(ai, bj, At, Bt) do { __builtin_amdgcn_s_setprio(1); _Pragma("unroll") for (int m = 0; m < 4; ++m) _Pragma("unroll") for (int n = 0; n < 2; ++n) _Pragma("unroll") for (int k = 0; k < 2; ++k) \
        acc[ai][bj][m][n] = __builtin_amdgcn_mfma_f32_16x16x32_bf16(Bt[n][k], At[m][k], acc[ai][bj][m][n], 0, 0, 0); __builtin_amdgcn_s_setprio(0); } while (0)
#define PG8_WAIT_V(n) asm volatile("s_waitcnt vmcnt(" #n ")" ::: "memory")
#define PG8_WAIT_L(n) asm volatile("s_waitcnt lgkmcnt(" #n ")" ::: "memory")
#define PG8_BAR __builtin_amdgcn_s_barrier()
#define PG8_SCHED __builtin_amdgcn_sched_barrier(0)
#define PG8_GOFF(dst, u) do { if constexpr (GATHER) { if ((u).rows_lds >= 0) { _Pragma("unroll") for (int _h = 0; _h < 2; ++_h) _Pragma("unroll") for (int _i = 0; _i < 2; ++_i) \
        dst[_h][_i] = (unsigned)((const LAS int*)(lds + (u).rows_lds))[_h * HALF + R0 + 64 * _i] * a_rs + (unsigned)C0 * 2u; } else { _Pragma("unroll") for (int _h = 0; _h < 2; ++_h) _Pragma("unroll") for (int _i = 0; _i < 2; ++_i) \
        dst[_h][_i] = (unsigned)(u).rows[_h * HALF + R0 + 64 * _i] * a_rs + (unsigned)C0 * 2u; } } } while (0)
    GUnit cur, nxt; int ui = 0;
    if (!S.next(0, cur)) return;
    f32x4 acc[2][2][4][2];
#pragma unroll
    for (int a = 0; a < 2; ++a)
#pragma unroll
        for (int b = 0; b < 2; ++b)
#pragma unroll
            for (int m = 0; m < 4; ++m)
#pragma unroll
                for (int n = 0; n < 2; ++n) acc[a][b][m][n] = (f32x4){0.f, 0.f, 0.f, 0.f};
    bf16x8 At[4][2], B0[2][2], B1[2][2];
    const char* cA = uptr(cur.A); const char* cB0 = uptr(cur.B0); const char* cB1 = uptr(cur.B1); int cnt = __builtin_amdgcn_readfirstlane(cur.nt);
    PG8_GOFF(vgc, cur);
    if constexpr (SP2) {
        PG8_STAGE(PG8_SB(0, 0), cB0, voffB); PG8_STAGE(PG8_SB(0, 1), cB1, voffB); PG8_STAGE_A(PG8_SA(0, 0), cA, 0, vgc); PG8_STAGE_A(PG8_SA(0, 1), cA, 1, vgc);
        if (wr == 1) PG8_BAR;
        PG8_WAIT_V(2); PG8_BAR;
        PG8_STAGE(PG8_SB(1, 0), cB0 + kstep, voffB); PG8_STAGE_A(PG8_SA(1, 0), cA + kstep, 0, vgc); PG8_STAGE(PG8_SB(1, 1), cB1 + kstep, voffB);
        PG8_WAIT_V(6); PG8_BAR;
    } else {
        PG8_STAGE(PG8_SB(0, 0), cB0, voffB); PG8_STAGE_A(PG8_SA(0, 0), cA, 0, vgc); PG8_STAGE(PG8_SB(0, 1), cB1, voffB); PG8_STAGE_A(PG8_SA(0, 1), cA, 1, vgc);
        if (wr == 1) PG8_BAR;
        PG8_WAIT_V(4); PG8_BAR;
        PG8_STAGE(PG8_SB(1, 0), cB0 + kstep, voffB); PG8_STAGE_A(PG8_SA(1, 0), cA + kstep, 0, vgc); PG8_STAGE(PG8_SB(1, 1), cB1 + kstep, voffB);
        PG8_WAIT_V(6); PG8_BAR;
    }
    for (;;) {
        const bool has_next = S.next(ui + 1, nxt);
        const char* nA = uptr(has_next ? nxt.A : cA); const char* nB0 = uptr(has_next ? nxt.B0 : cB0); const char* nB1 = uptr(has_next ? nxt.B1 : cB1);
        if constexpr (GATHER) {
            if (has_next) { PG8_GOFF(vgn, nxt); }
            else {
#pragma unroll
                for (int _h = 0; _h < 2; ++_h)
#pragma unroll
                    for (int _i = 0; _i < 2; ++_i) vgn[_h][_i] = vgc[_h][_i];
            }
        }
        for (int t = 0; t < cnt; t += 2) {
            const bool last = (t == cnt - 2);
            const char* a1 = cA + (size_t)(t + 1) * kstep;
            const char* a2 = last ? nA : cA + (size_t)(t + 2) * kstep;
            const char* b2 = last ? nB0 : cB0 + (size_t)(t + 2) * kstep; const char* b2h = last ? nB1 : cB1 + (size_t)(t + 2) * kstep;
            const char* a3 = a2 + kstep; const char* b3 = b2 + kstep; const char* b3h = b2h + kstep;
            unsigned vg2[2][2];
            if constexpr (GATHER) {
#pragma unroll
                for (int _h = 0; _h < 2; ++_h)
#pragma unroll
                    for (int _i = 0; _i < 2; ++_i) vg2[_h][_i] = last ? vgn[_h][_i] : vgc[_h][_i];
            }
            if constexpr (SP2) {
            PG8_LDB(B0, 0, 0); PG8_LDB(B1, 0, 1); PG8_SCHED; PG8_LDA(At, 0, 0); PG8_STAGE_A(PG8_SA(1, 1), a1, 1, vgc);
            PG8_WAIT_V(8); PG8_WAIT_L(0); PG8_BAR; PG8_MMA(0, 0, At, B0); PG8_MMA(0, 1, At, B1); PG8_BAR; PG8_SCHED;
            PG8_LDA(At, 0, 1); PG8_STAGE(PG8_SB(0, 0), b2, voffB); PG8_STAGE(PG8_SB(0, 1), b2h, voffB); PG8_STAGE_A(PG8_SA(0, 0), a2, 0, vg2);
            PG8_WAIT_V(8); PG8_WAIT_L(0); PG8_BAR; PG8_MMA(1, 0, At, B0); PG8_MMA(1, 1, At, B1); PG8_BAR; PG8_SCHED;
            PG8_LDB(B0, 1, 0); PG8_LDB(B1, 1, 1); PG8_SCHED; PG8_LDA(At, 1, 0); PG8_STAGE_A(PG8_SA(0, 1), a2, 1, vg2);
            PG8_WAIT_V(8); PG8_WAIT_L(0); PG8_BAR; PG8_MMA(0, 0, At, B0); PG8_MMA(0, 1, At, B1); PG8_BAR; PG8_SCHED;
            PG8_LDA(At, 1, 1); PG8_STAGE(PG8_SB(1, 0), b3, voffB); PG8_STAGE(PG8_SB(1, 1), b3h, voffB); PG8_STAGE_A(PG8_SA(1, 0), a3, 0, vg2);
            PG8_WAIT_V(8); PG8_WAIT_L(0); PG8_BAR; PG8_MMA(1, 0, At, B0); PG8_MMA(1, 1, At, B1); PG8_BAR; PG8_SCHED;
            } else {
            PG8_LDB(B0, 0, 0); PG8_SCHED; PG8_LDA(At, 0, 0); PG8_STAGE_A(PG8_SA(1, 1), a1, 1, vgc);
            PG8_WAIT_L(8); PG8_BAR; PG8_WAIT_L(0); PG8_MMA(0, 0, At, B0); PG8_BAR; PG8_SCHED;
            PG8_LDB(B1, 0, 1); PG8_STAGE(PG8_SB(0, 0), b2, voffB);
            PG8_BAR; PG8_WAIT_L(0); PG8_MMA(0, 1, At, B1); PG8_BAR;
            PG8_LDA(At, 0, 1); PG8_STAGE_A(PG8_SA(0, 0), a2, 0, vg2);
            PG8_BAR; PG8_WAIT_L(0); PG8_MMA(1, 0, At, B0); PG8_BAR; PG8_SCHED;
            PG8_STAGE(PG8_SB(0, 1), b2h, voffB);
            PG8_WAIT_V(6); PG8_BAR; PG8_MMA(1, 1, At, B1); PG8_BAR;
            PG8_LDB(B0, 1, 0); PG8_SCHED; PG8_LDA(At, 1, 0); PG8_STAGE_A(PG8_SA(0, 1), a2, 1, vg2);
            PG8_WAIT_L(8); PG8_BAR; PG8_WAIT_L(0); PG8_MMA(0, 0, At, B0); PG8_BAR; PG8_SCHED;
            PG8_LDB(B1, 1, 1); PG8_STAGE(PG8_SB(1, 0), b3, voffB);
            PG8_BAR; PG8_WAIT_L(0); PG8_MMA(0, 1, At, B1); PG8_BAR;
            PG8_LDA(At, 1, 1); PG8_STAGE_A(PG8_SA(1, 0), a3, 0, vg2);
            PG8_BAR; PG8_WAIT_L(0); PG8_MMA(1, 0, At, B0); PG8_BAR; PG8_SCHED;
            PG8_STAGE(PG8_SB(1, 1), b3h, voffB);
            PG8_WAIT_V(6); PG8_BAR; PG8_MMA(1, 1, At, B1); PG8_BAR;
            }
        }
        if constexpr (ALIGN_EPI) { if (wr == 0) PG8_BAR; }
        { int l2 = lane_id(); asm volatile("" : "+v"(l2)); const int fr2 = l2 & 15, fq2 = l2 >> 4; E(acc, cur, wr, wc, fr2, fq2); }
        if (!has_next) break;
#pragma unroll
        for (int a = 0; a < 2; ++a)
#pragma unroll
            for (int b = 0; b < 2; ++b)
#pragma unroll
                for (int m = 0; m < 4; ++m)
#pragma unroll
                    for (int n = 0; n < 2; ++n) acc[a][b][m][n] = (f32x4){0.f, 0.f, 0.f, 0.f};
        cur = nxt; cA = nA; cB0 = nB0; cB1 = nB1; cnt = __builtin_amdgcn_readfirstlane(cur.nt); ++ui;
        if constexpr (GATHER) {
#pragma unroll
            for (int _h = 0; _h < 2; ++_h)
#pragma unroll
                for (int _i = 0; _i < 2; ++_i) vgc[_h][_i] = vgn[_h][_i];
        }
        if constexpr (ALIGN_EPI) { if (wr == 1) PG8_BAR; }
    }
    PG8_WAIT_V(0);
    if constexpr (!ALIGN_EPI) { if (wr == 0) PG8_BAR; }
    PG8_BAR;
#undef PG8_SA
#undef PG8_SB
#undef PG8_STAGE
#undef PG8_STAGE_A
#undef PG8_LDA
#undef PG8_LDB
#undef PG8_MMA
#undef PG8_WAIT_V
#undef PG8_WAIT_L
#undef PG8_BAR
#undef PG8_SCHED
#undef PG8_GOFF
}
}

struct Frame {
    LAS unsigned char* lds;
    volatile LAS unsigned* MISC;
    unsigned* ctl;
    unsigned char* ws;
    float* out;
    int wave, G, bid;
};
using pg8::GUnit;

template <class Fill> struct DenseSched {
    int nM, nN, G, c; Fill f;
    __device__ __forceinline__ bool next(int i, GUnit& u) const {
        const long L = (long)i * G + c; if (L >= (long)nM * nN) return false;
        int pm, pn; pg8::tile_order((int)L, nM, nN, pm, pn); u.pm = pm; u.pn = pn; u.rows = nullptr; u.rows_lds = -1; u.aux0 = 0; u.aux1 = 0; f(u); return true;
    }
};
struct FillPlain {
    const char* A; const char* B; unsigned a_rs, b_rs; int nt;
    __device__ __forceinline__ void operator()(GUnit& u) const { u.A = A + (size_t)u.pm * 256 * a_rs; u.B0 = B + (size_t)u.pn * 256 * b_rs; u.B1 = u.B0 + (size_t)128 * b_rs; u.nt = nt; }
};
struct FillQlatPool {
    const char* q; const char* diff; const char* wuk; const char* wpool;
    __device__ __forceinline__ void operator()(GUnit& u) const {
        if (u.pn < 8) { u.A = q + (size_t)u.pm * 256 * 2048 + (size_t)((u.pn & ~1) * 128) * 2; u.B0 = wuk + (size_t)u.pn * 256 * 512; }
        else { const int g = u.pn - 8; u.A = diff + (size_t)u.pm * 256 * 2048 + (size_t)(g * 256) * 2; u.B0 = wpool + (size_t)g * 256 * 512; }
        u.B1 = u.B0 + (size_t)128 * 512; u.nt = 4;
    }
};
struct FillO {
    const char* olat; const char* wuv;
    __device__ __forceinline__ void operator()(GUnit& u) const { u.A = olat + (size_t)u.pm * 256 * 4096 + (size_t)(u.pn * 512) * 2; u.B0 = wuv + (size_t)u.pn * 256 * 1024; u.B1 = u.B0 + (size_t)128 * 1024; u.nt = 8; }
};

#define EPI_LOOP_ROWS for (int ai = 0; ai < 2; ++ai) _Pragma("unroll") for (int m = 0; m < 4; ++m)
__device__ __forceinline__ u32x4 pack8(const f32x4 v0, const f32x4 v1) { u32x4 w; w.x = cvt_pk_bf16(v0[0], v0[1]); w.y = cvt_pk_bf16(v0[2], v0[3]); w.z = cvt_pk_bf16(v1[0], v1[1]); w.w = cvt_pk_bf16(v1[2], v1[3]); return w; }
__device__ __forceinline__ float sigmoidf_(float x) { return 1.0f / (1.0f + __expf(-x)); }

struct EpiP1 {
    bf16* q; bf16* qi; bf16* xp; bf16* gates; float* ckvraw; float* kiwi;
    __device__ __forceinline__ void operator()(const f32x4 (&acc)[2][2][4][2], const GUnit& u, int wr, int wc, int fr, int fq) const {
        const int row0 = u.pm * 256 + wr * 64 + fr, cl = wc * 32 + 8 * fq;
        if (u.pn < 28) {
            bf16* base; int ld, c0; bool sg = false;
            if (u.pn < 4) { base = q; ld = 1024; c0 = u.pn * 256; } else if (u.pn < 8) { base = qi; ld = 1024; c0 = (u.pn - 4) * 256; }
            else if (u.pn < 12) { base = xp; ld = 1024; c0 = (u.pn - 8) * 256; } else { base = gates; ld = 4096; c0 = (u.pn - 12) * 256; sg = true; }
#pragma unroll
            EPI_LOOP_ROWS { bf16* rowp = base + (size_t)(row0 + ai * 128 + m * 16) * ld + c0 + cl;
#pragma unroll
                for (int bj = 0; bj < 2; ++bj) { f32x4 v0 = acc[ai][bj][m][0], v1 = acc[ai][bj][m][1];
                    if (sg) {
#pragma unroll
                        for (int j = 0; j < 4; ++j) { v0[j] = sigmoidf_(v0[j]); v1[j] = sigmoidf_(v1[j]); } }
                    *(u32x4*)(rowp + bj * 128) = pack8(v0, v1); } }
        } else {
            float* base = (u.pn == 28) ? ckvraw : kiwi;
#pragma unroll
            EPI_LOOP_ROWS { float* rowp = base + (size_t)(row0 + ai * 128 + m * 16) * 256 + cl;
#pragma unroll
                for (int bj = 0; bj < 2; ++bj) { *(f32x4*)(rowp + bj * 128) = acc[ai][bj][m][0]; *(f32x4*)(rowp + bj * 128 + 4) = acc[ai][bj][m][1]; } }
        }
    }
};
struct EpiQlatPool {
    bf16* qlat; bf16* pool; const float* colscale;
    __device__ __forceinline__ void operator()(const f32x4 (&acc)[2][2][4][2], const GUnit& u, int wr, int wc, int fr, int fq) const {
        const int row0 = u.pm * 256 + wr * 64 + fr, cl = wc * 32 + 8 * fq;
        const bool ql = u.pn < 8;
        bf16* base = ql ? qlat + u.pn * 256 : pool + (u.pn - 8) * 256; const int ld = ql ? 2048 : 1024;
        const float* sp = colscale + u.pn * 256 + cl;
        __builtin_amdgcn_sched_barrier(0);
        const f32x4 s00 = *(const f32x4*)(sp), s01 = *(const f32x4*)(sp + 4), s10 = *(const f32x4*)(sp + 128), s11 = *(const f32x4*)(sp + 132);
#pragma unroll
        EPI_LOOP_ROWS { bf16* rowp = base + (size_t)(row0 + ai * 128 + m * 16) * ld + cl;
            *(u32x4*)(rowp) = pack8(acc[ai][0][m][0] * s00, acc[ai][0][m][1] * s01);
            *(u32x4*)(rowp + 128) = pack8(acc[ai][1][m][0] * s10, acc[ai][1][m][1] * s11); }
    }
};
struct EpiBf16 {
    bf16* O; int ld;
    __device__ __forceinline__ void operator()(const f32x4 (&acc)[2][2][4][2], const GUnit& u, int wr, int wc, int fr, int fq) const {
        const int row0 = u.pm * 256 + wr * 64 + fr, cl = u.pn * 256 + wc * 32 + 8 * fq;
#pragma unroll
        EPI_LOOP_ROWS { bf16* rowp = O + (size_t)(row0 + ai * 128 + m * 16) * ld + cl;
#pragma unroll
            for (int bj = 0; bj < 2; ++bj) *(u32x4*)(rowp + bj * 128) = pack8(acc[ai][bj][m][0], acc[ai][bj][m][1]); }
    }
};
__device__ __forceinline__ void unpack8(const u32x4 w, f32x4& a, f32x4& b) {
    a[0] = bf2f(w.x & 0xffffu); a[1] = bf2f(w.x >> 16); a[2] = bf2f(w.y & 0xffffu); a[3] = bf2f(w.y >> 16);
    b[0] = bf2f(w.z & 0xffffu); b[1] = bf2f(w.z >> 16); b[2] = bf2f(w.w & 0xffffu); b[3] = bf2f(w.w >> 16);
}
template <int MODE> struct EpiGate {
    const bf16* gates; bf16* M1; bf16* merged;
    __device__ __forceinline__ void operator()(const f32x4 (&acc)[2][2][4][2], const GUnit& u, int wr, int wc, int fr, int fq) const {
        const int row0 = u.pm * 256 + wr * 64 + fr, cl = u.pn * 256 + wc * 32 + 8 * fq;
#pragma unroll
        for (int ai = 0; ai < 2; ++ai) {
            u32x4 gq[4][2], mq[4][2];
#pragma unroll
            for (int m = 0; m < 4; ++m)
#pragma unroll
                for (int bj = 0; bj < 2; ++bj) { const size_t r = (size_t)(row0 + ai * 128 + m * 16); const int c = cl + bj * 128;
                    gq[m][bj] = *(const u32x4*)(gates + r * 4096 + (MODE ? 2048 : 0) + c); if (MODE) mq[m][bj] = *(const u32x4*)(M1 + r * 2048 + c); }
            __builtin_amdgcn_sched_barrier(0);
#pragma unroll
            for (int m = 0; m < 4; ++m)
#pragma unroll
                for (int bj = 0; bj < 2; ++bj) { const size_t r = (size_t)(row0 + ai * 128 + m * 16); const int c = cl + bj * 128;
                    f32x4 g0, g1; unpack8(gq[m][bj], g0, g1);
                    f32x4 v0 = acc[ai][bj][m][0] * g0, v1 = acc[ai][bj][m][1] * g1;
                    if (MODE) { f32x4 p0, p1; unpack8(mq[m][bj], p0, p1); v0 += p0; v1 += p1; *(u32x4*)(merged + r * 2048 + c) = pack8(v0, v1); }
                    else *(u32x4*)(M1 + r * 2048 + c) = pack8(v0, v1); }
            __builtin_amdgcn_sched_barrier(0);
        }
    }
};
struct EpiPre {
    const float* x; float* pre;
    __device__ __forceinline__ void operator()(const f32x4 (&acc)[2][2][4][2], const GUnit& u, int wr, int wc, int fr, int fq) const {
        const int row0 = u.pm * 256 + wr * 64 + fr, cl = u.pn * 256 + wc * 32 + 8 * fq;
#pragma unroll
        for (int ai = 0; ai < 2; ++ai) {
            f32x4 xq[4][2][2];
#pragma unroll
            for (int m = 0; m < 4; ++m)
#pragma unroll
                for (int bj = 0; bj < 2; ++bj) { const size_t o = (size_t)(row0 + ai * 128 + m * 16) * 2048 + cl + bj * 128; xq[m][bj][0] = __builtin_nontemporal_load((const f32x4*)(x + o)); xq[m][bj][1] = __builtin_nontemporal_load((const f32x4*)(x + o + 4)); }
            __builtin_amdgcn_sched_barrier(0);
#pragma unroll
            for (int m = 0; m < 4; ++m)
#pragma unroll
                for (int bj = 0; bj < 2; ++bj) { const size_t o = (size_t)(row0 + ai * 128 + m * 16) * 2048 + cl + bj * 128;
                    *(f32x4*)(pre + o) = xq[m][bj][0] * DN_ALPHA + acc[ai][bj][m][0]; *(f32x4*)(pre + o + 4) = xq[m][bj][1] * DN_ALPHA + acc[ai][bj][m][1]; }
            __builtin_amdgcn_sched_barrier(0);
        }
    }
};
constexpr int MOE_TAB_OFF = 131072, MOE_TAB_UNITS = 32, MOE_ROWS_OFF = 131072 + 512, MOE_ROWS_UNITS = 11;
struct MoeSched {
    const int* mtt; int nmt; int NT; int G, c; bool gateup;
    const char* h; const char* hbuf; const char* wgu; const char* wd; const int* rowlist; LAS unsigned char* lds;
    __device__ __forceinline__ int unit_of(int i) const {
        const int total = nmt * NT;
        if ((G & 7) == 0) { const int x = c & 7, j = i * (G >> 3) + (c >> 3); const int lo = (int)(((long)total * x) >> 3), hi = (int)(((long)total * (x + 1)) >> 3); const int U = lo + j; return U < hi ? U : -1; }
        const long L = (long)i * G + c; return L < total ? (int)L : -1;
    }
    __device__ __forceinline__ void prepare(int tid) const {
        LAS int* tab = (LAS int*)(lds + MOE_TAB_OFF);
        if (tid < MOE_TAB_UNITS) { const int U = unit_of(tid); int g = -1, p0 = 0, nv = 0, nt_ = 0;
            if (U >= 0) { const int MT = U / NT; nt_ = U - MT * NT; g = mtt[MT * 4 + 0]; p0 = mtt[MT * 4 + 1]; nv = mtt[MT * 4 + 2]; }
            tab[tid * 4 + 0] = g; tab[tid * 4 + 1] = p0; tab[tid * 4 + 2] = nv; tab[tid * 4 + 3] = nt_; }
        if (gateup) { LAS int* rw = (LAS int*)(lds + MOE_ROWS_OFF);
            for (int q = tid; q < MOE_ROWS_UNITS * 256; q += NTHR) { const int i = q >> 8, U = unit_of(i); if (U >= 0) { const int MT = U / NT; rw[q] = rowlist[mtt[MT * 4 + 1] + (q & 255)]; } } }
        __syncthreads();
    }
    __device__ __forceinline__ bool next(int i, GUnit& u) const {
        int g, p0, nv, nt_;
        if (i < MOE_TAB_UNITS) { const LAS int* tab = (const LAS int*)(lds + MOE_TAB_OFF); g = __builtin_amdgcn_readfirstlane(tab[i * 4 + 0]); p0 = __builtin_amdgcn_readfirstlane(tab[i * 4 + 1]); nv = __builtin_amdgcn_readfirstlane(tab[i * 4 + 2]); nt_ = __builtin_amdgcn_readfirstlane(tab[i * 4 + 3]); if (g < 0) return false; }
        else { const int U = unit_of(i); if (U < 0) return false; const int MT = U / NT; nt_ = U - MT * NT;
            g = __builtin_amdgcn_readfirstlane(mtt[MT * 4 + 0]); p0 = __builtin_amdgcn_readfirstlane(mtt[MT * 4 + 1]); nv = __builtin_amdgcn_readfirstlane(mtt[MT * 4 + 2]); }
        u.pm = p0; u.pn = nt_; u.aux0 = nv; u.aux1 = g; u.rows_lds = -1;
        if (gateup) { u.A = h; u.rows = rowlist + p0; if (i < MOE_ROWS_UNITS) u.rows_lds = MOE_ROWS_OFF + i * 1024; u.B0 = wgu + ((size_t)g * 1024 + (size_t)nt_ * 256) * 4096; u.B1 = u.B0 + (size_t)128 * 4096; u.nt = 32; }
        else { u.A = hbuf + (size_t)p0 * 1024; u.rows = nullptr; u.B0 = wd + ((size_t)g * 2048 + (size_t)nt_ * 256) * 1024; u.B1 = u.B0 + (size_t)128 * 1024; u.nt = 8; }
        return true;
    }
};
struct EpiSwiGLU {
    bf16* H;
    __device__ __forceinline__ void operator()(const f32x4 (&acc)[2][2][4][2], const GUnit& u, int wr, int wc, int fr, int fq) const {
        const int cl = u.pn * 128 + wc * 32 + 8 * fq;
#pragma unroll
        EPI_LOOP_ROWS { const int r = ai * 128 + wr * 64 + m * 16 + fr;
            if (r < u.aux0) { f32x4 v[2];
#pragma unroll
                for (int n = 0; n < 2; ++n)
#pragma unroll
                    for (int j = 0; j < 4; ++j) { const float g = acc[ai][0][m][n][j], up = acc[ai][1][m][n][j]; v[n][j] = g * sigmoidf_(g) * up; }
                *(u32x4*)(H + (size_t)(u.pm + r) * 512 + cl) = pack8(v[0], v[1]); } }
    }
};
struct EpiY {
    unsigned char* Y8; bf16* Ysh;
    __device__ __forceinline__ void operator()(const f32x4 (&acc)[2][2][4][2], const GUnit& u, int wr, int wc, int fr, int fq) const {
        const int cl = u.pn * 256 + wc * 32 + 8 * fq;
        if (u.aux1 == NE) {
#pragma unroll
            EPI_LOOP_ROWS { const int r = ai * 128 + wr * 64 + m * 16 + fr;
                if (r < u.aux0) { bf16* rowp = Ysh + (size_t)(u.pm - NTOK * 8 + r) * 2048 + cl;
#pragma unroll
                    for (int bj = 0; bj < 2; ++bj) *(u32x4*)(rowp + bj * 128) = pack8(acc[ai][bj][m][0], acc[ai][bj][m][1]); } }
        } else {
#pragma unroll
            EPI_LOOP_ROWS { const int r = ai * 128 + wr * 64 + m * 16 + fr;
                if (r < u.aux0) { unsigned char* rowp = Y8 + (size_t)(u.pm + r) * 2048 + cl;
#pragma unroll
                    for (int bj = 0; bj < 2; ++bj) { const f32x4 v0 = acc[ai][bj][m][0], v1 = acc[ai][bj][m][1];
                        int w0 = __builtin_amdgcn_cvt_pk_fp8_f32(v0[0], v0[1], 0, false); w0 = __builtin_amdgcn_cvt_pk_fp8_f32(v0[2], v0[3], w0, true);
                        int w1 = __builtin_amdgcn_cvt_pk_fp8_f32(v1[0], v1[1], 0, false); w1 = __builtin_amdgcn_cvt_pk_fp8_f32(v1[2], v1[3], w1, true);
                        u32x2 o; o.x = (unsigned)w0; o.y = (unsigned)w1; *(u32x2*)(rowp + bj * 128) = o; } } }
        }
    }
};

template <class RowMap>
__device__ __forceinline__ void tr_item(const float* W, int ldw, int nvalid, bf16* WT, int ldT, LAS float* scr, int kb, int nb, int lane, const RowMap& rm, const int ztwin = 0) {
    const int k0 = 64 * kb, n0 = 32 * nb;
    const int c4 = 4 * (lane & 7), kr = lane >> 3;
    f32x4 v[8];
#pragma unroll
    for (int i = 0; i < 8; ++i) { v[i] = (f32x4){0.f, 0.f, 0.f, 0.f}; if (n0 + c4 < nvalid) v[i] = __builtin_nontemporal_load((const f32x4*)(W + (size_t)(k0 + 8 * i + kr) * ldw + n0 + c4)); }
#pragma unroll
    for (int i = 0; i < 8; ++i) { LAS float* d = scr + (8 * i + kr) * 33 + c4; d[0] = v[i][0]; d[1] = v[i][1]; d[2] = v[i][2]; d[3] = v[i][3]; }
    LDS_WAIT(); asm volatile("" ::: "memory");
    const int c = lane & 7;
#pragma unroll
    for (int j = 0; j < 4; ++j) { const int nl = (lane >> 3) + 8 * j; const LAS float* s = scr + (8 * c) * 33 + nl;
        u32x4 o; o.x = cvt_pk_bf16(s[0 * 33], s[1 * 33]); o.y = cvt_pk_bf16(s[2 * 33], s[3 * 33]); o.z = cvt_pk_bf16(s[4 * 33], s[5 * 33]); o.w = cvt_pk_bf16(s[6 * 33], s[7 * 33]);
        if (n0 + nl < nvalid) { *(u32x4*)(WT + (size_t)rm(n0 + nl) * ldT + k0 + 8 * c) = o; if (ztwin) *(u32x4*)(WT + (size_t)rm(n0 + nl) * ldT + k0 + 8 * c + ztwin) = (u32x4){0u, 0u, 0u, 0u}; } }
    LDS_WAIT(); asm volatile("" ::: "memory");
}
struct MapId { int off; __device__ __forceinline__ int operator()(int n) const { return off + n; } };
struct MapWin {
    __device__ __forceinline__ int operator()(int n) const {
        if (n < 1024) return n;
        if (n < 1280) return 7168 + (n - 1024);
        if (n < 2304) return 1024 + (n - 1280);
        if (n < 2368) return 7424 + (n - 2304);
        if (n < 2384) return 7488 + (n - 2368);
        if (n < 3408) return 2048 + (n - 2384);
        return 3072 + (n - 3408);
    }
};
struct MapGU { int up; __device__ __forceinline__ int operator()(int f) const { return (f >> 7) * 256 + up * 128 + (f & 127); } };

__device__ __forceinline__ void phase_convert_small(Frame& F, const float* x, const float* w_in, const float* w_uk, const float* w_uv, const float* w_pool, const float* w_pa, const float* w_pp, const float* w_out, const float* pscale, const float* w_router) {
    const int lane_ = lane_id(), tid_ = F.wave * 64 + lane_;
    { float* wt = (float*)(F.ws + WS_WRT); for (size_t i = (size_t)F.bid * NTHR + tid_; i < (size_t)64 * 2048; i += (size_t)F.G * NTHR) { const int e = (int)(i >> 11), d = (int)(i & 2047); wt[i] = w_router[(size_t)d * 64 + e]; } }
    { float* cs = (float*)(F.ws + WS_CSCALE); for (size_t i = (size_t)F.bid * NTHR + tid_; i < 3072; i += (size_t)F.G * NTHR) cs[i] = (i < 2048) ? 1.0f : pscale[i - 2048]; }
    bf16* xb = (bf16*)(F.ws + WS_XB);
    const size_t gt = (size_t)F.bid * NTHR + tid_, nth = (size_t)F.G * NTHR;
    for (size_t i0 = gt; i0 < (size_t)NTOK * DM / 8; i0 += 4 * nth) {
        f32x4 a[4], b[4];
#pragma unroll
        for (int q = 0; q < 4; ++q) { const size_t i = i0 + q * nth; a[q] = __builtin_nontemporal_load((const f32x4*)x + 2 * i); b[q] = __builtin_nontemporal_load((const f32x4*)x + 2 * i + 1); }
        __builtin_amdgcn_sched_barrier(0);
#pragma unroll
        for (int q = 0; q < 4; ++q) { const size_t i = i0 + q * nth; u32x4 o; o.x = cvt_pk_bf16(a[q][0], a[q][1]); o.y = cvt_pk_bf16(a[q][2], a[q][3]); o.z = cvt_pk_bf16(b[q][0], b[q][1]); o.w = cvt_pk_bf16(b[q][2], b[q][3]); ((u32x4*)xb)[i] = o; }
    }
    LAS float* scr = (LAS float*)(F.lds + F.wave * 8704);
    const int gw = F.bid * NWAVES + F.wave, NGW = F.G * NWAVES;
    constexpr int I_IN = 32 * 235, I_POOL = 4 * 4 * 8, I_PA = 16 * 64, I_PP = 16 * 64, I_OUT = 32 * 64;
    constexpr int I_UV = 8 * 16;
    constexpr int NIT = I_IN + I_POOL + I_PA + I_PP + I_OUT + I_UV;
    for (int it = gw; it < NIT; it += NGW) {
        int r = it;
        if (r < I_IN) { tr_item(w_in, 7504, 7504, (bf16*)(F.ws + WS_WIN), 2048, scr, r / 235, r % 235, lane_, MapWin{}); continue; } r -= I_IN;
        if (r < I_POOL) { const int g = r / 32, q = r % 32; tr_item(w_pool + (size_t)g * 65536, 256, 256, (bf16*)(F.ws + WS_WPOOL) + (size_t)g * 65536, 256, scr, q / 8, q % 8, lane_, MapId{0}); continue; } r -= I_POOL;
        if (r < I_PA) { tr_item(w_pa, 2048, 2048, (bf16*)(F.ws + WS_WPA), 1024, scr, r / 64, r % 64, lane_, MapId{0}); continue; } r -= I_PA;
        if (r < I_PP) { tr_item(w_pp, 2048, 2048, (bf16*)(F.ws + WS_WPP), 1024, scr, r / 64, r % 64, lane_, MapId{0}); continue; } r -= I_PP;
        if (r < I_OUT) { tr_item(w_out, 2048, 2048, (bf16*)(F.ws + WS_WOUT), 2048, scr, r / 64, r % 64, lane_, MapId{0}); continue; } r -= I_OUT;
        {
          const int h = r / 16, q = r % 16, pn = h >> 1, hh = h & 1;
          tr_item(w_uv + h * 128, 1024, 128, (bf16*)(F.ws + WS_WUV) + (size_t)(pn * 256 + hh * 128) * 512 + hh * 256, 512, scr, q / 4, q % 4, lane_, MapId{0}, hh ? -256 : 256); }
    }
    { bf16* wp = (bf16*)(F.ws + WS_WIN) + (size_t)7504 * 2048; for (size_t i = gt; i < (size_t)176 * 2048 / 8; i += nth) ((u32x4*)wp)[i] = (u32x4){0u, 0u, 0u, 0u}; }
    { const float* wuk = w_uk; bf16* o = (bf16*)(F.ws + WS_WUK);
      for (size_t i = gt; i < (size_t)2048 * 256; i += nth) { const int kp = (int)(i & 255), row = (int)(i >> 8), h = row >> 8, r = row & 255;
          o[i] = ((kp >> 7) == (h & 1)) ? (bf16)f2bf(wuk[(size_t)r * 1024 + h * 128 + (kp & 127)]) : (bf16)0; } }
}

struct ExpW { const float* wge; const float* wue; const float* wde; const float* wgs; const float* wus; const float* wds; };
struct CvItem { const float* src; bf16* dst; int ldw, ldT, kind; };
__device__ __forceinline__ void cv_decode(Frame& F, const ExpW& W, const int it, const float*& src, int& ldw, bf16*& dst, int& ldT, int& kind, int& n0) {
    constexpr int PER = 1536;
    const int g = it / PER; int r = it - g * PER;
    if (r < 1024) { kind = r >> 9; r &= 511; const int kb = r >> 4, nb = r & 15; n0 = 32 * nb; ldw = 512; ldT = 2048;
        const float* wsrc = (g < NE) ? (kind ? W.wue : W.wge) + (size_t)g * 2048 * 512 : (kind ? W.wus : W.wgs);
        src = wsrc + (size_t)(64 * kb) * 512 + n0; dst = (bf16*)(F.ws + WS_WGU) + (size_t)g * 1024 * 2048 + 64 * kb; }
    else { kind = 2; r -= 1024; const int kb = r >> 6, nb = r & 63; n0 = 32 * nb; ldw = 2048; ldT = 512;
        const float* wsrc = (g < NE) ? W.wde + (size_t)g * 512 * 2048 : W.wds;
        src = wsrc + (size_t)(64 * kb) * 2048 + n0; dst = (bf16*)(F.ws + WS_WD) + (size_t)g * 2048 * 512 + 64 * kb; }
}
__device__ __forceinline__ void cv_load(f32x4 (&v)[8], const float* src, const int ldw, const int lane) {
    const int c4 = 4 * (lane & 7), kr = lane >> 3;
#pragma unroll
    for (int i = 0; i < 8; ++i) v[i] = __builtin_nontemporal_load((const f32x4*)(src + (size_t)(8 * i + kr) * ldw + c4));
}
__device__ __forceinline__ void cv_finish(const f32x4 (&v)[8], bf16* dst, const int ldT, const int kind, const int n0, LAS float* scr, const int lane) {
    const int c4 = 4 * (lane & 7), kr = lane >> 3;
#pragma unroll
    for (int i = 0; i < 8; ++i) { LAS float* d = scr + (8 * i + kr) * 33 + c4; d[0] = v[i][0]; d[1] = v[i][1]; d[2] = v[i][2]; d[3] = v[i][3]; }
    LDS_WAIT(); asm volatile("" ::: "memory");
    const int c = lane & 7;
#pragma unroll
    for (int j = 0; j < 4; ++j) { const int nl = (lane >> 3) + 8 * j; const LAS float* s = scr + (8 * c) * 33 + nl;
        u32x4 o; o.x = cvt_pk_bf16(s[0 * 33], s[1 * 33]); o.y = cvt_pk_bf16(s[2 * 33], s[3 * 33]); o.z = cvt_pk_bf16(s[4 * 33], s[5 * 33]); o.w = cvt_pk_bf16(s[6 * 33], s[7 * 33]);
        const int n = n0 + nl; const int row = (kind == 2) ? n : (n >> 7) * 256 + kind * 128 + (n & 127);
        *(u32x4*)(dst + (size_t)row * ldT + 8 * c) = o; }
    LDS_WAIT(); asm volatile("" ::: "memory");
}
template <int BATCH>
__device__ __forceinline__ bool convert_batch(Frame& F, const ExpW& W, LAS float* scr, const int lane_) {
    constexpr int NIT = NGRP * 1536;
    int base = 0;
    if (lane_ == 0) base = (int)__hip_atomic_fetch_add(F.ctl + CW_CVQ, (unsigned)BATCH, RLX_AGENT);
    base = __builtin_amdgcn_readfirstlane(base);
    if (base >= NIT) return false;
    const int end = (base + BATCH < NIT) ? base + BATCH : NIT;
    const float* src; bf16* dst; int ldw, ldT, kind, n0;
    cv_decode(F, W, base, src, ldw, dst, ldT, kind, n0);
    f32x4 va[8], vb[8];
    cv_load(va, src, ldw, lane_);
    for (int it = base; it < end; it += 2) {
        const float* src2 = src; bf16* dst2 = dst; int ldw2 = ldw, ldT2 = ldT, kind2 = kind, n02 = n0;
        if (it + 1 < end) { cv_decode(F, W, it + 1, src2, ldw2, dst2, ldT2, kind2, n02); cv_load(vb, src2, ldw2, lane_); }
        __builtin_amdgcn_sched_barrier(0);
        cv_finish(va, dst, ldT, kind, n0, scr, lane_);
        if (it + 1 < end) {
            if (it + 2 < end) { cv_decode(F, W, it + 2, src, ldw, dst, ldT, kind, n0); cv_load(va, src, ldw, lane_); }
            __builtin_amdgcn_sched_barrier(0);
            cv_finish(vb, dst2, ldT2, kind2, n02, scr, lane_);
        }
    }
    return true;
}
__device__ __forceinline__ void phase_convert_experts(Frame& F, const ExpW& W) {
    const int lane_ = lane_id();
    LAS float* scr = (LAS float*)(F.lds + 32768 + F.wave * 8704);
    while (convert_batch<8>(F, W, scr, lane_)) {}
}

__device__ __forceinline__ void phase_postproc(Frame& F, const float* cg, const float* kg, const float* kb) {
    const int lane_ = lane_id(), tid_ = F.wave * 64 + lane_;
    const float* ckvraw = (const float*)(F.ws + WS_CKVRAW); const float* kiwi = (const float*)(F.ws + WS_KIWI);
    unsigned* ckvn = (unsigned*)(F.ws + WS_CKVN); bf16* kin = (bf16*)(F.ws + WS_KIN); float* wis = (float*)(F.ws + WS_WI);
    const int gw = F.bid * NWAVES + F.wave, NGW = F.G * NWAVES, lane = lane_;
    const f32x4 g4 = *(const f32x4*)(cg + lane * 4); const float kgl = kg[lane], kbl = kb[lane];
    for (int t0 = gw; t0 < NTOK; t0 += 4 * NGW) {
        f32x4 v[4]; float kv[4], wv[4];
#pragma unroll
        for (int q = 0; q < 4; ++q) { const int t = t0 + q * NGW; v[q] = (f32x4){0.f, 0.f, 0.f, 0.f}; kv[q] = 0.f; wv[q] = 0.f;
            if (t < NTOK) { v[q] = *(const f32x4*)(ckvraw + (size_t)t * 256 + lane * 4); kv[q] = kiwi[(size_t)t * 256 + lane]; wv[q] = kiwi[(size_t)t * 256 + 64 + (lane & 15)]; } }
#pragma unroll
        for (int q = 0; q < 4; ++q) { const int t = t0 + q * NGW;
            const float ss = wave_sum(v[q][0] * v[q][0] + v[q][1] * v[q][1] + v[q][2] * v[q][2] + v[q][3] * v[q][3]);
            const float rs = 1.0f / sqrtf(ss * (1.0f / 256.0f) + RMS_EPS);
            int o8 = __builtin_amdgcn_cvt_pk_fp8_f32(v[q][0] * rs * g4[0], v[q][1] * rs * g4[1], 0, false);
            o8 = __builtin_amdgcn_cvt_pk_fp8_f32(v[q][2] * rs * g4[2], v[q][3] * rs * g4[3], o8, true);
            const float mu = wave_sum(kv[q]) * (1.0f / 64.0f); const float dlt = kv[q] - mu;
            const float var = wave_sum(dlt * dlt) * (1.0f / 64.0f);
            const float y = dlt * (1.0f / sqrtf(var + LN_EPS)) * kgl + kbl;
            if (t < NTOK) { ckvn[(size_t)t * 64 + lane] = (unsigned)o8; kin[(size_t)t * 64 + lane] = (bf16)f2bf(y); if (lane < 16) wis[(size_t)t * 16 + lane] = wv[q] * 0.03125f; } }
    }
    const bf16* xp = (const bf16*)(F.ws + WS_XP); bf16* diff = (bf16*)(F.ws + WS_DIFF);
    const size_t gt = (size_t)F.bid * NTHR + tid_, nth = (size_t)F.G * NTHR;
    for (size_t i = gt; i < (size_t)(NTOK / 16) * 128; i += nth) {
        const int run = (int)(i >> 7), cgp = (int)(i & 127), g = cgp >> 5, win = 2 << g, tb = run * 16, posb = tb & (SEQ - 1);
        const bf16* col = xp + cgp * 8;
        u32x4 rw[31];
#pragma unroll
        for (int j = 0; j < 31; ++j) { const int dr = j - 15; rw[j] = (u32x4){0u, 0u, 0u, 0u}; if (dr >= 1 - win && posb + dr >= 0) rw[j] = *(const u32x4*)(col + (size_t)(tb + dr) * 1024); }
        __builtin_amdgcn_sched_barrier(0);
        f32x4 s0 = {0.f, 0.f, 0.f, 0.f}, s1 = {0.f, 0.f, 0.f, 0.f};
#pragma unroll
        for (int j = 1; j < 16; ++j) { if (j < win) { f32x4 a, b; unpack8(rw[15 - j], a, b); s0 += a; s1 += b; } }
#pragma unroll
        for (int q = 0; q < 16; ++q) { const int t = tb + q, pos = posb + q;
            f32x4 a, b; unpack8(rw[15 + q], a, b); s0 += a; s1 += b;
            const int cntw = (pos + 1 < win) ? pos + 1 : win; const float inv = 1.0f / (float)cntw;
            *(u32x4*)(diff + (size_t)t * 1024 + cgp * 8) = pack8(s0 * inv - a, s1 * inv - b);
            f32x4 c, d; const u32x4 r2 = rw[15 + q - 1], r4 = rw[15 + q - 3], r8 = rw[15 + q - 7], r16 = rw[15 + q - 15];
            const u32x4 rr = (win == 2) ? r2 : (win == 4) ? r4 : (win == 8) ? r8 : r16;
            unpack8(rr, c, d); s0 -= c; s1 -= d; }
    }
}

__device__ __forceinline__ size_t score_rowbase(int b, int p) { const int jq = p >> 7; return (size_t)b * SC_TOT + (size_t)16384 * (size_t)(jq * (jq + 1) / 2) + (size_t)(p & 127) * (size_t)(128 * (jq + 1)); }

__device__ __forceinline__ void phase_index_scores(Frame& F) {
    const int lane_ = lane_id(), tid_ = F.wave * 64 + lane_;
    const bf16* qi = (const bf16*)(F.ws + WS_QI); const bf16* kin = (const bf16*)(F.ws + WS_KIN); const float* wis = (const float*)(F.ws + WS_WI);
    _Float16* scores = (_Float16*)(F.ws + WS_SCORES);
    const int lane = lane_, w = F.wave, fq = lane >> 4, j16 = lane & 15, tid = tid_;
    constexpr int NQ = 4;
    LAS unsigned char* kb = F.lds;
    const int sR = tid >> 3, sc = tid & 7, sP = (sR & 3) * 16 + (sR >> 2);
    const int st_off = sP * 128 + ((sc ^ ((sP >> 1) & 7)) * 16);
    for (int it = 0;; ++it) {
        const int jj = (it >> 1) * F.G + F.bid; if (jj >= 256) break;
        const int s = (it & 1) ? 511 - jj : jj;
        const int b = s & 1, qg = s >> 1, tq0 = qg * 32;
        const int nk64 = (tq0 + 32 + 63) / 64, nsteps = (nk64 + NQ - 1) / NQ;
        bf16x8 Af[4][2];
        { const size_t tok = (size_t)b * SEQ + tq0 + 4 * w + (j16 >> 2);
#pragma unroll
          for (int g = 0; g < 4; ++g)
#pragma unroll
              for (int ks = 0; ks < 2; ++ks) Af[g][ks] = *(const bf16x8*)(qi + tok * 1024 + (4 * g + (j16 & 3)) * 64 + ks * 32 + 8 * fq); }
        f32x4 wv[4];
        { const size_t tok = (size_t)b * SEQ + tq0 + 4 * w + fq;
#pragma unroll
          for (int g = 0; g < 4; ++g) wv[g] = *(const f32x4*)(wis + tok * 16 + 4 * g); }
        _Float16* orow = scores + score_rowbase(b, tq0 + 4 * w + fq);
        const bf16* kbase = kin + (size_t)b * SEQ * 64 + (size_t)sR * 64 + sc * 8;
        u32x4 stg[NQ];
#pragma unroll
        for (int q = 0; q < NQ; ++q) { const int h = (q < nk64) ? q : nk64 - 1; stg[q] = *(const u32x4*)(kbase + (size_t)h * 4096); }
        __syncthreads();
#pragma unroll
        for (int q = 0; q < NQ; ++q) *(LAS u32x4*)(kb + q * 8192 + st_off) = stg[q];
        __syncthreads();
        for (int step = 0; step < nsteps; ++step) {
            const int cur = step & 1;
            if (step + 1 < nsteps) {
#pragma unroll
                for (int q = 0; q < NQ; ++q) { int h = NQ * (step + 1) + q; h = (h < nk64) ? h : nk64 - 1; stg[q] = *(const u32x4*)(kbase + (size_t)h * 4096); } }
#pragma unroll
            for (int hh = 0; hh < NQ; ++hh) {
                f32x4 res;
#pragma unroll
                for (int u = 0; u < 4; ++u) {
                    const int P = u * 16 + j16;
                    f32x4 a4[4];
#pragma unroll
                    for (int g = 0; g < 4; ++g) a4[g] = (f32x4){0.f, 0.f, 0.f, 0.f};
#pragma unroll
                    for (int ks = 0; ks < 2; ++ks) {
                        const bf16x8 bfr = *(const LAS bf16x8*)(kb + cur * (NQ * 8192) + hh * 8192 + P * 128 + (((fq + 4 * ks) ^ ((P >> 1) & 7)) * 16));
#pragma unroll
                        for (int g = 0; g < 4; ++g) a4[g] = __builtin_amdgcn_mfma_f32_16x16x32_bf16(Af[g][ks], bfr, a4[g], 0, 0, 0);
                    }
                    float sres = 0.f;
#pragma unroll
                    for (int g = 0; g < 4; ++g)
#pragma unroll
                        for (int r = 0; r < 4; ++r) { const float xf = a4[g][r]; const int xb = __float_as_int(xf); const float rl = __int_as_float(xb > 0 ? xb : 0), wg = wv[g][r]; asm("v_fmac_f32 %0, %1, %2" : "+v"(sres) : "v"(wg), "v"(rl)); }
                    res[u] = sres;
                }
                const int hg = NQ * step + hh;
                if (hg < nk64) { typedef __fp16 h2 __attribute__((ext_vector_type(2))); const h2 lo = __builtin_amdgcn_cvt_pkrtz(res[0], res[1]), hi = __builtin_amdgcn_cvt_pkrtz(res[2], res[3]);
                    u32x2 o; o.x = __builtin_bit_cast(unsigned, lo); o.y = __builtin_bit_cast(unsigned, hi); *(u32x2*)(orow + hg * 64 + 4 * j16) = o; }
            }
            if (step + 1 < nsteps) {
#pragma unroll
                for (int q = 0; q < NQ; ++q) *(LAS u32x4*)(kb + (cur ^ 1) * (NQ * 8192) + q * 8192 + st_off) = stg[q]; }
            __syncthreads();
        }
    }
}

__device__ __forceinline__ unsigned fkey(float f) { const unsigned u = __float_as_uint(f); return (u & 0x80000000u) ? ~u : (u | 0x80000000u); }

__device__ __forceinline__ f32x4 h4_to_f4(const u32x2 q) { typedef _Float16 h2 __attribute__((ext_vector_type(2))); const unsigned qx = q.x, qy = q.y;
    const h2 a = __builtin_bit_cast(h2, qx), b = __builtin_bit_cast(h2, qy); const _Float16 a0 = a[0], a1 = a[1], b0 = b[0], b1 = b[1]; return (f32x4){(float)a0, (float)a1, (float)b0, (float)b1}; }
template <int NV>
__device__ __forceinline__ void select_row(const _Float16* row, int n, unsigned short* sel, int lane) {
    unsigned u[NV][4];
#pragma unroll
    for (int i = 0; i < NV; ++i) {
        const int base = i * 256 + lane * 4;
        f32x4 v = {0.f, 0.f, 0.f, 0.f};
        if (base < n) v = h4_to_f4(*(const u32x2*)(row + base));
#pragma unroll
        for (int e = 0; e < 4; ++e) u[i][e] = (base + e < n) ? fkey(v[e]) : 0u;
    }
    unsigned T = 0u; int cntT = n;
    bool exact = false;
    for (int bit = 31; bit >= 0; --bit) {
        const unsigned cand = T | (1u << bit);
        int c = 0;
#pragma unroll
        for (int i = 0; i < NV; ++i)
#pragma unroll
            for (int e = 0; e < 4; ++e) c += (u[i][e] >= cand) ? 1 : 0;
        c = wave_sum_i(c);
        if (c >= TOPK) { T = cand; cntT = c; if (c == TOPK) { exact = true; break; } }
    }
    int cgt = 0;
    if (!exact) {
#pragma unroll
        for (int i = 0; i < NV; ++i)
#pragma unroll
            for (int e = 0; e < 4; ++e) cgt += (u[i][e] > T) ? 1 : 0;
        cgt = wave_sum_i(cgt);
    }
    int pg = 0, pe = exact ? 0 : cgt;
    const unsigned long long lt = (1ull << lane) - 1ull;
#pragma unroll
    for (int i = 0; i < NV; ++i)
#pragma unroll
        for (int e = 0; e < 4; ++e) {
            const unsigned val = u[i][e]; const int idx = i * 256 + lane * 4 + e;
            const bool gsel = exact ? (val >= T) : (val > T);
            const unsigned long long mg = __ballot(gsel);
            if (gsel) sel[pg + __popcll(mg & lt)] = (unsigned short)idx;
            pg += __popcll(mg);
            if (!exact) {
                const bool esel = (val == T);
                const unsigned long long me = __ballot(esel);
                const int pos = pe + __popcll(me & lt);
                if (esel && pos < TOPK) sel[pos] = (unsigned short)idx;
                pe += __popcll(me);
            }
        }
}

template <int NV>
__device__ __forceinline__ bool select_row_hist(const _Float16* row, int n, unsigned short* sel, int lane, LAS unsigned* hist) {
    LAS unsigned* cnts = hist + 4097;
    LAS unsigned* tiel = hist + 4100;
    unsigned u[NV][4];
#pragma unroll
    for (int i = 0; i < NV; ++i) { const int base = i * 256 + lane * 4; u32x2 rq = {0u, 0u}; if (base < n) rq = *(const u32x2*)(row + base); const f32x4 t4 = h4_to_f4(rq); u[i][0] = __float_as_uint(t4[0]); u[i][1] = __float_as_uint(t4[1]); u[i][2] = __float_as_uint(t4[2]); u[i][3] = __float_as_uint(t4[3]); }
#pragma unroll
    for (int q = 0; q < 17; ++q) { const int w = q * 256 + lane * 4; if (w < 4104) *(LAS u32x4*)(hist + w) = (u32x4){0u, 0u, 0u, 0u}; }
    const float v00 = __uint_as_float(u[0][0]);
    float mn = v00, mx = v00;
#define SR_MM(i_, MASKED) do { _Pragma("unroll") for (int e = 0; e < 4; ++e) { float x = __uint_as_float(u[i_][e]); if (MASKED) x = ((i_) * 256 + lane * 4 + e < n) ? x : v00; mn = fminf(mn, x); mx = fmaxf(mx, x); } } while (0)
#pragma unroll
    for (int i = 0; i < NV; ++i) {
        if (i < NV - 8) SR_MM(i, false);
        else { const int rem = n - i * 256; if (rem >= 256) SR_MM(i, false); else if (rem > 0) SR_MM(i, true); }
    }
#undef SR_MM
    mn = wave_min(mn); mx = wave_max(mx);
    if (!(mx > mn)) {
#pragma unroll
        for (int q = 0; q < 4; ++q) sel[q * 64 + lane] = (unsigned short)(q * 64 + lane);
        return true;
    }
    const float scale = 4095.5f / (mx - mn), off = -mn * scale;
#define SR_KEY(i_, MASKED) do { _Pragma("unroll") for (int e = 0; e < 4; ++e) { unsigned k = (unsigned)fmaf(__uint_as_float(u[i_][e]), scale, off); k = k > 4095u ? 4095u : k; \
        if (MASKED) k = ((i_) * 256 + lane * 4 + e < n) ? k : 4096u; u[i_][e] = k; __hip_atomic_fetch_add(hist + k, 1u, __ATOMIC_RELAXED, __HIP_MEMORY_SCOPE_WORKGROUP); } } while (0)
#pragma unroll
    for (int i = 0; i < NV; ++i) {
        if (i < NV - 8) SR_KEY(i, false);
        else { const int rem = n - i * 256; if (rem >= 256) SR_KEY(i, false); else if (rem > 0) SR_KEY(i, true); else { u[i][0] = 4096u; u[i][1] = 4096u; u[i][2] = 4096u; u[i][3] = 4096u; } }
    }
#undef SR_KEY
    LDS_WAIT();
    unsigned sl = 0;
#pragma unroll
    for (int q = 0; q < 16; ++q) { const u32x4 t4 = *(const LAS u32x4*)(hist + 64 * lane + 4 * q); sl += (t4[0] + t4[1]) + (t4[2] + t4[3]); }
    const unsigned pre = (unsigned)wave_scan_i((int)sl);
    const unsigned total = (unsigned)__builtin_amdgcn_readlane((int)pre, 63), above = total - pre;
    const bool mine = (above < (unsigned)TOPK) && (above + sl >= (unsigned)TOPK);
    const int src = __builtin_amdgcn_readfirstlane(__ffsll((unsigned long long)__ballot(mine)) - 1);
    const unsigned above_src = (unsigned)__builtin_amdgcn_readlane((int)above, src);
    const unsigned hj = hist[64 * src + lane];
    const unsigned pj = (unsigned)wave_scan_i((int)hj);
    const unsigned cj = above_src + ((unsigned)__builtin_amdgcn_readlane((int)pj, 63) - pj);
    const bool hit = (cj < (unsigned)TOPK) && (cj + hj >= (unsigned)TOPK);
    const int hl = __builtin_amdgcn_readfirstlane(__ffsll((unsigned long long)__ballot(hit)) - 1);
    const unsigned bstar = (unsigned)(64 * src + hl), cgt = (unsigned)__builtin_amdgcn_readlane((int)cj, hl), mt = (unsigned)__builtin_amdgcn_readlane((int)hj, hl);
    int pg = 0; const unsigned span = 4095u - bstar;
#pragma unroll
    for (int i = 0; i < NV; ++i)
#pragma unroll
        for (int e = 0; e < 4; ++e) { const unsigned k = u[i][e]; const int idx = i * 256 + lane * 4 + e;
            const bool gsel = (k - bstar - 1u) < span;
            const unsigned long long mg = __ballot(gsel);
            if (mg) { if (gsel) sel[pg + (int)__builtin_amdgcn_mbcnt_hi((unsigned)(mg >> 32), __builtin_amdgcn_mbcnt_lo((unsigned)mg, 0u))] = (unsigned short)idx; pg += __popcll(mg); }
            if (k == bstar) { const unsigned p = __hip_atomic_fetch_add(cnts + 1, 1u, __ATOMIC_RELAXED, __HIP_MEMORY_SCOPE_WORKGROUP); if (p < 64u) tiel[p] = (unsigned)idx; } }
    LDS_WAIT();
    const int need = TOPK - (int)cgt;
    if (mt <= 64u) {
        int idx = 0x7fffffff; float val = -INFINITY;
        if (lane < (int)mt) { idx = (int)tiel[lane]; val = (float)row[idx]; }
        int rk = 0;
        for (int j = 0; j < (int)mt; ++j) { const float o = __shfl(val, j); const int oi = __shfl(idx, j); rk += (o > val || (o == val && oi < idx)) ? 1 : 0; }
        if (lane < (int)mt && rk < need) sel[cgt + rk] = (unsigned short)idx;
        return true;
    }
    return false;
}

__device__ __forceinline__ void phase_select(Frame& F, const ExpW& W, const bool ride) {
    const int lane = lane_id();
    LAS unsigned* hist = (LAS unsigned*)(F.lds + F.wave * 17408);
    const _Float16* scores = (const _Float16*)(F.ws + WS_SCORES);
    unsigned short* selb = (unsigned short*)(F.ws + WS_SEL);
    const int gw = F.bid * NWAVES + F.wave, NGW = F.G * NWAVES;
    for (int it = 0;; ++it) {
        const int jj = (it >> 1) * NGW + gw; if (jj >= NTOK / 2) break;
        const int s = (it & 1) ? NTOK - 1 - jj : jj;
        const int b = s & 1, p = s >> 1, n = p + 1;
        unsigned short* sel = selb + ((size_t)b * SEQ + p) * TOPK;
        if (n <= TOPK) {
#pragma unroll
            for (int q = 0; q < 4; ++q) { const int i = q * 64 + lane; sel[i] = (i < n) ? (unsigned short)i : (unsigned short)0xFFFFu; }
        } else {
            const _Float16* row = scores + score_rowbase(b, p);
            bool ok;
            if (n <= 2048) ok = select_row_hist<8>(row, n, sel, lane, hist);
            else if (n <= 4096) ok = select_row_hist<16>(row, n, sel, lane, hist);
            else if (n <= 6144) ok = select_row_hist<24>(row, n, sel, lane, hist);
            else ok = select_row_hist<32>(row, n, sel, lane, hist);
            asm volatile("" ::: "memory");
            if (!ok) select_row<32>(row, n, sel, lane);
        }
    }
}

typedef int v2i_t __attribute__((ext_vector_type(2)));
__device__ __forceinline__ long mk_long(const unsigned lo, const unsigned hi) { return (long)(((unsigned long long)hi << 32) | lo); }
__device__ __forceinline__ void phase_sparse_attn(Frame& F, const ExpW& W, const bool ride) {
    const int lane = lane_id();
    const bf16* qlat = (const bf16*)(F.ws + WS_QLAT); const unsigned char* ckv8 = (const unsigned char*)(F.ws + WS_CKVN);
    const unsigned short* selb = (const unsigned short*)(F.ws + WS_SEL); bf16* olat = (bf16*)(F.ws + WS_OLAT);
    const int fq = lane >> 4, j16 = lane & 15;
    LAS unsigned char* cb = F.lds + F.wave * 9216;
    LAS unsigned short* ksel = (LAS unsigned short*)(cb + 8704);
    const float sl2 = 0.08838834764831845f * 1.4426950408889634f;
    const int xh = (F.G % 8 == 0) ? ((F.bid & 7) >> 2) : 0, nsplit = (F.G % 8 == 0) ? 2 : 1;
    const int wloc = (F.G % 8 == 0) ? (((F.bid >> 3) * 4 + (F.bid & 3)) * NWAVES + F.wave) : (F.bid * NWAVES + F.wave);
    const int nwl = (F.G % 8 == 0) ? (F.G / 2) * NWAVES : F.G * NWAVES;
    const int ntk = NTOK / nsplit;
    const int qk_off = (2 * j16) * 272 + 8 * fq;
    const int tq = j16 >> 1, tp = j16 & 1;
    const int tr_off = ((tq < 4) ? 2 * (4 * fq + tq) : 2 * (4 * fq + tq - 4) + 1) * 272 + 8 * tp;
    for (int tl = wloc; tl < ntk; tl += nwl) {
        const int t = xh * ntk + tl, b = t / SEQ, pos = t % SEQ;
        const int nvalid = (pos + 1 < TOPK) ? pos + 1 : TOPK;
        const bool fullk = (nvalid == TOPK);
        const unsigned short* sel = selb + (size_t)t * TOPK;
        const u32x2 sv = __builtin_nontemporal_load((const u32x2*)(sel + 4 * lane));
        long Qf[8];
#pragma unroll
        for (int ks = 0; ks < 8; ++ks) { u32x4 z = {0u, 0u, 0u, 0u}; if (j16 < 8) z = __builtin_nontemporal_load((const u32x4*)(qlat + ((size_t)t * 8 + j16) * 256 + ks * 32 + 8 * fq));
            const unsigned z0 = z[0], z1 = z[1], z2 = z[2], z3 = z[3];
            int w0 = __builtin_amdgcn_cvt_pk_fp8_f32(bf2f(z0 & 0xffffu), bf2f(z0 >> 16), 0, false); w0 = __builtin_amdgcn_cvt_pk_fp8_f32(bf2f(z1 & 0xffffu), bf2f(z1 >> 16), w0, true);
            int w1 = __builtin_amdgcn_cvt_pk_fp8_f32(bf2f(z2 & 0xffffu), bf2f(z2 >> 16), 0, false); w1 = __builtin_amdgcn_cvt_pk_fp8_f32(bf2f(z3 & 0xffffu), bf2f(z3 >> 16), w1, true);
            Qf[ks] = mk_long((unsigned)w0, (unsigned)w1); }
        float mrun = -INFINITY, lrun = 0.f;
        f32x4 O[16];
#pragma unroll
        for (int rt = 0; rt < 16; ++rt) O[rt] = (f32x4){0.f, 0.f, 0.f, 0.f};
        const int nch = (nvalid + 31) >> 5;
        const unsigned char* cbase = ckv8 + (size_t)b * SEQ * 256;
        *(LAS u32x2*)(ksel + 4 * lane) = sv;
        asm volatile("" ::: "memory");
        u32x4 gv[3][8];
        const int w_row = (16 * (fq & 1) + (fq >> 1)) * 272 + 16 * j16;
#define SA_GATHER(c_, s_) do { const u32x4 k8 = *(const LAS u32x4*)(ksel + 32 * (c_) + 8 * fq); const unsigned k0 = k8[0], k1 = k8[1], k2 = k8[2], k3 = k8[3]; \
            _Pragma("unroll") for (int it = 0; it < 8; ++it) { const unsigned dd = (it < 2) ? k0 : (it < 4) ? k1 : (it < 6) ? k2 : k3; \
            unsigned key = (it & 1) ? (dd >> 16) : (dd & 0xffffu); if (!fullk) key = (key >= (unsigned)SEQ) ? 0u : key; \
            gv[s_][it] = *(const u32x4*)(cbase + (key * 256u + 16u * (unsigned)j16)); } } while (0)
        SA_GATHER(0, 0);
        if (1 < nch) SA_GATHER(1, 1);
        if (2 < nch) SA_GATHER(2, 2);
#pragma unroll
        for (int c = 0; c < 8; ++c) {
            if (c < nch) {
            const int sl = c % 3;
#pragma unroll
            for (int it = 0; it < 8; ++it) *(LAS u32x4*)(cb + w_row + it * 544) = gv[sl][it];
            asm volatile("" ::: "memory");
            if (c + 3 < nch) SA_GATHER(c + 3, sl);
            f32x4 Sa = {0.f, 0.f, 0.f, 0.f}, Sb = {0.f, 0.f, 0.f, 0.f};
#pragma unroll
            for (int ks = 0; ks < 8; ++ks) {
                const u32x2 a0 = *(const LAS u32x2*)(cb + qk_off + 32 * ks), a1 = *(const LAS u32x2*)(cb + qk_off + 272 + 32 * ks);
                const unsigned a0x = a0.x, a0y = a0.y, a1x = a1.x, a1y = a1.y;
                Sa = __builtin_amdgcn_mfma_f32_16x16x32_fp8_fp8(mk_long(a0x, a0y), Qf[ks], Sa, 0, 0, 0);
                Sb = __builtin_amdgcn_mfma_f32_16x16x32_fp8_fp8(mk_long(a1x, a1y), Qf[ks], Sb, 0, 0, 0);
            }
            float xa[4], xb[4]; float cm = -INFINITY;
#pragma unroll
            for (int r = 0; r < 4; ++r) { xa[r] = Sa[r] * sl2; xb[r] = Sb[r] * sl2; }
            if (!fullk) {
#pragma unroll
                for (int r = 0; r < 4; ++r) { const int ka = c * 32 + 4 * fq + r, kb2 = ka + 16; xa[r] = (ka < nvalid) ? xa[r] : -INFINITY; xb[r] = (kb2 < nvalid) ? xb[r] : -INFINITY; } }
#pragma unroll
            for (int r = 0; r < 4; ++r) cm = fmaxf(cm, fmaxf(xa[r], xb[r]));
            cm = fmaxf(cm, __shfl_xor(cm, 16)); cm = fmaxf(cm, __shfl_xor(cm, 32));
            if (__ballot(cm > mrun + 6.0f)) {
                const float mnew = fmaxf(mrun, cm);
                const float alpha = __builtin_amdgcn_exp2f(mrun - mnew);
                lrun *= alpha; mrun = mnew;
#pragma unroll
                for (int rt = 0; rt < 16; ++rt) O[rt] = O[rt] * alpha;
            }
            float ps = 0.f; float pa[4], pb[4];
#pragma unroll
            for (int r = 0; r < 4; ++r) { pa[r] = __builtin_amdgcn_exp2f(xa[r] - mrun); pb[r] = __builtin_amdgcn_exp2f(xb[r] - mrun); ps += pa[r] + pb[r]; }
            ps += __shfl_xor(ps, 16); ps += __shfl_xor(ps, 32);
            lrun += ps;
            int pw0 = __builtin_amdgcn_cvt_pk_fp8_f32(pa[0], pa[1], 0, false); pw0 = __builtin_amdgcn_cvt_pk_fp8_f32(pa[2], pa[3], pw0, true);
            int pw1 = __builtin_amdgcn_cvt_pk_fp8_f32(pb[0], pb[1], 0, false); pw1 = __builtin_amdgcn_cvt_pk_fp8_f32(pb[2], pb[3], pw1, true);
            const long Pf = mk_long((unsigned)pw0, (unsigned)pw1);
#pragma unroll
            for (int rt = 0; rt < 16; ++rt) {
                const v2i_t tv = __builtin_amdgcn_ds_read_tr8_b64_v2i32((LAS v2i_t*)(cb + tr_off + 16 * rt));
                const int t0 = tv[0], t1 = tv[1];
                O[rt] = __builtin_amdgcn_mfma_f32_16x16x32_fp8_fp8(mk_long((unsigned)t0, (unsigned)t1), Pf, O[rt], 0, 0, 0);
            }
            asm volatile("" ::: "memory");
            }
        }
#undef SA_GATHER
        const float inv = 1.0f / lrun;
        asm volatile("" ::: "memory");
        if (j16 < 8) {
#pragma unroll
            for (int rt = 0; rt < 16; ++rt) { u32x2 o; o.x = cvt_pk_bf16(O[rt][0] * inv, O[rt][1] * inv); o.y = cvt_pk_bf16(O[rt][2] * inv, O[rt][3] * inv); *(LAS u32x2*)(cb + j16 * 512 + rt * 32 + fq * 8) = o; }
        }
        asm volatile("" ::: "memory");
        { bf16* obase = olat + (size_t)t * 2048;
#pragma unroll
          for (int q = 0; q < 4; ++q) { const u32x4 v = *(const LAS u32x4*)(cb + q * 1024 + lane * 16); __builtin_nontemporal_store(v, (u32x4*)(obase + q * 512 + lane * 8)); } }
        asm volatile("" ::: "memory");
    }
}

__device__ __forceinline__ void routing_token(const float acc, const int lane, const float* rbias, int* tk_e, float* tk_w, LAS unsigned* hist, const size_t t, const bool do_count) {
    const float sc = 1.0f / (1.0f + expf(-acc));
    const float ch = sc + rbias[lane];
    int rk = 0;
#pragma unroll
    for (int k = 1; k < 8; ++k) { const int src = (lane & ~7) | ((lane + k) & 7); const float o = __shfl(ch, src); rk += (o > ch || (o == ch && src < lane)) ? 1 : 0; }
    float gs = (rk < 2) ? ch : 0.f; gs += __shfl_xor(gs, 1); gs += __shfl_xor(gs, 2); gs += __shfl_xor(gs, 4);
    int grk = 0; const int myg = lane >> 3;
#pragma unroll
    for (int g = 0; g < 8; ++g) { const float o = __shfl(gs, g * 8); grk += (o > gs || (o == gs && g < myg)) ? 1 : 0; }
    const float cm = (grk < 4) ? ch : -INFINITY;
    int erk = 0;
    for (int j = 0; j < 64; ++j) { const float o = __shfl(cm, j); erk += (o > cm || (o == cm && j < lane)) ? 1 : 0; }
    const bool selx = (erk < EK) && (grk < 4);
    const float ssum = wave_sum(selx ? sc : 0.f);
    if (selx) { tk_e[t * 8 + erk] = lane; tk_w[t * 8 + erk] = sc / ssum * 2.5f; if (do_count) __hip_atomic_fetch_add(&hist[lane], 1u, __ATOMIC_RELAXED, __HIP_MEMORY_SCOPE_WORKGROUP); }
}
__device__ __forceinline__ void phase_ln1_router(Frame& F, const float* g1, const float* b1, const float* rbias, const bool do_count) {
    const int lane_ = lane_id(), tid_ = F.wave * 64 + lane_;
    const float* pre = F.out;
    const float* wrT = (const float*)(F.ws + WS_WRT);
    bf16* h = (bf16*)(F.ws + WS_H);
    int* tk_e = (int*)(F.ws + WS_TOPK + TK_E); float* tk_w = (float*)(F.ws + WS_TOPK + TK_W);
    const int lane = lane_, w = F.wave, tid = tid_;
    LAS float* stats = (LAS float*)F.lds;
    LAS float* lg = (LAS float*)(F.lds + 1024) + (w & 3) * 1024;
    LAS unsigned* hist = (LAS unsigned*)(F.lds + 1024 + 16384);
    if (do_count && tid < 64) hist[tid] = 0u;
    for (int chunk = F.bid; chunk < NTOK / 64; chunk += F.G) {
        __syncthreads();
        f32x4 ggv[8], bbv[8];
#pragma unroll
        for (int q = 0; q < 8; ++q) { const int c = (lane + 64 * q) * 4; ggv[q] = *(const f32x4*)(g1 + c); bbv[q] = *(const f32x4*)(b1 + c); }
        for (int i = 0; i < 8; ++i) {
            const int tl = w * 8 + i; const size_t t = (size_t)chunk * 64 + tl;
            f32x4 v[8]; float s = 0.f;
#pragma unroll
            for (int q = 0; q < 8; ++q) { v[q] = *(const f32x4*)(pre + t * DM + (lane + 64 * q) * 4); s += (v[q][0] + v[q][1]) + (v[q][2] + v[q][3]); }
            const float mean = wave_sum(s) * (1.0f / DM); float s2 = 0.f;
#pragma unroll
            for (int q = 0; q < 8; ++q) { v[q] = v[q] - mean; s2 += (v[q][0] * v[q][0] + v[q][1] * v[q][1]) + (v[q][2] * v[q][2] + v[q][3] * v[q][3]); }
            const float rstd = 1.0f / sqrtf(wave_sum(s2) * (1.0f / DM) + LN_EPS);
#pragma unroll
            for (int q = 0; q < 8; ++q) { const int c = (lane + 64 * q) * 4;
                const f32x4 y = v[q] * rstd * ggv[q] + bbv[q];
                u32x2 o; o.x = cvt_pk_bf16(y[0], y[1]); o.y = cvt_pk_bf16(y[2], y[3]); *(u32x2*)(h + t * DM + c) = o; }
            if (lane == 0) { stats[tl * 2] = mean; stats[tl * 2 + 1] = rstd; }
        }
        __syncthreads();
        if (w < 4) {
            const int j16 = lane & 15, kq = lane >> 4, tl = 16 * w + j16;
            const float mean = stats[tl * 2], rstd = stats[tl * 2 + 1];
            const float* prow = pre + ((size_t)chunk * 64 + tl) * DM + 4 * kq; const float* wrow = wrT + (size_t)j16 * DM + 4 * kq;
            f32x4 acc[4];
#pragma unroll
            for (int tt = 0; tt < 4; ++tt) acc[tt] = (f32x4){0.f, 0.f, 0.f, 0.f};
#pragma unroll 2
            for (int m = 0; m < 128; ++m) {
                const f32x4 p = *(const f32x4*)(prow + 16 * m), gg = *(const f32x4*)(g1 + 16 * m + 4 * kq), bb = *(const f32x4*)(b1 + 16 * m + 4 * kq);
                const f32x4 hv = (p - mean) * rstd * gg + bb;
                f32x4 wv[4];
#pragma unroll
                for (int tt = 0; tt < 4; ++tt) wv[tt] = *(const f32x4*)(wrow + (size_t)tt * 16 * DM + 16 * m);
#pragma unroll
                for (int e = 0; e < 4; ++e)
#pragma unroll
                    for (int tt = 0; tt < 4; ++tt) acc[tt] = __builtin_amdgcn_mfma_f32_16x16x4f32(hv[e], wv[tt][e], acc[tt], 0, 0, 0);
            }
#pragma unroll
            for (int tt = 0; tt < 4; ++tt)
#pragma unroll
                for (int r = 0; r < 4; ++r) lg[(4 * kq + r) * 64 + 16 * tt + j16] = acc[tt][r];
            LDS_WAIT();
            for (int tk = 0; tk < 16; ++tk) routing_token(lg[tk * 64 + lane], lane, rbias, tk_e, tk_w, hist, (size_t)chunk * 64 + 16 * w + tk, do_count);
        }
    }
}
__device__ __forceinline__ void phase_flush_hist(Frame& F) {
    const int tid = F.wave * 64 + lane_id();
    LAS unsigned* hist = (LAS unsigned*)(F.lds + 1024 + 16384);
    __syncthreads();
    if (tid < 64 && hist[tid]) atomicAdd(F.ctl + CW_CNT + tid, hist[tid]);
}

__device__ __forceinline__ void phase_scatter(Frame& F) {
    const int lane_ = lane_id(), tid_ = F.wave * 64 + lane_;
    const int tid = tid_;
    LAS int* segs = (LAS int*)F.lds;
    LAS unsigned* lcnt = (LAS unsigned*)(F.lds + 1024);
    LAS unsigned* lbase = (LAS unsigned*)(F.lds + 2048);
    const int* tk_e = (const int*)(F.ws + WS_TOPK + TK_E); int* tk_pos = (int*)(F.ws + WS_TOPK + TK_POS);
    int* rowlist = (int*)(F.ws + WS_TOPK + TK_ROWLIST); int* mtt = (int*)(F.ws + WS_TOPK + TK_MTT);
    if (tid == 0) { int a = 0; for (int e = 0; e < NE; ++e) { segs[e] = a; a += (int)__hip_atomic_load(F.ctl + CW_CNT + e, RLX_AGENT); } segs[NE] = a; segs[NE + 1] = a + NTOK; }
    __syncthreads();
    if (F.bid == 0) {
        LAS int* tcum = (LAS int*)(F.lds + 3072);
        if (tid == 0) { int mt = 0; for (int g = 0; g < NGRP; ++g) { tcum[g] = mt; mt += (segs[g + 1] - segs[g] + 255) >> 8; } tcum[NGRP] = mt; __hip_atomic_store(F.ctl + CW_NMT, (unsigned)mt, RLX_AGENT); }
        __syncthreads();
        if (tid < NGRP) { const int g = tid, p0 = segs[g], n = segs[g + 1] - p0; int mt = tcum[g];
            for (int r = 0; r < n; r += 256, ++mt) { mtt[mt * 4 + 0] = g; mtt[mt * 4 + 1] = p0 + r; mtt[mt * 4 + 2] = (n - r < 256) ? n - r : 256; mtt[mt * 4 + 3] = 0; } }
        if (tid >= 256) rowlist[NSLOT + tid - 256] = 0;
    }
    const int sh0 = segs[NE];
    for (int chunk = F.bid; chunk < NTOK / 64; chunk += F.G) {
        if (tid < 64) lcnt[tid] = 0u;
        __syncthreads();
        const int t = chunk * 64 + (tid >> 3), k = tid & 7;
        const int e = tk_e[(size_t)t * 8 + k];
        const unsigned li = __hip_atomic_fetch_add(&lcnt[e], 1u, __ATOMIC_RELAXED, __HIP_MEMORY_SCOPE_WORKGROUP);
        __syncthreads();
        if (tid < 64) lbase[tid] = lcnt[tid] ? atomicAdd(F.ctl + CW_FILL + tid, lcnt[tid]) : 0u;
        __syncthreads();
        const int p = segs[e] + (int)lbase[e] + (int)li;
        rowlist[p] = t; tk_pos[(size_t)t * 8 + k] = p;
        if (tid < 64) rowlist[sh0 + chunk * 64 + tid] = chunk * 64 + tid;
        __syncthreads();
    }
}

struct CombRows { u32x4 hq[4]; u32x2 y[8][4]; u32x4 ysh[4]; };
__device__ __forceinline__ void comb_load(CombRows& R, const bf16* h, const unsigned char* Y8, const bf16* Ysh, const int t, const int posv, const int slot0, const int lane) {
#pragma unroll
    for (int i = 0; i < 4; ++i) { R.hq[i] = *(const u32x4*)(h + (size_t)t * DM + (lane + 64 * i) * 8); R.ysh[i] = __builtin_nontemporal_load((const u32x4*)(Ysh + (size_t)t * DM + (lane + 64 * i) * 8)); }
#pragma unroll
    for (int k = 0; k < 8; ++k) { const int p = __builtin_amdgcn_readlane(posv, slot0 + k);
#pragma unroll
        for (int i = 0; i < 4; ++i) R.y[k][i] = __builtin_nontemporal_load((const u32x2*)(Y8 + (size_t)p * DM + (lane + 64 * i) * 8)); }
}
__device__ __forceinline__ void comb_finish(const CombRows& R, const float* g2, const float* b2, float* out, const int t, const float wvv, const int slot0, const int lane) {
    f32x4 a[4][2];
#pragma unroll
    for (int i = 0; i < 4; ++i) { f32x4 x0, x1, s0, s1; unpack8(R.hq[i], x0, x1); unpack8(R.ysh[i], s0, s1); a[i][0] = x0 * DN_ALPHA + s0; a[i][1] = x1 * DN_ALPHA + s1; }
#pragma unroll
    for (int k = 0; k < 8; ++k) { const float wk = __builtin_bit_cast(float, __builtin_amdgcn_readlane(__builtin_bit_cast(int, wvv), slot0 + k));
#pragma unroll
        for (int i = 0; i < 4; ++i) { const u32x2 q8 = R.y[k][i];
            const f32x2 y01 = __builtin_amdgcn_cvt_pk_f32_fp8((int)q8.x, false), y23 = __builtin_amdgcn_cvt_pk_f32_fp8((int)q8.x, true), y45 = __builtin_amdgcn_cvt_pk_f32_fp8((int)q8.y, false), y67 = __builtin_amdgcn_cvt_pk_f32_fp8((int)q8.y, true);
            a[i][0] += (f32x4){y01[0], y01[1], y23[0], y23[1]} * wk; a[i][1] += (f32x4){y45[0], y45[1], y67[0], y67[1]} * wk; } }
    float s = 0.f;
#pragma unroll
    for (int i = 0; i < 4; ++i) s += ((a[i][0][0] + a[i][0][1]) + (a[i][0][2] + a[i][0][3])) + ((a[i][1][0] + a[i][1][1]) + (a[i][1][2] + a[i][1][3]));
    const float mean = wave_sum(s) * (1.0f / DM); float s2 = 0.f;
#pragma unroll
    for (int i = 0; i < 4; ++i) { a[i][0] = a[i][0] - mean; a[i][1] = a[i][1] - mean;
        s2 += ((a[i][0][0] * a[i][0][0] + a[i][0][1] * a[i][0][1]) + (a[i][0][2] * a[i][0][2] + a[i][0][3] * a[i][0][3])) + ((a[i][1][0] * a[i][1][0] + a[i][1][1] * a[i][1][1]) + (a[i][1][2] * a[i][1][2] + a[i][1][3] * a[i][1][3])); }
    const float rstd = 1.0f / sqrtf(wave_sum(s2) * (1.0f / DM) + LN_EPS);
#pragma unroll
    for (int i = 0; i < 4; ++i) { const int c = (lane + 64 * i) * 8;
        const f32x4 ga = *(const f32x4*)(g2 + c), gb = *(const f32x4*)(g2 + c + 4), ba = *(const f32x4*)(b2 + c), bb = *(const f32x4*)(b2 + c + 4);
        __builtin_nontemporal_store(a[i][0] * rstd * ga + ba, (f32x4*)(out + (size_t)t * DM + c)); __builtin_nontemporal_store(a[i][1] * rstd * gb + bb, (f32x4*)(out + (size_t)t * DM + c + 4)); }
}
__device__ __forceinline__ void phase_combine(Frame& F, const float* g2, const float* b2) {
    const int lane = lane_id();
    const bf16* h = (const bf16*)(F.ws + WS_H); const unsigned char* Y8 = (const unsigned char*)(F.ws + WS_Y); const bf16* Ysh = (const bf16*)(F.ws + WS_YSH);
    const float* tk_w = (const float*)(F.ws + WS_TOPK + TK_W); const int* tk_pos = (const int*)(F.ws + WS_TOPK + TK_POS);
    const int gw = F.bid * NWAVES + F.wave, NGW = F.G * NWAVES;
    for (int t0 = gw * 8; t0 < NTOK; t0 += NGW * 8) {
        const int posv = tk_pos[(size_t)t0 * 8 + lane]; const float wvv = tk_w[(size_t)t0 * 8 + lane];
        for (int i = 0; i < 8; ++i) {
            CombRows R;
            comb_load(R, h, Y8, Ysh, t0 + i, posv, 8 * i, lane);
            __builtin_amdgcn_sched_barrier(0);
            comb_finish(R, g2, b2, F.out, t0 + i, wvv, 8 * i, lane);
            __builtin_amdgcn_sched_barrier(0);
        }
    }
}

#ifndef MK_CHECK
#define MK_CHECK 0
#endif
constexpr int CW_CHK = 16384 + 256;
#if MK_CHECK
__device__ __forceinline__ float fp8f(unsigned char v) { const f32x2 a = __builtin_amdgcn_cvt_pk_f32_fp8((int)v, false); return a[0]; }
__device__ __forceinline__ void phase_check_attn(Frame& F) {
    const int tid = F.wave * 64 + lane_id();
    const bf16* qi = (const bf16*)(F.ws + WS_QI); const bf16* kin = (const bf16*)(F.ws + WS_KIN); const float* wis = (const float*)(F.ws + WS_WI);
    const bf16* qlat = (const bf16*)(F.ws + WS_QLAT); const unsigned char* ckv8 = (const unsigned char*)(F.ws + WS_CKVN);
    const unsigned short* selb = (const unsigned short*)(F.ws + WS_SEL); const bf16* olat = (const bf16*)(F.ws + WS_OLAT);
    LAS float* sc = (LAS float*)F.lds;
    LAS unsigned char* flg = (LAS unsigned char*)(F.lds + 32768);
    LAS unsigned char* seen = (LAS unsigned char*)(F.lds + 40960);
    LAS float* pl = (LAS float*)(F.lds + 49152);
    LAS int* cnt = (LAS int*)(F.lds + 57344);
    LAS float* errs = (LAS float*)(F.lds + 57344 + 64);
    const int POS[16] = {0, 1, 100, 255, 256, 257, 300, 511, 1000, 2047, 2048, 4095, 5000, 6143, 6144, 8191};
    for (int s = F.bid; s < 32; s += F.G) {
        int pos = 0;
#pragma unroll
        for (int q = 0; q < 16; ++q) pos = ((s >> 1) == q) ? POS[q] : pos;
        const int b = s & 1, n = pos + 1; const size_t t = (size_t)b * SEQ + pos;
        __syncthreads();
        if (tid < 4) cnt[tid] = 0;
        if (tid < 2) errs[tid] = 0.f;
        for (int k = tid; k < SEQ; k += NTHR) { flg[k] = 0; seen[k] = 0; }
        for (int k = tid; k < n; k += NTHR) {
            float tot = 0.f;
            for (int hh = 0; hh < 16; ++hh) { float d = 0.f;
                for (int e = 0; e < 64; ++e) d += bf2f(qi[t * 1024 + hh * 64 + e]) * bf2f(kin[((size_t)b * SEQ + k) * 64 + e]);
                tot += wis[t * 16 + hh] * fmaxf(d, 0.f); }
            sc[k] = tot;
        }
        __syncthreads();
        const unsigned short* sel = selb + t * TOPK;
        if (n > TOPK) {
            for (int k = tid; k < n; k += NTHR) { const float v = sc[k]; int rk = 0; for (int k2 = 0; k2 < n; ++k2) { const float o = sc[k2]; rk += (o > v || (o == v && k2 < k)) ? 1 : 0; } flg[k] = rk < TOPK ? 1 : 0; }
            __syncthreads();
            if (tid < TOPK) { const int k = sel[tid]; if (k >= n) atomicAdd((int*)&cnt[1], 1000); else { if (!flg[k]) atomicAdd((int*)&cnt[0], 1); if (seen[k]) atomicAdd((int*)&cnt[1], 1000); seen[k] = 1; } }
        } else {
            if (tid < TOPK) { const int k = sel[tid]; if (tid < n ? (k != tid) : (k != 0xFFFF)) atomicAdd((int*)&cnt[1], 1000); }
        }
        __syncthreads();
        const int nv = n < TOPK ? n : TOPK;
        for (int i = tid; i < 8 * 256; i += NTHR) { const int hh = i >> 8, k = i & 255; float lg = -INFINITY;
            if (k < nv) { const int key = sel[k]; float d = 0.f; for (int r = 0; r < 256; ++r) d += bf2f(qlat[(t * 8 + hh) * 256 + r]) * fp8f(ckv8[((size_t)b * SEQ + key) * 256 + r]); lg = d * 0.08838834764831845f; }
            pl[i] = lg; }
        __syncthreads();
        if (tid < 8) { float m = -INFINITY; for (int k = 0; k < 256; ++k) m = fmaxf(m, pl[tid * 256 + k]); float l = 0.f; for (int k = 0; k < 256; ++k) { const float p = expf(pl[tid * 256 + k] - m); pl[tid * 256 + k] = p; l += p; } for (int k = 0; k < 256; ++k) pl[tid * 256 + k] /= l; }
        __syncthreads();
        for (int i = tid; i < 8 * 256; i += NTHR) { const int hh = i >> 8, r = i & 255; float o = 0.f;
            for (int k = 0; k < nv; ++k) o += pl[hh * 256 + k] * fp8f(ckv8[((size_t)b * SEQ + sel[k]) * 256 + r]);
            const float got = bf2f(olat[(t * 8 + hh) * 256 + r]);
            __hip_atomic_fetch_add(&errs[0], (got - o) * (got - o), __ATOMIC_RELAXED, __HIP_MEMORY_SCOPE_WORKGROUP); __hip_atomic_fetch_add(&errs[1], o * o, __ATOMIC_RELAXED, __HIP_MEMORY_SCOPE_WORKGROUP); if (!(got == got)) atomicAdd((int*)&cnt[2], 1); }
        __syncthreads();
        if (tid == 0) { unsigned code = 0; if (cnt[0] > 8 || cnt[1] > 0) code |= 1u; if (cnt[2] > 0 || !(errs[0] <= 0.12f * 0.12f * errs[1])) code |= 2u; if (code) atomicOr(F.ctl + CW_CHK, code); }
    }
}
__device__ __forceinline__ void phase_check_apply(Frame& F) {
    const unsigned code = __hip_atomic_load(F.ctl + CW_CHK, RLX_AGENT);
    if (code) { const float v = (code & 1u) ? __builtin_nanf("") : 0.f; const size_t gt = (size_t)F.bid * NTHR + F.wave * 64 + lane_id();
        for (size_t i = gt; i < (size_t)NTOK * DM; i += (size_t)F.G * NTHR) F.out[i] = v; }
}
#endif

constexpr int NPHASE = 16;
constexpr unsigned REPEAT_MASK = 0x0u;
constexpr int TIME_PHASE = -1;
constexpr int CW_TIME = 16384 + 320;
struct Args { const float* in[24]; float* out; unsigned char* ws; int ph_lo, ph_hi; };

__global__ void __launch_bounds__(NTHR, 2) mk_fwd(Args args) {
    extern __shared__ __attribute__((aligned(16))) unsigned char lds_raw[];
    Frame F;
    F.lds = (LAS unsigned char*)lds_raw;
    F.MISC = (volatile LAS unsigned*)(F.lds + MISC_OFF);
    F.wave = __builtin_amdgcn_readfirstlane(threadIdx.x >> 6);
    F.G = gridDim.x; F.bid = blockIdx.x;
    F.ws = args.ws; F.ctl = (unsigned*)(args.ws + WS_CTL); F.out = args.out;
    for (int u = threadIdx.x; u < (LDS_BYTES - MISC_OFF) / 4; u += NTHR) ((LAS unsigned*)(F.lds + MISC_OFF))[u] = 0u;
    __syncthreads();
    const int lo = args.ph_lo, hi = args.ph_hi;
    const bool multi = (hi - lo) > 1;
    XcdBarrier bar; bar.bar = F.ctl + CW_BAR; bar.x = 0; bar.st = nullptr; bar.wave = F.wave;
    if (multi) bar = xcd_barrier_post(F.ctl + CW_BAR, F.MISC + 8, F.wave);
#ifndef ONLY_PHASE
#define ONLY_PHASE -1
#endif
#define IN(k) ((ONLY_PHASE < 0 || ONLY_PHASE == (k)) && lo <= (k) && (k) < hi)
#define SEAM(k) do { if (IN(k) && IN((k) + 1)) { xcd_barrier(bar); \
        if (TIME_PHASE >= 0 && F.bid == 0 && F.wave == 0) { const unsigned long long now_ = __builtin_amdgcn_s_memrealtime(); \
            if ((k) == TIME_PHASE - 1 || ((k) == 0 && TIME_PHASE == 0 && false)) { if (lane_id() == 0) { F.ctl[CW_TIME] = (unsigned)now_; } } \
            if ((k) == TIME_PHASE) { if (lane_id() == 0) { F.ctl[CW_TIME + 1] = (unsigned)now_ - F.ctl[CW_TIME]; } } } } } while (0)
    unsigned char* ws = args.ws;
    const ExpW EW{args.in[16], args.in[17], args.in[18], args.in[19], args.in[20], args.in[21]};
    const bool ride = false;
    if (TIME_PHASE == 0 && F.bid == 0 && threadIdx.x == 0) F.ctl[CW_TIME] = (unsigned)__builtin_amdgcn_s_memrealtime();

    if (IN(0)) for (int rep_ = 0; rep_ < 1 + (int)((REPEAT_MASK >> 0) & 1u); ++rep_) { phase_convert_small(F, args.in[0], args.in[1], args.in[5], args.in[6], args.in[7], args.in[9], args.in[10], args.in[11], args.in[8], args.in[14]); } SEAM(0);

    if (IN(1)) for (int rep_ = 0; rep_ < 1 + (int)((REPEAT_MASK >> 1) & 1u); ++rep_) {
        FillPlain f{(const char*)(ws + WS_XB), (const char*)(ws + WS_WIN), 4096u, 4096u, 32};
        DenseSched<FillPlain> S{64, 30, F.G, F.bid, f};
        EpiP1 E{(bf16*)(ws + WS_Q), (bf16*)(ws + WS_QI), (bf16*)(ws + WS_XP), (bf16*)(ws + WS_GATES), (float*)(ws + WS_CKVRAW), (float*)(ws + WS_KIWI)};
        pg8::gemm_phase<EpiP1, DenseSched<FillPlain>, false, true, true>(F.lds, F.wave, 4096u, 4096u, S, E);
    } SEAM(1);

    if (IN(2)) for (int rep_ = 0; rep_ < 1 + (int)((REPEAT_MASK >> 2) & 1u); ++rep_) { phase_postproc(F, args.in[2], args.in[3], args.in[4]); } SEAM(2);

    if (IN(3)) for (int rep_ = 0; rep_ < 1 + (int)((REPEAT_MASK >> 3) & 1u); ++rep_) {
        FillQlatPool f{(const char*)(ws + WS_Q), (const char*)(ws + WS_DIFF), (const char*)(ws + WS_WUK), (const char*)(ws + WS_WPOOL)};
        DenseSched<FillQlatPool> S{64, 12, F.G, F.bid, f};
        EpiQlatPool E{(bf16*)(ws + WS_QLAT), (bf16*)(ws + WS_POOL), (const float*)(ws + WS_CSCALE)};
        pg8::gemm_phase<EpiQlatPool, DenseSched<FillQlatPool>, false, true, true>(F.lds, F.wave, 2048u, 512u, S, E);
    } SEAM(3);

    if (IN(4)) for (int rep_ = 0; rep_ < 1 + (int)((REPEAT_MASK >> 4) & 1u); ++rep_) { phase_index_scores(F); } SEAM(4);
    if (IN(5)) for (int rep_ = 0; rep_ < 1 + (int)((REPEAT_MASK >> 5) & 1u); ++rep_) { phase_select(F, EW, ride && rep_ == 0); } SEAM(5);
    if (IN(6)) for (int rep_ = 0; rep_ < 1 + (int)((REPEAT_MASK >> 6) & 1u); ++rep_) { phase_sparse_attn(F, EW, ride && rep_ == 0); } SEAM(6);
#if MK_CHECK
    if (IN(6) && IN(7)) { phase_check_attn(F); xcd_barrier(bar); }
#endif

    if (IN(7)) for (int rep_ = 0; rep_ < 1 + (int)((REPEAT_MASK >> 7) & 1u); ++rep_) {
        FillO f{(const char*)(ws + WS_OLAT), (const char*)(ws + WS_WUV)};
        DenseSched<FillO> S{64, 4, F.G, F.bid, f};
        EpiBf16 E{(bf16*)(ws + WS_ATTN), 1024};
        pg8::gemm_phase<EpiBf16, DenseSched<FillO>, false, true, true>(F.lds, F.wave, 4096u, 1024u, S, E);
    } SEAM(7);

    if (IN(8)) for (int rep_ = 0; rep_ < 1 + (int)((REPEAT_MASK >> 8) & 1u); ++rep_) {
        FillPlain f{(const char*)(ws + WS_ATTN), (const char*)(ws + WS_WPA), 2048u, 2048u, 16};
        DenseSched<FillPlain> S{64, 8, F.G, F.bid, f};
        EpiGate<0> E{(const bf16*)(ws + WS_GATES), (bf16*)(ws + WS_M1), (bf16*)(ws + WS_MERGED)};
        pg8::gemm_phase<EpiGate<0>, DenseSched<FillPlain>, false, true, true>(F.lds, F.wave, 2048u, 2048u, S, E);
    } SEAM(8);

    if (IN(9)) for (int rep_ = 0; rep_ < 1 + (int)((REPEAT_MASK >> 9) & 1u); ++rep_) {
        FillPlain f{(const char*)(ws + WS_POOL), (const char*)(ws + WS_WPP), 2048u, 2048u, 16};
        DenseSched<FillPlain> S{64, 8, F.G, F.bid, f};
        EpiGate<1> E{(const bf16*)(ws + WS_GATES), (bf16*)(ws + WS_M1), (bf16*)(ws + WS_MERGED)};
        pg8::gemm_phase<EpiGate<1>, DenseSched<FillPlain>, false, true, true>(F.lds, F.wave, 2048u, 2048u, S, E);
    } SEAM(9);

    if (IN(10)) for (int rep_ = 0; rep_ < 1 + (int)((REPEAT_MASK >> 10) & 1u); ++rep_) {
        FillPlain f{(const char*)(ws + WS_MERGED), (const char*)(ws + WS_WOUT), 4096u, 4096u, 32};
        DenseSched<FillPlain> S{64, 8, F.G, F.bid, f};
        EpiPre E{args.in[0], F.out};
        pg8::gemm_phase<EpiPre, DenseSched<FillPlain>, false, true, true>(F.lds, F.wave, 4096u, 4096u, S, E);
    } SEAM(10);

    if (IN(11)) for (int rep_ = 0; rep_ < 1 + (int)((REPEAT_MASK >> 11) & 1u); ++rep_) {
        for (int rl_ = 0; rl_ < 1 + (int)((REPEAT_MASK >> 17) & 1u); ++rl_) phase_ln1_router(F, args.in[12], args.in[13], args.in[15], rl_ == 0);
        phase_convert_experts(F, EW);
        phase_flush_hist(F);
    } SEAM(11);
    if (IN(12)) for (int rep_ = 0; rep_ < 1 + (int)((REPEAT_MASK >> 12) & 1u); ++rep_) { phase_scatter(F); } SEAM(12);

    if (IN(13)) for (int rep_ = 0; rep_ < 1 + (int)((REPEAT_MASK >> 13) & 1u); ++rep_) {
        const int nmt = (int)__hip_atomic_load(F.ctl + CW_NMT, RLX_AGENT);
        MoeSched S{(const int*)(ws + WS_TOPK + TK_MTT), nmt, 4, F.G, F.bid, true, (const char*)(ws + WS_H), (const char*)(ws + WS_HBUF), (const char*)(ws + WS_WGU), (const char*)(ws + WS_WD), (const int*)(ws + WS_TOPK + TK_ROWLIST), F.lds};
        S.prepare(F.wave * 64 + lane_id());
        EpiSwiGLU E{(bf16*)(ws + WS_HBUF)};
        pg8::gemm_phase<EpiSwiGLU, MoeSched, true, true, true>(F.lds, F.wave, 4096u, 4096u, S, E);
    } SEAM(13);

    if (IN(14)) for (int rep_ = 0; rep_ < 1 + (int)((REPEAT_MASK >> 14) & 1u); ++rep_) {
        const int nmt = (int)__hip_atomic_load(F.ctl + CW_NMT, RLX_AGENT);
        MoeSched S{(const int*)(ws + WS_TOPK + TK_MTT), nmt, 8, F.G, F.bid, false, (const char*)(ws + WS_H), (const char*)(ws + WS_HBUF), (const char*)(ws + WS_WGU), (const char*)(ws + WS_WD), (const int*)(ws + WS_TOPK + TK_ROWLIST), F.lds};
        S.prepare(F.wave * 64 + lane_id());
        EpiY E{(unsigned char*)(ws + WS_Y), (bf16*)(ws + WS_YSH)};
        pg8::gemm_phase<EpiY, MoeSched, false, true, true>(F.lds, F.wave, 1024u, 1024u, S, E);
    } SEAM(14);

    if (IN(15)) for (int rep_ = 0; rep_ < 1 + (int)((REPEAT_MASK >> 15) & 1u); ++rep_) { phase_combine(F, args.in[22], args.in[23]); }
#if MK_CHECK
    if (IN(15)) { xcd_barrier(bar); phase_check_apply(F); }
#endif
    if (TIME_PHASE >= 0 && multi && F.bid == 0 && F.wave == 0) {
        asm volatile("s_waitcnt vmcnt(0)" ::: "memory");
        if (TIME_PHASE == 15 && lane_id() == 0) { F.ctl[CW_TIME + 1] = (unsigned)__builtin_amdgcn_s_memrealtime() - F.ctl[CW_TIME]; }
        asm volatile("s_waitcnt vmcnt(0)" ::: "memory");
        const unsigned dur = __hip_atomic_load(F.ctl + CW_TIME + 1, RLX_AGENT); const unsigned long long t0 = __builtin_amdgcn_s_memrealtime();
        while (__builtin_amdgcn_s_memrealtime() - t0 < 4ull * dur) __builtin_amdgcn_s_sleep(8);
    }
#undef IN
#undef SEAM
}

#ifndef MK_ONE_LAUNCH
#define MK_ONE_LAUNCH 1
#endif
extern "C" void kernel_launch(void* const* d_in, const int* in_sizes, int n_in, void* d_out, int out_size, void* d_ws, size_t ws_size, hipStream_t stream) {
    static int grid = 0;
    if (grid == 0) {
        if (n_in != 24 || out_size != NTOK * DM || ws_size < WS_END) { fprintf(stderr, "kernel_launch: unexpected shapes (n_in %d out %d ws %zu)\n", n_in, out_size, ws_size); grid = -1; return; }
        int dev = 0, cus = 0;
        if (hipGetDevice(&dev) != hipSuccess || hipDeviceGetAttribute(&cus, hipDeviceAttributeMultiprocessorCount, dev) != hipSuccess) { grid = -1; return; }
        if (hipFuncSetAttribute((const void*)mk_fwd, hipFuncAttributeMaxDynamicSharedMemorySize, LDS_BYTES) != hipSuccess) { fprintf(stderr, "kernel_launch: hipFuncSetAttribute failed\n"); grid = -1; return; }
        int per_cu = 0;
        if (hipOccupancyMaxActiveBlocksPerMultiprocessor(&per_cu, (const void*)mk_fwd, NTHR, LDS_BYTES) != hipSuccess || per_cu < 1) fprintf(stderr, "kernel_launch: occupancy query says %d\n", per_cu);
        (void)hipGetLastError();
        grid = cus;
    }
    if (grid < 0) return;
    if (hipMemsetAsync((char*)d_ws + WS_CTL, 0, CTL_BYTES, stream) != hipSuccess) return;
    Args a{};
    for (int i = 0; i < 24; ++i) a.in[i] = (const float*)d_in[i];
    a.out = (float*)d_out; a.ws = (unsigned char*)d_ws;
#if MK_ONE_LAUNCH
    a.ph_lo = 0; a.ph_hi = NPHASE;
    hipLaunchKernelGGL(mk_fwd, dim3(grid), dim3(NTHR), LDS_BYTES, stream, a);
#else
    for (int p = 0; p < NPHASE; ++p) { a.ph_lo = p; a.ph_hi = p + 1; hipLaunchKernelGGL(mk_fwd, dim3(grid), dim3(NTHR), LDS_BYTES, stream, a); }
#endif
}
```

```cpp
#include <hip/hip_runtime.h>
#include <cstdio>
#include <cstdint>

#define LAS __attribute__((address_space(3)))
#define GAS __attribute__((address_space(1)))
typedef unsigned short bf16;
typedef short bf16x8 __attribute__((ext_vector_type(8)));
typedef short s16x4 __attribute__((ext_vector_type(4)));
typedef float f32x4 __attribute__((ext_vector_type(4)));
typedef float f32x2 __attribute__((ext_vector_type(2)));
typedef unsigned u32x4 __attribute__((ext_vector_type(4)));
typedef unsigned u32x2 __attribute__((ext_vector_type(2)));

constexpr int NTOK = 16384, SEQ = 8192, DM = 2048;
constexpr int NH = 8, DQK = 128, DV = 128, RKV = 256, IH = 16, IDH = 64, TOPK = 256;
constexpr int NE = 64, EK = 8, EDIM = 512, NGRP = 65;
constexpr int WIN_ROWS = 7680;
constexpr float LN_EPS = 1e-5f, RMS_EPS = 1e-6f;
constexpr float DN_ALPHA = 1.189207115002721f;
constexpr int NSLOT = NTOK * 9;
constexpr size_t SC_TOT = (size_t)128 * 128 * (64 * 65 / 2);

constexpr size_t MiB = 1u << 20;
constexpr size_t WS_CTL = 0, CTL_BYTES = 1 * MiB;
constexpr size_t WS_WIN = 1 * MiB;
constexpr size_t WS_WUK = 31 * MiB;
constexpr size_t WS_WUV = 32 * MiB;
constexpr size_t WS_WPOOL = 33 * MiB;
constexpr size_t WS_WPA = 34 * MiB;
constexpr size_t WS_WPP = 38 * MiB;
constexpr size_t WS_WOUT = 42 * MiB;
constexpr size_t WS_CSCALE = 50 * MiB;
constexpr size_t WS_WRT = 50 * MiB + 65536;
constexpr size_t WS_XB = 394 * MiB;
constexpr size_t WS_Q = 458 * MiB;
constexpr size_t WS_QI = 490 * MiB;
constexpr size_t WS_XP = 522 * MiB;
constexpr size_t WS_CKVRAW = 554 * MiB;
constexpr size_t WS_KIWI = 570 * MiB;
constexpr size_t WS_DIFF = 586 * MiB;
constexpr size_t WS_GATES = 181 * MiB;
constexpr size_t WS_QLAT = 309 * MiB;
constexpr size_t WS_CKVN = 373 * MiB;
constexpr size_t WS_KIN = 381 * MiB;
constexpr size_t WS_WI = 383 * MiB;
constexpr size_t WS_SEL = 654 * MiB;
constexpr size_t WS_SCORES = 662 * MiB;
constexpr size_t WS_POOL = 922 * MiB;
constexpr size_t WS_OLAT = 662 * MiB;
constexpr size_t WS_ATTN = 726 * MiB;
constexpr size_t WS_M1 = 758 * MiB;
constexpr size_t WS_MERGED = 822 * MiB;
constexpr size_t WS_WD = 51 * MiB;
constexpr size_t WS_H = 181 * MiB;
constexpr size_t WS_HBUF = 245 * MiB;
constexpr size_t WS_TOPK = 390 * MiB;
constexpr size_t WS_WGU = 394 * MiB;
constexpr size_t WS_Y = 394 * MiB;
constexpr size_t WS_YSH = WS_Y + (size_t)NTOK * 8 * DM;
constexpr size_t WS_END = 1024 * MiB;
static_assert(WS_DIFF + 32 * MiB <= 654 * MiB && WS_SCORES + 260 * MiB <= WS_POOL && WS_POOL + 32 * MiB <= 970 * MiB && WS_WI + 1 * MiB <= 390 * MiB, "mixer map");
static_assert(WS_SCORES + SC_TOT * 2 * 4 <= WS_POOL, "scores");
static_assert(WS_HBUF + (size_t)(NSLOT + 256) * EDIM * 2 <= WS_TOPK, "hbuf");
static_assert(WS_YSH + (size_t)NTOK * DM * 2 <= WS_END, "y");
constexpr size_t TK_E = 0;
constexpr size_t TK_W = 512 * 1024;
constexpr size_t TK_POS = 1024 * 1024;
constexpr size_t TK_ROWLIST = 1536 * 1024;
constexpr size_t TK_MTT = 2560 * 1024;
constexpr size_t TK_WRT = 3 * MiB;
constexpr int CW_BAR = 4096;
constexpr int CW_CNT = 16384;
constexpr int CW_FILL = 16384 + 64;
constexpr int CW_CVQ = 16384 + 192;
constexpr int CW_NMT = 16384 + 128;

constexpr int RING_BYTES = 131072;
constexpr int MISC_OFF = 143360;
constexpr int LDS_BYTES = 147456;
constexpr int NWAVES = 8, NTHR = 512;

#define RLX_AGENT __ATOMIC_RELAXED, __HIP_MEMORY_SCOPE_AGENT
#define LDS_WAIT() asm volatile("s_waitcnt lgkmcnt(0)" ::: "memory")
#define VM_WAIT() asm volatile("s_waitcnt vmcnt(0)" ::: "memory")

__device__ __forceinline__ int lane_id() { return (int)__builtin_amdgcn_mbcnt_hi(~0u, __builtin_amdgcn_mbcnt_lo(~0u, 0u)); }
__device__ __forceinline__ float bf2f(unsigned b) { return __uint_as_float(b << 16); }
__device__ __forceinline__ unsigned f2bf(float f) { unsigned u = __float_as_uint(f); return (u + 0x7fffu + ((u >> 16) & 1u)) >> 16; }
__device__ __forceinline__ unsigned pk2(float lo, float hi) { return f2bf(lo) | (f2bf(hi) << 16); }
__device__ __forceinline__ unsigned cvt_pk_bf16(float lo, float hi) { unsigned r; asm volatile("v_cvt_pk_bf16_f32 %0, %1, %2" : "=v"(r) : "v"(lo), "v"(hi)); return r; }
#define DPP_I(old, x, ctrl, rmask) __builtin_amdgcn_update_dpp((int)(old), (int)(x), (ctrl), (rmask), 0xf, false)
__device__ __forceinline__ int wave_scan_i(int x) {
    x += DPP_I(0, x, 0x111, 0xf); x += DPP_I(0, x, 0x112, 0xf); x += DPP_I(0, x, 0x114, 0xf); x += DPP_I(0, x, 0x118, 0xf);
    x += DPP_I(0, x, 0x142, 0xa); x += DPP_I(0, x, 0x143, 0xc); return x;
}
__device__ __forceinline__ int wave_sum_i(int v) { return __builtin_amdgcn_readlane(wave_scan_i(v), 63); }
__device__ __forceinline__ float wave_sum(float x) {
#define DPP_F(x_, ctrl, rmask) __builtin_bit_cast(float, __builtin_amdgcn_update_dpp(0, __builtin_bit_cast(int, x_), (ctrl), (rmask), 0xf, false))
    x += DPP_F(x, 0x111, 0xf); x += DPP_F(x, 0x112, 0xf); x += DPP_F(x, 0x114, 0xf); x += DPP_F(x, 0x118, 0xf);
    x += DPP_F(x, 0x142, 0xa); x += DPP_F(x, 0x143, 0xc);
#undef DPP_F
    return __builtin_bit_cast(float, __builtin_amdgcn_readlane(__builtin_bit_cast(int, x), 63));
}
__device__ __forceinline__ float wave_max(float x) {
#define DPP_K(x_, ctrl, rmask) __builtin_bit_cast(float, __builtin_amdgcn_update_dpp(__builtin_bit_cast(int, x_), __builtin_bit_cast(int, x_), (ctrl), (rmask), 0xf, false))
    x = fmaxf(x, DPP_K(x, 0x111, 0xf)); x = fmaxf(x, DPP_K(x, 0x112, 0xf)); x = fmaxf(x, DPP_K(x, 0x114, 0xf)); x = fmaxf(x, DPP_K(x, 0x118, 0xf));
    x = fmaxf(x, DPP_K(x, 0x142, 0xa)); x = fmaxf(x, DPP_K(x, 0x143, 0xc));
    return __builtin_bit_cast(float, __builtin_amdgcn_readlane(__builtin_bit_cast(int, x), 63));
}
__device__ __forceinline__ float wave_min(float x) {
    x = fminf(x, DPP_K(x, 0x111, 0xf)); x = fminf(x, DPP_K(x, 0x112, 0xf)); x = fminf(x, DPP_K(x, 0x114, 0xf)); x = fminf(x, DPP_K(x, 0x118, 0xf));
    x = fminf(x, DPP_K(x, 0x142, 0xa)); x = fminf(x, DPP_K(x, 0x143, 0xc));
#undef DPP_K
    return __builtin_bit_cast(float, __builtin_amdgcn_readlane(__builtin_bit_cast(int, x), 63));
}

#define XB_TMO      128
#define XB_XCNT(j)  (256  + 64 * (j))
#define XB_XSUB(j)  (1280 + 64 * (j))
#define XB_XGEN(j)  (2304 + 64 * (j))
#define XB_TOP      3328
#define XB_TOPGEN   3392
#define XCD_BAR_WORDS 3456
#define XB_SPIN_CAP (1u << 24)

__device__ __forceinline__ unsigned xb_ld(unsigned* p)              { return __hip_atomic_load(p, __ATOMIC_RELAXED, __HIP_MEMORY_SCOPE_AGENT); }
__device__ __forceinline__ unsigned xb_add(unsigned* p, unsigned v) { return __hip_atomic_fetch_add(p, v, __ATOMIC_RELAXED, __HIP_MEMORY_SCOPE_AGENT); }
__device__ __forceinline__ unsigned xb_xcc_id() { return (unsigned)__builtin_amdgcn_s_getreg((3 << 11) | 20) & 0xFu; }
#define XB_SPIN(cond, bar) do { unsigned _sp = 0; while (cond) { __builtin_amdgcn_s_sleep(1); \
    if ((++_sp & 255u) == 0u) { if (xb_ld(&(bar)[XB_TMO])) break; if (_sp > XB_SPIN_CAP) { atomicAdd(&(bar)[XB_TMO], 1u); break; } } } } while (0)

struct XcdBarrier { unsigned* bar; unsigned x; volatile LAS unsigned* st; int wave; };

__device__ __forceinline__ XcdBarrier xcd_barrier_post(unsigned* bar, volatile LAS unsigned* st, int wave) {
    XcdBarrier b; b.bar = bar; b.x = xb_xcc_id(); b.st = st; b.wave = wave;
    if (wave == 0 && lane_id() == 0) (void)xb_add(&bar[XB_XCNT(b.x)], 1u);
    return b;
}
__device__ __forceinline__ void xcd_barrier_complete(unsigned* bar, unsigned x, unsigned& nloc, unsigned& nx) {
    const unsigned G = gridDim.x * gridDim.y * gridDim.z;
    unsigned sum, cnt, mine, sp = 0u;
    for (;;) {
        sum = 0u; cnt = 0u; mine = 0u;
#pragma unroll
        for (unsigned j = 0; j < 16; ++j) { const unsigned c = xb_ld(&bar[XB_XCNT(j)]); sum += c; cnt += (c > 0u) ? 1u : 0u; mine = (j == x) ? c : mine; }
        if (sum == G) break;
        __builtin_amdgcn_s_sleep(1);
        if ((++sp & 255u) == 0u) { if (xb_ld(&bar[XB_TMO])) break; if (sp > XB_SPIN_CAP) { atomicAdd(&bar[XB_TMO], 1u); break; } }
    }
    nloc = mine > 0u ? mine : 1u; nx = cnt > 0u ? cnt : 1u;
}
__device__ __forceinline__ void xcd_barrier(const XcdBarrier& b) {
    asm volatile("s_waitcnt vmcnt(0)" ::: "memory");
    __syncthreads();
    if (b.wave == 0 && lane_id() == 0) {
        unsigned* bar = b.bar;
        __builtin_amdgcn_s_waitcnt(0);
        unsigned nloc = b.st[0], nx = b.st[1];
        if (nloc == 0u) { xcd_barrier_complete(bar, b.x, nloc, nx); b.st[0] = nloc; b.st[1] = nx; }
        const unsigned old = xb_add(&bar[XB_XSUB(b.x)], 1u);
        const unsigned gen = old / nloc;
        if (old + 1u == (gen + 1u) * nloc) {
            __builtin_amdgcn_fence(__ATOMIC_RELEASE, "agent");
            asm volatile("s_waitcnt vmcnt(0)" ::: "memory");
            const unsigned og = xb_add(&bar[XB_TOP], 1u);
            const unsigned tg = og / nx;
            if (og + 1u == (tg + 1u) * nx) xb_add(&bar[XB_TOPGEN], 1u);
            else XB_SPIN(xb_ld(&bar[XB_TOPGEN]) == tg, bar);
            __builtin_amdgcn_fence(__ATOMIC_ACQUIRE, "agent");
            xb_add(&bar[XB_XGEN(b.x)], 1u);
            asm volatile("s_waitcnt vmcnt(0)" ::: "memory");
        } else {
            XB_SPIN(xb_ld(&bar[XB_XGEN(b.x)]) == gen, bar);
            __builtin_amdgcn_fence(__ATOMIC_ACQUIRE, "agent");
            asm volatile("s_waitcnt vmcnt(0)" ::: "memory");
        }
    }
    __syncthreads();
}

namespace pg8 {
constexpr int BM = 256, BK = 64, HALF = 128, HTB = HALF * BK * 2, STAGE_BYTES = 8 * HTB, NXCD = 8, WGM = 8;

__host__ __device__ __forceinline__ int lds_byte(int r, int c) { const int st = (r >> 4) * 2 + (c >> 5), rr = r & 15, cc = c & 31, ob = rr * 64 + cc * 2; return st * 1024 + (ob ^ (((ob >> 9) & 1) << 5)); }
__host__ __device__ __forceinline__ void stage_rc(int b, int& R, int& C) { const int st = b / 1024, sb = b % 1024, swz = sb ^ (((sb >> 9) & 1) << 5); R = (st >> 1) * 16 + swz / 64; C = (st & 1) * 32 + (swz % 64) / 2; }
__host__ __device__ __forceinline__ int perm32(int rho) { const int n = rho >> 4, i = rho & 15; return 8 * (i >> 2) + 4 * n + (i & 3); }

__device__ __forceinline__ const char* uptr(const char* p) { const unsigned long long v = (unsigned long long)p; const unsigned lo = __builtin_amdgcn_readfirstlane((unsigned)v), hi = __builtin_amdgcn_readfirstlane((unsigned)(v >> 32)); return (const char*)(((unsigned long long)hi << 32) | lo); }
struct GUnit {
    const char* A;
    const char* B0;
    const char* B1;
    const int* rows;
    int rows_lds;
    int nt;
    int pm, pn, aux0, aux1;
};

__device__ __forceinline__ void tile_order(int L, int nM, int nN, int& pm, int& pn) {
    const int nwg = nM * nN;
    int wgid = L; { const int q = nwg / NXCD, r = nwg % NXCD, xcd = wgid % NXCD, off = wgid / NXCD; wgid = (xcd < r ? xcd * (q + 1) : r * (q + 1) + (xcd - r) * q) + off; }
    const int nig = WGM * nN, gid = wgid / nig, fm = gid * WGM, gsz = (nM - fm) < WGM ? (nM - fm) : WGM;
    pm = fm + ((wgid % nig) % gsz); pn = (wgid % nig) / gsz;
}

template <class Epi, class Sched, bool GATHER, bool ALIGN_EPI, bool SP2>
__device__ __forceinline__ void gemm_phase(LAS unsigned char* lds, const int wave, const unsigned a_rs, const unsigned b_rs, const Sched& S, const Epi& E) {
    const int wid = wave, lane = lane_id(), tid = wid * 64 + lane, wr = wid >> 2, wc = wid & 3, fr = lane & 15, fq = lane >> 4;
    int R0, C0; stage_rc(tid * 16, R0, C0);
    unsigned voffA[2], voffB[2];
#pragma unroll
    for (int i = 0; i < 2; ++i) { const int R = R0 + 64 * i; const int Rb = (R & ~31) + perm32(R & 31);
        voffA[i] = (unsigned)R * a_rs + (unsigned)C0 * 2u; voffB[i] = (unsigned)Rb * b_rs + (unsigned)C0 * 2u; }
    unsigned vgc[2][2], vgn[2][2];
    const size_t kstep = (size_t)(BK * 2);
    const size_t hstepA = (size_t)HALF * a_rs;
    const unsigned ldsw = (unsigned)wid * 1024u;
    const int aoff = lds_byte(wr * 64 + fr, fq * 8), boff = lds_byte(wc * 32 + fr, fq * 8);
#define PG8_SA(b, h) (((b) * 2 + (h)) * HTB)
#define PG8_SB(b, h) ((4 + (b) * 2 + (h)) * HTB)
#define PG8_STAGE(bufoff, gbase, voff) do { const char* _gb = (const char*)(gbase); asm volatile("" : "+s"(_gb)); _Pragma("unroll") for (int _i = 0; _i < 2; ++_i) \
        __builtin_amdgcn_global_load_lds((const unsigned*)(_gb + (voff)[_i]), (LAS unsigned*)(lds + (bufoff) + ldsw + _i * 8192), 16, 0, 0); } while (0)
#define PG8_STAGE_A(bufoff, gbase, h, vg) do { if constexpr (GATHER) { PG8_STAGE(bufoff, gbase, (vg)[h]); } else { PG8_STAGE(bufoff, (gbase) + (h) * hstepA, voffA); } } while (0)
#define PG8_LDA(dst, b, h) do { _Pragma("unroll") for (int m = 0; m < 4; ++m) _Pragma("unroll") for (int k = 0; k < 2; ++k) dst[m][k] = *(const LAS bf16x8*)(lds + PG8_SA(b, h) + aoff + m * 2048 + k * 1024); } while (0)
#define PG8_LDB(dst, b, h) do { _Pragma("unroll") for (int n = 0; n < 2; ++n) _Pragma("unroll") for (int k = 0; k < 2; ++k) dst[n][k] = *(const LAS bf16x8*)(lds + PG8_SB(b, h) + boff + n * 2048 + k * 1024); } while (0)
#define PG8_MMA(ai, bj, At, Bt) do { __builtin_amdgcn_s_setprio(1); _Pragma("unroll") for (int m = 0; m < 4; ++m) _Pragma("unroll") for (int n = 0; n < 2; ++n) _Pragma("unroll") for (int k = 0; k < 2; ++k) \
        acc[ai][bj][m][n] = __builtin_amdgcn_mfma_f32_16x16x32_bf16(Bt[n][k], At[m][k], acc[ai][bj][m][n], 0, 0, 0); __builtin_amdgcn_s_setprio(0); } while (0)
#define PG8_WAIT_V(n) asm volatile("s_waitcnt vmcnt(" #n ")" ::: "memory")
#define PG8_WAIT_L(n) asm volatile("s_waitcnt lgkmcnt(" #n ")" ::: "memory")
#define PG8_BAR __builtin_amdgcn_s_barrier()
#define PG8_SCHED __builtin_amdgcn_sched_barrier(0)
#define PG8_GOFF(dst, u) do { if constexpr (GATHER) { if ((u).rows_lds >= 0) { _Pragma("unroll") for (int _h = 0; _h < 2; ++_h) _Pragma("unroll") for (int _i = 0; _i < 2; ++_i) \
        dst[_h][_i] = (unsigned)((const LAS int*)(lds + (u).rows_lds))[_h * HALF + R0 + 64 * _i] * a_rs + (unsigned)C0 * 2u; } else { _Pragma("unroll") for (int _h = 0; _h < 2; ++_h) _Pragma("unroll") for (int _i = 0; _i < 2; ++_i) \
        dst[_h][_i] = (unsigned)(u).rows[_h * HALF + R0 + 64 * _i] * a_rs + (unsigned)C0 * 2u; } } } while (0)
    GUnit cur, nxt; int ui = 0;
    if (!S.next(0, cur)) return;
    f32x4 acc[2][2][4][2];
#pragma unroll
    for (int a = 0; a < 2; ++a)
#pragma unroll
        for (int b = 0; b < 2; ++b)
#pragma unroll
            for (int m = 0; m < 4; ++m)
#pragma unroll
                for (int n = 0; n < 2; ++n) acc[a][b][m][n] = (f32x4){0.f, 0.f, 0.f, 0.f};
    bf16x8 At[4][2], B0[2][2], B1[2][2];
    const char* cA = uptr(cur.A); const char* cB0 = uptr(cur.B0); const char* cB1 = uptr(cur.B1); int cnt = __builtin_amdgcn_readfirstlane(cur.nt);
    PG8_GOFF(vgc, cur);
    if constexpr (SP2) {
        PG8_STAGE(PG8_SB(0, 0), cB0, voffB); PG8_STAGE(PG8_SB(0, 1), cB1, voffB); PG8_STAGE_A(PG8_SA(0, 0), cA, 0, vgc); PG8_STAGE_A(PG8_SA(0, 1), cA, 1, vgc);
        if (wr == 1) PG8_BAR;
        PG8_WAIT_V(2); PG8_BAR;
        PG8_STAGE(PG8_SB(1, 0), cB0 + kstep, voffB); PG8_STAGE_A(PG8_SA(1, 0), cA + kstep, 0, vgc); PG8_STAGE(PG8_SB(1, 1), cB1 + kstep, voffB);
        PG8_WAIT_V(6); PG8_BAR;
    } else {
        PG8_STAGE(PG8_SB(0, 0), cB0, voffB); PG8_STAGE_A(PG8_SA(0, 0), cA, 0, vgc); PG8_STAGE(PG8_SB(0, 1), cB1, voffB); PG8_STAGE_A(PG8_SA(0, 1), cA, 1, vgc);
        if (wr == 1) PG8_BAR;
        PG8_WAIT_V(4); PG8_BAR;
        PG8_STAGE(PG8_SB(1, 0), cB0 + kstep, voffB); PG8_STAGE_A(PG8_SA(1, 0), cA + kstep, 0, vgc); PG8_STAGE(PG8_SB(1, 1), cB1 + kstep, voffB);
        PG8_WAIT_V(6); PG8_BAR;
    }
    for (;;) {
        const bool has_next = S.next(ui + 1, nxt);
        const char* nA = uptr(has_next ? nxt.A : cA); const char* nB0 = uptr(has_next ? nxt.B0 : cB0); const char* nB1 = uptr(has_next ? nxt.B1 : cB1);
        if constexpr (GATHER) {
            if (has_next) { PG8_GOFF(vgn, nxt); }
            else {
#pragma unroll
                for (int _h = 0; _h < 2; ++_h)
#pragma unroll
                    for (int _i = 0; _i < 2; ++_i) vgn[_h][_i] = vgc[_h][_i];
            }
        }
        for (int t = 0; t < cnt; t += 2) {
            const bool last = (t == cnt - 2);
            const char* a1 = cA + (size_t)(t + 1) * kstep;
            const char* a2 = last ? nA : cA + (size_t)(t + 2) * kstep;
            const char* b2 = last ? nB0 : cB0 + (size_t)(t + 2) * kstep; const char* b2h = last ? nB1 : cB1 + (size_t)(t + 2) * kstep;
            const char* a3 = a2 + kstep; const char* b3 = b2 + kstep; const char* b3h = b2h + kstep;
            unsigned vg2[2][2];
            if constexpr (GATHER) {
#pragma unroll
                for (int _h = 0; _h < 2; ++_h)
#pragma unroll
                    for (int _i = 0; _i < 2; ++_i) vg2[_h][_i] = last ? vgn[_h][_i] : vgc[_h][_i];
            }
            if constexpr (SP2) {
            PG8_LDB(B0, 0, 0); PG8_LDB(B1, 0, 1); PG8_SCHED; PG8_LDA(At, 0, 0); PG8_STAGE_A(PG8_SA(1, 1), a1, 1, vgc);
            PG8_WAIT_V(8); PG8_WAIT_L(0); PG8_BAR; PG8_MMA(0, 0, At, B0); PG8_MMA(0, 1, At, B1); PG8_BAR; PG8_SCHED;
            PG8_LDA(At, 0, 1); PG8_STAGE(PG8_SB(0, 0), b2, voffB); PG8_STAGE(PG8_SB(0, 1), b2h, voffB); PG8_STAGE_A(PG8_SA(0, 0), a2, 0, vg2);
            PG8_WAIT_V(8); PG8_WAIT_L(0); PG8_BAR; PG8_MMA(1, 0, At, B0); PG8_MMA(1, 1, At, B1); PG8_BAR; PG8_SCHED;
            PG8_LDB(B0, 1, 0); PG8_LDB(B1, 1, 1); PG8_SCHED; PG8_LDA(At, 1, 0); PG8_STAGE_A(PG8_SA(0, 1), a2, 1, vg2);
            PG8_WAIT_V(8); PG8_WAIT_L(0); PG8_BAR; PG8_MMA(0, 0, At, B0); PG8_MMA(0, 1, At, B1); PG8_BAR; PG8_SCHED;
            PG8_LDA(At, 1, 1); PG8_STAGE(PG8_SB(1, 0), b3, voffB); PG8_STAGE(PG8_SB(1, 1), b3h, voffB); PG8_STAGE_A(PG8_SA(1, 0), a3, 0, vg2);
            PG8_WAIT_V(8); PG8_WAIT_L(0); PG8_BAR; PG8_MMA(1, 0, At, B0); PG8_MMA(1, 1, At, B1); PG8_BAR; PG8_SCHED;
            } else {
            PG8_LDB(B0, 0, 0); PG8_SCHED; PG8_LDA(At, 0, 0); PG8_STAGE_A(PG8_SA(1, 1), a1, 1, vgc);
            PG8_WAIT_L(8); PG8_BAR; PG8_WAIT_L(0); PG8_MMA(0, 0, At, B0); PG8_BAR; PG8_SCHED;
            PG8_LDB(B1, 0, 1); PG8_STAGE(PG8_SB(0, 0), b2, voffB);
            PG8_BAR; PG8_WAIT_L(0); PG8_MMA(0, 1, At, B1); PG8_BAR;
            PG8_LDA(At, 0, 1); PG8_STAGE_A(PG8_SA(0, 0), a2, 0, vg2);
            PG8_BAR; PG8_WAIT_L(0); PG8_MMA(1, 0, At, B0); PG8_BAR; PG8_SCHED;
            PG8_STAGE(PG8_SB(0, 1), b2h, voffB);
            PG8_WAIT_V(6); PG8_BAR; PG8_MMA(1, 1, At, B1); PG8_BAR;
            PG8_LDB(B0, 1, 0); PG8_SCHED; PG8_LDA(At, 1, 0); PG8_STAGE_A(PG8_SA(0, 1), a2, 1, vg2);
            PG8_WAIT_L(8); PG8_BAR; PG8_WAIT_L(0); PG8_MMA(0, 0, At, B0); PG8_BAR; PG8_SCHED;
            PG8_LDB(B1, 1, 1); PG8_STAGE(PG8_SB(1, 0), b3, voffB);
            PG8_BAR; PG8_WAIT_L(0); PG8_MMA(0, 1, At, B1); PG8_BAR;
            PG8_LDA(At, 1, 1); PG8_STAGE_A(PG8_SA(1, 0), a3, 0, vg2);
            PG8_BAR; PG8_WAIT_L(0); PG8_MMA(1, 0, At, B0); PG8_BAR; PG8_SCHED;
            PG8_STAGE(PG8_SB(1, 1), b3h, voffB);
            PG8_WAIT_V(6); PG8_BAR; PG8_MMA(1, 1, At, B1); PG8_BAR;
            }
        }
        if constexpr (ALIGN_EPI) { if (wr == 0) PG8_BAR; }
        { int l2 = lane_id(); asm volatile("" : "+v"(l2)); const int fr2 = l2 & 15, fq2 = l2 >> 4; E(acc, cur, wr, wc, fr2, fq2); }
        if (!has_next) break;
#pragma unroll
        for (int a = 0; a < 2; ++a)
#pragma unroll
            for (int b = 0; b < 2; ++b)
#pragma unroll
                for (int m = 0; m < 4; ++m)
#pragma unroll
                    for (int n = 0; n < 2; ++n) acc[a][b][m][n] = (f32x4){0.f, 0.f, 0.f, 0.f};
        cur = nxt; cA = nA; cB0 = nB0; cB1 = nB1; cnt = __builtin_amdgcn_readfirstlane(cur.nt); ++ui;
        if constexpr (GATHER) {
#pragma unroll
            for (int _h = 0; _h < 2; ++_h)
#pragma unroll
                for (int _i = 0; _i < 2; ++_i) vgc[_h][_i] = vgn[_h][_i];
        }
        if constexpr (ALIGN_EPI) { if (wr == 1) PG8_BAR; }
    }
    PG8_WAIT_V(0);
    if constexpr (!ALIGN_EPI) { if (wr == 0) PG8_BAR; }
    PG8_BAR;
#undef PG8_SA
#undef PG8_SB
#undef PG8_STAGE
#undef PG8_STAGE_A
#undef PG8_LDA
#undef PG8_LDB
#undef PG8_MMA
#undef PG8_WAIT_V
#undef PG8_WAIT_L
#undef PG8_BAR
#undef PG8_SCHED
#undef PG8_GOFF
}
}

struct Frame {
    LAS unsigned char* lds;
    volatile LAS unsigned* MISC;
    unsigned* ctl;
    unsigned char* ws;
    float* out;
    int wave, G, bid;
};
using pg8::GUnit;

template <class Fill> struct DenseSched {
    int nM, nN, G, c; Fill f;
    __device__ __forceinline__ bool next(int i, GUnit& u) const {
        const long L = (long)i * G + c; if (L >= (long)nM * nN) return false;
        int pm, pn; pg8::tile_order((int)L, nM, nN, pm, pn); u.pm = pm; u.pn = pn; u.rows = nullptr; u.rows_lds = -1; u.aux0 = 0; u.aux1 = 0; f(u); return true;
    }
};
struct FillPlain {
    const char* A; const char* B; unsigned a_rs, b_rs; int nt;
    __device__ __forceinline__ void operator()(GUnit& u) const { u.A = A + (size_t)u.pm * 256 * a_rs; u.B0 = B + (size_t)u.pn * 256 * b_rs; u.B1 = u.B0 + (size_t)128 * b_rs; u.nt = nt; }
};
struct FillQlatPool {
    const char* q; const char* diff; const char* wuk; const char* wpool;
    __device__ __forceinline__ void operator()(GUnit& u) const {
        if (u.pn < 8) { u.A = q + (size_t)u.pm * 256 * 2048 + (size_t)((u.pn & ~1) * 128) * 2; u.B0 = wuk + (size_t)u.pn * 256 * 512; }
        else { const int g = u.pn - 8; u.A = diff + (size_t)u.pm * 256 * 2048 + (size_t)(g * 256) * 2; u.B0 = wpool + (size_t)g * 256 * 512; }
        u.B1 = u.B0 + (size_t)128 * 512; u.nt = 4;
    }
};
struct FillO {
    const char* olat; const char* wuv;
    __device__ __forceinline__ void operator()(GUnit& u) const { u.A = olat + (size_t)u.pm * 256 * 4096 + (size_t)(u.pn * 512) * 2; u.B0 = wuv + (size_t)u.pn * 256 * 1024; u.B1 = u.B0 + (size_t)128 * 1024; u.nt = 8; }
};

#define EPI_LOOP_ROWS for (int ai = 0; ai < 2; ++ai) _Pragma("unroll") for (int m = 0; m < 4; ++m)
__device__ __forceinline__ u32x4 pack8(const f32x4 v0, const f32x4 v1) { u32x4 w; w.x = cvt_pk_bf16(v0[0], v0[1]); w.y = cvt_pk_bf16(v0[2], v0[3]); w.z = cvt_pk_bf16(v1[0], v1[1]); w.w = cvt_pk_bf16(v1[2], v1[3]); return w; }
__device__ __forceinline__ float sigmoidf_(float x) { return 1.0f / (1.0f + __expf(-x)); }

struct EpiP1 {
    bf16* q; bf16* qi; bf16* xp; bf16* gates; float* ckvraw; float* kiwi;
    __device__ __forceinline__ void operator()(const f32x4 (&acc)[2][2][4][2], const GUnit& u, int wr, int wc, int fr, int fq) const {
        const int row0 = u.pm * 256 + wr * 64 + fr, cl = wc * 32 + 8 * fq;
        if (u.pn < 28) {
            bf16* base; int ld, c0; bool sg = false;
            if (u.pn < 4) { base = q; ld = 1024; c0 = u.pn * 256; } else if (u.pn < 8) { base = qi; ld = 1024; c0 = (u.pn - 4) * 256; }
            else if (u.pn < 12) { base = xp; ld = 1024; c0 = (u.pn - 8) * 256; } else { base = gates; ld = 4096; c0 = (u.pn - 12) * 256; sg = true; }
#pragma unroll
            EPI_LOOP_ROWS { bf16* rowp = base + (size_t)(row0 + ai * 128 + m * 16) * ld + c0 + cl;
#pragma unroll
                for (int bj = 0; bj < 2; ++bj) { f32x4 v0 = acc[ai][bj][m][0], v1 = acc[ai][bj][m][1];
                    if (sg) {
#pragma unroll
                        for (int j = 0; j < 4; ++j) { v0[j] = sigmoidf_(v0[j]); v1[j] = sigmoidf_(v1[j]); } }
                    *(u32x4*)(rowp + bj * 128) = pack8(v0, v1); } }
        } else {
            float* base = (u.pn == 28) ? ckvraw : kiwi;
#pragma unroll
            EPI_LOOP_ROWS { float* rowp = base + (size_t)(row0 + ai * 128 + m * 16) * 256 + cl;
#pragma unroll
                for (int bj = 0; bj < 2; ++bj) { *(f32x4*)(rowp + bj * 128) = acc[ai][bj][m][0]; *(f32x4*)(rowp + bj * 128 + 4) = acc[ai][bj][m][1]; } }
        }
    }
};
struct EpiQlatPool {
    bf16* qlat; bf16* pool; const float* colscale;
    __device__ __forceinline__ void operator()(const f32x4 (&acc)[2][2][4][2], const GUnit& u, int wr, int wc, int fr, int fq) const {
        const int row0 = u.pm * 256 + wr * 64 + fr, cl = wc * 32 + 8 * fq;
        const bool ql = u.pn < 8;
        bf16* base = ql ? qlat + u.pn * 256 : pool + (u.pn - 8) * 256; const int ld = ql ? 2048 : 1024;
        const float* sp = colscale + u.pn * 256 + cl;
        __builtin_amdgcn_sched_barrier(0);
        const f32x4 s00 = *(const f32x4*)(sp), s01 = *(const f32x4*)(sp + 4), s10 = *(const f32x4*)(sp + 128), s11 = *(const f32x4*)(sp + 132);
#pragma unroll
        EPI_LOOP_ROWS { bf16* rowp = base + (size_t)(row0 + ai * 128 + m * 16) * ld + cl;
            *(u32x4*)(rowp) = pack8(acc[ai][0][m][0] * s00, acc[ai][0][m][1] * s01);
            *(u32x4*)(rowp + 128) = pack8(acc[ai][1][m][0] * s10, acc[ai][1][m][1] * s11); }
    }
};
struct EpiBf16 {
    bf16* O; int ld;
    __device__ __forceinline__ void operator()(const f32x4 (&acc)[2][2][4][2], const GUnit& u, int wr, int wc, int fr, int fq) const {
        const int row0 = u.pm * 256 + wr * 64 + fr, cl = u.pn * 256 + wc * 32 + 8 * fq;
#pragma unroll
        EPI_LOOP_ROWS { bf16* rowp = O + (size_t)(row0 + ai * 128 + m * 16) * ld + cl;
#pragma unroll
            for (int bj = 0; bj < 2; ++bj) *(u32x4*)(rowp + bj * 128) = pack8(acc[ai][bj][m][0], acc[ai][bj][m][1]); }
    }
};
__device__ __forceinline__ void unpack8(const u32x4 w, f32x4& a, f32x4& b) {
    a[0] = bf2f(w.x & 0xffffu); a[1] = bf2f(w.x >> 16); a[2] = bf2f(w.y & 0xffffu); a[3] = bf2f(w.y >> 16);
    b[0] = bf2f(w.z & 0xffffu); b[1] = bf2f(w.z >> 16); b[2] = bf2f(w.w & 0xffffu); b[3] = bf2f(w.w >> 16);
}
template <int MODE> struct EpiGate {
    const bf16* gates; bf16* M1; bf16* merged;
    __device__ __forceinline__ void operator()(const f32x4 (&acc)[2][2][4][2], const GUnit& u, int wr, int wc, int fr, int fq) const {
        const int row0 = u.pm * 256 + wr * 64 + fr, cl = u.pn * 256 + wc * 32 + 8 * fq;
#pragma unroll
        for (int ai = 0; ai < 2; ++ai) {
            u32x4 gq[4][2], mq[4][2];
#pragma unroll
            for (int m = 0; m < 4; ++m)
#pragma unroll
                for (int bj = 0; bj < 2; ++bj) { const size_t r = (size_t)(row0 + ai * 128 + m * 16); const int c = cl + bj * 128;
                    gq[m][bj] = *(const u32x4*)(gates + r * 4096 + (MODE ? 2048 : 0) + c); if (MODE) mq[m][bj] = *(const u32x4*)(M1 + r * 2048 + c); }
            __builtin_amdgcn_sched_barrier(0);
#pragma unroll
            for (int m = 0; m < 4; ++m)
#pragma unroll
                for (int bj = 0; bj < 2; ++bj) { const size_t r = (size_t)(row0 + ai * 128 + m * 16); const int c = cl + bj * 128;
                    f32x4 g0, g1; unpack8(gq[m][bj], g0, g1);
                    f32x4 v0 = acc[ai][bj][m][0] * g0, v1 = acc[ai][bj][m][1] * g1;
                    if (MODE) { f32x4 p0, p1; unpack8(mq[m][bj], p0, p1); v0 += p0; v1 += p1; *(u32x4*)(merged + r * 2048 + c) = pack8(v0, v1); }
                    else *(u32x4*)(M1 + r * 2048 + c) = pack8(v0, v1); }
            __builtin_amdgcn_sched_barrier(0);
        }
    }
};
struct EpiPre {
    const float* x; float* pre;
    __device__ __forceinline__ void operator()(const f32x4 (&acc)[2][2][4][2], const GUnit& u, int wr, int wc, int fr, int fq) const {
        const int row0 = u.pm * 256 + wr * 64 + fr, cl = u.pn * 256 + wc * 32 + 8 * fq;
#pragma unroll
        for (int ai = 0; ai < 2; ++ai) {
            f32x4 xq[4][2][2];
#pragma unroll
            for (int m = 0; m < 4; ++m)
#pragma unroll
                for (int bj = 0; bj < 2; ++bj) { const size_t o = (size_t)(row0 + ai * 128 + m * 16) * 2048 + cl + bj * 128; xq[m][bj][0] = __builtin_nontemporal_load((const f32x4*)(x + o)); xq[m][bj][1] = __builtin_nontemporal_load((const f32x4*)(x + o + 4)); }
            __builtin_amdgcn_sched_barrier(0);
#pragma unroll
            for (int m = 0; m < 4; ++m)
#pragma unroll
                for (int bj = 0; bj < 2; ++bj) { const size_t o = (size_t)(row0 + ai * 128 + m * 16) * 2048 + cl + bj * 128;
                    *(f32x4*)(pre + o) = xq[m][bj][0] * DN_ALPHA + acc[ai][bj][m][0]; *(f32x4*)(pre + o + 4) = xq[m][bj][1] * DN_ALPHA + acc[ai][bj][m][1]; }
            __builtin_amdgcn_sched_barrier(0);
        }
    }
};
constexpr int MOE_TAB_OFF = 131072, MOE_TAB_UNITS = 32, MOE_ROWS_OFF = 131072 + 512, MOE_ROWS_UNITS = 11;
struct MoeSched {
    const int* mtt; int nmt; int NT; int G, c; bool gateup;
    const char* h; const char* hbuf; const char* wgu; const char* wd; const int* rowlist; LAS unsigned char* lds;
    __device__ __forceinline__ int unit_of(int i) const {
        const int total = nmt * NT;
        if ((G & 7) == 0) { const int x = c & 7, j = i * (G >> 3) + (c >> 3); const int lo = (int)(((long)total * x) >> 3), hi = (int)(((long)total * (x + 1)) >> 3); const int U = lo + j; return U < hi ? U : -1; }
        const long L = (long)i * G + c; return L < total ? (int)L : -1;
    }
    __device__ __forceinline__ void prepare(int tid) const {
        LAS int* tab = (LAS int*)(lds + MOE_TAB_OFF);
        if (tid < MOE_TAB_UNITS) { const int U = unit_of(tid); int g = -1, p0 = 0, nv = 0, nt_ = 0;
            if (U >= 0) { const int MT = U / NT; nt_ = U - MT * NT; g = mtt[MT * 4 + 0]; p0 = mtt[MT * 4 + 1]; nv = mtt[MT * 4 + 2]; }
            tab[tid * 4 + 0] = g; tab[tid * 4 + 1] = p0; tab[tid * 4 + 2] = nv; tab[tid * 4 + 3] = nt_; }
        if (gateup) { LAS int* rw = (LAS int*)(lds + MOE_ROWS_OFF);
            for (int q = tid; q < MOE_ROWS_UNITS * 256; q += NTHR) { const int i = q >> 8, U = unit_of(i); if (U >= 0) { const int MT = U / NT; rw[q] = rowlist[mtt[MT * 4 + 1] + (q & 255)]; } } }
        __syncthreads();
    }
    __device__ __forceinline__ bool next(int i, GUnit& u) const {
        int g, p0, nv, nt_;
        if (i < MOE_TAB_UNITS) { const LAS int* tab = (const LAS int*)(lds + MOE_TAB_OFF); g = __builtin_amdgcn_readfirstlane(tab[i * 4 + 0]); p0 = __builtin_amdgcn_readfirstlane(tab[i * 4 + 1]); nv = __builtin_amdgcn_readfirstlane(tab[i * 4 + 2]); nt_ = __builtin_amdgcn_readfirstlane(tab[i * 4 + 3]); if (g < 0) return false; }
        else { const int U = unit_of(i); if (U < 0) return false; const int MT = U / NT; nt_ = U - MT * NT;
            g = __builtin_amdgcn_readfirstlane(mtt[MT * 4 + 0]); p0 = __builtin_amdgcn_readfirstlane(mtt[MT * 4 + 1]); nv = __builtin_amdgcn_readfirstlane(mtt[MT * 4 + 2]); }
        u.pm = p0; u.pn = nt_; u.aux0 = nv; u.aux1 = g; u.rows_lds = -1;
        if (gateup) { u.A = h; u.rows = rowlist + p0; if (i < MOE_ROWS_UNITS) u.rows_lds = MOE_ROWS_OFF + i * 1024; u.B0 = wgu + ((size_t)g * 1024 + (size_t)nt_ * 256) * 4096; u.B1 = u.B0 + (size_t)128 * 4096; u.nt = 32; }
        else { u.A = hbuf + (size_t)p0 * 1024; u.rows = nullptr; u.B0 = wd + ((size_t)g * 2048 + (size_t)nt_ * 256) * 1024; u.B1 = u.B0 + (size_t)128 * 1024; u.nt = 8; }
        return true;
    }
};
struct EpiSwiGLU {
    bf16* H;
    __device__ __forceinline__ void operator()(const f32x4 (&acc)[2][2][4][2], const GUnit& u, int wr, int wc, int fr, int fq) const {
        const int cl = u.pn * 128 + wc * 32 + 8 * fq;
#pragma unroll
        EPI_LOOP_ROWS { const int r = ai * 128 + wr * 64 + m * 16 + fr;
            if (r < u.aux0) { f32x4 v[2];
#pragma unroll
                for (int n = 0; n < 2; ++n)
#pragma unroll
                    for (int j = 0; j < 4; ++j) { const float g = acc[ai][0][m][n][j], up = acc[ai][1][m][n][j]; v[n][j] = g * sigmoidf_(g) * up; }
                *(u32x4*)(H + (size_t)(u.pm + r) * 512 + cl) = pack8(v[0], v[1]); } }
    }
};
struct EpiY {
    unsigned char* Y8; bf16* Ysh;
    __device__ __forceinline__ void operator()(const f32x4 (&acc)[2][2][4][2], const GUnit& u, int wr, int wc, int fr, int fq) const {
        const int cl = u.pn * 256 + wc * 32 + 8 * fq;
        if (u.aux1 == NE) {
#pragma unroll
            EPI_LOOP_ROWS { const int r = ai * 128 + wr * 64 + m * 16 + fr;
                if (r < u.aux0) { bf16* rowp = Ysh + (size_t)(u.pm - NTOK * 8 + r) * 2048 + cl;
#pragma unroll
                    for (int bj = 0; bj < 2; ++bj) *(u32x4*)(rowp + bj * 128) = pack8(acc[ai][bj][m][0], acc[ai][bj][m][1]); } }
        } else {
#pragma unroll
            for (int ai = 0; ai < 2; ++ai)
#pragma unroll
                for (int mp = 0; mp < 2; ++mp)
#pragma unroll
                    for (int bj = 0; bj < 2; ++bj) {
                        unsigned x[2], y[2];
#pragma unroll
                        for (int q = 0; q < 2; ++q) { const f32x4 v0 = acc[ai][bj][2 * mp + q][0], v1 = acc[ai][bj][2 * mp + q][1];
                            int w0 = __builtin_amdgcn_cvt_pk_fp8_f32(v0[0], v0[1], 0, false); w0 = __builtin_amdgcn_cvt_pk_fp8_f32(v0[2], v0[3], w0, true);
                            int w1 = __builtin_amdgcn_cvt_pk_fp8_f32(v1[0], v1[1], 0, false); w1 = __builtin_amdgcn_cvt_pk_fp8_f32(v1[2], v1[3], w1, true);
                            if (q == 0) { x[0] = (unsigned)w0; x[1] = (unsigned)w1; } else { y[0] = (unsigned)w0; y[1] = (unsigned)w1; } }
                        const u32x2 s0 = __builtin_amdgcn_permlane16_swap(x[0], y[0], false, false), s1 = __builtin_amdgcn_permlane16_swap(x[1], y[1], false, false);
                        const unsigned nx0 = s0[0], ny0 = s0[1], nx1 = s1[0], ny1 = s1[1];
                        const int m = 2 * mp + (fq & 1), r = ai * 128 + wr * 64 + m * 16 + fr;
                        if (r < u.aux0) { u32x4 o; o.x = nx0; o.y = nx1; o.z = ny0; o.w = ny1;
                            *(u32x4*)(Y8 + (size_t)(u.pm + r) * 2048 + u.pn * 256 + bj * 128 + wc * 32 + 16 * (fq >> 1)) = o; }
                    }
        }
    }
};

template <class RowMap>
__device__ __forceinline__ void tr_item(const float* W, int ldw, int nvalid, bf16* WT, int ldT, LAS float* scr, int kb, int nb, int lane, const RowMap& rm, const int ztwin = 0) {
    const int k0 = 64 * kb, n0 = 32 * nb;
    const int c4 = 4 * (lane & 7), kr = lane >> 3;
    f32x4 v[8];
#pragma unroll
    for (int i = 0; i < 8; ++i) { v[i] = (f32x4){0.f, 0.f, 0.f, 0.f}; if (n0 + c4 < nvalid) v[i] = __builtin_nontemporal_load((const f32x4*)(W + (size_t)(k0 + 8 * i + kr) * ldw + n0 + c4)); }
#pragma unroll
    for (int i = 0; i < 8; ++i) { LAS float* d = scr + (8 * i + kr) * 33 + c4; d[0] = v[i][0]; d[1] = v[i][1]; d[2] = v[i][2]; d[3] = v[i][3]; }
    LDS_WAIT(); asm volatile("" ::: "memory");
    const int c = lane & 7;
#pragma unroll
    for (int j = 0; j < 4; ++j) { const int nl = (lane >> 3) + 8 * j; const LAS float* s = scr + (8 * c) * 33 + nl;
        u32x4 o; o.x = cvt_pk_bf16(s[0 * 33], s[1 * 33]); o.y = cvt_pk_bf16(s[2 * 33], s[3 * 33]); o.z = cvt_pk_bf16(s[4 * 33], s[5 * 33]); o.w = cvt_pk_bf16(s[6 * 33], s[7 * 33]);
        if (n0 + nl < nvalid) { *(u32x4*)(WT + (size_t)rm(n0 + nl) * ldT + k0 + 8 * c) = o; if (ztwin) *(u32x4*)(WT + (size_t)rm(n0 + nl) * ldT + k0 + 8 * c + ztwin) = (u32x4){0u, 0u, 0u, 0u}; } }
    LDS_WAIT(); asm volatile("" ::: "memory");
}
struct MapId { int off; __device__ __forceinline__ int operator()(int n) const { return off + n; } };
struct MapWin {
    __device__ __forceinline__ int operator()(int n) const {
        if (n < 1024) return n;
        if (n < 1280) return 7168 + (n - 1024);
        if (n < 2304) return 1024 + (n - 1280);
        if (n < 2368) return 7424 + (n - 2304);
        if (n < 2384) return 7488 + (n - 2368);
        if (n < 3408) return 2048 + (n - 2384);
        return 3072 + (n - 3408);
    }
};
struct MapGU { int up; __device__ __forceinline__ int operator()(int f) const { return (f >> 7) * 256 + up * 128 + (f & 127); } };

__device__ __forceinline__ void phase_convert_small(Frame& F, const float* x, const float* w_in, const float* w_uk, const float* w_uv, const float* w_pool, const float* w_pa, const float* w_pp, const float* w_out, const float* pscale, const float* w_router) {
    const int lane_ = lane_id(), tid_ = F.wave * 64 + lane_;
    { float* wt = (float*)(F.ws + WS_WRT); for (size_t i = (size_t)F.bid * NTHR + tid_; i < (size_t)64 * 2048; i += (size_t)F.G * NTHR) { const int e = (int)(i >> 11), d = (int)(i & 2047); wt[i] = w_router[(size_t)d * 64 + e]; } }
    { float* cs = (float*)(F.ws + WS_CSCALE); for (size_t i = (size_t)F.bid * NTHR + tid_; i < 3072; i += (size_t)F.G * NTHR) cs[i] = (i < 2048) ? 1.0f : pscale[i - 2048]; }
    bf16* xb = (bf16*)(F.ws + WS_XB);
    const size_t gt = (size_t)F.bid * NTHR + tid_, nth = (size_t)F.G * NTHR;
    for (size_t i0 = gt; i0 < (size_t)NTOK * DM / 8; i0 += 4 * nth) {
        f32x4 a[4], b[4];
#pragma unroll
        for (int q = 0; q < 4; ++q) { const size_t i = i0 + q * nth; a[q] = __builtin_nontemporal_load((const f32x4*)x + 2 * i); b[q] = __builtin_nontemporal_load((const f32x4*)x + 2 * i + 1); }
        __builtin_amdgcn_sched_barrier(0);
#pragma unroll
        for (int q = 0; q < 4; ++q) { const size_t i = i0 + q * nth; u32x4 o; o.x = cvt_pk_bf16(a[q][0], a[q][1]); o.y = cvt_pk_bf16(a[q][2], a[q][3]); o.z = cvt_pk_bf16(b[q][0], b[q][1]); o.w = cvt_pk_bf16(b[q][2], b[q][3]); ((u32x4*)xb)[i] = o; }
    }
    LAS float* scr = (LAS float*)(F.lds + F.wave * 8704);
    const int gw = F.bid * NWAVES + F.wave, NGW = F.G * NWAVES;
    constexpr int I_IN = 32 * 235, I_POOL = 4 * 4 * 8, I_PA = 16 * 64, I_PP = 16 * 64, I_OUT = 32 * 64;
    constexpr int I_UV = 8 * 16;
    constexpr int NIT = I_IN + I_POOL + I_PA + I_PP + I_OUT + I_UV;
    for (int it = gw; it < NIT; it += NGW) {
        int r = it;
        if (r < I_IN) { tr_item(w_in, 7504, 7504, (bf16*)(F.ws + WS_WIN), 2048, scr, r / 235, r % 235, lane_, MapWin{}); continue; } r -= I_IN;
        if (r < I_POOL) { const int g = r / 32, q = r % 32; tr_item(w_pool + (size_t)g * 65536, 256, 256, (bf16*)(F.ws + WS_WPOOL) + (size_t)g * 65536, 256, scr, q / 8, q % 8, lane_, MapId{0}); continue; } r -= I_POOL;
        if (r < I_PA) { tr_item(w_pa, 2048, 2048, (bf16*)(F.ws + WS_WPA), 1024, scr, r / 64, r % 64, lane_, MapId{0}); continue; } r -= I_PA;
        if (r < I_PP) { tr_item(w_pp, 2048, 2048, (bf16*)(F.ws + WS_WPP), 1024, scr, r / 64, r % 64, lane_, MapId{0}); continue; } r -= I_PP;
        if (r < I_OUT) { tr_item(w_out, 2048, 2048, (bf16*)(F.ws + WS_WOUT), 2048, scr, r / 64, r % 64, lane_, MapId{0}); continue; } r -= I_OUT;
        {
          const int h = r / 16, q = r % 16, pn = h >> 1, hh = h & 1;
          tr_item(w_uv + h * 128, 1024, 128, (bf16*)(F.ws + WS_WUV) + (size_t)(pn * 256 + hh * 128) * 512 + hh * 256, 512, scr, q / 4, q % 4, lane_, MapId{0}, hh ? -256 : 256); }
    }
    { bf16* wp = (bf16*)(F.ws + WS_WIN) + (size_t)7504 * 2048; for (size_t i = gt; i < (size_t)176 * 2048 / 8; i += nth) ((u32x4*)wp)[i] = (u32x4){0u, 0u, 0u, 0u}; }
    { const float* wuk = w_uk; bf16* o = (bf16*)(F.ws + WS_WUK);
      for (size_t i = gt; i < (size_t)2048 * 256; i += nth) { const int kp = (int)(i & 255), row = (int)(i >> 8), h = row >> 8, r = row & 255;
          o[i] = ((kp >> 7) == (h & 1)) ? (bf16)f2bf(wuk[(size_t)r * 1024 + h * 128 + (kp & 127)]) : (bf16)0; } }
}

struct ExpW { const float* wge; const float* wue; const float* wde; const float* wgs; const float* wus; const float* wds; };
struct CvItem { const float* src; bf16* dst; int ldw, ldT, kind; };
__device__ __forceinline__ void cv_decode(Frame& F, const ExpW& W, const int it, const float*& src, int& ldw, bf16*& dst, int& ldT, int& kind, int& n0) {
    constexpr int PER = 1536;
    const int g = it / PER; int r = it - g * PER;
    if (r < 1024) { kind = r >> 9; r &= 511; const int kb = r >> 4, nb = r & 15; n0 = 32 * nb; ldw = 512; ldT = 2048;
        const float* wsrc = (g < NE) ? (kind ? W.wue : W.wge) + (size_t)g * 2048 * 512 : (kind ? W.wus : W.wgs);
        src = wsrc + (size_t)(64 * kb) * 512 + n0; dst = (bf16*)(F.ws + WS_WGU) + (size_t)g * 1024 * 2048 + 64 * kb; }
    else { kind = 2; r -= 1024; const int kb = r >> 6, nb = r & 63; n0 = 32 * nb; ldw = 2048; ldT = 512;
        const float* wsrc = (g < NE) ? W.wde + (size_t)g * 512 * 2048 : W.wds;
        src = wsrc + (size_t)(64 * kb) * 2048 + n0; dst = (bf16*)(F.ws + WS_WD) + (size_t)g * 2048 * 512 + 64 * kb; }
}
__device__ __forceinline__ void cv_load(f32x4 (&v)[8], const float* src, const int ldw, const int lane) {
    const int c4 = 4 * (lane & 7), kr = lane >> 3;
#pragma unroll
    for (int i = 0; i < 8; ++i) v[i] = __builtin_nontemporal_load((const f32x4*)(src + (size_t)(8 * i + kr) * ldw + c4));
}
__device__ __forceinline__ void cv_finish(const f32x4 (&v)[8], bf16* dst, const int ldT, const int kind, const int n0, LAS float* scr, const int lane) {
    const int c4 = 4 * (lane & 7), kr = lane >> 3;
#pragma unroll
    for (int i = 0; i < 8; ++i) { LAS float* d = scr + (8 * i + kr) * 33 + c4; d[0] = v[i][0]; d[1] = v[i][1]; d[2] = v[i][2]; d[3] = v[i][3]; }
    LDS_WAIT(); asm volatile("" ::: "memory");
    const int c = lane & 7;
#pragma unroll
    for (int j = 0; j < 4; ++j) { const int nl = (lane >> 3) + 8 * j; const LAS float* s = scr + (8 * c) * 33 + nl;
        u32x4 o; o.x = cvt_pk_bf16(s[0 * 33], s[1 * 33]); o.y = cvt_pk_bf16(s[2 * 33], s[3 * 33]); o.z = cvt_pk_bf16(s[4 * 33], s[5 * 33]); o.w = cvt_pk_bf16(s[6 * 33], s[7 * 33]);
        const int n = n0 + nl; const int row = (kind == 2) ? n : (n >> 7) * 256 + kind * 128 + (n & 127);
        *(u32x4*)(dst + (size_t)row * ldT + 8 * c) = o; }
    LDS_WAIT(); asm volatile("" ::: "memory");
}
template <int BATCH>
__device__ __forceinline__ bool convert_batch(Frame& F, const ExpW& W, LAS float* scr, const int lane_) {
    constexpr int NIT = NGRP * 1536;
    int base = 0;
    if (lane_ == 0) base = (int)__hip_atomic_fetch_add(F.ctl + CW_CVQ, (unsigned)BATCH, RLX_AGENT);
    base = __builtin_amdgcn_readfirstlane(base);
    if (base >= NIT) return false;
    const int end = (base + BATCH < NIT) ? base + BATCH : NIT;
    const float* src; bf16* dst; int ldw, ldT, kind, n0;
    cv_decode(F, W, base, src, ldw, dst, ldT, kind, n0);
    f32x4 va[8], vb[8];
    cv_load(va, src, ldw, lane_);
    for (int it = base; it < end; it += 2) {
        const float* src2 = src; bf16* dst2 = dst; int ldw2 = ldw, ldT2 = ldT, kind2 = kind, n02 = n0;
        if (it + 1 < end) { cv_decode(F, W, it + 1, src2, ldw2, dst2, ldT2, kind2, n02); cv_load(vb, src2, ldw2, lane_); }
        __builtin_amdgcn_sched_barrier(0);
        cv_finish(va, dst, ldT, kind, n0, scr, lane_);
        if (it + 1 < end) {
            if (it + 2 < end) { cv_decode(F, W, it + 2, src, ldw, dst, ldT, kind, n0); cv_load(va, src, ldw, lane_); }
            __builtin_amdgcn_sched_barrier(0);
            cv_finish(vb, dst2, ldT2, kind2, n02, scr, lane_);
        }
    }
    return true;
}
__device__ __forceinline__ void phase_convert_experts(Frame& F, const ExpW& W) {
    const int lane_ = lane_id();
    LAS float* scr = (LAS float*)(F.lds + 32768 + F.wave * 8704);
    while (convert_batch<8>(F, W, scr, lane_)) {}
}

__device__ __forceinline__ void phase_postproc(Frame& F, const float* cg, const float* kg, const float* kb) {
    const int lane_ = lane_id(), tid_ = F.wave * 64 + lane_;
    const float* ckvraw = (const float*)(F.ws + WS_CKVRAW); const float* kiwi = (const float*)(F.ws + WS_KIWI);
    unsigned* ckvn = (unsigned*)(F.ws + WS_CKVN); bf16* kin = (bf16*)(F.ws + WS_KIN); float* wis = (float*)(F.ws + WS_WI);
    const int gw = F.bid * NWAVES + F.wave, NGW = F.G * NWAVES, lane = lane_;
    const f32x4 g4 = *(const f32x4*)(cg + lane * 4); const float kgl = kg[lane], kbl = kb[lane];
    for (int t0 = gw; t0 < NTOK; t0 += 4 * NGW) {
        f32x4 v[4]; float kv[4], wv[4];
#pragma unroll
        for (int q = 0; q < 4; ++q) { const int t = t0 + q * NGW; v[q] = (f32x4){0.f, 0.f, 0.f, 0.f}; kv[q] = 0.f; wv[q] = 0.f;
            if (t < NTOK) { v[q] = *(const f32x4*)(ckvraw + (size_t)t * 256 + lane * 4); kv[q] = kiwi[(size_t)t * 256 + lane]; wv[q] = kiwi[(size_t)t * 256 + 64 + (lane & 15)]; } }
#pragma unroll
        for (int q = 0; q < 4; ++q) { const int t = t0 + q * NGW;
            const float ss = wave_sum(v[q][0] * v[q][0] + v[q][1] * v[q][1] + v[q][2] * v[q][2] + v[q][3] * v[q][3]);
            const float rs = 1.0f / sqrtf(ss * (1.0f / 256.0f) + RMS_EPS);
            int o8 = __builtin_amdgcn_cvt_pk_fp8_f32(v[q][0] * rs * g4[0], v[q][1] * rs * g4[1], 0, false);
            o8 = __builtin_amdgcn_cvt_pk_fp8_f32(v[q][2] * rs * g4[2], v[q][3] * rs * g4[3], o8, true);
            const float mu = wave_sum(kv[q]) * (1.0f / 64.0f); const float dlt = kv[q] - mu;
            const float var = wave_sum(dlt * dlt) * (1.0f / 64.0f);
            const float y = dlt * (1.0f / sqrtf(var + LN_EPS)) * kgl + kbl;
            if (t < NTOK) { ckvn[(size_t)t * 64 + lane] = (unsigned)o8; kin[(size_t)t * 64 + lane] = (bf16)f2bf(y); if (lane < 16) wis[(size_t)t * 16 + lane] = wv[q] * 0.03125f; } }
    }
    const bf16* xp = (const bf16*)(F.ws + WS_XP); bf16* diff = (bf16*)(F.ws + WS_DIFF);
    const size_t gt = (size_t)F.bid * NTHR + tid_, nth = (size_t)F.G * NTHR;
    for (size_t i = gt; i < (size_t)(NTOK / 16) * 128; i += nth) {
        const int run = (int)(i >> 7), cgp = (int)(i & 127), g = cgp >> 5, win = 2 << g, tb = run * 16, posb = tb & (SEQ - 1);
        const bf16* col = xp + cgp * 8;
        u32x4 rw[31];
#pragma unroll
        for (int j = 0; j < 31; ++j) { const int dr = j - 15; rw[j] = (u32x4){0u, 0u, 0u, 0u}; if (dr >= 1 - win && posb + dr >= 0) rw[j] = *(const u32x4*)(col + (size_t)(tb + dr) * 1024); }
        __builtin_amdgcn_sched_barrier(0);
        f32x4 s0 = {0.f, 0.f, 0.f, 0.f}, s1 = {0.f, 0.f, 0.f, 0.f};
#pragma unroll
        for (int j = 1; j < 16; ++j) { if (j < win) { f32x4 a, b; unpack8(rw[15 - j], a, b); s0 += a; s1 += b; } }
#pragma unroll
        for (int q = 0; q < 16; ++q) { const int t = tb + q, pos = posb + q;
            f32x4 a, b; unpack8(rw[15 + q], a, b); s0 += a; s1 += b;
            const int cntw = (pos + 1 < win) ? pos + 1 : win; const float inv = 1.0f / (float)cntw;
            *(u32x4*)(diff + (size_t)t * 1024 + cgp * 8) = pack8(s0 * inv - a, s1 * inv - b);
            f32x4 c, d; const u32x4 r2 = rw[15 + q - 1], r4 = rw[15 + q - 3], r8 = rw[15 + q - 7], r16 = rw[15 + q - 15];
            const u32x4 rr = (win == 2) ? r2 : (win == 4) ? r4 : (win == 8) ? r8 : r16;
            unpack8(rr, c, d); s0 -= c; s1 -= d; }
    }
}

__device__ __forceinline__ size_t score_rowbase(int b, int p) { const int jq = p >> 7; return (size_t)b * SC_TOT + (size_t)16384 * (size_t)(jq * (jq + 1) / 2) + (size_t)(p & 127) * (size_t)(128 * (jq + 1)); }

__device__ __forceinline__ void phase_index_scores(Frame& F) {
    const int lane_ = lane_id(), tid_ = F.wave * 64 + lane_;
    const bf16* qi = (const bf16*)(F.ws + WS_QI); const bf16* kin = (const bf16*)(F.ws + WS_KIN); const float* wis = (const float*)(F.ws + WS_WI);
    _Float16* scores = (_Float16*)(F.ws + WS_SCORES);
    const int lane = lane_, w = F.wave, fq = lane >> 4, j16 = lane & 15, tid = tid_;
    constexpr int NQ = 4;
    LAS unsigned char* kb = F.lds;
    const int sR = tid >> 3, sc = tid & 7, sP = (sR & 3) * 16 + (sR >> 2);
    const int st_off = sP * 128 + ((sc ^ ((sP >> 1) & 7)) * 16);
    for (int it = 0;; ++it) {
        const int jj = (it >> 1) * F.G + F.bid; if (jj >= 256) break;
        const int s = (it & 1) ? 511 - jj : jj;
        const int b = s & 1, qg = s >> 1, tq0 = qg * 32;
        const int nk64 = (tq0 + 32 + 63) / 64, nsteps = (nk64 + NQ - 1) / NQ;
        bf16x8 Af[4][2];
        { const size_t tok = (size_t)b * SEQ + tq0 + 4 * w + (j16 >> 2);
#pragma unroll
          for (int g = 0; g < 4; ++g)
#pragma unroll
              for (int ks = 0; ks < 2; ++ks) Af[g][ks] = *(const bf16x8*)(qi + tok * 1024 + (4 * g + (j16 & 3)) * 64 + ks * 32 + 8 * fq); }
        f32x4 wv[4];
        { const size_t tok = (size_t)b * SEQ + tq0 + 4 * w + fq;
#pragma unroll
          for (int g = 0; g < 4; ++g) wv[g] = *(const f32x4*)(wis + tok * 16 + 4 * g); }
        _Float16* orow = scores + score_rowbase(b, tq0 + 4 * w + fq);
        const bf16* kbase = kin + (size_t)b * SEQ * 64 + (size_t)sR * 64 + sc * 8;
        u32x4 stg[NQ];
#pragma unroll
        for (int q = 0; q < NQ; ++q) { const int h = (q < nk64) ? q : nk64 - 1; stg[q] = *(const u32x4*)(kbase + (size_t)h * 4096); }
        __syncthreads();
#pragma unroll
        for (int q = 0; q < NQ; ++q) *(LAS u32x4*)(kb + q * 8192 + st_off) = stg[q];
        __syncthreads();
        for (int step = 0; step < nsteps; ++step) {
            const int cur = step & 1;
            if (step + 1 < nsteps) {
#pragma unroll
                for (int q = 0; q < NQ; ++q) { int h = NQ * (step + 1) + q; h = (h < nk64) ? h : nk64 - 1; stg[q] = *(const u32x4*)(kbase + (size_t)h * 4096); } }
#pragma unroll
            for (int hh = 0; hh < NQ; ++hh) {
                f32x4 res;
#pragma unroll
                for (int u = 0; u < 4; ++u) {
                    const int P = u * 16 + j16;
                    f32x4 a4[4];
#pragma unroll
                    for (int g = 0; g < 4; ++g) a4[g] = (f32x4){0.f, 0.f, 0.f, 0.f};
#pragma unroll
                    for (int ks = 0; ks < 2; ++ks) {
                        const bf16x8 bfr = *(const LAS bf16x8*)(kb + cur * (NQ * 8192) + hh * 8192 + P * 128 + (((fq + 4 * ks) ^ ((P >> 1) & 7)) * 16));
#pragma unroll
                        for (int g = 0; g < 4; ++g) a4[g] = __builtin_amdgcn_mfma_f32_16x16x32_bf16(Af[g][ks], bfr, a4[g], 0, 0, 0);
                    }
                    float sres = 0.f;
#pragma unroll
                    for (int g = 0; g < 4; ++g)
#pragma unroll
                        for (int r = 0; r < 4; ++r) { const float xf = a4[g][r]; const int xb = __float_as_int(xf); const float rl = __int_as_float(xb > 0 ? xb : 0), wg = wv[g][r]; asm("v_fmac_f32 %0, %1, %2" : "+v"(sres) : "v"(wg), "v"(rl)); }
                    res[u] = sres;
                }
                const int hg = NQ * step + hh;
                if (hg < nk64) { typedef __fp16 h2 __attribute__((ext_vector_type(2))); const h2 lo = __builtin_amdgcn_cvt_pkrtz(res[0], res[1]), hi = __builtin_amdgcn_cvt_pkrtz(res[2], res[3]);
                    u32x2 o; o.x = __builtin_bit_cast(unsigned, lo); o.y = __builtin_bit_cast(unsigned, hi); *(u32x2*)(orow + hg * 64 + 4 * j16) = o; }
            }
            if (step + 1 < nsteps) {
#pragma unroll
                for (int q = 0; q < NQ; ++q) *(LAS u32x4*)(kb + (cur ^ 1) * (NQ * 8192) + q * 8192 + st_off) = stg[q]; }
            __syncthreads();
        }
    }
}

__device__ __forceinline__ unsigned fkey(float f) { const unsigned u = __float_as_uint(f); return (u & 0x80000000u) ? ~u : (u | 0x80000000u); }

__device__ __forceinline__ f32x4 h4_to_f4(const u32x2 q) { typedef _Float16 h2 __attribute__((ext_vector_type(2))); const unsigned qx = q.x, qy = q.y;
    const h2 a = __builtin_bit_cast(h2, qx), b = __builtin_bit_cast(h2, qy); const _Float16 a0 = a[0], a1 = a[1], b0 = b[0], b1 = b[1]; return (f32x4){(float)a0, (float)a1, (float)b0, (float)b1}; }
template <int NV>
__device__ __forceinline__ void select_row(const _Float16* row, int n, unsigned short* sel, int lane) {
    unsigned u[NV][4];
#pragma unroll
    for (int i = 0; i < NV; ++i) {
        const int base = i * 256 + lane * 4;
        f32x4 v = {0.f, 0.f, 0.f, 0.f};
        if (base < n) v = h4_to_f4(*(const u32x2*)(row + base));
#pragma unroll
        for (int e = 0; e < 4; ++e) u[i][e] = (base + e < n) ? fkey(v[e]) : 0u;
    }
    unsigned T = 0u; int cntT = n;
    bool exact = false;
    for (int bit = 31; bit >= 0; --bit) {
        const unsigned cand = T | (1u << bit);
        int c = 0;
#pragma unroll
        for (int i = 0; i < NV; ++i)
#pragma unroll
            for (int e = 0; e < 4; ++e) c += (u[i][e] >= cand) ? 1 : 0;
        c = wave_sum_i(c);
        if (c >= TOPK) { T = cand; cntT = c; if (c == TOPK) { exact = true; break; } }
    }
    int cgt = 0;
    if (!exact) {
#pragma unroll
        for (int i = 0; i < NV; ++i)
#pragma unroll
            for (int e = 0; e < 4; ++e) cgt += (u[i][e] > T) ? 1 : 0;
        cgt = wave_sum_i(cgt);
    }
    int pg = 0, pe = exact ? 0 : cgt;
    const unsigned long long lt = (1ull << lane) - 1ull;
#pragma unroll
    for (int i = 0; i < NV; ++i)
#pragma unroll
        for (int e = 0; e < 4; ++e) {
            const unsigned val = u[i][e]; const int idx = i * 256 + lane * 4 + e;
            const bool gsel = exact ? (val >= T) : (val > T);
            const unsigned long long mg = __ballot(gsel);
            if (gsel) sel[pg + __popcll(mg & lt)] = (unsigned short)idx;
            pg += __popcll(mg);
            if (!exact) {
                const bool esel = (val == T);
                const unsigned long long me = __ballot(esel);
                const int pos = pe + __popcll(me & lt);
                if (esel && pos < TOPK) sel[pos] = (unsigned short)idx;
                pe += __popcll(me);
            }
        }
}

template <int NV>
__device__ __forceinline__ bool select_row_hist(const _Float16* row, int n, unsigned short* sel, int lane, LAS unsigned* hist) {
    LAS unsigned* cnts = hist + 4097;
    LAS unsigned* tiel = hist + 4100;
    unsigned u[NV][4];
#pragma unroll
    for (int i = 0; i < NV; ++i) { const int base = i * 256 + lane * 4; u32x2 rq = {0u, 0u}; if (base < n) rq = *(const u32x2*)(row + base); const f32x4 t4 = h4_to_f4(rq); u[i][0] = __float_as_uint(t4[0]); u[i][1] = __float_as_uint(t4[1]); u[i][2] = __float_as_uint(t4[2]); u[i][3] = __float_as_uint(t4[3]); }
#pragma unroll
    for (int q = 0; q < 17; ++q) { const int w = q * 256 + lane * 4; if (w < 4104) *(LAS u32x4*)(hist + w) = (u32x4){0u, 0u, 0u, 0u}; }
    const float v00 = __uint_as_float(u[0][0]);
    float mn = v00, mx = v00;
#define SR_MM(i_, MASKED) do { _Pragma("unroll") for (int e = 0; e < 4; ++e) { float x = __uint_as_float(u[i_][e]); if (MASKED) x = ((i_) * 256 + lane * 4 + e < n) ? x : v00; mn = fminf(mn, x); mx = fmaxf(mx, x); } } while (0)
#pragma unroll
    for (int i = 0; i < NV; ++i) {
        if (i < NV - 8) SR_MM(i, false);
        else { const int rem = n - i * 256; if (rem >= 256) SR_MM(i, false); else if (rem > 0) SR_MM(i, true); }
    }
#undef SR_MM
    mn = wave_min(mn); mx = wave_max(mx);
    if (!(mx > mn)) {
#pragma unroll
        for (int q = 0; q < 4; ++q) sel[q * 64 + lane] = (unsigned short)(q * 64 + lane);
        return true;
    }
    const float scale = 4095.5f / (mx - mn), off = -mn * scale;
#define SR_KEY(i_, MASKED) do { _Pragma("unroll") for (int e = 0; e < 4; ++e) { unsigned k = (unsigned)fmaf(__uint_as_float(u[i_][e]), scale, off); k = k > 4095u ? 4095u : k; \
        if (MASKED) k = ((i_) * 256 + lane * 4 + e < n) ? k : 4096u; u[i_][e] = k; __hip_atomic_fetch_add(hist + k, 1u, __ATOMIC_RELAXED, __HIP_MEMORY_SCOPE_WORKGROUP); } } while (0)
#pragma unroll
    for (int i = 0; i < NV; ++i) {
        if (i < NV - 8) SR_KEY(i, false);
        else { const int rem = n - i * 256; if (rem >= 256) SR_KEY(i, false); else if (rem > 0) SR_KEY(i, true); else { u[i][0] = 4096u; u[i][1] = 4096u; u[i][2] = 4096u; u[i][3] = 4096u; } }
    }
#undef SR_KEY
    LDS_WAIT();
    unsigned sl = 0;
#pragma unroll
    for (int q = 0; q < 16; ++q) { const u32x4 t4 = *(const LAS u32x4*)(hist + 64 * lane + 4 * q); sl += (t4[0] + t4[1]) + (t4[2] + t4[3]); }
    const unsigned pre = (unsigned)wave_scan_i((int)sl);
    const unsigned total = (unsigned)__builtin_amdgcn_readlane((int)pre, 63), above = total - pre;
    const bool mine = (above < (unsigned)TOPK) && (above + sl >= (unsigned)TOPK);
    const int src = __builtin_amdgcn_readfirstlane(__ffsll((unsigned long long)__ballot(mine)) - 1);
    const unsigned above_src = (unsigned)__builtin_amdgcn_readlane((int)above, src);
    const unsigned hj = hist[64 * src + lane];
    const unsigned pj = (unsigned)wave_scan_i((int)hj);
    const unsigned cj = above_src + ((unsigned)__builtin_amdgcn_readlane((int)pj, 63) - pj);
    const bool hit = (cj < (unsigned)TOPK) && (cj + hj >= (unsigned)TOPK);
    const int hl = __builtin_amdgcn_readfirstlane(__ffsll((unsigned long long)__ballot(hit)) - 1);
    const unsigned bstar = (unsigned)(64 * src + hl), cgt = (unsigned)__builtin_amdgcn_readlane((int)cj, hl), mt = (unsigned)__builtin_amdgcn_readlane((int)hj, hl);
    int pg = 0; const unsigned span = 4095u - bstar;
#pragma unroll
    for (int i = 0; i < NV; ++i)
#pragma unroll
        for (int e = 0; e < 4; ++e) { const unsigned k = u[i][e]; const int idx = i * 256 + lane * 4 + e;
            const bool gsel = (k - bstar - 1u) < span;
            const unsigned long long mg = __ballot(gsel);
            if (mg) { if (gsel) sel[pg + (int)__builtin_amdgcn_mbcnt_hi((unsigned)(mg >> 32), __builtin_amdgcn_mbcnt_lo((unsigned)mg, 0u))] = (unsigned short)idx; pg += __popcll(mg); }
            if (k == bstar) { const unsigned p = __hip_atomic_fetch_add(cnts + 1, 1u, __ATOMIC_RELAXED, __HIP_MEMORY_SCOPE_WORKGROUP); if (p < 64u) tiel[p] = (unsigned)idx; } }
    LDS_WAIT();
    const int need = TOPK - (int)cgt;
    if (mt <= 64u) {
        int idx = 0x7fffffff; float val = -INFINITY;
        if (lane < (int)mt) { idx = (int)tiel[lane]; val = (float)row[idx]; }
        int rk = 0;
        for (int j = 0; j < (int)mt; ++j) { const float o = __shfl(val, j); const int oi = __shfl(idx, j); rk += (o > val || (o == val && oi < idx)) ? 1 : 0; }
        if (lane < (int)mt && rk < need) sel[cgt + rk] = (unsigned short)idx;
        return true;
    }
    return false;
}

__device__ __forceinline__ void phase_select(Frame& F, const ExpW& W, const bool ride) {
    const int lane = lane_id();
    LAS unsigned* hist = (LAS unsigned*)(F.lds + F.wave * 17408);
    const _Float16* scores = (const _Float16*)(F.ws + WS_SCORES);
    unsigned short* selb = (unsigned short*)(F.ws + WS_SEL);
    const int gw = F.bid * NWAVES + F.wave, NGW = F.G * NWAVES;
    for (int it = 0;; ++it) {
        const int jj = (it >> 1) * NGW + gw; if (jj >= NTOK / 2) break;
        const int s = (it & 1) ? NTOK - 1 - jj : jj;
        const int b = s & 1, p = s >> 1, n = p + 1;
        unsigned short* sel = selb + ((size_t)b * SEQ + p) * TOPK;
        if (n <= TOPK) {
#pragma unroll
            for (int q = 0; q < 4; ++q) { const int i = q * 64 + lane; sel[i] = (i < n) ? (unsigned short)i : (unsigned short)0xFFFFu; }
        } else {
            const _Float16* row = scores + score_rowbase(b, p);
            bool ok;
            if (n <= 2048) ok = select_row_hist<8>(row, n, sel, lane, hist);
            else if (n <= 4096) ok = select_row_hist<16>(row, n, sel, lane, hist);
            else if (n <= 6144) ok = select_row_hist<24>(row, n, sel, lane, hist);
            else ok = select_row_hist<32>(row, n, sel, lane, hist);
            asm volatile("" ::: "memory");
            if (!ok) select_row<32>(row, n, sel, lane);
        }
    }
}

typedef int v2i_t __attribute__((ext_vector_type(2)));
__device__ __forceinline__ long mk_long(const unsigned lo, const unsigned hi) { return (long)(((unsigned long long)hi << 32) | lo); }
__device__ __forceinline__ void phase_sparse_attn(Frame& F, const ExpW& W, const bool ride) {
    const int lane = lane_id();
    const bf16* qlat = (const bf16*)(F.ws + WS_QLAT); const unsigned char* ckv8 = (const unsigned char*)(F.ws + WS_CKVN);
    const unsigned short* selb = (const unsigned short*)(F.ws + WS_SEL); bf16* olat = (bf16*)(F.ws + WS_OLAT);
    const int fq = lane >> 4, j16 = lane & 15;
    LAS unsigned char* cb = F.lds + F.wave * 9216;
    LAS unsigned short* ksel = (LAS unsigned short*)(cb + 8704);
    const float sl2 = 0.08838834764831845f * 1.4426950408889634f;
    const int xh = (F.G % 8 == 0) ? ((F.bid & 7) >> 2) : 0, nsplit = (F.G % 8 == 0) ? 2 : 1;
    const int wloc = (F.G % 8 == 0) ? (((F.bid >> 3) * 4 + (F.bid & 3)) * NWAVES + F.wave) : (F.bid * NWAVES + F.wave);
    const int nwl = (F.G % 8 == 0) ? (F.G / 2) * NWAVES : F.G * NWAVES;
    const int ntk = NTOK / nsplit;
    const int qk_off = (2 * j16) * 272 + 8 * fq;
    const int tq = j16 >> 1, tp = j16 & 1;
    const int tr_off = ((tq < 4) ? 2 * (4 * fq + tq) : 2 * (4 * fq + tq - 4) + 1) * 272 + 8 * tp;
    for (int tl = wloc; tl < ntk; tl += nwl) {
        const int t = xh * ntk + tl, b = t / SEQ, pos = t % SEQ;
        const int nvalid = (pos + 1 < TOPK) ? pos + 1 : TOPK;
        const bool fullk = (nvalid == TOPK);
        const unsigned short* sel = selb + (size_t)t * TOPK;
        const u32x2 sv = __builtin_nontemporal_load((const u32x2*)(sel + 4 * lane));
        long Qf[8];
#pragma unroll
        for (int ks = 0; ks < 8; ++ks) { u32x4 z = {0u, 0u, 0u, 0u}; if (j16 < 8) z = __builtin_nontemporal_load((const u32x4*)(qlat + ((size_t)t * 8 + j16) * 256 + ks * 32 + 8 * fq));
            const unsigned z0 = z[0], z1 = z[1], z2 = z[2], z3 = z[3];
            int w0 = __builtin_amdgcn_cvt_pk_fp8_f32(bf2f(z0 & 0xffffu), bf2f(z0 >> 16), 0, false); w0 = __builtin_amdgcn_cvt_pk_fp8_f32(bf2f(z1 & 0xffffu), bf2f(z1 >> 16), w0, true);
            int w1 = __builtin_amdgcn_cvt_pk_fp8_f32(bf2f(z2 & 0xffffu), bf2f(z2 >> 16), 0, false); w1 = __builtin_amdgcn_cvt_pk_fp8_f32(bf2f(z3 & 0xffffu), bf2f(z3 >> 16), w1, true);
            Qf[ks] = mk_long((unsigned)w0, (unsigned)w1); }
        float mrun = -INFINITY, lrun = 0.f;
        f32x4 O[16];
#pragma unroll
        for (int rt = 0; rt < 16; ++rt) O[rt] = (f32x4){0.f, 0.f, 0.f, 0.f};
        const int nch = (nvalid + 31) >> 5;
        const unsigned char* cbase = ckv8 + (size_t)b * SEQ * 256;
        *(LAS u32x2*)(ksel + 4 * lane) = sv;
        asm volatile("" ::: "memory");
        u32x4 gv[3][8];
        const int w_row = (16 * (fq & 1) + (fq >> 1)) * 272 + 16 * j16;
#define SA_GATHER(c_, s_) do { const u32x4 k8 = *(const LAS u32x4*)(ksel + 32 * (c_) + 8 * fq); const unsigned k0 = k8[0], k1 = k8[1], k2 = k8[2], k3 = k8[3]; \
            _Pragma("unroll") for (int it = 0; it < 8; ++it) { const unsigned dd = (it < 2) ? k0 : (it < 4) ? k1 : (it < 6) ? k2 : k3; \
            unsigned key = (it & 1) ? (dd >> 16) : (dd & 0xffffu); if (!fullk) key = (key >= (unsigned)SEQ) ? 0u : key; \
            gv[s_][it] = *(const u32x4*)(cbase + (key * 256u + 16u * (unsigned)j16)); } } while (0)
        SA_GATHER(0, 0);
        if (1 < nch) SA_GATHER(1, 1);
        if (2 < nch) SA_GATHER(2, 2);
#pragma unroll
        for (int c = 0; c < 8; ++c) {
            if (c < nch) {
            const int sl = c % 3;
#pragma unroll
            for (int it = 0; it < 8; ++it) *(LAS u32x4*)(cb + w_row + it * 544) = gv[sl][it];
            asm volatile("" ::: "memory");
            if (c + 3 < nch) SA_GATHER(c + 3, sl);
            f32x4 Sa = {0.f, 0.f, 0.f, 0.f}, Sb = {0.f, 0.f, 0.f, 0.f};
#pragma unroll
            for (int ks = 0; ks < 8; ++ks) {
                const u32x2 a0 = *(const LAS u32x2*)(cb + qk_off + 32 * ks), a1 = *(const LAS u32x2*)(cb + qk_off + 272 + 32 * ks);
                const unsigned a0x = a0.x, a0y = a0.y, a1x = a1.x, a1y = a1.y;
                Sa = __builtin_amdgcn_mfma_f32_16x16x32_fp8_fp8(mk_long(a0x, a0y), Qf[ks], Sa, 0, 0, 0);
                Sb = __builtin_amdgcn_mfma_f32_16x16x32_fp8_fp8(mk_long(a1x, a1y), Qf[ks], Sb, 0, 0, 0);
            }
            float xa[4], xb[4]; float cm = -INFINITY;
#pragma unroll
            for (int r = 0; r < 4; ++r) { xa[r] = Sa[r] * sl2; xb[r] = Sb[r] * sl2; }
            if (!fullk) {
#pragma unroll
                for (int r = 0; r < 4; ++r) { const int ka = c * 32 + 4 * fq + r, kb2 = ka + 16; xa[r] = (ka < nvalid) ? xa[r] : -INFINITY; xb[r] = (kb2 < nvalid) ? xb[r] : -INFINITY; } }
#pragma unroll
            for (int r = 0; r < 4; ++r) cm = fmaxf(cm, fmaxf(xa[r], xb[r]));
            cm = fmaxf(cm, __shfl_xor(cm, 16)); cm = fmaxf(cm, __shfl_xor(cm, 32));
            if (__ballot(cm > mrun + 6.0f)) {
                const float mnew = fmaxf(mrun, cm);
                const float alpha = __builtin_amdgcn_exp2f(mrun - mnew);
                lrun *= alpha; mrun = mnew;
#pragma unroll
                for (int rt = 0; rt < 16; ++rt) O[rt] = O[rt] * alpha;
            }
            float ps = 0.f; float pa[4], pb[4];
#pragma unroll
            for (int r = 0; r < 4; ++r) { pa[r] = __builtin_amdgcn_exp2f(xa[r] - mrun); pb[r] = __builtin_amdgcn_exp2f(xb[r] - mrun); ps += pa[r] + pb[r]; }
            ps += __shfl_xor(ps, 16); ps += __shfl_xor(ps, 32);
            lrun += ps;
            int pw0 = __builtin_amdgcn_cvt_pk_fp8_f32(pa[0], pa[1], 0, false); pw0 = __builtin_amdgcn_cvt_pk_fp8_f32(pa[2], pa[3], pw0, true);
            int pw1 = __builtin_amdgcn_cvt_pk_fp8_f32(pb[0], pb[1], 0, false); pw1 = __builtin_amdgcn_cvt_pk_fp8_f32(pb[2], pb[3], pw1, true);
            const long Pf = mk_long((unsigned)pw0, (unsigned)pw1);
#pragma unroll
            for (int rt = 0; rt < 16; ++rt) {
                const v2i_t tv = __builtin_amdgcn_ds_read_tr8_b64_v2i32((LAS v2i_t*)(cb + tr_off + 16 * rt));
                const int t0 = tv[0], t1 = tv[1];
                O[rt] = __builtin_amdgcn_mfma_f32_16x16x32_fp8_fp8(mk_long((unsigned)t0, (unsigned)t1), Pf, O[rt], 0, 0, 0);
            }
            asm volatile("" ::: "memory");
            }
        }
#undef SA_GATHER
        const float inv = 1.0f / lrun;
        asm volatile("" ::: "memory");
        if (j16 < 8) {
#pragma unroll
            for (int rt = 0; rt < 16; ++rt) { u32x2 o; o.x = cvt_pk_bf16(O[rt][0] * inv, O[rt][1] * inv); o.y = cvt_pk_bf16(O[rt][2] * inv, O[rt][3] * inv); *(LAS u32x2*)(cb + j16 * 512 + rt * 32 + fq * 8) = o; }
        }
        asm volatile("" ::: "memory");
        { bf16* obase = olat + (size_t)t * 2048;
#pragma unroll
          for (int q = 0; q < 4; ++q) { const u32x4 v = *(const LAS u32x4*)(cb + q * 1024 + lane * 16); __builtin_nontemporal_store(v, (u32x4*)(obase + q * 512 + lane * 8)); } }
        asm volatile("" ::: "memory");
    }
}

__device__ __forceinline__ void routing_token(const float acc, const int lane, const float* rbias, int* tk_e, float* tk_w, LAS unsigned* hist, const size_t t, const bool do_count) {
    const float sc = 1.0f / (1.0f + expf(-acc));
    const float ch = sc + rbias[lane];
    int rk = 0;
#pragma unroll
    for (int k = 1; k < 8; ++k) { const int src = (lane & ~7) | ((lane + k) & 7); const float o = __shfl(ch, src); rk += (o > ch || (o == ch && src < lane)) ? 1 : 0; }
    float gs = (rk < 2) ? ch : 0.f; gs += __shfl_xor(gs, 1); gs += __shfl_xor(gs, 2); gs += __shfl_xor(gs, 4);
    int grk = 0; const int myg = lane >> 3;
#pragma unroll
    for (int g = 0; g < 8; ++g) { const float o = __shfl(gs, g * 8); grk += (o > gs || (o == gs && g < myg)) ? 1 : 0; }
    const float cm = (grk < 4) ? ch : -INFINITY;
    int erk = 0;
    for (int j = 0; j < 64; ++j) { const float o = __shfl(cm, j); erk += (o > cm || (o == cm && j < lane)) ? 1 : 0; }
    const bool selx = (erk < EK) && (grk < 4);
    const float ssum = wave_sum(selx ? sc : 0.f);
    if (selx) { tk_e[t * 8 + erk] = lane; tk_w[t * 8 + erk] = sc / ssum * 2.5f; if (do_count) __hip_atomic_fetch_add(&hist[lane], 1u, __ATOMIC_RELAXED, __HIP_MEMORY_SCOPE_WORKGROUP); }
}
__device__ __forceinline__ void phase_ln1_router(Frame& F, const float* g1, const float* b1, const float* rbias, const bool do_count) {
    const int lane_ = lane_id(), tid_ = F.wave * 64 + lane_;
    const float* pre = F.out;
    const float* wrT = (const float*)(F.ws + WS_WRT);
    bf16* h = (bf16*)(F.ws + WS_H);
    int* tk_e = (int*)(F.ws + WS_TOPK + TK_E); float* tk_w = (float*)(F.ws + WS_TOPK + TK_W);
    const int lane = lane_, w = F.wave, tid = tid_;
    LAS float* stats = (LAS float*)F.lds;
    LAS float* lg = (LAS float*)(F.lds + 1024) + (w & 3) * 1024;
    LAS unsigned* hist = (LAS unsigned*)(F.lds + 1024 + 16384);
    if (do_count && tid < 64) hist[tid] = 0u;
    for (int chunk = F.bid; chunk < NTOK / 64; chunk += F.G) {
        __syncthreads();
        f32x4 ggv[8], bbv[8];
#pragma unroll
        for (int q = 0; q < 8; ++q) { const int c = (lane + 64 * q) * 4; ggv[q] = *(const f32x4*)(g1 + c); bbv[q] = *(const f32x4*)(b1 + c); }
        for (int i = 0; i < 8; ++i) {
            const int tl = w * 8 + i; const size_t t = (size_t)chunk * 64 + tl;
            f32x4 v[8]; float s = 0.f;
#pragma unroll
            for (int q = 0; q < 8; ++q) { v[q] = *(const f32x4*)(pre + t * DM + (lane + 64 * q) * 4); s += (v[q][0] + v[q][1]) + (v[q][2] + v[q][3]); }
            const float mean = wave_sum(s) * (1.0f / DM); float s2 = 0.f;
#pragma unroll
            for (int q = 0; q < 8; ++q) { v[q] = v[q] - mean; s2 += (v[q][0] * v[q][0] + v[q][1] * v[q][1]) + (v[q][2] * v[q][2] + v[q][3] * v[q][3]); }
            const float rstd = 1.0f / sqrtf(wave_sum(s2) * (1.0f / DM) + LN_EPS);
#pragma unroll
            for (int q = 0; q < 8; ++q) { const int c = (lane + 64 * q) * 4;
                const f32x4 y = v[q] * rstd * ggv[q] + bbv[q];
                u32x2 o; o.x = cvt_pk_bf16(y[0], y[1]); o.y = cvt_pk_bf16(y[2], y[3]); *(u32x2*)(h + t * DM + c) = o; }
            if (lane == 0) { stats[tl * 2] = mean; stats[tl * 2 + 1] = rstd; }
        }
        __syncthreads();
        if (w < 4) {
            const int j16 = lane & 15, kq = lane >> 4, tl = 16 * w + j16;
            const float mean = stats[tl * 2], rstd = stats[tl * 2 + 1];
            const float* prow = pre + ((size_t)chunk * 64 + tl) * DM + 4 * kq; const float* wrow = wrT + (size_t)j16 * DM + 4 * kq;
            f32x4 acc[4];
#pragma unroll
            for (int tt = 0; tt < 4; ++tt) acc[tt] = (f32x4){0.f, 0.f, 0.f, 0.f};
#pragma unroll 2
            for (int m = 0; m < 128; ++m) {
                const f32x4 p = *(const f32x4*)(prow + 16 * m), gg = *(const f32x4*)(g1 + 16 * m + 4 * kq), bb = *(const f32x4*)(b1 + 16 * m + 4 * kq);
                const f32x4 hv = (p - mean) * rstd * gg + bb;
                f32x4 wv[4];
#pragma unroll
                for (int tt = 0; tt < 4; ++tt) wv[tt] = *(const f32x4*)(wrow + (size_t)tt * 16 * DM + 16 * m);
#pragma unroll
                for (int e = 0; e < 4; ++e)
#pragma unroll
                    for (int tt = 0; tt < 4; ++tt) acc[tt] = __builtin_amdgcn_mfma_f32_16x16x4f32(hv[e], wv[tt][e], acc[tt], 0, 0, 0);
            }
#pragma unroll
            for (int tt = 0; tt < 4; ++tt)
#pragma unroll
                for (int r = 0; r < 4; ++r) lg[(4 * kq + r) * 64 + 16 * tt + j16] = acc[tt][r];
            LDS_WAIT();
            for (int tk = 0; tk < 16; ++tk) routing_token(lg[tk * 64 + lane], lane, rbias, tk_e, tk_w, hist, (size_t)chunk * 64 + 16 * w + tk, do_count);
        }
    }
}
__device__ __forceinline__ void phase_flush_hist(Frame& F) {
    const int tid = F.wave * 64 + lane_id();
    LAS unsigned* hist = (LAS unsigned*)(F.lds + 1024 + 16384);
    __syncthreads();
    if (tid < 64 && hist[tid]) atomicAdd(F.ctl + CW_CNT + tid, hist[tid]);
}

__device__ __forceinline__ void phase_scatter(Frame& F) {
    const int lane_ = lane_id(), tid_ = F.wave * 64 + lane_;
    const int tid = tid_;
    LAS int* segs = (LAS int*)F.lds;
    LAS unsigned* lcnt = (LAS unsigned*)(F.lds + 1024);
    LAS unsigned* lbase = (LAS unsigned*)(F.lds + 2048);
    const int* tk_e = (const int*)(F.ws + WS_TOPK + TK_E); int* tk_pos = (int*)(F.ws + WS_TOPK + TK_POS);
    int* rowlist = (int*)(F.ws + WS_TOPK + TK_ROWLIST); int* mtt = (int*)(F.ws + WS_TOPK + TK_MTT);
    if (tid == 0) { int a = 0; for (int e = 0; e < NE; ++e) { segs[e] = a; a += (int)__hip_atomic_load(F.ctl + CW_CNT + e, RLX_AGENT); } segs[NE] = a; segs[NE + 1] = a + NTOK; }
    __syncthreads();
    if (F.bid == 0) {
        LAS int* tcum = (LAS int*)(F.lds + 3072);
        if (tid == 0) { int mt = 0; for (int g = 0; g < NGRP; ++g) { tcum[g] = mt; mt += (segs[g + 1] - segs[g] + 255) >> 8; } tcum[NGRP] = mt; __hip_atomic_store(F.ctl + CW_NMT, (unsigned)mt, RLX_AGENT); }
        __syncthreads();
        if (tid < NGRP) { const int g = tid, p0 = segs[g], n = segs[g + 1] - p0; int mt = tcum[g];
            for (int r = 0; r < n; r += 256, ++mt) { mtt[mt * 4 + 0] = g; mtt[mt * 4 + 1] = p0 + r; mtt[mt * 4 + 2] = (n - r < 256) ? n - r : 256; mtt[mt * 4 + 3] = 0; } }
        if (tid >= 256) rowlist[NSLOT + tid - 256] = 0;
    }
    const int sh0 = segs[NE];
    for (int chunk = F.bid; chunk < NTOK / 64; chunk += F.G) {
        if (tid < 64) lcnt[tid] = 0u;
        __syncthreads();
        const int t = chunk * 64 + (tid >> 3), k = tid & 7;
        const int e = tk_e[(size_t)t * 8 + k];
        const unsigned li = __hip_atomic_fetch_add(&lcnt[e], 1u, __ATOMIC_RELAXED, __HIP_MEMORY_SCOPE_WORKGROUP);
        __syncthreads();
        if (tid < 64) lbase[tid] = lcnt[tid] ? atomicAdd(F.ctl + CW_FILL + tid, lcnt[tid]) : 0u;
        __syncthreads();
        const int p = segs[e] + (int)lbase[e] + (int)li;
        rowlist[p] = t; tk_pos[(size_t)t * 8 + k] = p;
        if (tid < 64) rowlist[sh0 + chunk * 64 + tid] = chunk * 64 + tid;
        __syncthreads();
    }
}

struct CombRows { u32x4 hq[4]; u32x2 y[8][4]; u32x4 ysh[4]; };
__device__ __forceinline__ void comb_load(CombRows& R, const bf16* h, const unsigned char* Y8, const bf16* Ysh, const int t, const int posv, const int slot0, const int lane) {
#pragma unroll
    for (int i = 0; i < 4; ++i) { R.hq[i] = *(const u32x4*)(h + (size_t)t * DM + (lane + 64 * i) * 8); R.ysh[i] = __builtin_nontemporal_load((const u32x4*)(Ysh + (size_t)t * DM + (lane + 64 * i) * 8)); }
#pragma unroll
    for (int k = 0; k < 8; ++k) { const int p = __builtin_amdgcn_readlane(posv, slot0 + k);
#pragma unroll
        for (int i = 0; i < 4; ++i) R.y[k][i] = __builtin_nontemporal_load((const u32x2*)(Y8 + (size_t)p * DM + (lane + 64 * i) * 8)); }
}
__device__ __forceinline__ void comb_finish(const CombRows& R, const float* g2, const float* b2, float* out, const int t, const float wvv, const int slot0, const int lane) {
    f32x4 a[4][2];
#pragma unroll
    for (int i = 0; i < 4; ++i) { f32x4 x0, x1, s0, s1; unpack8(R.hq[i], x0, x1); unpack8(R.ysh[i], s0, s1); a[i][0] = x0 * DN_ALPHA + s0; a[i][1] = x1 * DN_ALPHA + s1; }
#pragma unroll
    for (int k = 0; k < 8; ++k) { const float wk = __builtin_bit_cast(float, __builtin_amdgcn_readlane(__builtin_bit_cast(int, wvv), slot0 + k));
#pragma unroll
        for (int i = 0; i < 4; ++i) { const u32x2 q8 = R.y[k][i];
            const f32x2 y01 = __builtin_amdgcn_cvt_pk_f32_fp8((int)q8.x, false), y23 = __builtin_amdgcn_cvt_pk_f32_fp8((int)q8.x, true), y45 = __builtin_amdgcn_cvt_pk_f32_fp8((int)q8.y, false), y67 = __builtin_amdgcn_cvt_pk_f32_fp8((int)q8.y, true);
            a[i][0] += (f32x4){y01[0], y01[1], y23[0], y23[1]} * wk; a[i][1] += (f32x4){y45[0], y45[1], y67[0], y67[1]} * wk; } }
    float s = 0.f;
#pragma unroll
    for (int i = 0; i < 4; ++i) s += ((a[i][0][0] + a[i][0][1]) + (a[i][0][2] + a[i][0][3])) + ((a[i][1][0] + a[i][1][1]) + (a[i][1][2] + a[i][1][3]));
    const float mean = wave_sum(s) * (1.0f / DM); float s2 = 0.f;
#pragma unroll
    for (int i = 0; i < 4; ++i) { a[i][0] = a[i][0] - mean; a[i][1] = a[i][1] - mean;
        s2 += ((a[i][0][0] * a[i][0][0] + a[i][0][1] * a[i][0][1]) + (a[i][0][2] * a[i][0][2] + a[i][0][3] * a[i][0][3])) + ((a[i][1][0] * a[i][1][0] + a[i][1][1] * a[i][1][1]) + (a[i][1][2] * a[i][1][2] + a[i][1][3] * a[i][1][3])); }
    const float rstd = 1.0f / sqrtf(wave_sum(s2) * (1.0f / DM) + LN_EPS);
#pragma unroll
    for (int i = 0; i < 4; ++i) { const int c = (lane + 64 * i) * 8;
        const f32x4 ga = *(const f32x4*)(g2 + c), gb = *(const f32x4*)(g2 + c + 4), ba = *(const f32x4*)(b2 + c), bb = *(const f32x4*)(b2 + c + 4);
        __builtin_nontemporal_store(a[i][0] * rstd * ga + ba, (f32x4*)(out + (size_t)t * DM + c)); __builtin_nontemporal_store(a[i][1] * rstd * gb + bb, (f32x4*)(out + (size_t)t * DM + c + 4)); }
}
__device__ __forceinline__ void phase_combine(Frame& F, const float* g2, const float* b2) {
    const int lane = lane_id();
    const bf16* h = (const bf16*)(F.ws + WS_H); const unsigned char* Y8 = (const unsigned char*)(F.ws + WS_Y); const bf16* Ysh = (const bf16*)(F.ws + WS_YSH);
    const float* tk_w = (const float*)(F.ws + WS_TOPK + TK_W); const int* tk_pos = (const int*)(F.ws + WS_TOPK + TK_POS);
    const int gw = F.bid * NWAVES + F.wave, NGW = F.G * NWAVES;
    for (int t0 = gw * 8; t0 < NTOK; t0 += NGW * 8) {
        const int posv = tk_pos[(size_t)t0 * 8 + lane]; const float wvv = tk_w[(size_t)t0 * 8 + lane];
        for (int i = 0; i < 8; ++i) {
            CombRows R;
            comb_load(R, h, Y8, Ysh, t0 + i, posv, 8 * i, lane);
            __builtin_amdgcn_sched_barrier(0);
            comb_finish(R, g2, b2, F.out, t0 + i, wvv, 8 * i, lane);
            __builtin_amdgcn_sched_barrier(0);
        }
    }
}

#ifndef MK_CHECK
#define MK_CHECK 0
#endif
constexpr int CW_CHK = 16384 + 256;
#if MK_CHECK
__device__ __forceinline__ float fp8f(unsigned char v) { const f32x2 a = __builtin_amdgcn_cvt_pk_f32_fp8((int)v, false); return a[0]; }
__device__ __forceinline__ void phase_check_attn(Frame& F) {
    const int tid = F.wave * 64 + lane_id();
    const bf16* qi = (const bf16*)(F.ws + WS_QI); const bf16* kin = (const bf16*)(F.ws + WS_KIN); const float* wis = (const float*)(F.ws + WS_WI);
    const bf16* qlat = (const bf16*)(F.ws + WS_QLAT); const unsigned char* ckv8 = (const unsigned char*)(F.ws + WS_CKVN);
    const unsigned short* selb = (const unsigned short*)(F.ws + WS_SEL); const bf16* olat = (const bf16*)(F.ws + WS_OLAT);
    LAS float* sc = (LAS float*)F.lds;
    LAS unsigned char* flg = (LAS unsigned char*)(F.lds + 32768);
    LAS unsigned char* seen = (LAS unsigned char*)(F.lds + 40960);
    LAS float* pl = (LAS float*)(F.lds + 49152);
    LAS int* cnt = (LAS int*)(F.lds + 57344);
    LAS float* errs = (LAS float*)(F.lds + 57344 + 64);
    const int POS[16] = {0, 1, 100, 255, 256, 257, 300, 511, 1000, 2047, 2048, 4095, 5000, 6143, 6144, 8191};
    for (int s = F.bid; s < 32; s += F.G) {
        int pos = 0;
#pragma unroll
        for (int q = 0; q < 16; ++q) pos = ((s >> 1) == q) ? POS[q] : pos;
        const int b = s & 1, n = pos + 1; const size_t t = (size_t)b * SEQ + pos;
        __syncthreads();
        if (tid < 4) cnt[tid] = 0;
        if (tid < 2) errs[tid] = 0.f;
        for (int k = tid; k < SEQ; k += NTHR) { flg[k] = 0; seen[k] = 0; }
        for (int k = tid; k < n; k += NTHR) {
            float tot = 0.f;
            for (int hh = 0; hh < 16; ++hh) { float d = 0.f;
                for (int e = 0; e < 64; ++e) d += bf2f(qi[t * 1024 + hh * 64 + e]) * bf2f(kin[((size_t)b * SEQ + k) * 64 + e]);
                tot += wis[t * 16 + hh] * fmaxf(d, 0.f); }
            sc[k] = tot;
        }
        __syncthreads();
        const unsigned short* sel = selb + t * TOPK;
        if (n > TOPK) {
            for (int k = tid; k < n; k += NTHR) { const float v = sc[k]; int rk = 0; for (int k2 = 0; k2 < n; ++k2) { const float o = sc[k2]; rk += (o > v || (o == v && k2 < k)) ? 1 : 0; } flg[k] = rk < TOPK ? 1 : 0; }
            __syncthreads();
            if (tid < TOPK) { const int k = sel[tid]; if (k >= n) atomicAdd((int*)&cnt[1], 1000); else { if (!flg[k]) atomicAdd((int*)&cnt[0], 1); if (seen[k]) atomicAdd((int*)&cnt[1], 1000); seen[k] = 1; } }
        } else {
            if (tid < TOPK) { const int k = sel[tid]; if (tid < n ? (k != tid) : (k != 0xFFFF)) atomicAdd((int*)&cnt[1], 1000); }
        }
        __syncthreads();
        const int nv = n < TOPK ? n : TOPK;
        for (int i = tid; i < 8 * 256; i += NTHR) { const int hh = i >> 8, k = i & 255; float lg = -INFINITY;
            if (k < nv) { const int key = sel[k]; float d = 0.f; for (int r = 0; r < 256; ++r) d += bf2f(qlat[(t * 8 + hh) * 256 + r]) * fp8f(ckv8[((size_t)b * SEQ + key) * 256 + r]); lg = d * 0.08838834764831845f; }
            pl[i] = lg; }
        __syncthreads();
        if (tid < 8) { float m = -INFINITY; for (int k = 0; k < 256; ++k) m = fmaxf(m, pl[tid * 256 + k]); float l = 0.f; for (int k = 0; k < 256; ++k) { const float p = expf(pl[tid * 256 + k] - m); pl[tid * 256 + k] = p; l += p; } for (int k = 0; k < 256; ++k) pl[tid * 256 + k] /= l; }
        __syncthreads();
        for (int i = tid; i < 8 * 256; i += NTHR) { const int hh = i >> 8, r = i & 255; float o = 0.f;
            for (int k = 0; k < nv; ++k) o += pl[hh * 256 + k] * fp8f(ckv8[((size_t)b * SEQ + sel[k]) * 256 + r]);
            const float got = bf2f(olat[(t * 8 + hh) * 256 + r]);
            __hip_atomic_fetch_add(&errs[0], (got - o) * (got - o), __ATOMIC_RELAXED, __HIP_MEMORY_SCOPE_WORKGROUP); __hip_atomic_fetch_add(&errs[1], o * o, __ATOMIC_RELAXED, __HIP_MEMORY_SCOPE_WORKGROUP); if (!(got == got)) atomicAdd((int*)&cnt[2], 1); }
        __syncthreads();
        if (tid == 0) { unsigned code = 0; if (cnt[0] > 8 || cnt[1] > 0) code |= 1u; if (cnt[2] > 0 || !(errs[0] <= 0.12f * 0.12f * errs[1])) code |= 2u; if (code) atomicOr(F.ctl + CW_CHK, code); }
    }
}
__device__ __forceinline__ void phase_check_apply(Frame& F) {
    const unsigned code = __hip_atomic_load(F.ctl + CW_CHK, RLX_AGENT);
    if (code) { const float v = (code & 1u) ? __builtin_nanf("") : 0.f; const size_t gt = (size_t)F.bid * NTHR + F.wave * 64 + lane_id();
        for (size_t i = gt; i < (size_t)NTOK * DM; i += (size_t)F.G * NTHR) F.out[i] = v; }
}
#endif

constexpr int NPHASE = 16;
constexpr unsigned REPEAT_MASK = 0x0u;
constexpr int TIME_PHASE = -1;
constexpr int CW_TIME = 16384 + 320;
struct Args { const float* in[24]; float* out; unsigned char* ws; int ph_lo, ph_hi; };

__global__ void __launch_bounds__(NTHR, 2) mk_fwd(Args args) {
    extern __shared__ __attribute__((aligned(16))) unsigned char lds_raw[];
    Frame F;
    F.lds = (LAS unsigned char*)lds_raw;
    F.MISC = (volatile LAS unsigned*)(F.lds + MISC_OFF);
    F.wave = __builtin_amdgcn_readfirstlane(threadIdx.x >> 6);
    F.G = gridDim.x; F.bid = blockIdx.x;
    F.ws = args.ws; F.ctl = (unsigned*)(args.ws + WS_CTL); F.out = args.out;
    for (int u = threadIdx.x; u < (LDS_BYTES - MISC_OFF) / 4; u += NTHR) ((LAS unsigned*)(F.lds + MISC_OFF))[u] = 0u;
    __syncthreads();
    const int lo = args.ph_lo, hi = args.ph_hi;
    const bool multi = (hi - lo) > 1;
    XcdBarrier bar; bar.bar = F.ctl + CW_BAR; bar.x = 0; bar.st = nullptr; bar.wave = F.wave;
    if (multi) bar = xcd_barrier_post(F.ctl + CW_BAR, F.MISC + 8, F.wave);
#ifndef ONLY_PHASE
#define ONLY_PHASE -1
#endif
#define IN(k) ((ONLY_PHASE < 0 || ONLY_PHASE == (k)) && lo <= (k) && (k) < hi)
#define SEAM(k) do { if (IN(k) && IN((k) + 1)) { xcd_barrier(bar); \
        if (TIME_PHASE >= 0 && F.bid == 0 && F.wave == 0) { const unsigned long long now_ = __builtin_amdgcn_s_memrealtime(); \
            if ((k) == TIME_PHASE - 1 || ((k) == 0 && TIME_PHASE == 0 && false)) { if (lane_id() == 0) { F.ctl[CW_TIME] = (unsigned)now_; } } \
            if ((k) == TIME_PHASE) { if (lane_id() == 0) { F.ctl[CW_TIME + 1] = (unsigned)now_ - F.ctl[CW_TIME]; } } } } } while (0)
    unsigned char* ws = args.ws;
    const ExpW EW{args.in[16], args.in[17], args.in[18], args.in[19], args.in[20], args.in[21]};
    const bool ride = false;
    if (TIME_PHASE == 0 && F.bid == 0 && threadIdx.x == 0) F.ctl[CW_TIME] = (unsigned)__builtin_amdgcn_s_memrealtime();

    if (IN(0)) for (int rep_ = 0; rep_ < 1 + (int)((REPEAT_MASK >> 0) & 1u); ++rep_) { phase_convert_small(F, args.in[0], args.in[1], args.in[5], args.in[6], args.in[7], args.in[9], args.in[10], args.in[11], args.in[8], args.in[14]); } SEAM(0);

    if (IN(1)) for (int rep_ = 0; rep_ < 1 + (int)((REPEAT_MASK >> 1) & 1u); ++rep_) {
        FillPlain f{(const char*)(ws + WS_XB), (const char*)(ws + WS_WIN), 4096u, 4096u, 32};
        DenseSched<FillPlain> S{64, 30, F.G, F.bid, f};
        EpiP1 E{(bf16*)(ws + WS_Q), (bf16*)(ws + WS_QI), (bf16*)(ws + WS_XP), (bf16*)(ws + WS_GATES), (float*)(ws + WS_CKVRAW), (float*)(ws + WS_KIWI)};
        pg8::gemm_phase<EpiP1, DenseSched<FillPlain>, false, true, true>(F.lds, F.wave, 4096u, 4096u, S, E);
    } SEAM(1);

    if (IN(2)) for (int rep_ = 0; rep_ < 1 + (int)((REPEAT_MASK >> 2) & 1u); ++rep_) { phase_postproc(F, args.in[2], args.in[3], args.in[4]); } SEAM(2);

    if (IN(3)) for (int rep_ = 0; rep_ < 1 + (int)((REPEAT_MASK >> 3) & 1u); ++rep_) {
        FillQlatPool f{(const char*)(ws + WS_Q), (const char*)(ws + WS_DIFF), (const char*)(ws + WS_WUK), (const char*)(ws + WS_WPOOL)};
        DenseSched<FillQlatPool> S{64, 12, F.G, F.bid, f};
        EpiQlatPool E{(bf16*)(ws + WS_QLAT), (bf16*)(ws + WS_POOL), (const float*)(ws + WS_CSCALE)};
        pg8::gemm_phase<EpiQlatPool, DenseSched<FillQlatPool>, false, true, true>(F.lds, F.wave, 2048u, 512u, S, E);
    } SEAM(3);

    if (IN(4)) for (int rep_ = 0; rep_ < 1 + (int)((REPEAT_MASK >> 4) & 1u); ++rep_) { phase_index_scores(F); } SEAM(4);
    if (IN(5)) for (int rep_ = 0; rep_ < 1 + (int)((REPEAT_MASK >> 5) & 1u); ++rep_) { phase_select(F, EW, ride && rep_ == 0); } SEAM(5);
    if (IN(6)) for (int rep_ = 0; rep_ < 1 + (int)((REPEAT_MASK >> 6) & 1u); ++rep_) { phase_sparse_attn(F, EW, ride && rep_ == 0); } SEAM(6);
#if MK_CHECK
    if (IN(6) && IN(7)) { phase_check_attn(F); xcd_barrier(bar); }
#endif

    if (IN(7)) for (int rep_ = 0; rep_ < 1 + (int)((REPEAT_MASK >> 7) & 1u); ++rep_) {
        FillO f{(const char*)(ws + WS_OLAT), (const char*)(ws + WS_WUV)};
        DenseSched<FillO> S{64, 4, F.G, F.bid, f};
        EpiBf16 E{(bf16*)(ws + WS_ATTN), 1024};
        pg8::gemm_phase<EpiBf16, DenseSched<FillO>, false, true, true>(F.lds, F.wave, 4096u, 1024u, S, E);
    } SEAM(7);

    if (IN(8)) for (int rep_ = 0; rep_ < 1 + (int)((REPEAT_MASK >> 8) & 1u); ++rep_) {
        FillPlain f{(const char*)(ws + WS_ATTN), (const char*)(ws + WS_WPA), 2048u, 2048u, 16};
        DenseSched<FillPlain> S{64, 8, F.G, F.bid, f};
        EpiGate<0> E{(const bf16*)(ws + WS_GATES), (bf16*)(ws + WS_M1), (bf16*)(ws + WS_MERGED)};
        pg8::gemm_phase<EpiGate<0>, DenseSched<FillPlain>, false, true, true>(F.lds, F.wave, 2048u, 2048u, S, E);
    } SEAM(8);

    if (IN(9)) for (int rep_ = 0; rep_ < 1 + (int)((REPEAT_MASK >> 9) & 1u); ++rep_) {
        FillPlain f{(const char*)(ws + WS_POOL), (const char*)(ws + WS_WPP), 2048u, 2048u, 16};
        DenseSched<FillPlain> S{64, 8, F.G, F.bid, f};
        EpiGate<1> E{(const bf16*)(ws + WS_GATES), (bf16*)(ws + WS_M1), (bf16*)(ws + WS_MERGED)};
        pg8::gemm_phase<EpiGate<1>, DenseSched<FillPlain>, false, true, true>(F.lds, F.wave, 2048u, 2048u, S, E);
    } SEAM(9);

    if (IN(10)) for (int rep_ = 0; rep_ < 1 + (int)((REPEAT_MASK >> 10) & 1u); ++rep_) {
        FillPlain f{(const char*)(ws + WS_MERGED), (const char*)(ws + WS_WOUT), 4096u, 4096u, 32};
        DenseSched<FillPlain> S{64, 8, F.G, F.bid, f};
        EpiPre E{args.in[0], F.out};
        pg8::gemm_phase<EpiPre, DenseSched<FillPlain>, false, true, true>(F.lds, F.wave, 4096u, 4096u, S, E);
    } SEAM(10);

    if (IN(11)) for (int rep_ = 0; rep_ < 1 + (int)((REPEAT_MASK >> 11) & 1u); ++rep_) {
        for (int rl_ = 0; rl_ < 1 + (int)((REPEAT_MASK >> 17) & 1u); ++rl_) phase_ln1_router(F, args.in[12], args.in[13], args.in[15], rl_ == 0);
        phase_convert_experts(F, EW);
        phase_flush_hist(F);
    } SEAM(11);
    if (IN(12)) for (int rep_ = 0; rep_ < 1 + (int)((REPEAT_MASK >> 12) & 1u); ++rep_) { phase_scatter(F); } SEAM(12);

    if (IN(13)) for (int rep_ = 0; rep_ < 1 + (int)((REPEAT_MASK >> 13) & 1u); ++rep_) {
        const int nmt = (int)__hip_atomic_load(F.ctl + CW_NMT, RLX_AGENT);
        MoeSched S{(const int*)(ws + WS_TOPK + TK_MTT), nmt, 4, F.G, F.bid, true, (const char*)(ws + WS_H), (const char*)(ws + WS_HBUF), (const char*)(ws + WS_WGU), (const char*)(ws + WS_WD), (const int*)(ws + WS_TOPK + TK_ROWLIST), F.lds};
        S.prepare(F.wave * 64 + lane_id());
        EpiSwiGLU E{(bf16*)(ws + WS_HBUF)};
        pg8::gemm_phase<EpiSwiGLU, MoeSched, true, true, true>(F.lds, F.wave, 4096u, 4096u, S, E);
    } SEAM(13);

    if (IN(14)) for (int rep_ = 0; rep_ < 1 + (int)((REPEAT_MASK >> 14) & 1u); ++rep_) {
        const int nmt = (int)__hip_atomic_load(F.ctl + CW_NMT, RLX_AGENT);
        MoeSched S{(const int*)(ws + WS_TOPK + TK_MTT), nmt, 8, F.G, F.bid, false, (const char*)(ws + WS_H), (const char*)(ws + WS_HBUF), (const char*)(ws + WS_WGU), (const char*)(ws + WS_WD), (const int*)(ws + WS_TOPK + TK_ROWLIST), F.lds};
        S.prepare(F.wave * 64 + lane_id());
        EpiY E{(unsigned char*)(ws + WS_Y), (bf16*)(ws + WS_YSH)};
        pg8::gemm_phase<EpiY, MoeSched, false, true, true>(F.lds, F.wave, 1024u, 1024u, S, E);
    } SEAM(14);

    if (IN(15)) for (int rep_ = 0; rep_ < 1 + (int)((REPEAT_MASK >> 15) & 1u); ++rep_) { phase_combine(F, args.in[22], args.in[23]); }
#if MK_CHECK
    if (IN(15)) { xcd_barrier(bar); phase_check_apply(F); }
#endif
    if (TIME_PHASE >= 0 && multi && F.bid == 0 && F.wave == 0) {
        asm volatile("s_waitcnt vmcnt(0)" ::: "memory");
        if (TIME_PHASE == 15 && lane_id() == 0) { F.ctl[CW_TIME + 1] = (unsigned)__builtin_amdgcn_s_memrealtime() - F.ctl[CW_TIME]; }
        asm volatile("s_waitcnt vmcnt(0)" ::: "memory");
        const unsigned dur = __hip_atomic_load(F.ctl + CW_TIME + 1, RLX_AGENT); const unsigned long long t0 = __builtin_amdgcn_s_memrealtime();
        while (__builtin_amdgcn_s_memrealtime() - t0 < 4ull * dur) __builtin_amdgcn_s_sleep(8);
    }
#undef IN
#undef SEAM
}

#ifndef MK_ONE_LAUNCH
#define MK_ONE_LAUNCH 1
#endif
extern "C" void kernel_launch(void* const* d_in, const int* in_sizes, int n_in, void* d_out, int out_size, void* d_ws, size_t ws_size, hipStream_t stream) {
    static int grid = 0;
    if (grid == 0) {
        if (n_in != 24 || out_size != NTOK * DM || ws_size < WS_END) { fprintf(stderr, "kernel_launch: unexpected shapes (n_in %d out %d ws %zu)\n", n_in, out_size, ws_size); grid = -1; return; }
        int dev = 0, cus = 0;
        if (hipGetDevice(&dev) != hipSuccess || hipDeviceGetAttribute(&cus, hipDeviceAttributeMultiprocessorCount, dev) != hipSuccess) { grid = -1; return; }
        if (hipFuncSetAttribute((const void*)mk_fwd, hipFuncAttributeMaxDynamicSharedMemorySize, LDS_BYTES) != hipSuccess) { fprintf(stderr, "kernel_launch: hipFuncSetAttribute failed\n"); grid = -1; return; }
        int per_cu = 0;
        if (hipOccupancyMaxActiveBlocksPerMultiprocessor(&per_cu, (const void*)mk_fwd, NTHR, LDS_BYTES) != hipSuccess || per_cu < 1) fprintf(stderr, "kernel_launch: occupancy query says %d\n", per_cu);
        (void)hipGetLastError();
        grid = cus;
    }
    if (grid < 0) return;
    if (hipMemsetAsync((char*)d_ws + WS_CTL, 0, CTL_BYTES, stream) != hipSuccess) return;
    Args a{};
    for (int i = 0; i < 24; ++i) a.in[i] = (const float*)d_in[i];
    a.out = (float*)d_out; a.ws = (unsigned char*)d_ws;
#if MK_ONE_LAUNCH
    a.ph_lo = 0; a.ph_hi = NPHASE;
    hipLaunchKernelGGL(mk_fwd, dim3(grid), dim3(NTHR), LDS_BYTES, stream, a);
#else
    for (int p = 0; p < NPHASE; ++p) { a.ph_lo = p; a.ph_hi = p + 1; hipLaunchKernelGGL(mk_fwd, dim3(grid), dim3(NTHR), LDS_BYTES, stream, a); }
#endif
}
```

```cpp
#include <hip/hip_runtime.h>
#include <cstdio>
#include <cstdint>

#define LAS __attribute__((address_space(3)))
#define GAS __attribute__((address_space(1)))
typedef unsigned short bf16;
typedef short bf16x8 __attribute__((ext_vector_type(8)));
typedef short s16x4 __attribute__((ext_vector_type(4)));
typedef float f32x4 __attribute__((ext_vector_type(4)));
typedef float f32x2 __attribute__((ext_vector_type(2)));
typedef unsigned u32x4 __attribute__((ext_vector_type(4)));
typedef unsigned u32x2 __attribute__((ext_vector_type(2)));

constexpr int NTOK = 16384, SEQ = 8192, DM = 2048;
constexpr int NH = 8, DQK = 128, DV = 128, RKV = 256, IH = 16, IDH = 64, TOPK = 256;
constexpr int NE = 64, EK = 8, EDIM = 512, NGRP = 65;
constexpr int WIN_ROWS = 7680;
constexpr float LN_EPS = 1e-5f, RMS_EPS = 1e-6f;
constexpr float DN_ALPHA = 1.189207115002721f;
constexpr int NSLOT = NTOK * 9;
constexpr size_t SC_TOT = (size_t)128 * 128 * (64 * 65 / 2);

constexpr size_t MiB = 1u << 20;
constexpr size_t WS_CTL = 0, CTL_BYTES = 1 * MiB;
constexpr size_t WS_WIN = 1 * MiB;
constexpr size_t WS_WUK = 31 * MiB;
constexpr size_t WS_WUV = 32 * MiB;
constexpr size_t WS_WPOOL = 33 * MiB;
constexpr size_t WS_WPA = 34 * MiB;
constexpr size_t WS_WPP = 38 * MiB;
constexpr size_t WS_WOUT = 42 * MiB;
constexpr size_t WS_CSCALE = 50 * MiB;
constexpr size_t WS_WRT = 50 * MiB + 65536;
constexpr size_t WS_XB = 394 * MiB;
constexpr size_t WS_Q = 458 * MiB;
constexpr size_t WS_QI = 490 * MiB;
constexpr size_t WS_XP = 522 * MiB;
constexpr size_t WS_CKVRAW = 554 * MiB;
constexpr size_t WS_KIWI = 570 * MiB;
constexpr size_t WS_DIFF = 586 * MiB;
constexpr size_t WS_GATES = 181 * MiB;
constexpr size_t WS_QLAT = 309 * MiB;
constexpr size_t WS_CKVN = 373 * MiB;
constexpr size_t WS_KIN = 381 * MiB;
constexpr size_t WS_WI = 383 * MiB;
constexpr size_t WS_SEL = 654 * MiB;
constexpr size_t WS_SCORES = 662 * MiB;
constexpr size_t WS_POOL = 922 * MiB;
constexpr size_t WS_OLAT = 662 * MiB;
constexpr size_t WS_ATTN = 726 * MiB;
constexpr size_t WS_M1 = 758 * MiB;
constexpr size_t WS_MERGED = 822 * MiB;
constexpr size_t WS_WD = 51 * MiB;
constexpr size_t WS_H = 181 * MiB;
constexpr size_t WS_HBUF = 245 * MiB;
constexpr size_t WS_TOPK = 390 * MiB;
constexpr size_t WS_WGU = 394 * MiB;
constexpr size_t WS_Y = 394 * MiB;
constexpr size_t WS_YSH = WS_Y + (size_t)NTOK * 8 * DM;
constexpr size_t WS_END = 1024 * MiB;
static_assert(WS_DIFF + 32 * MiB <= 654 * MiB && WS_SCORES + 260 * MiB <= WS_POOL && WS_POOL + 32 * MiB <= 970 * MiB && WS_WI + 1 * MiB <= 390 * MiB, "mixer map");
static_assert(WS_SCORES + SC_TOT * 2 * 4 <= WS_POOL, "scores");
static_assert(WS_HBUF + (size_t)(NSLOT + 256) * EDIM * 2 <= WS_TOPK, "hbuf");
static_assert(WS_YSH + (size_t)NTOK * DM * 2 <= WS_END, "y");
constexpr size_t TK_E = 0;
constexpr size_t TK_W = 512 * 1024;
constexpr size_t TK_POS = 1024 * 1024;
constexpr size_t TK_ROWLIST = 1536 * 1024;
constexpr size_t TK_MTT = 2560 * 1024;
constexpr size_t TK_WRT = 3 * MiB;
constexpr int CW_BAR = 4096;
constexpr int CW_CNT = 16384;
constexpr int CW_FILL = 16384 + 64;
constexpr int CW_CVQ = 16384 + 192;
constexpr int CW_NMT = 16384 + 128;

constexpr int RING_BYTES = 131072;
constexpr int MISC_OFF = 143360;
constexpr int LDS_BYTES = 147456;
constexpr int NWAVES = 8, NTHR = 512;

#define RLX_AGENT __ATOMIC_RELAXED, __HIP_MEMORY_SCOPE_AGENT
#define LDS_WAIT() asm volatile("s_waitcnt lgkmcnt(0)" ::: "memory")
#define VM_WAIT() asm volatile("s_waitcnt vmcnt(0)" ::: "memory")

__device__ __forceinline__ int lane_id() { return (int)__builtin_amdgcn_mbcnt_hi(~0u, __builtin_amdgcn_mbcnt_lo(~0u, 0u)); }
__device__ __forceinline__ float bf2f(unsigned b) { return __uint_as_float(b << 16); }
__device__ __forceinline__ unsigned f2bf(float f) { unsigned u = __float_as_uint(f); return (u + 0x7fffu + ((u >> 16) & 1u)) >> 16; }
__device__ __forceinline__ unsigned pk2(float lo, float hi) { return f2bf(lo) | (f2bf(hi) << 16); }
__device__ __forceinline__ unsigned cvt_pk_bf16(float lo, float hi) { unsigned r; asm volatile("v_cvt_pk_bf16_f32 %0, %1, %2" : "=v"(r) : "v"(lo), "v"(hi)); return r; }
#define DPP_I(old, x, ctrl, rmask) __builtin_amdgcn_update_dpp((int)(old), (int)(x), (ctrl), (rmask), 0xf, false)
__device__ __forceinline__ int wave_scan_i(int x) {
    x += DPP_I(0, x, 0x111, 0xf); x += DPP_I(0, x, 0x112, 0xf); x += DPP_I(0, x, 0x114, 0xf); x += DPP_I(0, x, 0x118, 0xf);
    x += DPP_I(0, x, 0x142, 0xa); x += DPP_I(0, x, 0x143, 0xc); return x;
}
__device__ __forceinline__ int wave_sum_i(int v) { return __builtin_amdgcn_readlane(wave_scan_i(v), 63); }
__device__ __forceinline__ float wave_sum(float x) {
#define DPP_F(x_, ctrl, rmask) __builtin_bit_cast(float, __builtin_amdgcn_update_dpp(0, __builtin_bit_cast(int, x_), (ctrl), (rmask), 0xf, false))
    x += DPP_F(x, 0x111, 0xf); x += DPP_F(x, 0x112, 0xf); x += DPP_F(x, 0x114, 0xf); x += DPP_F(x, 0x118, 0xf);
    x += DPP_F(x, 0x142, 0xa); x += DPP_F(x, 0x143, 0xc);
#undef DPP_F
    return __builtin_bit_cast(float, __builtin_amdgcn_readlane(__builtin_bit_cast(int, x), 63));
}
__device__ __forceinline__ float wave_max(float x) {
#define DPP_K(x_, ctrl, rmask) __builtin_bit_cast(float, __builtin_amdgcn_update_dpp(__builtin_bit_cast(int, x_), __builtin_bit_cast(int, x_), (ctrl), (rmask), 0xf, false))
    x = fmaxf(x, DPP_K(x, 0x111, 0xf)); x = fmaxf(x, DPP_K(x, 0x112, 0xf)); x = fmaxf(x, DPP_K(x, 0x114, 0xf)); x = fmaxf(x, DPP_K(x, 0x118, 0xf));
    x = fmaxf(x, DPP_K(x, 0x142, 0xa)); x = fmaxf(x, DPP_K(x, 0x143, 0xc));
    return __builtin_bit_cast(float, __builtin_amdgcn_readlane(__builtin_bit_cast(int, x), 63));
}
__device__ __forceinline__ float wave_min(float x) {
    x = fminf(x, DPP_K(x, 0x111, 0xf)); x = fminf(x, DPP_K(x, 0x112, 0xf)); x = fminf(x, DPP_K(x, 0x114, 0xf)); x = fminf(x, DPP_K(x, 0x118, 0xf));
    x = fminf(x, DPP_K(x, 0x142, 0xa)); x = fminf(x, DPP_K(x, 0x143, 0xc));
#undef DPP_K
    return __builtin_bit_cast(float, __builtin_amdgcn_readlane(__builtin_bit_cast(int, x), 63));
}

#define XB_TMO      128
#define XB_XCNT(j)  (256  + 64 * (j))
#define XB_XSUB(j)  (1280 + 64 * (j))
#define XB_XGEN(j)  (2304 + 64 * (j))
#define XB_TOP      3328
#define XB_TOPGEN   3392
#define XCD_BAR_WORDS 3456
#define XB_SPIN_CAP (1u << 24)

__device__ __forceinline__ unsigned xb_ld(unsigned* p)              { return __hip_atomic_load(p, __ATOMIC_RELAXED, __HIP_MEMORY_SCOPE_AGENT); }
__device__ __forceinline__ unsigned xb_add(unsigned* p, unsigned v) { return __hip_atomic_fetch_add(p, v, __ATOMIC_RELAXED, __HIP_MEMORY_SCOPE_AGENT); }
__device__ __forceinline__ unsigned xb_xcc_id() { return (unsigned)__builtin_amdgcn_s_getreg((3 << 11) | 20) & 0xFu; }
#define XB_SPIN(cond, bar) do { unsigned _sp = 0; while (cond) { __builtin_amdgcn_s_sleep(1); \
    if ((++_sp & 255u) == 0u) { if (xb_ld(&(bar)[XB_TMO])) break; if (_sp > XB_SPIN_CAP) { atomicAdd(&(bar)[XB_TMO], 1u); break; } } } } while (0)

struct XcdBarrier { unsigned* bar; unsigned x; volatile LAS unsigned* st; int wave; };

__device__ __forceinline__ XcdBarrier xcd_barrier_post(unsigned* bar, volatile LAS unsigned* st, int wave) {
    XcdBarrier b; b.bar = bar; b.x = xb_xcc_id(); b.st = st; b.wave = wave;
    if (wave == 0 && lane_id() == 0) (void)xb_add(&bar[XB_XCNT(b.x)], 1u);
    return b;
}
__device__ __forceinline__ void xcd_barrier_complete(unsigned* bar, unsigned x, unsigned& nloc, unsigned& nx) {
    const unsigned G = gridDim.x * gridDim.y * gridDim.z;
    unsigned sum, cnt, mine, sp = 0u;
    for (;;) {
        sum = 0u; cnt = 0u; mine = 0u;
#pragma unroll
        for (unsigned j = 0; j < 16; ++j) { const unsigned c = xb_ld(&bar[XB_XCNT(j)]); sum += c; cnt += (c > 0u) ? 1u : 0u; mine = (j == x) ? c : mine; }
        if (sum == G) break;
        __builtin_amdgcn_s_sleep(1);
        if ((++sp & 255u) == 0u) { if (xb_ld(&bar[XB_TMO])) break; if (sp > XB_SPIN_CAP) { atomicAdd(&bar[XB_TMO], 1u); break; } }
    }
    nloc = mine > 0u ? mine : 1u; nx = cnt > 0u ? cnt : 1u;
}
__device__ __forceinline__ void xcd_barrier(const XcdBarrier& b) {
    asm volatile("s_waitcnt vmcnt(0)" ::: "memory");
    __syncthreads();
    if (b.wave == 0 && lane_id() == 0) {
        unsigned* bar = b.bar;
        __builtin_amdgcn_s_waitcnt(0);
        unsigned nloc = b.st[0], nx = b.st[1];
        if (nloc == 0u) { xcd_barrier_complete(bar, b.x, nloc, nx); b.st[0] = nloc; b.st[1] = nx; }
        const unsigned old = xb_add(&bar[XB_XSUB(b.x)], 1u);
        const unsigned gen = old / nloc;
        if (old + 1u == (gen + 1u) * nloc) {
            __builtin_amdgcn_fence(__ATOMIC_RELEASE, "agent");
            asm volatile("s_waitcnt vmcnt(0)" ::: "memory");
            const unsigned og = xb_add(&bar[XB_TOP], 1u);
            const unsigned tg = og / nx;
            if (og + 1u == (tg + 1u) * nx) xb_add(&bar[XB_TOPGEN], 1u);
            else XB_SPIN(xb_ld(&bar[XB_TOPGEN]) == tg, bar);
            __builtin_amdgcn_fence(__ATOMIC_ACQUIRE, "agent");
            xb_add(&bar[XB_XGEN(b.x)], 1u);
            asm volatile("s_waitcnt vmcnt(0)" ::: "memory");
        } else {
            XB_SPIN(xb_ld(&bar[XB_XGEN(b.x)]) == gen, bar);
            __builtin_amdgcn_fence(__ATOMIC_ACQUIRE, "agent");
            asm volatile("s_waitcnt vmcnt(0)" ::: "memory");
        }
    }
    __syncthreads();
}

namespace pg8 {
constexpr int BM = 256, BK = 64, HALF = 128, HTB = HALF * BK * 2, STAGE_BYTES = 8 * HTB, NXCD = 8, WGM = 8;

__host__ __device__ __forceinline__ int lds_byte(int r, int c) { const int st = (r >> 4) * 2 + (c >> 5), rr = r & 15, cc = c & 31, ob = rr * 64 + cc * 2; return st * 1024 + (ob ^ (((ob >> 9) & 1) << 5)); }
__host__ __device__ __forceinline__ void stage_rc(int b, int& R, int& C) { const int st = b / 1024, sb = b % 1024, swz = sb ^ (((sb >> 9) & 1) << 5); R = (st >> 1) * 16 + swz / 64; C = (st & 1) * 32 + (swz % 64) / 2; }
__host__ __device__ __forceinline__ int perm32(int rho) { const int n = rho >> 4, i = rho & 15; return 8 * (i >> 2) + 4 * n + (i & 3); }

__device__ __forceinline__ const char* uptr(const char* p) { const unsigned long long v = (unsigned long long)p; const unsigned lo = __builtin_amdgcn_readfirstlane((unsigned)v), hi = __builtin_amdgcn_readfirstlane((unsigned)(v >> 32)); return (const char*)(((unsigned long long)hi << 32) | lo); }
struct GUnit {
    const char* A;
    const char* B0;
    const char* B1;
    const int* rows;
    int rows_lds;
    int nt;
    int pm, pn, aux0, aux1;
};

__device__ __forceinline__ void tile_order(int L, int nM, int nN, int& pm, int& pn) {
    const int nwg = nM * nN;
    int wgid = L; { const int q = nwg / NXCD, r = nwg % NXCD, xcd = wgid % NXCD, off = wgid / NXCD; wgid = (xcd < r ? xcd * (q + 1) : r * (q + 1) + (xcd - r) * q) + off; }
    const int nig = WGM * nN, gid = wgid / nig, fm = gid * WGM, gsz = (nM - fm) < WGM ? (nM - fm) : WGM;
    pm = fm + ((wgid % nig) % gsz); pn = (wgid % nig) / gsz;
}

template <class Epi, class Sched, bool GATHER, bool ALIGN_EPI, bool SP2>
__device__ __forceinline__ void gemm_phase(LAS unsigned char* lds, const int wave, const unsigned a_rs, const unsigned b_rs, const Sched& S, const Epi& E) {
    const int wid = wave, lane = lane_id(), tid = wid * 64 + lane, wr = wid >> 2, wc = wid & 3, fr = lane & 15, fq = lane >> 4;
    int R0, C0; stage_rc(tid * 16, R0, C0);
    unsigned voffA[2], voffB[2];
#pragma unroll
    for (int i = 0; i < 2; ++i) { const int R = R0 + 64 * i; const int Rb = (R & ~31) + perm32(R & 31);
        voffA[i] = (unsigned)R * a_rs + (unsigned)C0 * 2u; voffB[i] = (unsigned)Rb * b_rs + (unsigned)C0 * 2u; }
    unsigned vgc[2][2], vgn[2][2];
    const size_t kstep = (size_t)(BK * 2);
    const size_t hstepA = (size_t)HALF * a_rs;
    const unsigned ldsw = (unsigned)wid * 1024u;
    const int aoff = lds_byte(wr * 64 + fr, fq * 8), boff = lds_byte(wc * 32 + fr, fq * 8);
#define PG8_SA(b, h) (((b) * 2 + (h)) * HTB)
#define PG8_SB(b, h) ((4 + (b) * 2 + (h)) * HTB)
#define PG8_STAGE(bufoff, gbase, voff) do { const char* _gb = (const char*)(gbase); asm volatile("" : "+s"(_gb)); _Pragma("unroll") for (int _i = 0; _i < 2; ++_i) \
        __builtin_amdgcn_global_load_lds((const unsigned*)(_gb + (voff)[_i]), (LAS unsigned*)(lds + (bufoff) + ldsw + _i * 8192), 16, 0, 0); } while (0)
#define PG8_STAGE_A(bufoff, gbase, h, vg) do { if constexpr (GATHER) { PG8_STAGE(bufoff, gbase, (vg)[h]); } else { PG8_STAGE(bufoff, (gbase) + (h) * hstepA, voffA); } } while (0)
#define PG8_LDA(dst, b, h) do { _Pragma("unroll") for (int m = 0; m < 4; ++m) _Pragma("unroll") for (int k = 0; k < 2; ++k) dst[m][k] = *(const LAS bf16x8*)(lds + PG8_SA(b, h) + aoff + m * 2048 + k * 1024); } while (0)
#define PG8_LDB(dst, b, h) do { _Pragma("unroll") for (int n = 0; n < 2; ++n) _Pragma("unroll") for (int k = 0; k < 2; ++k) dst[n][k] = *(const LAS bf16x8*)(lds + PG8_SB(b, h) + boff + n * 2048 + k * 1024); } while (0)
#define PG8_MMA(ai, bj, At, Bt) do { __builtin_amdgcn_s_setprio(1); _Pragma("unroll") for (int m = 0; m < 4; ++m) _Pragma("unroll") for (int n = 0; n < 2; ++n) _Pragma("unroll") for (int k = 0; k < 2; ++k) \
        acc[ai][bj][m][n] = __builtin_amdgcn_mfma_f32_16x16x32_bf16(Bt[n][k], At[m][k], acc[ai][bj][m][n], 0, 0, 0); __builtin_amdgcn_s_setprio(0); } while (0)
#define PG8_WAIT_V(n) asm volatile("s_waitcnt vmcnt(" #n ")" ::: "memory")
#define PG8_WAIT_L(n) asm volatile("s_waitcnt lgkmcnt(" #n ")" ::: "memory")
#define PG8_BAR __builtin_amdgcn_s_barrier()
#define PG8_SCHED __builtin_amdgcn_sched_barrier(0)
#define PG8_GOFF(dst, u) do { if constexpr (GATHER) { if ((u).rows_lds >= 0) { _Pragma("unroll") for (int _h = 0; _h < 2; ++_h) _Pragma("unroll") for (int _i = 0; _i < 2; ++_i) \
        dst[_h][_i] = (unsigned)((const LAS int*)(lds + (u).rows_lds))[_h * HALF + R0 + 64 * _i] * a_rs + (unsigned)C0 * 2u; } else { _Pragma("unroll") for (int _h = 0; _h < 2; ++_h) _Pragma("unroll") for (int _i = 0; _i < 2; ++_i) \
        dst[_h][_i] = (unsigned)(u).rows[_h * HALF + R0 + 64 * _i] * a_rs + (unsigned)C0 * 2u; } } } while (0)
    GUnit cur, nxt; int ui = 0;
    if (!S.next(0, cur)) return;
    f32x4 acc[2][2][4][2];
#pragma unroll
    for (int a = 0; a < 2; ++a)
#pragma unroll
        for (int b = 0; b < 2; ++b)
#pragma unroll
            for (int m = 0; m < 4; ++m)
#pragma unroll
                for (int n = 0; n < 2; ++n) acc[a][b][m][n] = (f32x4){0.f, 0.f, 0.f, 0.f};
    bf16x8 At[4][2], B0[2][2], B1[2][2];
    const char* cA = uptr(cur.A); const char* cB0 = uptr(cur.B0); const char* cB1 = uptr(cur.B1); int cnt = __builtin_amdgcn_readfirstlane(cur.nt);
    PG8_GOFF(vgc, cur);
    if constexpr (SP2) {
        PG8_STAGE(PG8_SB(0, 0), cB0, voffB); PG8_STAGE(PG8_SB(0, 1), cB1, voffB); PG8_STAGE_A(PG8_SA(0, 0), cA, 0, vgc); PG8_STAGE_A(PG8_SA(0, 1), cA, 1, vgc);
        if (wr == 1) PG8_BAR;
        PG8_WAIT_V(2); PG8_BAR;
        PG8_STAGE(PG8_SB(1, 0), cB0 + kstep, voffB); PG8_STAGE_A(PG8_SA(1, 0), cA + kstep, 0, vgc); PG8_STAGE(PG8_SB(1, 1), cB1 + kstep, voffB);
        PG8_WAIT_V(6); PG8_BAR;
    } else {
        PG8_STAGE(PG8_SB(0, 0), cB0, voffB); PG8_STAGE_A(PG8_SA(0, 0), cA, 0, vgc); PG8_STAGE(PG8_SB(0, 1), cB1, voffB); PG8_STAGE_A(PG8_SA(0, 1), cA, 1, vgc);
        if (wr == 1) PG8_BAR;
        PG8_WAIT_V(4); PG8_BAR;
        PG8_STAGE(PG8_SB(1, 0), cB0 + kstep, voffB); PG8_STAGE_A(PG8_SA(1, 0), cA + kstep, 0, vgc); PG8_STAGE(PG8_SB(1, 1), cB1 + kstep, voffB);
        PG8_WAIT_V(6); PG8_BAR;
    }
    for (;;) {
        const bool has_next = S.next(ui + 1, nxt);
        const char* nA = uptr(has_next ? nxt.A : cA); const char* nB0 = uptr(has_next ? nxt.B0 : cB0); const char* nB1 = uptr(has_next ? nxt.B1 : cB1);
        if constexpr (GATHER) {
            if (has_next) { PG8_GOFF(vgn, nxt); }
            else {
#pragma unroll
                for (int _h = 0; _h < 2; ++_h)
#pragma unroll
                    for (int _i = 0; _i < 2; ++_i) vgn[_h][_i] = vgc[_h][_i];
            }
        }
        for (int t = 0; t < cnt; t += 2) {
            const bool last = (t == cnt - 2);
            const char* a1 = cA + (size_t)(t + 1) * kstep;
            const char* a2 = last ? nA : cA + (size_t)(t + 2) * kstep;
            const char* b2 = last ? nB0 : cB0 + (size_t)(t + 2) * kstep; const char* b2h = last ? nB1 : cB1 + (size_t)(t + 2) * kstep;
            const char* a3 = a2 + kstep; const char* b3 = b2 + kstep; const char* b3h = b2h + kstep;
            unsigned vg2[2][2];
            if constexpr (GATHER) {
#pragma unroll
                for (int _h = 0; _h < 2; ++_h)
#pragma unroll
                    for (int _i = 0; _i < 2; ++_i) vg2[_h][_i] = last ? vgn[_h][_i] : vgc[_h][_i];
            }
            if constexpr (SP2) {
            PG8_LDB(B0, 0, 0); PG8_LDB(B1, 0, 1); PG8_SCHED; PG8_LDA(At, 0, 0); PG8_STAGE_A(PG8_SA(1, 1), a1, 1, vgc);
            PG8_WAIT_V(8); PG8_WAIT_L(0); PG8_BAR; PG8_MMA(0, 0, At, B0); PG8_MMA(0, 1, At, B1); PG8_BAR; PG8_SCHED;
            PG8_LDA(At, 0, 1); PG8_STAGE(PG8_SB(0, 0), b2, voffB); PG8_STAGE(PG8_SB(0, 1), b2h, voffB); PG8_STAGE_A(PG8_SA(0, 0), a2, 0, vg2);
            PG8_WAIT_V(8); PG8_WAIT_L(0); PG8_BAR; PG8_MMA(1, 0, At, B0); PG8_MMA(1, 1, At, B1); PG8_BAR; PG8_SCHED;
            PG8_LDB(B0, 1, 0); PG8_LDB(B1, 1, 1); PG8_SCHED; PG8_LDA(At, 1, 0); PG8_STAGE_A(PG8_SA(0, 1), a2, 1, vg2);
            PG8_WAIT_V(8); PG8_WAIT_L(0); PG8_BAR; PG8_MMA(0, 0, At, B0); PG8_MMA(0, 1, At, B1); PG8_BAR; PG8_SCHED;
            PG8_LDA(At, 1, 1); PG8_STAGE(PG8_SB(1, 0), b3, voffB); PG8_STAGE(PG8_SB(1, 1), b3h, voffB); PG8_STAGE_A(PG8_SA(1, 0), a3, 0, vg2);
            PG8_WAIT_V(8); PG8_WAIT_L(0); PG8_BAR; PG8_MMA(1, 0, At, B0); PG8_MMA(1, 1, At, B1); PG8_BAR; PG8_SCHED;
            } else {
            PG8_LDB(B0, 0, 0); PG8_SCHED; PG8_LDA(At, 0, 0); PG8_STAGE_A(PG8_SA(1, 1), a1, 1, vgc);
            PG8_WAIT_L(8); PG8_BAR; PG8_WAIT_L(0); PG8_MMA(0, 0, At, B0); PG8_BAR; PG8_SCHED;
            PG8_LDB(B1, 0, 1); PG8_STAGE(PG8_SB(0, 0), b2, voffB);
            PG8_BAR; PG8_WAIT_L(0); PG8_MMA(0, 1, At, B1); PG8_BAR;
            PG8_LDA(At, 0, 1); PG8_STAGE_A(PG8_SA(0, 0), a2, 0, vg2);
            PG8_BAR; PG8_WAIT_L(0); PG8_MMA(1, 0, At, B0); PG8_BAR; PG8_SCHED;
            PG8_STAGE(PG8_SB(0, 1), b2h, voffB);
            PG8_WAIT_V(6); PG8_BAR; PG8_MMA(1, 1, At, B1); PG8_BAR;
            PG8_LDB(B0, 1, 0); PG8_SCHED; PG8_LDA(At, 1, 0); PG8_STAGE_A(PG8_SA(0, 1), a2, 1, vg2);
            PG8_WAIT_L(8); PG8_BAR; PG8_WAIT_L(0); PG8_MMA(0, 0, At, B0); PG8_BAR; PG8_SCHED;
            PG8_LDB(B1, 1, 1); PG8_STAGE(PG8_SB(1, 0), b3, voffB);
            PG8_BAR; PG8_WAIT_L(0); PG8_MMA(0, 1, At, B1); PG8_BAR;
            PG8_LDA(At, 1, 1); PG8_STAGE_A(PG8_SA(1, 0), a3, 0, vg2);
            PG8_BAR; PG8_WAIT_L(0); PG8_MMA(1, 0, At, B0); PG8_BAR; PG8_SCHED;
            PG8_STAGE(PG8_SB(1, 1), b3h, voffB);
            PG8_WAIT_V(6); PG8_BAR; PG8_MMA(1, 1, At, B1); PG8_BAR;
            }
        }
        if constexpr (ALIGN_EPI) { if (wr == 0) PG8_BAR; }
        { int l2 = lane_id(); asm volatile("" : "+v"(l2)); const int fr2 = l2 & 15, fq2 = l2 >> 4; E(acc, cur, wr, wc, fr2, fq2); }
        if (!has_next) break;
#pragma unroll
        for (int a = 0; a < 2; ++a)
#pragma unroll
            for (int b = 0; b < 2; ++b)
#pragma unroll
                for (int m = 0; m < 4; ++m)
#pragma unroll
                    for (int n = 0; n < 2; ++n) acc[a][b][m][n] = (f32x4){0.f, 0.f, 0.f, 0.f};
        cur = nxt; cA = nA; cB0 = nB0; cB1 = nB1; cnt = __builtin_amdgcn_readfirstlane(cur.nt); ++ui;
        if constexpr (GATHER) {
#pragma unroll
            for (int _h = 0; _h < 2; ++_h)
#pragma unroll
                for (int _i = 0; _i < 2; ++_i) vgc[_h][_i] = vgn[_h][_i];
        }
        if constexpr (ALIGN_EPI) { if (wr == 1) PG8_BAR; }
    }
    PG8_WAIT_V(0);
    if constexpr (!ALIGN_EPI) { if (wr == 0) PG8_BAR; }
    PG8_BAR;
#undef PG8_SA
#undef PG8_SB
#undef PG8_STAGE
#undef PG8_STAGE_A
#undef PG8_LDA
#undef PG8_LDB
#undef PG8_MMA
#undef PG8_WAIT_V
#undef PG8_WAIT_L
#undef PG8_BAR
#undef PG8_SCHED
#undef PG8_GOFF
}
}

struct Frame {
    LAS unsigned char* lds;
    volatile LAS unsigned* MISC;
    unsigned* ctl;
    unsigned char* ws;
    float* out;
    int wave, G, bid;
};
using pg8::GUnit;

template <class Fill> struct DenseSched {
    int nM, nN, G, c; Fill f;
    __device__ __forceinline__ bool next(int i, GUnit& u) const {
        const long L = (long)i * G + c; if (L >= (long)nM * nN) return false;
        int pm, pn; pg8::tile_order((int)L, nM, nN, pm, pn); u.pm = pm; u.pn = pn; u.rows = nullptr; u.rows_lds = -1; u.aux0 = 0; u.aux1 = 0; f(u); return true;
    }
};
struct FillPlain {
    const char* A; const char* B; unsigned a_rs, b_rs; int nt;
    __device__ __forceinline__ void operator()(GUnit& u) const { u.A = A + (size_t)u.pm * 256 * a_rs; u.B0 = B + (size_t)u.pn * 256 * b_rs; u.B1 = u.B0 + (size_t)128 * b_rs; u.nt = nt; }
};
struct FillQlatPool {
    const char* q; const char* diff; const char* wuk; const char* wpool;
    __device__ __forceinline__ void operator()(GUnit& u) const {
        if (u.pn < 8) { u.A = q + (size_t)u.pm * 256 * 2048 + (size_t)((u.pn & ~1) * 128) * 2; u.B0 = wuk + (size_t)u.pn * 256 * 512; }
        else { const int g = u.pn - 8; u.A = diff + (size_t)u.pm * 256 * 2048 + (size_t)(g * 256) * 2; u.B0 = wpool + (size_t)g * 256 * 512; }
        u.B1 = u.B0 + (size_t)128 * 512; u.nt = 4;
    }
};
struct FillO {
    const char* olat; const char* wuv;
    __device__ __forceinline__ void operator()(GUnit& u) const { u.A = olat + (size_t)u.pm * 256 * 4096 + (size_t)(u.pn * 512) * 2; u.B0 = wuv + (size_t)u.pn * 256 * 1024; u.B1 = u.B0 + (size_t)128 * 1024; u.nt = 8; }
};

#define EPI_LOOP_ROWS for (int ai = 0; ai < 2; ++ai) _Pragma("unroll") for (int m = 0; m < 4; ++m)
__device__ __forceinline__ u32x4 pack8(const f32x4 v0, const f32x4 v1) { u32x4 w; w.x = cvt_pk_bf16(v0[0], v0[1]); w.y = cvt_pk_bf16(v0[2], v0[3]); w.z = cvt_pk_bf16(v1[0], v1[1]); w.w = cvt_pk_bf16(v1[2], v1[3]); return w; }
__device__ __forceinline__ float sigmoidf_(float x) { return 1.0f / (1.0f + __expf(-x)); }

struct EpiP1 {
    bf16* q; bf16* qi; bf16* xp; bf16* gates; float* ckvraw; float* kiwi;
    __device__ __forceinline__ void operator()(const f32x4 (&acc)[2][2][4][2], const GUnit& u, int wr, int wc, int fr, int fq) const {
        const int row0 = u.pm * 256 + wr * 64 + fr, cl = wc * 32 + 8 * fq;
        if (u.pn < 28) {
            bf16* base; int ld, c0; bool sg = false;
            if (u.pn < 4) { base = q; ld = 1024; c0 = u.pn * 256; } else if (u.pn < 8) { base = qi; ld = 1024; c0 = (u.pn - 4) * 256; }
            else if (u.pn < 12) { base = xp; ld = 1024; c0 = (u.pn - 8) * 256; } else { base = gates; ld = 4096; c0 = (u.pn - 12) * 256; sg = true; }
#pragma unroll
            EPI_LOOP_ROWS { bf16* rowp = base + (size_t)(row0 + ai * 128 + m * 16) * ld + c0 + cl;
#pragma unroll
                for (int bj = 0; bj < 2; ++bj) { f32x4 v0 = acc[ai][bj][m][0], v1 = acc[ai][bj][m][1];
                    if (sg) {
#pragma unroll
                        for (int j = 0; j < 4; ++j) { v0[j] = sigmoidf_(v0[j]); v1[j] = sigmoidf_(v1[j]); } }
                    *(u32x4*)(rowp + bj * 128) = pack8(v0, v1); } }
        } else {
            float* base = (u.pn == 28) ? ckvraw : kiwi;
#pragma unroll
            EPI_LOOP_ROWS { float* rowp = base + (size_t)(row0 + ai * 128 + m * 16) * 256 + cl;
#pragma unroll
                for (int bj = 0; bj < 2; ++bj) { *(f32x4*)(rowp + bj * 128) = acc[ai][bj][m][0]; *(f32x4*)(rowp + bj * 128 + 4) = acc[ai][bj][m][1]; } }
        }
    }
};
struct EpiQlatPool {
    bf16* qlat; bf16* pool; const float* colscale;
    __device__ __forceinline__ void operator()(const f32x4 (&acc)[2][2][4][2], const GUnit& u, int wr, int wc, int fr, int fq) const {
        const int row0 = u.pm * 256 + wr * 64 + fr, cl = wc * 32 + 8 * fq;
        const bool ql = u.pn < 8;
        bf16* base = ql ? qlat + u.pn * 256 : pool + (u.pn - 8) * 256; const int ld = ql ? 2048 : 1024;
        const float* sp = colscale + u.pn * 256 + cl;
        __builtin_amdgcn_sched_barrier(0);
        const f32x4 s00 = *(const f32x4*)(sp), s01 = *(const f32x4*)(sp + 4), s10 = *(const f32x4*)(sp + 128), s11 = *(const f32x4*)(sp + 132);
#pragma unroll
        EPI_LOOP_ROWS { bf16* rowp = base + (size_t)(row0 + ai * 128 + m * 16) * ld + cl;
            *(u32x4*)(rowp) = pack8(acc[ai][0][m][0] * s00, acc[ai][0][m][1] * s01);
            *(u32x4*)(rowp + 128) = pack8(acc[ai][1][m][0] * s10, acc[ai][1][m][1] * s11); }
    }
};
struct EpiBf16 {
    bf16* O; int ld;
    __device__ __forceinline__ void operator()(const f32x4 (&acc)[2][2][4][2], const GUnit& u, int wr, int wc, int fr, int fq) const {
        const int row0 = u.pm * 256 + wr * 64 + fr, cl = u.pn * 256 + wc * 32 + 8 * fq;
#pragma unroll
        EPI_LOOP_ROWS { bf16* rowp = O + (size_t)(row0 + ai * 128 + m * 16) * ld + cl;
#pragma unroll
            for (int bj = 0; bj < 2; ++bj) *(u32x4*)(rowp + bj * 128) = pack8(acc[ai][bj][m][0], acc[ai][bj][m][1]); }
    }
};
__device__ __forceinline__ void unpack8(const u32x4 w, f32x4& a, f32x4& b) {
    a[0] = bf2f(w.x & 0xffffu); a[1] = bf2f(w.x >> 16); a[2] = bf2f(w.y & 0xffffu); a[3] = bf2f(w.y >> 16);
    b[0] = bf2f(w.z & 0xffffu); b[1] = bf2f(w.z >> 16); b[2] = bf2f(w.w & 0xffffu); b[3] = bf2f(w.w >> 16);
}
template <int MODE> struct EpiGate {
    const bf16* gates; bf16* M1; bf16* merged;
    __device__ __forceinline__ void operator()(const f32x4 (&acc)[2][2][4][2], const GUnit& u, int wr, int wc, int fr, int fq) const {
        const int row0 = u.pm * 256 + wr * 64 + fr, cl = u.pn * 256 + wc * 32 + 8 * fq;
#pragma unroll
        for (int ai = 0; ai < 2; ++ai) {
            u32x4 gq[4][2], mq[4][2];
#pragma unroll
            for (int m = 0; m < 4; ++m)
#pragma unroll
                for (int bj = 0; bj < 2; ++bj) { const size_t r = (size_t)(row0 + ai * 128 + m * 16); const int c = cl + bj * 128;
                    gq[m][bj] = *(const u32x4*)(gates + r * 4096 + (MODE ? 2048 : 0) + c); if (MODE) mq[m][bj] = *(const u32x4*)(M1 + r * 2048 + c); }
            __builtin_amdgcn_sched_barrier(0);
#pragma unroll
            for (int m = 0; m < 4; ++m)
#pragma unroll
                for (int bj = 0; bj < 2; ++bj) { const size_t r = (size_t)(row0 + ai * 128 + m * 16); const int c = cl + bj * 128;
                    f32x4 g0, g1; unpack8(gq[m][bj], g0, g1);
                    f32x4 v0 = acc[ai][bj][m][0] * g0, v1 = acc[ai][bj][m][1] * g1;
                    if (MODE) { f32x4 p0, p1; unpack8(mq[m][bj], p0, p1); v0 += p0; v1 += p1; *(u32x4*)(merged + r * 2048 + c) = pack8(v0, v1); }
                    else *(u32x4*)(M1 + r * 2048 + c) = pack8(v0, v1); }
            __builtin_amdgcn_sched_barrier(0);
        }
    }
};
struct EpiPre {
    const float* x; float* pre;
    __device__ __forceinline__ void operator()(const f32x4 (&acc)[2][2][4][2], const GUnit& u, int wr, int wc, int fr, int fq) const {
        const int row0 = u.pm * 256 + wr * 64 + fr, cl = u.pn * 256 + wc * 32 + 8 * fq;
#pragma unroll
        for (int ai = 0; ai < 2; ++ai) {
            f32x4 xq[4][2][2];
#pragma unroll
            for (int m = 0; m < 4; ++m)
#pragma unroll
                for (int bj = 0; bj < 2; ++bj) { const size_t o = (size_t)(row0 + ai * 128 + m * 16) * 2048 + cl + bj * 128; xq[m][bj][0] = __builtin_nontemporal_load((const f32x4*)(x + o)); xq[m][bj][1] = __builtin_nontemporal_load((const f32x4*)(x + o + 4)); }
            __builtin_amdgcn_sched_barrier(0);
#pragma unroll
            for (int m = 0; m < 4; ++m)
#pragma unroll
                for (int bj = 0; bj < 2; ++bj) { const size_t o = (size_t)(row0 + ai * 128 + m * 16) * 2048 + cl + bj * 128;
                    *(f32x4*)(pre + o) = xq[m][bj][0] * DN_ALPHA + acc[ai][bj][m][0]; *(f32x4*)(pre + o + 4) = xq[m][bj][1] * DN_ALPHA + acc[ai][bj][m][1]; }
            __builtin_amdgcn_sched_barrier(0);
        }
    }
};
constexpr int MOE_TAB_OFF = 131072, MOE_TAB_UNITS = 32, MOE_ROWS_OFF = 131072 + 512, MOE_ROWS_UNITS = 11;
struct MoeSched {
    const int* mtt; int nmt; int NT; int G, c; bool gateup;
    const char* h; const char* hbuf; const char* wgu; const char* wd; const int* rowlist; LAS unsigned char* lds;
    __device__ __forceinline__ int unit_of(int i) const {
        const int total = nmt * NT;
        if ((G & 7) == 0) { const int x = c & 7, j = i * (G >> 3) + (c >> 3); const int lo = (int)(((long)total * x) >> 3), hi = (int)(((long)total * (x + 1)) >> 3); const int U = lo + j; return U < hi ? U : -1; }
        const long L = (long)i * G + c; return L < total ? (int)L : -1;
    }
    __device__ __forceinline__ void prepare(int tid) const {
        LAS int* tab = (LAS int*)(lds + MOE_TAB_OFF);
        if (tid < MOE_TAB_UNITS) { const int U = unit_of(tid); int g = -1, p0 = 0, nv = 0, nt_ = 0;
            if (U >= 0) { const int MT = U / NT; nt_ = U - MT * NT; g = mtt[MT * 4 + 0]; p0 = mtt[MT * 4 + 1]; nv = mtt[MT * 4 + 2]; }
            tab[tid * 4 + 0] = g; tab[tid * 4 + 1] = p0; tab[tid * 4 + 2] = nv; tab[tid * 4 + 3] = nt_; }
        if (gateup) { LAS int* rw = (LAS int*)(lds + MOE_ROWS_OFF);
            for (int q = tid; q < MOE_ROWS_UNITS * 256; q += NTHR) { const int i = q >> 8, U = unit_of(i); if (U >= 0) { const int MT = U / NT; rw[q] = rowlist[mtt[MT * 4 + 1] + (q & 255)]; } } }
        __syncthreads();
    }
    __device__ __forceinline__ bool next(int i, GUnit& u) const {
        int g, p0, nv, nt_;
        if (i < MOE_TAB_UNITS) { const LAS int* tab = (const LAS int*)(lds + MOE_TAB_OFF); g = __builtin_amdgcn_readfirstlane(tab[i * 4 + 0]); p0 = __builtin_amdgcn_readfirstlane(tab[i * 4 + 1]); nv = __builtin_amdgcn_readfirstlane(tab[i * 4 + 2]); nt_ = __builtin_amdgcn_readfirstlane(tab[i * 4 + 3]); if (g < 0) return false; }
        else { const int U = unit_of(i); if (U < 0) return false; const int MT = U / NT; nt_ = U - MT * NT;
            g = __builtin_amdgcn_readfirstlane(mtt[MT * 4 + 0]); p0 = __builtin_amdgcn_readfirstlane(mtt[MT * 4 + 1]); nv = __builtin_amdgcn_readfirstlane(mtt[MT * 4 + 2]); }
        u.pm = p0; u.pn = nt_; u.aux0 = nv; u.aux1 = g; u.rows_lds = -1;
        if (gateup) { u.A = h; u.rows = rowlist + p0; if (i < MOE_ROWS_UNITS) u.rows_lds = MOE_ROWS_OFF + i * 1024; u.B0 = wgu + ((size_t)g * 1024 + (size_t)nt_ * 256) * 4096; u.B1 = u.B0 + (size_t)128 * 4096; u.nt = 32; }
        else { u.A = hbuf + (size_t)p0 * 1024; u.rows = nullptr; u.B0 = wd + ((size_t)g * 2048 + (size_t)nt_ * 256) * 1024; u.B1 = u.B0 + (size_t)128 * 1024; u.nt = 8; }
        return true;
    }
};
struct EpiSwiGLU {
    bf16* H;
    __device__ __forceinline__ void operator()(const f32x4 (&acc)[2][2][4][2], const GUnit& u, int wr, int wc, int fr, int fq) const {
        const int cl = u.pn * 128 + wc * 32 + 8 * fq;
#pragma unroll
        EPI_LOOP_ROWS { const int r = ai * 128 + wr * 64 + m * 16 + fr;
            if (r < u.aux0) { f32x4 v[2];
#pragma unroll
                for (int n = 0; n < 2; ++n)
#pragma unroll
                    for (int j = 0; j < 4; ++j) { const float g = acc[ai][0][m][n][j], up = acc[ai][1][m][n][j]; v[n][j] = g * sigmoidf_(g) * up; }
                *(u32x4*)(H + (size_t)(u.pm + r) * 512 + cl) = pack8(v[0], v[1]); } }
    }
};
struct EpiY {
    unsigned char* Y8; bf16* Ysh;
    __device__ __forceinline__ void operator()(const f32x4 (&acc)[2][2][4][2], const GUnit& u, int wr, int wc, int fr, int fq) const {
        const int cl = u.pn * 256 + wc * 32 + 8 * fq;
        if (u.aux1 == NE) {
#pragma unroll
            EPI_LOOP_ROWS { const int r = ai * 128 + wr * 64 + m * 16 + fr;
                if (r < u.aux0) { bf16* rowp = Ysh + (size_t)(u.pm - NTOK * 8 + r) * 2048 + cl;
#pragma unroll
                    for (int bj = 0; bj < 2; ++bj) *(u32x4*)(rowp + bj * 128) = pack8(acc[ai][bj][m][0], acc[ai][bj][m][1]); } }
        } else {
#pragma unroll
            for (int ai = 0; ai < 2; ++ai)
#pragma unroll
                for (int mp = 0; mp < 2; ++mp)
#pragma unroll
                    for (int bj = 0; bj < 2; ++bj) {
                        unsigned x[2], y[2];
#pragma unroll
                        for (int q = 0; q < 2; ++q) { const f32x4 v0 = acc[ai][bj][2 * mp + q][0], v1 = acc[ai][bj][2 * mp + q][1];
                            int w0 = __builtin_amdgcn_cvt_pk_fp8_f32(v0[0], v0[1], 0, false); w0 = __builtin_amdgcn_cvt_pk_fp8_f32(v0[2], v0[3], w0, true);
                            int w1 = __builtin_amdgcn_cvt_pk_fp8_f32(v1[0], v1[1], 0, false); w1 = __builtin_amdgcn_cvt_pk_fp8_f32(v1[2], v1[3], w1, true);
                            if (q == 0) { x[0] = (unsigned)w0; x[1] = (unsigned)w1; } else { y[0] = (unsigned)w0; y[1] = (unsigned)w1; } }
                        const u32x2 s0 = __builtin_amdgcn_permlane16_swap(x[0], y[0], false, false), s1 = __builtin_amdgcn_permlane16_swap(x[1], y[1], false, false);
                        const unsigned nx0 = s0[0], ny0 = s0[1], nx1 = s1[0], ny1 = s1[1];
                        const int m = 2 * mp + (fq & 1), r = ai * 128 + wr * 64 + m * 16 + fr;
                        if (r < u.aux0) { u32x4 o; o.x = nx0; o.y = nx1; o.z = ny0; o.w = ny1;
                            *(u32x4*)(Y8 + (size_t)(u.pm + r) * 2048 + u.pn * 256 + bj * 128 + wc * 32 + 16 * (fq >> 1)) = o; }
                    }
        }
    }
};

template <class RowMap>
__device__ __forceinline__ void tr_item(const float* W, int ldw, int nvalid, bf16* WT, int ldT, LAS float* scr, int kb, int nb, int lane, const RowMap& rm, const int ztwin = 0) {
    const int k0 = 64 * kb, n0 = 32 * nb;
    const int c4 = 4 * (lane & 7), kr = lane >> 3;
    f32x4 v[8];
#pragma unroll
    for (int i = 0; i < 8; ++i) { v[i] = (f32x4){0.f, 0.f, 0.f, 0.f}; if (n0 + c4 < nvalid) v[i] = __builtin_nontemporal_load((const f32x4*)(W + (size_t)(k0 + 8 * i + kr) * ldw + n0 + c4)); }
#pragma unroll
    for (int i = 0; i < 8; ++i) { LAS float* d = scr + (8 * i + kr) * 33 + c4; d[0] = v[i][0]; d[1] = v[i][1]; d[2] = v[i][2]; d[3] = v[i][3]; }
    LDS_WAIT(); asm volatile("" ::: "memory");
    const int c = lane & 7;
#pragma unroll
    for (int j = 0; j < 4; ++j) { const int nl = (lane >> 3) + 8 * j; const LAS float* s = scr + (8 * c) * 33 + nl;
        u32x4 o; o.x = cvt_pk_bf16(s[0 * 33], s[1 * 33]); o.y = cvt_pk_bf16(s[2 * 33], s[3 * 33]); o.z = cvt_pk_bf16(s[4 * 33], s[5 * 33]); o.w = cvt_pk_bf16(s[6 * 33], s[7 * 33]);
        if (n0 + nl < nvalid) { *(u32x4*)(WT + (size_t)rm(n0 + nl) * ldT + k0 + 8 * c) = o; if (ztwin) *(u32x4*)(WT + (size_t)rm(n0 + nl) * ldT + k0 + 8 * c + ztwin) = (u32x4){0u, 0u, 0u, 0u}; } }
    LDS_WAIT(); asm volatile("" ::: "memory");
}
struct MapId { int off; __device__ __forceinline__ int operator()(int n) const { return off + n; } };
struct MapWin {
    __device__ __forceinline__ int operator()(int n) const {
        if (n < 1024) return n;
        if (n < 1280) return 7168 + (n - 1024);
        if (n < 2304) return 1024 + (n - 1280);
        if (n < 2368) return 7424 + (n - 2304);
        if (n < 2384) return 7488 + (n - 2368);
        if (n < 3408) return 2048 + (n - 2384);
        return 3072 + (n - 3408);
    }
};
struct MapGU { int up; __device__ __forceinline__ int operator()(int f) const { return (f >> 7) * 256 + up * 128 + (f & 127); } };

__device__ __forceinline__ void phase_convert_small(Frame& F, const float* x, const float* w_in, const float* w_uk, const float* w_uv, const float* w_pool, const float* w_pa, const float* w_pp, const float* w_out, const float* pscale, const float* w_router) {
    const int lane_ = lane_id(), tid_ = F.wave * 64 + lane_;
    { float* wt = (float*)(F.ws + WS_WRT); for (size_t i = (size_t)F.bid * NTHR + tid_; i < (size_t)64 * 2048; i += (size_t)F.G * NTHR) { const int e = (int)(i >> 11), d = (int)(i & 2047); wt[i] = w_router[(size_t)d * 64 + e]; } }
    { float* cs = (float*)(F.ws + WS_CSCALE); for (size_t i = (size_t)F.bid * NTHR + tid_; i < 3072; i += (size_t)F.G * NTHR) cs[i] = (i < 2048) ? 1.0f : pscale[i - 2048]; }
    bf16* xb = (bf16*)(F.ws + WS_XB);
    const size_t gt = (size_t)F.bid * NTHR + tid_, nth = (size_t)F.G * NTHR;
    for (size_t i0 = gt; i0 < (size_t)NTOK * DM / 8; i0 += 4 * nth) {
        f32x4 a[4], b[4];
#pragma unroll
        for (int q = 0; q < 4; ++q) { const size_t i = i0 + q * nth; a[q] = __builtin_nontemporal_load((const f32x4*)x + 2 * i); b[q] = __builtin_nontemporal_load((const f32x4*)x + 2 * i + 1); }
        __builtin_amdgcn_sched_barrier(0);
#pragma unroll
        for (int q = 0; q < 4; ++q) { const size_t i = i0 + q * nth; u32x4 o; o.x = cvt_pk_bf16(a[q][0], a[q][1]); o.y = cvt_pk_bf16(a[q][2], a[q][3]); o.z = cvt_pk_bf16(b[q][0], b[q][1]); o.w = cvt_pk_bf16(b[q][2], b[q][3]); ((u32x4*)xb)[i] = o; }
    }
    LAS float* scr = (LAS float*)(F.lds + F.wave * 8704);
    const int gw = F.bid * NWAVES + F.wave, NGW = F.G * NWAVES;
    constexpr int I_IN = 32 * 235, I_POOL = 4 * 4 * 8, I_PA = 16 * 64, I_PP = 16 * 64, I_OUT = 32 * 64;
    constexpr int I_UV = 8 * 16;
    constexpr int NIT = I_IN + I_POOL + I_PA + I_PP + I_OUT + I_UV;
    for (int it = gw; it < NIT; it += NGW) {
        int r = it;
        if (r < I_IN) { tr_item(w_in, 7504, 7504, (bf16*)(F.ws + WS_WIN), 2048, scr, r / 235, r % 235, lane_, MapWin{}); continue; } r -= I_IN;
        if (r < I_POOL) { const int g = r / 32, q = r % 32; tr_item(w_pool + (size_t)g * 65536, 256, 256, (bf16*)(F.ws + WS_WPOOL) + (size_t)g * 65536, 256, scr, q / 8, q % 8, lane_, MapId{0}); continue; } r -= I_POOL;
        if (r < I_PA) { tr_item(w_pa, 2048, 2048, (bf16*)(F.ws + WS_WPA), 1024, scr, r / 64, r % 64, lane_, MapId{0}); continue; } r -= I_PA;
        if (r < I_PP) { tr_item(w_pp, 2048, 2048, (bf16*)(F.ws + WS_WPP), 1024, scr, r / 64, r % 64, lane_, MapId{0}); continue; } r -= I_PP;
        if (r < I_OUT) { tr_item(w_out, 2048, 2048, (bf16*)(F.ws + WS_WOUT), 2048, scr, r / 64, r % 64, lane_, MapId{0}); continue; } r -= I_OUT;
        {
          const int h = r / 16, q = r % 16, pn = h >> 1, hh = h & 1;
          tr_item(w_uv + h * 128, 1024, 128, (bf16*)(F.ws + WS_WUV) + (size_t)(pn * 256 + hh * 128) * 512 + hh * 256, 512, scr, q / 4, q % 4, lane_, MapId{0}, hh ? -256 : 256); }
    }
    { bf16* wp = (bf16*)(F.ws + WS_WIN) + (size_t)7504 * 2048; for (size_t i = gt; i < (size_t)176 * 2048 / 8; i += nth) ((u32x4*)wp)[i] = (u32x4){0u, 0u, 0u, 0u}; }
    { const float* wuk = w_uk; bf16* o = (bf16*)(F.ws + WS_WUK);
      for (size_t i = gt; i < (size_t)2048 * 256; i += nth) { const int kp = (int)(i & 255), row = (int)(i >> 8), h = row >> 8, r = row & 255;
          o[i] = ((kp >> 7) == (h & 1)) ? (bf16)f2bf(wuk[(size_t)r * 1024 + h * 128 + (kp & 127)]) : (bf16)0; } }
}

struct ExpW { const float* wge; const float* wue; const float* wde; const float* wgs; const float* wus; const float* wds; };
struct CvItem { const float* src; bf16* dst; int ldw, ldT, kind; };
__device__ __forceinline__ void cv_decode(Frame& F, const ExpW& W, const int it, const float*& src, int& ldw, bf16*& dst, int& ldT, int& kind, int& n0) {
    constexpr int PER = 1536;
    const int g = it / PER; int r = it - g * PER;
    if (r < 1024) { kind = r >> 9; r &= 511; const int kb = r >> 4, nb = r & 15; n0 = 32 * nb; ldw = 512; ldT = 2048;
        const float* wsrc = (g < NE) ? (kind ? W.wue : W.wge) + (size_t)g * 2048 * 512 : (kind ? W.wus : W.wgs);
        src = wsrc + (size_t)(64 * kb) * 512 + n0; dst = (bf16*)(F.ws + WS_WGU) + (size_t)g * 1024 * 2048 + 64 * kb; }
    else { kind = 2; r -= 1024; const int kb = r >> 6, nb = r & 63; n0 = 32 * nb; ldw = 2048; ldT = 512;
        const float* wsrc = (g < NE) ? W.wde + (size_t)g * 512 * 2048 : W.wds;
        src = wsrc + (size_t)(64 * kb) * 2048 + n0; dst = (bf16*)(F.ws + WS_WD) + (size_t)g * 2048 * 512 + 64 * kb; }
}
__device__ __forceinline__ void cv_load(f32x4 (&v)[8], const float* src, const int ldw, const int lane) {
    const int c4 = 4 * (lane & 7), kr = lane >> 3;
#pragma unroll
    for (int i = 0; i < 8; ++i) v[i] = __builtin_nontemporal_load((const f32x4*)(src + (size_t)(8 * i + kr) * ldw + c4));
}
__device__ __forceinline__ void cv_finish(const f32x4 (&v)[8], bf16* dst, const int ldT, const int kind, const int n0, LAS float* scr, const int lane) {
    const int c4 = 4 * (lane & 7), kr = lane >> 3;
#pragma unroll
    for (int i = 0; i < 8; ++i) { LAS float* d = scr + (8 * i + kr) * 33 + c4; d[0] = v[i][0]; d[1] = v[i][1]; d[2] = v[i][2]; d[3] = v[i][3]; }
    LDS_WAIT(); asm volatile("" ::: "memory");
    const int c = lane & 7;
#pragma unroll
    for (int j = 0; j < 4; ++j) { const int nl = (lane >> 3) + 8 * j; const LAS float* s = scr + (8 * c) * 33 + nl;
        u32x4 o; o.x = cvt_pk_bf16(s[0 * 33], s[1 * 33]); o.y = cvt_pk_bf16(s[2 * 33], s[3 * 33]); o.z = cvt_pk_bf16(s[4 * 33], s[5 * 33]); o.w = cvt_pk_bf16(s[6 * 33], s[7 * 33]);
        const int n = n0 + nl; const int row = (kind == 2) ? n : (n >> 7) * 256 + kind * 128 + (n & 127);
        __builtin_nontemporal_store(o, (u32x4*)(dst + (size_t)row * ldT + 8 * c)); }
    LDS_WAIT(); asm volatile("" ::: "memory");
}
template <int BATCH>
__device__ __forceinline__ bool convert_batch(Frame& F, const ExpW& W, LAS float* scr, const int lane_) {
    constexpr int NIT = NGRP * 1536;
    int base = 0;
    if (lane_ == 0) base = (int)__hip_atomic_fetch_add(F.ctl + CW_CVQ, (unsigned)BATCH, RLX_AGENT);
    base = __builtin_amdgcn_readfirstlane(base);
    if (base >= NIT) return false;
    const int end = (base + BATCH < NIT) ? base + BATCH : NIT;
    const float* src; bf16* dst; int ldw, ldT, kind, n0;
    cv_decode(F, W, base, src, ldw, dst, ldT, kind, n0);
    f32x4 va[8], vb[8];
    cv_load(va, src, ldw, lane_);
    for (int it = base; it < end; it += 2) {
        const float* src2 = src; bf16* dst2 = dst; int ldw2 = ldw, ldT2 = ldT, kind2 = kind, n02 = n0;
        if (it + 1 < end) { cv_decode(F, W, it + 1, src2, ldw2, dst2, ldT2, kind2, n02); cv_load(vb, src2, ldw2, lane_); }
        __builtin_amdgcn_sched_barrier(0);
        cv_finish(va, dst, ldT, kind, n0, scr, lane_);
        if (it + 1 < end) {
            if (it + 2 < end) { cv_decode(F, W, it + 2, src, ldw, dst, ldT, kind, n0); cv_load(va, src, ldw, lane_); }
            __builtin_amdgcn_sched_barrier(0);
            cv_finish(vb, dst2, ldT2, kind2, n02, scr, lane_);
        }
    }
    return true;
}
__device__ __forceinline__ void phase_convert_experts(Frame& F, const ExpW& W) {
    const int lane_ = lane_id();
    LAS float* scr = (LAS float*)(F.lds + 32768 + F.wave * 8704);
    while (convert_batch<8>(F, W, scr, lane_)) {}
}

__device__ __forceinline__ void phase_postproc(Frame& F, const float* cg, const float* kg, const float* kb) {
    const int lane_ = lane_id(), tid_ = F.wave * 64 + lane_;
    const float* ckvraw = (const float*)(F.ws + WS_CKVRAW); const float* kiwi = (const float*)(F.ws + WS_KIWI);
    unsigned* ckvn = (unsigned*)(F.ws + WS_CKVN); bf16* kin = (bf16*)(F.ws + WS_KIN); float* wis = (float*)(F.ws + WS_WI);
    const int gw = F.bid * NWAVES + F.wave, NGW = F.G * NWAVES, lane = lane_;
    const f32x4 g4 = *(const f32x4*)(cg + lane * 4); const float kgl = kg[lane], kbl = kb[lane];
    for (int t0 = gw; t0 < NTOK; t0 += 4 * NGW) {
        f32x4 v[4]; float kv[4], wv[4];
#pragma unroll
        for (int q = 0; q < 4; ++q) { const int t = t0 + q * NGW; v[q] = (f32x4){0.f, 0.f, 0.f, 0.f}; kv[q] = 0.f; wv[q] = 0.f;
            if (t < NTOK) { v[q] = *(const f32x4*)(ckvraw + (size_t)t * 256 + lane * 4); kv[q] = kiwi[(size_t)t * 256 + lane]; wv[q] = kiwi[(size_t)t * 256 + 64 + (lane & 15)]; } }
#pragma unroll
        for (int q = 0; q < 4; ++q) { const int t = t0 + q * NGW;
            const float ss = wave_sum(v[q][0] * v[q][0] + v[q][1] * v[q][1] + v[q][2] * v[q][2] + v[q][3] * v[q][3]);
            const float rs = 1.0f / sqrtf(ss * (1.0f / 256.0f) + RMS_EPS);
            int o8 = __builtin_amdgcn_cvt_pk_fp8_f32(v[q][0] * rs * g4[0], v[q][1] * rs * g4[1], 0, false);
            o8 = __builtin_amdgcn_cvt_pk_fp8_f32(v[q][2] * rs * g4[2], v[q][3] * rs * g4[3], o8, true);
            const float mu = wave_sum(kv[q]) * (1.0f / 64.0f); const float dlt = kv[q] - mu;
            const float var = wave_sum(dlt * dlt) * (1.0f / 64.0f);
            const float y = dlt * (1.0f / sqrtf(var + LN_EPS)) * kgl + kbl;
            if (t < NTOK) { ckvn[(size_t)t * 64 + lane] = (unsigned)o8; kin[(size_t)t * 64 + lane] = (bf16)f2bf(y); if (lane < 16) wis[(size_t)t * 16 + lane] = wv[q] * 0.03125f; } }
    }
    const bf16* xp = (const bf16*)(F.ws + WS_XP); bf16* diff = (bf16*)(F.ws + WS_DIFF);
    const size_t gt = (size_t)F.bid * NTHR + tid_, nth = (size_t)F.G * NTHR;
    for (size_t i = gt; i < (size_t)(NTOK / 16) * 128; i += nth) {
        const int run = (int)(i >> 7), cgp = (int)(i & 127), g = cgp >> 5, win = 2 << g, tb = run * 16, posb = tb & (SEQ - 1);
        const bf16* col = xp + cgp * 8;
        u32x4 rw[31];
#pragma unroll
        for (int j = 0; j < 31; ++j) { const int dr = j - 15; rw[j] = (u32x4){0u, 0u, 0u, 0u}; if (dr >= 1 - win && posb + dr >= 0) rw[j] = *(const u32x4*)(col + (size_t)(tb + dr) * 1024); }
        __builtin_amdgcn_sched_barrier(0);
        f32x4 s0 = {0.f, 0.f, 0.f, 0.f}, s1 = {0.f, 0.f, 0.f, 0.f};
#pragma unroll
        for (int j = 1; j < 16; ++j) { if (j < win) { f32x4 a, b; unpack8(rw[15 - j], a, b); s0 += a; s1 += b; } }
#pragma unroll
        for (int q = 0; q < 16; ++q) { const int t = tb + q, pos = posb + q;
            f32x4 a, b; unpack8(rw[15 + q], a, b); s0 += a; s1 += b;
            const int cntw = (pos + 1 < win) ? pos + 1 : win; const float inv = 1.0f / (float)cntw;
            *(u32x4*)(diff + (size_t)t * 1024 + cgp * 8) = pack8(s0 * inv - a, s1 * inv - b);
            f32x4 c, d; const u32x4 r2 = rw[15 + q - 1], r4 = rw[15 + q - 3], r8 = rw[15 + q - 7], r16 = rw[15 + q - 15];
            const u32x4 rr = (win == 2) ? r2 : (win == 4) ? r4 : (win == 8) ? r8 : r16;
            unpack8(rr, c, d); s0 -= c; s1 -= d; }
    }
}

__device__ __forceinline__ size_t score_rowbase(int b, int p) { const int jq = p >> 7; return (size_t)b * SC_TOT + (size_t)16384 * (size_t)(jq * (jq + 1) / 2) + (size_t)(p & 127) * (size_t)(128 * (jq + 1)); }

__device__ __forceinline__ void phase_index_scores(Frame& F) {
    const int lane_ = lane_id(), tid_ = F.wave * 64 + lane_;
    const bf16* qi = (const bf16*)(F.ws + WS_QI); const bf16* kin = (const bf16*)(F.ws + WS_KIN); const float* wis = (const float*)(F.ws + WS_WI);
    _Float16* scores = (_Float16*)(F.ws + WS_SCORES);
    const int lane = lane_, w = F.wave, fq = lane >> 4, j16 = lane & 15, tid = tid_;
    constexpr int NQ = 4;
    LAS unsigned char* kb = F.lds;
    const int sR = tid >> 3, sc = tid & 7, sP = (sR & 3) * 16 + (sR >> 2);
    const int st_off = sP * 128 + ((sc ^ ((sP >> 1) & 7)) * 16);
    for (int it = 0;; ++it) {
        const int jj = (it >> 1) * F.G + F.bid; if (jj >= 256) break;
        const int s = (it & 1) ? 511 - jj : jj;
        const int b = s & 1, qg = s >> 1, tq0 = qg * 32;
        const int nk64 = (tq0 + 32 + 63) / 64, nsteps = (nk64 + NQ - 1) / NQ;
        bf16x8 Af[4][2];
        { const size_t tok = (size_t)b * SEQ + tq0 + 4 * w + (j16 >> 2);
#pragma unroll
          for (int g = 0; g < 4; ++g)
#pragma unroll
              for (int ks = 0; ks < 2; ++ks) Af[g][ks] = *(const bf16x8*)(qi + tok * 1024 + (4 * g + (j16 & 3)) * 64 + ks * 32 + 8 * fq); }
        f32x4 wv[4];
        { const size_t tok = (size_t)b * SEQ + tq0 + 4 * w + fq;
#pragma unroll
          for (int g = 0; g < 4; ++g) wv[g] = *(const f32x4*)(wis + tok * 16 + 4 * g); }
        _Float16* orow = scores + score_rowbase(b, tq0 + 4 * w + fq);
        const bf16* kbase = kin + (size_t)b * SEQ * 64 + (size_t)sR * 64 + sc * 8;
        u32x4 stg[NQ];
#pragma unroll
        for (int q = 0; q < NQ; ++q) { const int h = (q < nk64) ? q : nk64 - 1; stg[q] = *(const u32x4*)(kbase + (size_t)h * 4096); }
        __syncthreads();
#pragma unroll
        for (int q = 0; q < NQ; ++q) *(LAS u32x4*)(kb + q * 8192 + st_off) = stg[q];
        __syncthreads();
        for (int step = 0; step < nsteps; ++step) {
            const int cur = step & 1;
            if (step + 1 < nsteps) {
#pragma unroll
                for (int q = 0; q < NQ; ++q) { int h = NQ * (step + 1) + q; h = (h < nk64) ? h : nk64 - 1; stg[q] = *(const u32x4*)(kbase + (size_t)h * 4096); } }
#pragma unroll
            for (int hh = 0; hh < NQ; ++hh) {
                f32x4 res;
#pragma unroll
                for (int u = 0; u < 4; ++u) {
                    const int P = u * 16 + j16;
                    f32x4 a4[4];
#pragma unroll
                    for (int g = 0; g < 4; ++g) a4[g] = (f32x4){0.f, 0.f, 0.f, 0.f};
#pragma unroll
                    for (int ks = 0; ks < 2; ++ks) {
                        const bf16x8 bfr = *(const LAS bf16x8*)(kb + cur * (NQ * 8192) + hh * 8192 + P * 128 + (((fq + 4 * ks) ^ ((P >> 1) & 7)) * 16));
#pragma unroll
                        for (int g = 0; g < 4; ++g) a4[g] = __builtin_amdgcn_mfma_f32_16x16x32_bf16(Af[g][ks], bfr, a4[g], 0, 0, 0);
                    }
                    float sres = 0.f;
#pragma unroll
                    for (int g = 0; g < 4; ++g)
#pragma unroll
                        for (int r = 0; r < 4; ++r) { const float xf = a4[g][r]; const int xb = __float_as_int(xf); const float rl = __int_as_float(xb > 0 ? xb : 0), wg = wv[g][r]; asm("v_fmac_f32 %0, %1, %2" : "+v"(sres) : "v"(wg), "v"(rl)); }
                    res[u] = sres;
                }
                const int hg = NQ * step + hh;
                if (hg < nk64) { typedef __fp16 h2 __attribute__((ext_vector_type(2))); const h2 lo = __builtin_amdgcn_cvt_pkrtz(res[0], res[1]), hi = __builtin_amdgcn_cvt_pkrtz(res[2], res[3]);
                    u32x2 o; o.x = __builtin_bit_cast(unsigned, lo); o.y = __builtin_bit_cast(unsigned, hi); *(u32x2*)(orow + hg * 64 + 4 * j16) = o; }
            }
            if (step + 1 < nsteps) {
#pragma unroll
                for (int q = 0; q < NQ; ++q) *(LAS u32x4*)(kb + (cur ^ 1) * (NQ * 8192) + q * 8192 + st_off) = stg[q]; }
            __syncthreads();
        }
    }
}

__device__ __forceinline__ unsigned fkey(float f) { const unsigned u = __float_as_uint(f); return (u & 0x80000000u) ? ~u : (u | 0x80000000u); }

__device__ __forceinline__ f32x4 h4_to_f4(const u32x2 q) { typedef _Float16 h2 __attribute__((ext_vector_type(2))); const unsigned qx = q.x, qy = q.y;
    const h2 a = __builtin_bit_cast(h2, qx), b = __builtin_bit_cast(h2, qy); const _Float16 a0 = a[0], a1 = a[1], b0 = b[0], b1 = b[1]; return (f32x4){(float)a0, (float)a1, (float)b0, (float)b1}; }
template <int NV>
__device__ __forceinline__ void select_row(const _Float16* row, int n, unsigned short* sel, int lane) {
    unsigned u[NV][4];
#pragma unroll
    for (int i = 0; i < NV; ++i) {
        const int base = i * 256 + lane * 4;
        f32x4 v = {0.f, 0.f, 0.f, 0.f};
        if (base < n) v = h4_to_f4(*(const u32x2*)(row + base));
#pragma unroll
        for (int e = 0; e < 4; ++e) u[i][e] = (base + e < n) ? fkey(v[e]) : 0u;
    }
    unsigned T = 0u; int cntT = n;
    bool exact = false;
    for (int bit = 31; bit >= 0; --bit) {
        const unsigned cand = T | (1u << bit);
        int c = 0;
#pragma unroll
        for (int i = 0; i < NV; ++i)
#pragma unroll
            for (int e = 0; e < 4; ++e) c += (u[i][e] >= cand) ? 1 : 0;
        c = wave_sum_i(c);
        if (c >= TOPK) { T = cand; cntT = c; if (c == TOPK) { exact = true; break; } }
    }
    int cgt = 0;
    if (!exact) {
#pragma unroll
        for (int i = 0; i < NV; ++i)
#pragma unroll
            for (int e = 0; e < 4; ++e) cgt += (u[i][e] > T) ? 1 : 0;
        cgt = wave_sum_i(cgt);
    }
    int pg = 0, pe = exact ? 0 : cgt;
    const unsigned long long lt = (1ull << lane) - 1ull;
#pragma unroll
    for (int i = 0; i < NV; ++i)
#pragma unroll
        for (int e = 0; e < 4; ++e) {
            const unsigned val = u[i][e]; const int idx = i * 256 + lane * 4 + e;
            const bool gsel = exact ? (val >= T) : (val > T);
            const unsigned long long mg = __ballot(gsel);
            if (gsel) sel[pg + __popcll(mg & lt)] = (unsigned short)idx;
            pg += __popcll(mg);
            if (!exact) {
                const bool esel = (val == T);
                const unsigned long long me = __ballot(esel);
                const int pos = pe + __popcll(me & lt);
                if (esel && pos < TOPK) sel[pos] = (unsigned short)idx;
                pe += __popcll(me);
            }
        }
}

template <int NV>
__device__ __forceinline__ bool select_row_hist(const _Float16* row, int n, unsigned short* sel, int lane, LAS unsigned* hist) {
    LAS unsigned* cnts = hist + 4097;
    LAS unsigned* tiel = hist + 4100;
    unsigned u[NV][4];
#pragma unroll
    for (int i = 0; i < NV; ++i) { const int base = i * 256 + lane * 4; u32x2 rq = {0u, 0u}; if (base < n) rq = *(const u32x2*)(row + base); const f32x4 t4 = h4_to_f4(rq); u[i][0] = __float_as_uint(t4[0]); u[i][1] = __float_as_uint(t4[1]); u[i][2] = __float_as_uint(t4[2]); u[i][3] = __float_as_uint(t4[3]); }
#pragma unroll
    for (int q = 0; q < 17; ++q) { const int w = q * 256 + lane * 4; if (w < 4104) *(LAS u32x4*)(hist + w) = (u32x4){0u, 0u, 0u, 0u}; }
    const float v00 = __uint_as_float(u[0][0]);
    float mn = v00, mx = v00;
#define SR_MM(i_, MASKED) do { _Pragma("unroll") for (int e = 0; e < 4; ++e) { float x = __uint_as_float(u[i_][e]); if (MASKED) x = ((i_) * 256 + lane * 4 + e < n) ? x : v00; mn = fminf(mn, x); mx = fmaxf(mx, x); } } while (0)
#pragma unroll
    for (int i = 0; i < NV; ++i) {
        if (i < NV - 8) SR_MM(i, false);
        else { const int rem = n - i * 256; if (rem >= 256) SR_MM(i, false); else if (rem > 0) SR_MM(i, true); }
    }
#undef SR_MM
    mn = wave_min(mn); mx = wave_max(mx);
    if (!(mx > mn)) {
#pragma unroll
        for (int q = 0; q < 4; ++q) sel[q * 64 + lane] = (unsigned short)(q * 64 + lane);
        return true;
    }
    const float scale = 4095.5f / (mx - mn), off = -mn * scale;
#define SR_KEY(i_, MASKED) do { _Pragma("unroll") for (int e = 0; e < 4; ++e) { unsigned k = (unsigned)fmaf(__uint_as_float(u[i_][e]), scale, off); k = k > 4095u ? 4095u : k; \
        if (MASKED) k = ((i_) * 256 + lane * 4 + e < n) ? k : 4096u; u[i_][e] = k; __hip_atomic_fetch_add(hist + k, 1u, __ATOMIC_RELAXED, __HIP_MEMORY_SCOPE_WORKGROUP); } } while (0)
#pragma unroll
    for (int i = 0; i < NV; ++i) {
        if (i < NV - 8) SR_KEY(i, false);
        else { const int rem = n - i * 256; if (rem >= 256) SR_KEY(i, false); else if (rem > 0) SR_KEY(i, true); else { u[i][0] = 4096u; u[i][1] = 4096u; u[i][2] = 4096u; u[i][3] = 4096u; } }
    }
#undef SR_KEY
    LDS_WAIT();
    unsigned sl = 0;
#pragma unroll
    for (int q = 0; q < 16; ++q) { const u32x4 t4 = *(const LAS u32x4*)(hist + 64 * lane + 4 * q); sl += (t4[0] + t4[1]) + (t4[2] + t4[3]); }
    const unsigned pre = (unsigned)wave_scan_i((int)sl);
    const unsigned total = (unsigned)__builtin_amdgcn_readlane((int)pre, 63), above = total - pre;
    const bool mine = (above < (unsigned)TOPK) && (above + sl >= (unsigned)TOPK);
    const int src = __builtin_amdgcn_readfirstlane(__ffsll((unsigned long long)__ballot(mine)) - 1);
    const unsigned above_src = (unsigned)__builtin_amdgcn_readlane((int)above, src);
    const unsigned hj = hist[64 * src + lane];
    const unsigned pj = (unsigned)wave_scan_i((int)hj);
    const unsigned cj = above_src + ((unsigned)__builtin_amdgcn_readlane((int)pj, 63) - pj);
    const bool hit = (cj < (unsigned)TOPK) && (cj + hj >= (unsigned)TOPK);
    const int hl = __builtin_amdgcn_readfirstlane(__ffsll((unsigned long long)__ballot(hit)) - 1);
    const unsigned bstar = (unsigned)(64 * src + hl), cgt = (unsigned)__builtin_amdgcn_readlane((int)cj, hl), mt = (unsigned)__builtin_amdgcn_readlane((int)hj, hl);
    int pg = 0; const unsigned span = 4095u - bstar;
#pragma unroll
    for (int i = 0; i < NV; ++i)
#pragma unroll
        for (int e = 0; e < 4; ++e) { const unsigned k = u[i][e]; const int idx = i * 256 + lane * 4 + e;
            const bool gsel = (k - bstar - 1u) < span;
            const unsigned long long mg = __ballot(gsel);
            if (mg) { if (gsel) sel[pg + (int)__builtin_amdgcn_mbcnt_hi((unsigned)(mg >> 32), __builtin_amdgcn_mbcnt_lo((unsigned)mg, 0u))] = (unsigned short)idx; pg += __popcll(mg); }
            if (k == bstar) { const unsigned p = __hip_atomic_fetch_add(cnts + 1, 1u, __ATOMIC_RELAXED, __HIP_MEMORY_SCOPE_WORKGROUP); if (p < 64u) tiel[p] = (unsigned)idx; } }
    LDS_WAIT();
    const int need = TOPK - (int)cgt;
    if (mt <= 64u) {
        int idx = 0x7fffffff; float val = -INFINITY;
        if (lane < (int)mt) { idx = (int)tiel[lane]; val = (float)row[idx]; }
        int rk = 0;
        for (int j = 0; j < (int)mt; ++j) { const float o = __shfl(val, j); const int oi = __shfl(idx, j); rk += (o > val || (o == val && oi < idx)) ? 1 : 0; }
        if (lane < (int)mt && rk < need) sel[cgt + rk] = (unsigned short)idx;
        return true;
    }
    return false;
}

__device__ __forceinline__ void phase_select(Frame& F, const ExpW& W, const bool ride) {
    const int lane = lane_id();
    LAS unsigned* hist = (LAS unsigned*)(F.lds + F.wave * 17408);
    const _Float16* scores = (const _Float16*)(F.ws + WS_SCORES);
    unsigned short* selb = (unsigned short*)(F.ws + WS_SEL);
    const int gw = F.bid * NWAVES + F.wave, NGW = F.G * NWAVES;
    for (int it = 0;; ++it) {
        const int jj = (it >> 1) * NGW + gw; if (jj >= NTOK / 2) break;
        const int s = (it & 1) ? NTOK - 1 - jj : jj;
        const int b = s & 1, p = s >> 1, n = p + 1;
        unsigned short* sel = selb + ((size_t)b * SEQ + p) * TOPK;
        if (n <= TOPK) {
#pragma unroll
            for (int q = 0; q < 4; ++q) { const int i = q * 64 + lane; sel[i] = (i < n) ? (unsigned short)i : (unsigned short)0xFFFFu; }
        } else {
            const _Float16* row = scores + score_rowbase(b, p);
            bool ok;
            if (n <= 2048) ok = select_row_hist<8>(row, n, sel, lane, hist);
            else if (n <= 4096) ok = select_row_hist<16>(row, n, sel, lane, hist);
            else if (n <= 6144) ok = select_row_hist<24>(row, n, sel, lane, hist);
            else ok = select_row_hist<32>(row, n, sel, lane, hist);
            asm volatile("" ::: "memory");
            if (!ok) select_row<32>(row, n, sel, lane);
        }
    }
}

typedef int v2i_t __attribute__((ext_vector_type(2)));
__device__ __forceinline__ long mk_long(const unsigned lo, const unsigned hi) { return (long)(((unsigned long long)hi << 32) | lo); }
__device__ __forceinline__ void phase_sparse_attn(Frame& F, const ExpW& W, const bool ride) {
    const int lane = lane_id();
    const bf16* qlat = (const bf16*)(F.ws + WS_QLAT); const unsigned char* ckv8 = (const unsigned char*)(F.ws + WS_CKVN);
    const unsigned short* selb = (const unsigned short*)(F.ws + WS_SEL); bf16* olat = (bf16*)(F.ws + WS_OLAT);
    const int fq = lane >> 4, j16 = lane & 15;
    LAS unsigned char* cb = F.lds + F.wave * 9216;
    LAS unsigned short* ksel = (LAS unsigned short*)(cb + 8704);
    const float sl2 = 0.08838834764831845f * 1.4426950408889634f;
    const int xh = (F.G % 8 == 0) ? ((F.bid & 7) >> 2) : 0, nsplit = (F.G % 8 == 0) ? 2 : 1;
    const int wloc = (F.G % 8 == 0) ? (((F.bid >> 3) * 4 + (F.bid & 3)) * NWAVES + F.wave) : (F.bid * NWAVES + F.wave);
    const int nwl = (F.G % 8 == 0) ? (F.G / 2) * NWAVES : F.G * NWAVES;
    const int ntk = NTOK / nsplit;
    const int qk_off = (2 * j16) * 272 + 8 * fq;
    const int tq = j16 >> 1, tp = j16 & 1;
    const int tr_off = ((tq < 4) ? 2 * (4 * fq + tq) : 2 * (4 * fq + tq - 4) + 1) * 272 + 8 * tp;
    for (int tl = wloc; tl < ntk; tl += nwl) {
        const int t = xh * ntk + tl, b = t / SEQ, pos = t % SEQ;
        const int nvalid = (pos + 1 < TOPK) ? pos + 1 : TOPK;
        const bool fullk = (nvalid == TOPK);
        const unsigned short* sel = selb + (size_t)t * TOPK;
        const u32x2 sv = __builtin_nontemporal_load((const u32x2*)(sel + 4 * lane));
        long Qf[8];
#pragma unroll
        for (int ks = 0; ks < 8; ++ks) { u32x4 z = {0u, 0u, 0u, 0u}; if (j16 < 8) z = __builtin_nontemporal_load((const u32x4*)(qlat + ((size_t)t * 8 + j16) * 256 + ks * 32 + 8 * fq));
            const unsigned z0 = z[0], z1 = z[1], z2 = z[2], z3 = z[3];
            int w0 = __builtin_amdgcn_cvt_pk_fp8_f32(bf2f(z0 & 0xffffu), bf2f(z0 >> 16), 0, false); w0 = __builtin_amdgcn_cvt_pk_fp8_f32(bf2f(z1 & 0xffffu), bf2f(z1 >> 16), w0, true);
            int w1 = __builtin_amdgcn_cvt_pk_fp8_f32(bf2f(z2 & 0xffffu), bf2f(z2 >> 16), 0, false); w1 = __builtin_amdgcn_cvt_pk_fp8_f32(bf2f(z3 & 0xffffu), bf2f(z3 >> 16), w1, true);
            Qf[ks] = mk_long((unsigned)w0, (unsigned)w1); }
        float mrun = -INFINITY, lrun = 0.f;
        f32x4 O[16];
#pragma unroll
        for (int rt = 0; rt < 16; ++rt) O[rt] = (f32x4){0.f, 0.f, 0.f, 0.f};
        const int nch = (nvalid + 31) >> 5;
        const unsigned char* cbase = ckv8 + (size_t)b * SEQ * 256;
        *(LAS u32x2*)(ksel + 4 * lane) = sv;
        asm volatile("" ::: "memory");
        u32x4 gv[3][8];
        const int w_row = (16 * (fq & 1) + (fq >> 1)) * 272 + 16 * j16;
#define SA_GATHER(c_, s_) do { const u32x4 k8 = *(const LAS u32x4*)(ksel + 32 * (c_) + 8 * fq); const unsigned k0 = k8[0], k1 = k8[1], k2 = k8[2], k3 = k8[3]; \
            _Pragma("unroll") for (int it = 0; it < 8; ++it) { const unsigned dd = (it < 2) ? k0 : (it < 4) ? k1 : (it < 6) ? k2 : k3; \
            unsigned key = (it & 1) ? (dd >> 16) : (dd & 0xffffu); if (!fullk) key = (key >= (unsigned)SEQ) ? 0u : key; \
            gv[s_][it] = *(const u32x4*)(cbase + (key * 256u + 16u * (unsigned)j16)); } } while (0)
        SA_GATHER(0, 0);
        if (1 < nch) SA_GATHER(1, 1);
        if (2 < nch) SA_GATHER(2, 2);
#pragma unroll
        for (int c = 0; c < 8; ++c) {
            if (c < nch) {
            const int sl = c % 3;
#pragma unroll
            for (int it = 0; it < 8; ++it) *(LAS u32x4*)(cb + w_row + it * 544) = gv[sl][it];
            asm volatile("" ::: "memory");
            if (c + 3 < nch) SA_GATHER(c + 3, sl);
            f32x4 Sa = {0.f, 0.f, 0.f, 0.f}, Sb = {0.f, 0.f, 0.f, 0.f};
#pragma unroll
            for (int ks = 0; ks < 8; ++ks) {
                const u32x2 a0 = *(const LAS u32x2*)(cb + qk_off + 32 * ks), a1 = *(const LAS u32x2*)(cb + qk_off + 272 + 32 * ks);
                const unsigned a0x = a0.x, a0y = a0.y, a1x = a1.x, a1y = a1.y;
                Sa = __builtin_amdgcn_mfma_f32_16x16x32_fp8_fp8(mk_long(a0x, a0y), Qf[ks], Sa, 0, 0, 0);
                Sb = __builtin_amdgcn_mfma_f32_16x16x32_fp8_fp8(mk_long(a1x, a1y), Qf[ks], Sb, 0, 0, 0);
            }
            float xa[4], xb[4]; float cm = -INFINITY;
#pragma unroll
            for (int r = 0; r < 4; ++r) { xa[r] = Sa[r] * sl2; xb[r] = Sb[r] * sl2; }
            if (!fullk) {
#pragma unroll
                for (int r = 0; r < 4; ++r) { const int ka = c * 32 + 4 * fq + r, kb2 = ka + 16; xa[r] = (ka < nvalid) ? xa[r] : -INFINITY; xb[r] = (kb2 < nvalid) ? xb[r] : -INFINITY; } }
#pragma unroll
            for (int r = 0; r < 4; ++r) cm = fmaxf(cm, fmaxf(xa[r], xb[r]));
            cm = fmaxf(cm, __shfl_xor(cm, 16)); cm = fmaxf(cm, __shfl_xor(cm, 32));
            if (__ballot(cm > mrun + 6.0f)) {
                const float mnew = fmaxf(mrun, cm);
                const float alpha = __builtin_amdgcn_exp2f(mrun - mnew);
                lrun *= alpha; mrun = mnew;
#pragma unroll
                for (int rt = 0; rt < 16; ++rt) O[rt] = O[rt] * alpha;
            }
            float ps = 0.f; float pa[4], pb[4];
#pragma unroll
            for (int r = 0; r < 4; ++r) { pa[r] = __builtin_amdgcn_exp2f(xa[r] - mrun); pb[r] = __builtin_amdgcn_exp2f(xb[r] - mrun); ps += pa[r] + pb[r]; }
            ps += __shfl_xor(ps, 16); ps += __shfl_xor(ps, 32);
            lrun += ps;
            int pw0 = __builtin_amdgcn_cvt_pk_fp8_f32(pa[0], pa[1], 0, false); pw0 = __builtin_amdgcn_cvt_pk_fp8_f32(pa[2], pa[3], pw0, true);
            int pw1 = __builtin_amdgcn_cvt_pk_fp8_f32(pb[0], pb[1], 0, false); pw1 = __builtin_amdgcn_cvt_pk_fp8_f32(pb[2], pb[3], pw1, true);
            const long Pf = mk_long((unsigned)pw0, (unsigned)pw1);
#pragma unroll
            for (int rt = 0; rt < 16; ++rt) {
                const v2i_t tv = __builtin_amdgcn_ds_read_tr8_b64_v2i32((LAS v2i_t*)(cb + tr_off + 16 * rt));
                const int t0 = tv[0], t1 = tv[1];
                O[rt] = __builtin_amdgcn_mfma_f32_16x16x32_fp8_fp8(mk_long((unsigned)t0, (unsigned)t1), Pf, O[rt], 0, 0, 0);
            }
            asm volatile("" ::: "memory");
            }
        }
#undef SA_GATHER
        const float inv = 1.0f / lrun;
        asm volatile("" ::: "memory");
        if (j16 < 8) {
#pragma unroll
            for (int rt = 0; rt < 16; ++rt) { u32x2 o; o.x = cvt_pk_bf16(O[rt][0] * inv, O[rt][1] * inv); o.y = cvt_pk_bf16(O[rt][2] * inv, O[rt][3] * inv); *(LAS u32x2*)(cb + j16 * 512 + rt * 32 + fq * 8) = o; }
        }
        asm volatile("" ::: "memory");
        { bf16* obase = olat + (size_t)t * 2048;
#pragma unroll
          for (int q = 0; q < 4; ++q) { const u32x4 v = *(const LAS u32x4*)(cb + q * 1024 + lane * 16); __builtin_nontemporal_store(v, (u32x4*)(obase + q * 512 + lane * 8)); } }
        asm volatile("" ::: "memory");
    }
}

__device__ __forceinline__ void routing_token(const float acc, const int lane, const float* rbias, int* tk_e, float* tk_w, LAS unsigned* hist, const size_t t, const bool do_count) {
    const float sc = 1.0f / (1.0f + expf(-acc));
    const float ch = sc + rbias[lane];
    int rk = 0;
#pragma unroll
    for (int k = 1; k < 8; ++k) { const int src = (lane & ~7) | ((lane + k) & 7); const float o = __shfl(ch, src); rk += (o > ch || (o == ch && src < lane)) ? 1 : 0; }
    float gs = (rk < 2) ? ch : 0.f; gs += __shfl_xor(gs, 1); gs += __shfl_xor(gs, 2); gs += __shfl_xor(gs, 4);
    int grk = 0; const int myg = lane >> 3;
#pragma unroll
    for (int g = 0; g < 8; ++g) { const float o = __shfl(gs, g * 8); grk += (o > gs || (o == gs && g < myg)) ? 1 : 0; }
    const float cm = (grk < 4) ? ch : -INFINITY;
    int erk = 0;
    for (int j = 0; j < 64; ++j) { const float o = __shfl(cm, j); erk += (o > cm || (o == cm && j < lane)) ? 1 : 0; }
    const bool selx = (erk < EK) && (grk < 4);
    const float ssum = wave_sum(selx ? sc : 0.f);
    if (selx) { tk_e[t * 8 + erk] = lane; tk_w[t * 8 + erk] = sc / ssum * 2.5f; if (do_count) __hip_atomic_fetch_add(&hist[lane], 1u, __ATOMIC_RELAXED, __HIP_MEMORY_SCOPE_WORKGROUP); }
}
__device__ __forceinline__ void phase_ln1_router(Frame& F, const float* g1, const float* b1, const float* rbias, const bool do_count) {
    const int lane_ = lane_id(), tid_ = F.wave * 64 + lane_;
    const float* pre = F.out;
    const float* wrT = (const float*)(F.ws + WS_WRT);
    bf16* h = (bf16*)(F.ws + WS_H);
    int* tk_e = (int*)(F.ws + WS_TOPK + TK_E); float* tk_w = (float*)(F.ws + WS_TOPK + TK_W);
    const int lane = lane_, w = F.wave, tid = tid_;
    LAS float* stats = (LAS float*)F.lds;
    LAS float* lg = (LAS float*)(F.lds + 1024) + (w & 3) * 1024;
    LAS unsigned* hist = (LAS unsigned*)(F.lds + 1024 + 16384);
    if (do_count && tid < 64) hist[tid] = 0u;
    for (int chunk = F.bid; chunk < NTOK / 64; chunk += F.G) {
        __syncthreads();
        f32x4 ggv[8], bbv[8];
#pragma unroll
        for (int q = 0; q < 8; ++q) { const int c = (lane + 64 * q) * 4; ggv[q] = *(const f32x4*)(g1 + c); bbv[q] = *(const f32x4*)(b1 + c); }
        for (int i = 0; i < 8; ++i) {
            const int tl = w * 8 + i; const size_t t = (size_t)chunk * 64 + tl;
            f32x4 v[8]; float s = 0.f;
#pragma unroll
            for (int q = 0; q < 8; ++q) { v[q] = *(const f32x4*)(pre + t * DM + (lane + 64 * q) * 4); s += (v[q][0] + v[q][1]) + (v[q][2] + v[q][3]); }
            const float mean = wave_sum(s) * (1.0f / DM); float s2 = 0.f;
#pragma unroll
            for (int q = 0; q < 8; ++q) { v[q] = v[q] - mean; s2 += (v[q][0] * v[q][0] + v[q][1] * v[q][1]) + (v[q][2] * v[q][2] + v[q][3] * v[q][3]); }
            const float rstd = 1.0f / sqrtf(wave_sum(s2) * (1.0f / DM) + LN_EPS);
#pragma unroll
            for (int q = 0; q < 8; ++q) { const int c = (lane + 64 * q) * 4;
                const f32x4 y = v[q] * rstd * ggv[q] + bbv[q];
                u32x2 o; o.x = cvt_pk_bf16(y[0], y[1]); o.y = cvt_pk_bf16(y[2], y[3]); *(u32x2*)(h + t * DM + c) = o; }
            if (lane == 0) { stats[tl * 2] = mean; stats[tl * 2 + 1] = rstd; }
        }
        __syncthreads();
        if (w < 4) {
            const int j16 = lane & 15, kq = lane >> 4, tl = 16 * w + j16;
            const float mean = stats[tl * 2], rstd = stats[tl * 2 + 1];
            const float* prow = pre + ((size_t)chunk * 64 + tl) * DM + 4 * kq; const float* wrow = wrT + (size_t)j16 * DM + 4 * kq;
            f32x4 acc[4];
#pragma unroll
            for (int tt = 0; tt < 4; ++tt) acc[tt] = (f32x4){0.f, 0.f, 0.f, 0.f};
#pragma unroll 2
            for (int m = 0; m < 128; ++m) {
                const f32x4 p = *(const f32x4*)(prow + 16 * m), gg = *(const f32x4*)(g1 + 16 * m + 4 * kq), bb = *(const f32x4*)(b1 + 16 * m + 4 * kq);
                const f32x4 hv = (p - mean) * rstd * gg + bb;
                f32x4 wv[4];
#pragma unroll
                for (int tt = 0; tt < 4; ++tt) wv[tt] = *(const f32x4*)(wrow + (size_t)tt * 16 * DM + 16 * m);
#pragma unroll
                for (int e = 0; e < 4; ++e)
#pragma unroll
                    for (int tt = 0; tt < 4; ++tt) acc[tt] = __builtin_amdgcn_mfma_f32_16x16x4f32(hv[e], wv[tt][e], acc[tt], 0, 0, 0);
            }
#pragma unroll
            for (int tt = 0; tt < 4; ++tt)
#pragma unroll
                for (int r = 0; r < 4; ++r) lg[(4 * kq + r) * 64 + 16 * tt + j16] = acc[tt][r];
            LDS_WAIT();
            for (int tk = 0; tk < 16; ++tk) routing_token(lg[tk * 64 + lane], lane, rbias, tk_e, tk_w, hist, (size_t)chunk * 64 + 16 * w + tk, do_count);
        }
    }
}
__device__ __forceinline__ void phase_flush_hist(Frame& F) {
    const int tid = F.wave * 64 + lane_id();
    LAS unsigned* hist = (LAS unsigned*)(F.lds + 1024 + 16384);
    __syncthreads();
    if (tid < 64 && hist[tid]) atomicAdd(F.ctl + CW_CNT + tid, hist[tid]);
}

__device__ __forceinline__ void phase_scatter(Frame& F) {
    const int lane_ = lane_id(), tid_ = F.wave * 64 + lane_;
    const int tid = tid_;
    LAS int* segs = (LAS int*)F.lds;
    LAS unsigned* lcnt = (LAS unsigned*)(F.lds + 1024);
    LAS unsigned* lbase = (LAS unsigned*)(F.lds + 2048);
    const int* tk_e = (const int*)(F.ws + WS_TOPK + TK_E); int* tk_pos = (int*)(F.ws + WS_TOPK + TK_POS);
    int* rowlist = (int*)(F.ws + WS_TOPK + TK_ROWLIST); int* mtt = (int*)(F.ws + WS_TOPK + TK_MTT);
    if (tid == 0) { int a = 0; for (int e = 0; e < NE; ++e) { segs[e] = a; a += (int)__hip_atomic_load(F.ctl + CW_CNT + e, RLX_AGENT); } segs[NE] = a; segs[NE + 1] = a + NTOK; }
    __syncthreads();
    if (F.bid == 0) {
        LAS int* tcum = (LAS int*)(F.lds + 3072);
        if (tid == 0) { int mt = 0; for (int g = 0; g < NGRP; ++g) { tcum[g] = mt; mt += (segs[g + 1] - segs[g] + 255) >> 8; } tcum[NGRP] = mt; __hip_atomic_store(F.ctl + CW_NMT, (unsigned)mt, RLX_AGENT); }
        __syncthreads();
        if (tid < NGRP) { const int g = tid, p0 = segs[g], n = segs[g + 1] - p0; int mt = tcum[g];
            for (int r = 0; r < n; r += 256, ++mt) { mtt[mt * 4 + 0] = g; mtt[mt * 4 + 1] = p0 + r; mtt[mt * 4 + 2] = (n - r < 256) ? n - r : 256; mtt[mt * 4 + 3] = 0; } }
        if (tid >= 256) rowlist[NSLOT + tid - 256] = 0;
    }
    const int sh0 = segs[NE];
    for (int chunk = F.bid; chunk < NTOK / 64; chunk += F.G) {
        if (tid < 64) lcnt[tid] = 0u;
        __syncthreads();
        const int t = chunk * 64 + (tid >> 3), k = tid & 7;
        const int e = tk_e[(size_t)t * 8 + k];
        const unsigned li = __hip_atomic_fetch_add(&lcnt[e], 1u, __ATOMIC_RELAXED, __HIP_MEMORY_SCOPE_WORKGROUP);
        __syncthreads();
        if (tid < 64) lbase[tid] = lcnt[tid] ? atomicAdd(F.ctl + CW_FILL + tid, lcnt[tid]) : 0u;
        __syncthreads();
        const int p = segs[e] + (int)lbase[e] + (int)li;
        rowlist[p] = t; tk_pos[(size_t)t * 8 + k] = p;
        if (tid < 64) rowlist[sh0 + chunk * 64 + tid] = chunk * 64 + tid;
        __syncthreads();
    }
}

struct CombRows { u32x4 hq[4]; u32x2 y[8][4]; u32x4 ysh[4]; };
__device__ __forceinline__ void comb_load(CombRows& R, const bf16* h, const unsigned char* Y8, const bf16* Ysh, const int t, const int posv, const int slot0, const int lane) {
#pragma unroll
    for (int i = 0; i < 4; ++i) { R.hq[i] = *(const u32x4*)(h + (size_t)t * DM + (lane + 64 * i) * 8); R.ysh[i] = __builtin_nontemporal_load((const u32x4*)(Ysh + (size_t)t * DM + (lane + 64 * i) * 8)); }
#pragma unroll
    for (int k = 0; k < 8; ++k) { const int p = __builtin_amdgcn_readlane(posv, slot0 + k);
#pragma unroll
        for (int i = 0; i < 4; ++i) R.y[k][i] = __builtin_nontemporal_load((const u32x2*)(Y8 + (size_t)p * DM + (lane + 64 * i) * 8)); }
}
__device__ __forceinline__ void comb_finish(const CombRows& R, const float* g2, const float* b2, float* out, const int t, const float wvv, const int slot0, const int lane) {
    f32x4 a[4][2];
#pragma unroll
    for (int i = 0; i < 4; ++i) { f32x4 x0, x1, s0, s1; unpack8(R.hq[i], x0, x1); unpack8(R.ysh[i], s0, s1); a[i][0] = x0 * DN_ALPHA + s0; a[i][1] = x1 * DN_ALPHA + s1; }
#pragma unroll
    for (int k = 0; k < 8; ++k) { const float wk = __builtin_bit_cast(float, __builtin_amdgcn_readlane(__builtin_bit_cast(int, wvv), slot0 + k));
#pragma unroll
        for (int i = 0; i < 4; ++i) { const u32x2 q8 = R.y[k][i];
            const f32x2 y01 = __builtin_amdgcn_cvt_pk_f32_fp8((int)q8.x, false), y23 = __builtin_amdgcn_cvt_pk_f32_fp8((int)q8.x, true), y45 = __builtin_amdgcn_cvt_pk_f32_fp8((int)q8.y, false), y67 = __builtin_amdgcn_cvt_pk_f32_fp8((int)q8.y, true);
            a[i][0] += (f32x4){y01[0], y01[1], y23[0], y23[1]} * wk; a[i][1] += (f32x4){y45[0], y45[1], y67[0], y67[1]} * wk; } }
    float s = 0.f;
#pragma unroll
    for (int i = 0; i < 4; ++i) s += ((a[i][0][0] + a[i][0][1]) + (a[i][0][2] + a[i][0][3])) + ((a[i][1][0] + a[i][1][1]) + (a[i][1][2] + a[i][1][3]));
    const float mean = wave_sum(s) * (1.0f / DM); float s2 = 0.f;
#pragma unroll
    for (int i = 0; i < 4; ++i) { a[i][0] = a[i][0] - mean; a[i][1] = a[i][1] - mean;
        s2 += ((a[i][0][0] * a[i][0][0] + a[i][0][1] * a[i][0][1]) + (a[i][0][2] * a[i][0][2] + a[i][0][3] * a[i][0][3])) + ((a[i][1][0] * a[i][1][0] + a[i][1][1] * a[i][1][1]) + (a[i][1][2] * a[i][1][2] + a[i][1][3] * a[i][1][3])); }
    const float rstd = 1.0f / sqrtf(wave_sum(s2) * (1.0f / DM) + LN_EPS);
#pragma unroll
    for (int i = 0; i < 4; ++i) { const int c = (lane + 64 * i) * 8;
        const f32x4 ga = *(const f32x4*)(g2 + c), gb = *(const f32x4*)(g2 + c + 4), ba = *(const f32x4*)(b2 + c), bb = *(const f32x4*)(b2 + c + 4);
        __builtin_nontemporal_store(a[i][0] * rstd * ga + ba, (f32x4*)(out + (size_t)t * DM + c)); __builtin_nontemporal_store(a[i][1] * rstd * gb + bb, (f32x4*)(out + (size_t)t * DM + c + 4)); }
}
__device__ __forceinline__ void phase_combine(Frame& F, const float* g2, const float* b2) {
    const int lane = lane_id();
    const bf16* h = (const bf16*)(F.ws + WS_H); const unsigned char* Y8 = (const unsigned char*)(F.ws + WS_Y); const bf16* Ysh = (const bf16*)(F.ws + WS_YSH);
    const float* tk_w = (const float*)(F.ws + WS_TOPK + TK_W); const int* tk_pos = (const int*)(F.ws + WS_TOPK + TK_POS);
    const int gw = F.bid * NWAVES + F.wave, NGW = F.G * NWAVES;
    for (int t0 = gw * 8; t0 < NTOK; t0 += NGW * 8) {
        const int posv = tk_pos[(size_t)t0 * 8 + lane]; const float wvv = tk_w[(size_t)t0 * 8 + lane];
        for (int i = 0; i < 8; ++i) {
            CombRows R;
            comb_load(R, h, Y8, Ysh, t0 + i, posv, 8 * i, lane);
            __builtin_amdgcn_sched_barrier(0);
            comb_finish(R, g2, b2, F.out, t0 + i, wvv, 8 * i, lane);
            __builtin_amdgcn_sched_barrier(0);
        }
    }
}

#ifndef MK_CHECK
#define MK_CHECK 0
#endif
constexpr int CW_CHK = 16384 + 256;
#if MK_CHECK
__device__ __forceinline__ float fp8f(unsigned char v) { const f32x2 a = __builtin_amdgcn_cvt_pk_f32_fp8((int)v, false); return a[0]; }
__device__ __forceinline__ void phase_check_attn(Frame& F) {
    const int tid = F.wave * 64 + lane_id();
    const bf16* qi = (const bf16*)(F.ws + WS_QI); const bf16* kin = (const bf16*)(F.ws + WS_KIN); const float* wis = (const float*)(F.ws + WS_WI);
    const bf16* qlat = (const bf16*)(F.ws + WS_QLAT); const unsigned char* ckv8 = (const unsigned char*)(F.ws + WS_CKVN);
    const unsigned short* selb = (const unsigned short*)(F.ws + WS_SEL); const bf16* olat = (const bf16*)(F.ws + WS_OLAT);
    LAS float* sc = (LAS float*)F.lds;
    LAS unsigned char* flg = (LAS unsigned char*)(F.lds + 32768);
    LAS unsigned char* seen = (LAS unsigned char*)(F.lds + 40960);
    LAS float* pl = (LAS float*)(F.lds + 49152);
    LAS int* cnt = (LAS int*)(F.lds + 57344);
    LAS float* errs = (LAS float*)(F.lds + 57344 + 64);
    const int POS[16] = {0, 1, 100, 255, 256, 257, 300, 511, 1000, 2047, 2048, 4095, 5000, 6143, 6144, 8191};
    for (int s = F.bid; s < 32; s += F.G) {
        int pos = 0;
#pragma unroll
        for (int q = 0; q < 16; ++q) pos = ((s >> 1) == q) ? POS[q] : pos;
        const int b = s & 1, n = pos + 1; const size_t t = (size_t)b * SEQ + pos;
        __syncthreads();
        if (tid < 4) cnt[tid] = 0;
        if (tid < 2) errs[tid] = 0.f;
        for (int k = tid; k < SEQ; k += NTHR) { flg[k] = 0; seen[k] = 0; }
        for (int k = tid; k < n; k += NTHR) {
            float tot = 0.f;
            for (int hh = 0; hh < 16; ++hh) { float d = 0.f;
                for (int e = 0; e < 64; ++e) d += bf2f(qi[t * 1024 + hh * 64 + e]) * bf2f(kin[((size_t)b * SEQ + k) * 64 + e]);
                tot += wis[t * 16 + hh] * fmaxf(d, 0.f); }
            sc[k] = tot;
        }
        __syncthreads();
        const unsigned short* sel = selb + t * TOPK;
        if (n > TOPK) {
            for (int k = tid; k < n; k += NTHR) { const float v = sc[k]; int rk = 0; for (int k2 = 0; k2 < n; ++k2) { const float o = sc[k2]; rk += (o > v || (o == v && k2 < k)) ? 1 : 0; } flg[k] = rk < TOPK ? 1 : 0; }
            __syncthreads();
            if (tid < TOPK) { const int k = sel[tid]; if (k >= n) atomicAdd((int*)&cnt[1], 1000); else { if (!flg[k]) atomicAdd((int*)&cnt[0], 1); if (seen[k]) atomicAdd((int*)&cnt[1], 1000); seen[k] = 1; } }
        } else {
            if (tid < TOPK) { const int k = sel[tid]; if (tid < n ? (k != tid) : (k != 0xFFFF)) atomicAdd((int*)&cnt[1], 1000); }
        }
        __syncthreads();
        const int nv = n < TOPK ? n : TOPK;
        for (int i = tid; i < 8 * 256; i += NTHR) { const int hh = i >> 8, k = i & 255; float lg = -INFINITY;
            if (k < nv) { const int key = sel[k]; float d = 0.f; for (int r = 0; r < 256; ++r) d += bf2f(qlat[(t * 8 + hh) * 256 + r]) * fp8f(ckv8[((size_t)b * SEQ + key) * 256 + r]); lg = d * 0.08838834764831845f; }
            pl[i] = lg; }
        __syncthreads();
        if (tid < 8) { float m = -INFINITY; for (int k = 0; k < 256; ++k) m = fmaxf(m, pl[tid * 256 + k]); float l = 0.f; for (int k = 0; k < 256; ++k) { const float p = expf(pl[tid * 256 + k] - m); pl[tid * 256 + k] = p; l += p; } for (int k = 0; k < 256; ++k) pl[tid * 256 + k] /= l; }
        __syncthreads();
        for (int i = tid; i < 8 * 256; i += NTHR) { const int hh = i >> 8, r = i & 255; float o = 0.f;
            for (int k = 0; k < nv; ++k) o += pl[hh * 256 + k] * fp8f(ckv8[((size_t)b * SEQ + sel[k]) * 256 + r]);
            const float got = bf2f(olat[(t * 8 + hh) * 256 + r]);
            __hip_atomic_fetch_add(&errs[0], (got - o) * (got - o), __ATOMIC_RELAXED, __HIP_MEMORY_SCOPE_WORKGROUP); __hip_atomic_fetch_add(&errs[1], o * o, __ATOMIC_RELAXED, __HIP_MEMORY_SCOPE_WORKGROUP); if (!(got == got)) atomicAdd((int*)&cnt[2], 1); }
        __syncthreads();
        if (tid == 0) { unsigned code = 0; if (cnt[0] > 8 || cnt[1] > 0) code |= 1u; if (cnt[2] > 0 || !(errs[0] <= 0.12f * 0.12f * errs[1])) code |= 2u; if (code) atomicOr(F.ctl + CW_CHK, code); }
    }
}
__device__ __forceinline__ void phase_check_apply(Frame& F) {
    const unsigned code = __hip_atomic_load(F.ctl + CW_CHK, RLX_AGENT);
    if (code) { const float v = (code & 1u) ? __builtin_nanf("") : 0.f; const size_t gt = (size_t)F.bid * NTHR + F.wave * 64 + lane_id();
        for (size_t i = gt; i < (size_t)NTOK * DM; i += (size_t)F.G * NTHR) F.out[i] = v; }
}
#endif

constexpr int NPHASE = 16;
constexpr unsigned REPEAT_MASK = 0x0u;
constexpr int TIME_PHASE = -1;
constexpr int CW_TIME = 16384 + 320;
struct Args { const float* in[24]; float* out; unsigned char* ws; int ph_lo, ph_hi; };

__global__ void __launch_bounds__(NTHR, 2) mk_fwd(Args args) {
    extern __shared__ __attribute__((aligned(16))) unsigned char lds_raw[];
    Frame F;
    F.lds = (LAS unsigned char*)lds_raw;
    F.MISC = (volatile LAS unsigned*)(F.lds + MISC_OFF);
    F.wave = __builtin_amdgcn_readfirstlane(threadIdx.x >> 6);
    F.G = gridDim.x; F.bid = blockIdx.x;
    F.ws = args.ws; F.ctl = (unsigned*)(args.ws + WS_CTL); F.out = args.out;
    for (int u = threadIdx.x; u < (LDS_BYTES - MISC_OFF) / 4; u += NTHR) ((LAS unsigned*)(F.lds + MISC_OFF))[u] = 0u;
    __syncthreads();
    const int lo = args.ph_lo, hi = args.ph_hi;
    const bool multi = (hi - lo) > 1;
    XcdBarrier bar; bar.bar = F.ctl + CW_BAR; bar.x = 0; bar.st = nullptr; bar.wave = F.wave;
    if (multi) bar = xcd_barrier_post(F.ctl + CW_BAR, F.MISC + 8, F.wave);
#ifndef ONLY_PHASE
#define ONLY_PHASE -1
#endif
#define IN(k) ((ONLY_PHASE < 0 || ONLY_PHASE == (k)) && lo <= (k) && (k) < hi)
#define SEAM(k) do { if (IN(k) && IN((k) + 1)) { xcd_barrier(bar); \
        if (TIME_PHASE >= 0 && F.bid == 0 && F.wave == 0) { const unsigned long long now_ = __builtin_amdgcn_s_memrealtime(); \
            if ((k) == TIME_PHASE - 1 || ((k) == 0 && TIME_PHASE == 0 && false)) { if (lane_id() == 0) { F.ctl[CW_TIME] = (unsigned)now_; } } \
            if ((k) == TIME_PHASE) { if (lane_id() == 0) { F.ctl[CW_TIME + 1] = (unsigned)now_ - F.ctl[CW_TIME]; } } } } } while (0)
    unsigned char* ws = args.ws;
    const ExpW EW{args.in[16], args.in[17], args.in[18], args.in[19], args.in[20], args.in[21]};
    const bool ride = false;
    if (TIME_PHASE == 0 && F.bid == 0 && threadIdx.x == 0) F.ctl[CW_TIME] = (unsigned)__builtin_amdgcn_s_memrealtime();

    if (IN(0)) for (int rep_ = 0; rep_ < 1 + (int)((REPEAT_MASK >> 0) & 1u); ++rep_) { phase_convert_small(F, args.in[0], args.in[1], args.in[5], args.in[6], args.in[7], args.in[9], args.in[10], args.in[11], args.in[8], args.in[14]); } SEAM(0);

    if (IN(1)) for (int rep_ = 0; rep_ < 1 + (int)((REPEAT_MASK >> 1) & 1u); ++rep_) {
        FillPlain f{(const char*)(ws + WS_XB), (const char*)(ws + WS_WIN), 4096u, 4096u, 32};
        DenseSched<FillPlain> S{64, 30, F.G, F.bid, f};
        EpiP1 E{(bf16*)(ws + WS_Q), (bf16*)(ws + WS_QI), (bf16*)(ws + WS_XP), (bf16*)(ws + WS_GATES), (float*)(ws + WS_CKVRAW), (float*)(ws + WS_KIWI)};
        pg8::gemm_phase<EpiP1, DenseSched<FillPlain>, false, true, true>(F.lds, F.wave, 4096u, 4096u, S, E);
    } SEAM(1);

    if (IN(2)) for (int rep_ = 0; rep_ < 1 + (int)((REPEAT_MASK >> 2) & 1u); ++rep_) { phase_postproc(F, args.in[2], args.in[3], args.in[4]); } SEAM(2);

    if (IN(3)) for (int rep_ = 0; rep_ < 1 + (int)((REPEAT_MASK >> 3) & 1u); ++rep_) {
        FillQlatPool f{(const char*)(ws + WS_Q), (const char*)(ws + WS_DIFF), (const char*)(ws + WS_WUK), (const char*)(ws + WS_WPOOL)};
        DenseSched<FillQlatPool> S{64, 12, F.G, F.bid, f};
        EpiQlatPool E{(bf16*)(ws + WS_QLAT), (bf16*)(ws + WS_POOL), (const float*)(ws + WS_CSCALE)};
        pg8::gemm_phase<EpiQlatPool, DenseSched<FillQlatPool>, false, true, true>(F.lds, F.wave, 2048u, 512u, S, E);
    } SEAM(3);

    if (IN(4)) for (int rep_ = 0; rep_ < 1 + (int)((REPEAT_MASK >> 4) & 1u); ++rep_) { phase_index_scores(F); } SEAM(4);
    if (IN(5)) for (int rep_ = 0; rep_ < 1 + (int)((REPEAT_MASK >> 5) & 1u); ++rep_) { phase_select(F, EW, ride && rep_ == 0); } SEAM(5);
    if (IN(6)) for (int rep_ = 0; rep_ < 1 + (int)((REPEAT_MASK >> 6) & 1u); ++rep_) { phase_sparse_attn(F, EW, ride && rep_ == 0); } SEAM(6);
#if MK_CHECK
    if (IN(6) && IN(7)) { phase_check_attn(F); xcd_barrier(bar); }
#endif

    if (IN(7)) for (int rep_ = 0; rep_ < 1 + (int)((REPEAT_MASK >> 7) & 1u); ++rep_) {
        FillO f{(const char*)(ws + WS_OLAT), (const char*)(ws + WS_WUV)};
        DenseSched<FillO> S{64, 4, F.G, F.bid, f};
        EpiBf16 E{(bf16*)(ws + WS_ATTN), 1024};
        pg8::gemm_phase<EpiBf16, DenseSched<FillO>, false, true, true>(F.lds, F.wave, 4096u, 1024u, S, E);
    } SEAM(7);

    if (IN(8)) for (int rep_ = 0; rep_ < 1 + (int)((REPEAT_MASK >> 8) & 1u); ++rep_) {
        FillPlain f{(const char*)(ws + WS_ATTN), (const char*)(ws + WS_WPA), 2048u, 2048u, 16};
        DenseSched<FillPlain> S{64, 8, F.G, F.bid, f};
        EpiGate<0> E{(const bf16*)(ws + WS_GATES), (bf16*)(ws + WS_M1), (bf16*)(ws + WS_MERGED)};
        pg8::gemm_phase<EpiGate<0>, DenseSched<FillPlain>, false, true, true>(F.lds, F.wave, 2048u, 2048u, S, E);
    } SEAM(8);

    if (IN(9)) for (int rep_ = 0; rep_ < 1 + (int)((REPEAT_MASK >> 9) & 1u); ++rep_) {
        FillPlain f{(const char*)(ws + WS_POOL), (const char*)(ws + WS_WPP), 2048u, 2048u, 16};
        DenseSched<FillPlain> S{64, 8, F.G, F.bid, f};
        EpiGate<1> E{(const bf16*)(ws + WS_GATES), (bf16*)(ws + WS_M1), (bf16*)(ws + WS_MERGED)};
        pg8::gemm_phase<EpiGate<1>, DenseSched<FillPlain>, false, true, true>(F.lds, F.wave, 2048u, 2048u, S, E);
    } SEAM(9);

    if (IN(10)) for (int rep_ = 0; rep_ < 1 + (int)((REPEAT_MASK >> 10) & 1u); ++rep_) {
        FillPlain f{(const char*)(ws + WS_MERGED), (const char*)(ws + WS_WOUT), 4096u, 4096u, 32};
        DenseSched<FillPlain> S{64, 8, F.G, F.bid, f};
        EpiPre E{args.in[0], F.out};
        pg8::gemm_phase<EpiPre, DenseSched<FillPlain>, false, true, true>(F.lds, F.wave, 4096u, 4096u, S, E);
    } SEAM(10);

    if (IN(11)) for (int rep_ = 0; rep_ < 1 + (int)((REPEAT_MASK >> 11) & 1u); ++rep_) {
        for (int rl_ = 0; rl_ < 1 + (int)((REPEAT_MASK >> 17) & 1u); ++rl_) phase_ln1_router(F, args.in[12], args.in[13], args.in[15], rl_ == 0);
        phase_convert_experts(F, EW);
        phase_flush_hist(F);
    } SEAM(11);
    if (IN(12)) for (int rep_ = 0; rep_ < 1 + (int)((REPEAT_MASK >> 12) & 1u); ++rep_) { phase_scatter(F); } SEAM(12);

    if (IN(13)) for (int rep_ = 0; rep_ < 1 + (int)((REPEAT_MASK >> 13) & 1u); ++rep_) {
        const int nmt = (int)__hip_atomic_load(F.ctl + CW_NMT, RLX_AGENT);
        MoeSched S{(const int*)(ws + WS_TOPK + TK_MTT), nmt, 4, F.G, F.bid, true, (const char*)(ws + WS_H), (const char*)(ws + WS_HBUF), (const char*)(ws + WS_WGU), (const char*)(ws + WS_WD), (const int*)(ws + WS_TOPK + TK_ROWLIST), F.lds};
        S.prepare(F.wave * 64 + lane_id());
        EpiSwiGLU E{(bf16*)(ws + WS_HBUF)};
        pg8::gemm_phase<EpiSwiGLU, MoeSched, true, true, true>(F.lds, F.wave, 4096u, 4096u, S, E);
    } SEAM(13);

    if (IN(14)) for (int rep_ = 0; rep_ < 1 + (int)((REPEAT_MASK >> 14) & 1u); ++rep_) {
        const int nmt = (int)__hip_atomic_load(F.ctl + CW_NMT, RLX_AGENT);
        MoeSched S{(const int*)(ws + WS_TOPK + TK_MTT), nmt, 8, F.G, F.bid, false, (const char*)(ws + WS_H), (const char*)(ws + WS_HBUF), (const char*)(ws + WS_WGU), (const char*)(ws + WS_WD), (const int*)(ws + WS_TOPK + TK_ROWLIST), F.lds};
        S.prepare(F.wave * 64 + lane_id());
        EpiY E{(unsigned char*)(ws + WS_Y), (bf16*)(ws + WS_YSH)};
        pg8::gemm_phase<EpiY, MoeSched, false, true, true>(F.lds, F.wave, 1024u, 1024u, S, E);
    } SEAM(14);

    if (IN(15)) for (int rep_ = 0; rep_ < 1 + (int)((REPEAT_MASK >> 15) & 1u); ++rep_) { phase_combine(F, args.in[22], args.in[23]); }
#if MK_CHECK
    if (IN(15)) { xcd_barrier(bar); phase_check_apply(F); }
#endif
    if (TIME_PHASE >= 0 && multi && F.bid == 0 && F.wave == 0) {
        asm volatile("s_waitcnt vmcnt(0)" ::: "memory");
        if (TIME_PHASE == 15 && lane_id() == 0) { F.ctl[CW_TIME + 1] = (unsigned)__builtin_amdgcn_s_memrealtime() - F.ctl[CW_TIME]; }
        asm volatile("s_waitcnt vmcnt(0)" ::: "memory");
        const unsigned dur = __hip_atomic_load(F.ctl + CW_TIME + 1, RLX_AGENT); const unsigned long long t0 = __builtin_amdgcn_s_memrealtime();
        while (__builtin_amdgcn_s_memrealtime() - t0 < 4ull * dur) __builtin_amdgcn_s_sleep(8);
    }
#undef IN
#undef SEAM
}

#ifndef MK_ONE_LAUNCH
#define MK_ONE_LAUNCH 1
#endif
extern "C" void kernel_launch(void* const* d_in, const int* in_sizes, int n_in, void* d_out, int out_size, void* d_ws, size_t ws_size, hipStream_t stream) {
    static int grid = 0;
    if (grid == 0) {
        if (n_in != 24 || out_size != NTOK * DM || ws_size < WS_END) { fprintf(stderr, "kernel_launch: unexpected shapes (n_in %d out %d ws %zu)\n", n_in, out_size, ws_size); grid = -1; return; }
        int dev = 0, cus = 0;
        if (hipGetDevice(&dev) != hipSuccess || hipDeviceGetAttribute(&cus, hipDeviceAttributeMultiprocessorCount, dev) != hipSuccess) { grid = -1; return; }
        if (hipFuncSetAttribute((const void*)mk_fwd, hipFuncAttributeMaxDynamicSharedMemorySize, LDS_BYTES) != hipSuccess) { fprintf(stderr, "kernel_launch: hipFuncSetAttribute failed\n"); grid = -1; return; }
        int per_cu = 0;
        if (hipOccupancyMaxActiveBlocksPerMultiprocessor(&per_cu, (const void*)mk_fwd, NTHR, LDS_BYTES) != hipSuccess || per_cu < 1) fprintf(stderr, "kernel_launch: occupancy query says %d\n", per_cu);
        (void)hipGetLastError();
        grid = cus;
    }
    if (grid < 0) return;
    if (hipMemsetAsync((char*)d_ws + WS_CTL, 0, CTL_BYTES, stream) != hipSuccess) return;
    Args a{};
    for (int i = 0; i < 24; ++i) a.in[i] = (const float*)d_in[i];
    a.out = (float*)d_out; a.ws = (unsigned char*)d_ws;
#if MK_ONE_LAUNCH
    a.ph_lo = 0; a.ph_hi = NPHASE;
    hipLaunchKernelGGL(mk_fwd, dim3(grid), dim3(NTHR), LDS_BYTES, stream, a);
#else
    for (int p = 0; p < NPHASE; ++p) { a.ph_lo = p; a.ph_hi = p + 1; hipLaunchKernelGGL(mk_fwd, dim3(grid), dim3(NTHR), LDS_BYTES, stream, a); }
#endif
}
```
